# Optimizing an MI355X kernel written in HIP

```python
import jax, jax.numpy as jnp
from jax import lax
import numpy as np

D_MODEL = 1024
BATCH = 8
SEQ = 4096
DEPTH = 2

N_A_LAYERS = DEPTH // 2
N_B_LAYERS = DEPTH - N_A_LAYERS
RMS_EPS = 1e-6
MEM_LEN = 256
MEM_HEADS = 4
MEM_HEAD_DIM = 64
MEM_WIDTH = MEM_HEADS * MEM_HEAD_DIM
HGRN_EXPAND = 128
HGRN_HEAD_V = 128
HGRN_HEADS = (D_MODEL - MEM_WIDTH) // HGRN_HEAD_V
HGRN_F = HGRN_HEADS * HGRN_EXPAND
HGRN_V = HGRN_HEADS * HGRN_HEAD_V
HGRN_CHUNK = 64
A_IN_WIDTH = 2 * HGRN_F + 2 * HGRN_V + MEM_WIDTH
SB_HEAD_DIM = 64
SB_WIDTH = D_MODEL - MEM_WIDTH
SB_HEADS = SB_WIDTH // SB_HEAD_DIM
SB_BLOCK = 128
B_IN_WIDTH = SB_WIDTH + MEM_WIDTH
MIX_WIDTH = D_MODEL
D_FF_DENSE = 2816
N_EXPERTS = 8
TOP_K = 2
D_FF_EXPERT = 3584
MOE_BLOCK = 512
N_DENSE_FFN = (DEPTH + 1) // 2
N_MOE_FFN = DEPTH // 2

kernel_name = "yoco_hgrn2_stickbreaking_moe_block"


def rms_norm(x, g):
    xf = x.astype(jnp.float32)
    var = jnp.mean(xf * xf, axis=-1, keepdims=True)
    return (xf * lax.rsqrt(var + RMS_EPS) * g.astype(jnp.float32)).astype(x.dtype)


def hgrn2_mix(q, f_logit, i, lower_bound, norm_g):
    B, T, _ = q.shape
    H, dk, dv, C = HGRN_HEADS, HGRN_EXPAND, HGRN_HEAD_V, HGRN_CHUNK
    n = T // C

    def heads(t, d):
        return t.astype(jnp.float32).reshape(B, n, C, H, d).transpose(0, 3, 1, 2, 4)

    f = lower_bound + (1.0 - lower_bound) * jax.nn.sigmoid(f_logit.astype(jnp.float32))
    qh = heads(jax.nn.silu(q.astype(jnp.float32)), dk)
    kh = heads(1.0 - f, dk)
    gh = heads(jnp.log(f), dk)
    vh = heads(i, dv)
    b = jnp.cumsum(gh, axis=-2)
    b_last = b[..., -1:, :]
    q_dec = qh * jnp.exp(b)
    k_intra = kh * jnp.exp(-b)
    k_state = kh * jnp.exp(b_last - b)
    causal = jnp.tril(jnp.ones((C, C), dtype=bool))
    scores = jnp.where(causal, jnp.einsum('bhnck,bhnsk->bhncs', q_dec, k_intra), 0.0)
    o_intra = jnp.einsum('bhncs,bhnsv->bhncv', scores, vh)

    def step(S, inp):
        qd, ks, vv, dec = inp
        o = jnp.einsum('bhck,bhkv->bhcv', qd, S)
        S = dec[..., None] * S + jnp.einsum('bhck,bhcv->bhkv', ks, vv)
        return S, o

    xs = (jnp.moveaxis(q_dec, 2, 0), jnp.moveaxis(k_state, 2, 0), jnp.moveaxis(vh, 2, 0),
          jnp.moveaxis(jnp.exp(b_last[..., 0, :]), 2, 0))
    S0 = jnp.zeros((B, H, dk, dv), jnp.float32)
    _, o_inter = lax.scan(step, S0, xs)
    o = o_intra + jnp.moveaxis(o_inter, 0, 2)
    o = rms_norm(o, norm_g)
    return o.transpose(0, 2, 3, 1, 4).reshape(B, T, H * dv)


def stick_breaking_attention(q, k, v):
    B, H, T, d = q.shape
    scale = d ** -0.5
    outs = []
    for blk in range(T // SB_BLOCK):
        lo, hi = blk * SB_BLOCK, (blk + 1) * SB_BLOCK
        qb = q[:, :, lo:hi].astype(jnp.float32)
        kb = k[:, :, :hi].astype(jnp.float32)
        vb = v[:, :, :hi].astype(jnp.float32)
        z = jnp.einsum('bhqd,bhsd->bhqs', qb, kb) * scale
        strict = jnp.arange(hi)[None, :] < jnp.arange(lo, hi)[:, None]
        log_beta = jax.nn.log_sigmoid(z)
        log_keep = jnp.where(strict, log_beta - z, 0.0)
        later = lax.cumsum(log_keep, axis=log_keep.ndim - 1, reverse=True) - log_keep
        w = jnp.where(strict, jnp.exp(log_beta + later), 0.0)
        outs.append(jnp.einsum('bhqs,bhsd->bhqd', w, vb))
    return jnp.concatenate(outs, axis=2)


def memory_attention(q, mem_k, mem_v):
    B, T = q.shape[:2]
    s = jnp.einsum('bthd,bmhd->bhtm', q.astype(jnp.float32), mem_k.astype(jnp.float32)) * (MEM_HEAD_DIM ** -0.5)
    p = jax.nn.softmax(s, axis=-1)
    o = jnp.einsum('bhtm,bmhd->bthd', p, mem_v.astype(jnp.float32))
    return o.reshape(B, T, MEM_WIDTH)


def swiglu(x, w_gate_up, w_down):
    g, u = jnp.split(x @ w_gate_up, 2, axis=-1)
    return (jax.nn.silu(g) * u) @ w_down


def moe_swiglu(x, w_router, w_gate_up, w_down):
    B, T, D = x.shape
    N = B * T
    NK = N * TOP_K
    xf = x.reshape(N, D)
    logits = jnp.dot(xf.astype(jnp.float32), w_router.astype(jnp.float32))
    top_logit, top_idx = lax.top_k(logits, TOP_K)
    gates = jax.nn.softmax(top_logit, axis=-1)
    expert = top_idx.reshape(-1)
    token = jnp.arange(NK, dtype=jnp.int32) // TOP_K
    order = jnp.argsort(expert)
    e_sorted = expert[order]
    tok_sorted = token[order]
    gate_sorted = gates.reshape(-1)[order]
    counts = jnp.bincount(expert, length=N_EXPERTS)
    starts = jnp.cumsum(counts) - counts
    padded = (counts + MOE_BLOCK - 1) // MOE_BLOCK * MOE_BLOCK
    padded_ends = jnp.cumsum(padded)
    padded_starts = padded_ends - padded
    dest = padded_starts[e_sorted] + jnp.arange(NK, dtype=jnp.int32) - starts[e_sorted]
    n_blocks = -(-NK // MOE_BLOCK) + N_EXPERTS
    x_buf = jnp.zeros((n_blocks * MOE_BLOCK, D), x.dtype).at[dest].set(xf[tok_sorted])
    block_start = jnp.arange(n_blocks, dtype=jnp.int32) * MOE_BLOCK
    block_expert = jnp.minimum(jnp.searchsorted(padded_ends, block_start, side='right'), N_EXPERTS - 1)

    def expert_block(args):
        xb, e = args
        return swiglu(xb, w_gate_up[e], w_down[e])

    y_buf = lax.map(expert_block, (x_buf.reshape(n_blocks, MOE_BLOCK, D), block_expert))
    y_sorted = y_buf.reshape(-1, D)[dest] * gate_sorted[:, None].astype(x.dtype)
    y = jax.ops.segment_sum(y_sorted, tok_sorted, num_segments=N)
    return y.reshape(B, T, D)


def setup_inputs(seed: int = 0) -> dict:
    key = jax.random.key(seed)
    ks = jax.random.split(key, 24)

    def w(k, shape, fan_in):
        return jax.random.normal(k, shape, jnp.float32) * fan_in ** -0.5

    def gain(k, shape):
        return 1.0 + 0.02 * jax.random.normal(k, shape, jnp.float32)

    return {
        "x": jax.random.normal(ks[0], (BATCH, SEQ, D_MODEL), jnp.float32),
        "mem": jax.random.normal(ks[1], (BATCH, MEM_LEN, D_MODEL), jnp.float32),
        "attn_norm_pre": gain(ks[2], (DEPTH, D_MODEL)),
        "attn_norm_post": gain(ks[3], (DEPTH, D_MODEL)),
        "ffn_norm_pre": gain(ks[4], (DEPTH, D_MODEL)),
        "ffn_norm_post": gain(ks[5], (DEPTH, D_MODEL)),
        "w_in_a": w(ks[6], (N_A_LAYERS, D_MODEL, A_IN_WIDTH), D_MODEL),
        "hgrn_lower_bounds": 0.1 * jax.random.normal(ks[7], (N_A_LAYERS + 1, HGRN_F), jnp.float32),
        "hgrn_out_norm": gain(ks[8], (N_A_LAYERS, HGRN_HEAD_V)),
        "w_in_b": w(ks[9], (N_B_LAYERS, D_MODEL, B_IN_WIDTH), D_MODEL),
        "kv_norm": gain(ks[10], (D_MODEL,)),
        "w_kv": w(ks[11], (D_MODEL, 2 * SB_WIDTH), D_MODEL),
        "mem_norm": gain(ks[12], (DEPTH, D_MODEL)),
        "w_mem_kv": w(ks[13], (DEPTH, D_MODEL, 2 * MEM_WIDTH), D_MODEL),
        "w_out": w(ks[14], (DEPTH, MIX_WIDTH, D_MODEL), MIX_WIDTH),
        "w_ffn_gate_up": w(ks[15], (N_DENSE_FFN, D_MODEL, 2 * D_FF_DENSE), D_MODEL),
        "w_ffn_down": w(ks[16], (N_DENSE_FFN, D_FF_DENSE, D_MODEL), D_FF_DENSE),
        "w_router": w(ks[17], (N_MOE_FFN, D_MODEL, N_EXPERTS), D_MODEL),
        "w_exp_gate_up": w(ks[18], (N_MOE_FFN, N_EXPERTS, D_MODEL, 2 * D_FF_EXPERT), D_MODEL),
        "w_exp_down": w(ks[19], (N_MOE_FFN, N_EXPERTS, D_FF_EXPERT, D_MODEL), D_FF_EXPERT),
    }


def reference(x, mem, attn_norm_pre, attn_norm_post, ffn_norm_pre, ffn_norm_post,
              w_in_a, hgrn_lower_bounds, hgrn_out_norm, w_in_b, kv_norm, w_kv,
              mem_norm, w_mem_kv, w_out, w_ffn_gate_up, w_ffn_down,
              w_router, w_exp_gate_up, w_exp_down):
    B, T, D = x.shape
    M = mem.shape[1]
    lower_bounds = jnp.cumsum(jax.nn.softmax(hgrn_lower_bounds.astype(jnp.float32), axis=0), axis=0)
    h = x
    sb_k = None
    sb_v = None
    for layer in range(DEPTH):
        u = rms_norm(h, attn_norm_pre[layer])
        mkv = rms_norm(mem, mem_norm[layer]) @ w_mem_kv[layer]
        mem_k, mem_v = jnp.split(mkv.reshape(B, M, 2 * MEM_HEADS, MEM_HEAD_DIM), 2, axis=2)
        if layer < N_A_LAYERS:
            proj = u @ w_in_a[layer]
            q, f, i, og, mq = jnp.split(proj, [HGRN_F, 2 * HGRN_F, 2 * HGRN_F + HGRN_V,
                                               2 * HGRN_F + 2 * HGRN_V], axis=-1)
            o_main = hgrn2_mix(q, f, i, lower_bounds[layer], hgrn_out_norm[layer]) * jax.nn.silu(og.astype(jnp.float32))
        else:
            proj = u @ w_in_b[layer - N_A_LAYERS]
            sq, mq = jnp.split(proj, [SB_WIDTH], axis=-1)
            sq = sq.reshape(B, T, SB_HEADS, SB_HEAD_DIM).transpose(0, 2, 1, 3)
            o_main = stick_breaking_attention(sq, sb_k, sb_v).transpose(0, 2, 1, 3).reshape(B, T, SB_WIDTH)
        o_mem = memory_attention(mq.reshape(B, T, MEM_HEADS, MEM_HEAD_DIM), mem_k, mem_v)
        mixed = jnp.concatenate([o_main, o_mem], axis=-1).astype(h.dtype) @ w_out[layer]
        h = h + rms_norm(mixed, attn_norm_post[layer])
        u = rms_norm(h, ffn_norm_pre[layer])
        if layer % 2 == 0:
            y = swiglu(u, w_ffn_gate_up[layer // 2], w_ffn_down[layer // 2])
        else:
            y = moe_swiglu(u, w_router[layer // 2], w_exp_gate_up[layer // 2], w_exp_down[layer // 2])
        h = h + rms_norm(y, ffn_norm_post[layer])
        if layer == N_A_LAYERS - 1:
            kv = (rms_norm(h, kv_norm) @ w_kv).reshape(B, T, 2 * SB_HEADS, SB_HEAD_DIM).transpose(0, 2, 1, 3)
            sb_k, sb_v = jnp.split(kv, 2, axis=1)
    return h
```

```cpp
#include <hip/hip_runtime.h>
#include <cstdio>
#include <cstdint>

#ifndef STOP_AFTER
#define STOP_AFTER 99
#endif

#define LAS __attribute__((address_space(3)))
#define GAS __attribute__((address_space(1)))
typedef unsigned short bf16_t;
typedef short bf16x8 __attribute__((ext_vector_type(8)));
typedef float f32x4 __attribute__((ext_vector_type(4)));
typedef float f32x16 __attribute__((ext_vector_type(16)));
typedef float f32x2 __attribute__((ext_vector_type(2)));
typedef unsigned u32x4 __attribute__((ext_vector_type(4)));
typedef unsigned u32x2 __attribute__((ext_vector_type(2)));
typedef __bf16 bf16x2_t __attribute__((ext_vector_type(2)));

constexpr int NB = 8, SEQ = 4096, DM = 1024, MTOK = NB * SEQ;
constexpr int MEML = 256, MROWS = NB * MEML;
constexpr int AW = 3328, HF = 768, DFF = 2816, NEXP = 8, DFE = 3584;
constexpr int KVQW = 2560;
constexpr int XS_ROWS = 2 * MTOK + NEXP * 256;
constexpr float RMS_EPS = 1e-6f;
constexpr float C2 = 0.125f * 1.4426950408889634f;
constexpr int NWAVES = 8, NTHR = 512;

constexpr size_t MiB = 1u << 20;
constexpr size_t WS_CTL = 0, CTL_ZERO_BYTES = 128 * 1024;
constexpr size_t WS_MEMN = 395 * MiB + 32 * MiB;
constexpr size_t WS_MEMN_OLD_UNUSED = 459 * MiB;
constexpr size_t WS_AS = 1 * MiB;
constexpr size_t WS_WSC = 2 * MiB;
constexpr int WSC_INA = 0, WSC_GU = 4352, WSC_KVB = 9984, WSC_N = 12544;
constexpr size_t WS_MKV = 5 * MiB;
constexpr size_t WS_META = 9 * MiB;
constexpr size_t WS_GATE = WS_META + 512 * 1024, WS_DEST = WS_GATE + 256 * 1024, WS_WGB = WS_DEST + 256 * 1024;
constexpr size_t WS_WOUT1 = 12 * MiB;
constexpr size_t WS_WKVB = 14 * MiB;
constexpr size_t WS_WEGU = 19 * MiB;
constexpr size_t WS_WEDN = 131 * MiB;
constexpr size_t WS_R1 = 187 * MiB;
constexpr size_t WS_EH = 395 * MiB;
constexpr size_t WS_U = 395 * MiB;
constexpr size_t WS_MIX = 459 * MiB;
constexpr size_t WS_MIXED = 523 * MiB;
constexpr size_t WS_WINA = 587 * MiB;
constexpr size_t WS_WMKV = 587 * MiB + (size_t)3328 * 1024;
constexpr size_t WS_WMKV_OLD_UNUSED = 587 * MiB + (size_t)3328 * 1024 * 2;
constexpr size_t WS_WOUT0 = 596 * MiB;
constexpr size_t WS_WGU = 598 * MiB;
constexpr size_t WS_WDN = 609 * MiB;
constexpr size_t WS_HGQD = 640 * MiB;
constexpr size_t WS_HGOI = 688 * MiB;
constexpr size_t WS_HGU = 736 * MiB;
constexpr size_t WS_HGDEC = 832 * MiB;
constexpr size_t WS_H16 = 640 * MiB;
constexpr size_t WS_END = 857 * MiB;
static_assert(WS_EH + (size_t)XS_ROWS * DFE * 2 <= WS_END, "EH fits");
static_assert(WS_R1 + (size_t)MTOK * AW * 2 <= WS_EH, "R1 fits");
constexpr int CW_BAR = 4096;
constexpr int CW_GCNT = 16384;
constexpr int CW_XRANK = 16448;
static_assert((CW_XRANK + 16) * 4 <= (int)CTL_ZERO_BYTES, "control words inside the zeroed region");

constexpr int RING_BYTES = 131072;
constexpr int LDSCTL_OFF = RING_BYTES, MISC_OFF = LDSCTL_OFF + 320;
constexpr int LDS_BYTES = 147456;

__device__ __forceinline__ unsigned f2bf(float f) { unsigned u = __builtin_bit_cast(unsigned, f); return (u + 0x7fffu + ((u >> 16) & 1u)) >> 16; }
__device__ __forceinline__ unsigned pk2(float lo, float hi) { f32x2 v = {lo, hi}; bf16x2_t b = __builtin_convertvector(v, bf16x2_t); return __builtin_bit_cast(unsigned, b); }
__device__ __forceinline__ float bflo(unsigned w) { return __builtin_bit_cast(float, w << 16); }
__device__ __forceinline__ float bfhi(unsigned w) { return __builtin_bit_cast(float, w & 0xffff0000u); }
__device__ __forceinline__ float bf1(unsigned short s) { return __builtin_bit_cast(float, (unsigned)s << 16); }
__device__ __forceinline__ float wave_sum(float v);
__device__ __forceinline__ float fexp2(float x) { return __builtin_amdgcn_exp2f(x); }
__device__ __forceinline__ float flog2(float x) { return __builtin_amdgcn_logf(x); }
__device__ __forceinline__ float frcp(float x) { return __builtin_amdgcn_rcpf(x); }
__device__ __forceinline__ float frsq(float x) { return __builtin_amdgcn_rsqf(x); }
template <int X> __device__ __forceinline__ float swz_xor(float v) { return __builtin_bit_cast(float, __builtin_amdgcn_ds_swizzle(__builtin_bit_cast(int, v), (X << 10) | 0x1F)); }
__device__ __forceinline__ float wave_sum(float v) {
    v += swz_xor<1>(v); v += swz_xor<2>(v); v += swz_xor<4>(v); v += swz_xor<8>(v); v += swz_xor<16>(v);
    const float lo = __builtin_bit_cast(float, __builtin_amdgcn_readlane(__builtin_bit_cast(int, v), 0)), hi = __builtin_bit_cast(float, __builtin_amdgcn_readlane(__builtin_bit_cast(int, v), 32));
    return lo + hi;
}
__device__ __forceinline__ float sigmoidf_(float x) { return frcp(1.0f + fexp2(-1.4426950408889634f * x)); }
typedef int i32x4 __attribute__((ext_vector_type(4)));
typedef int i32x8 __attribute__((ext_vector_type(8)));
__device__ __forceinline__ float sat8(float x) { return __builtin_amdgcn_fmed3f(x, -448.f, 448.f); }
__device__ __forceinline__ unsigned pk4_fp8s(float a, float b, float c, float d) { int w = 0; w = __builtin_amdgcn_cvt_pk_fp8_f32(sat8(a), sat8(b), w, false); w = __builtin_amdgcn_cvt_pk_fp8_f32(sat8(c), sat8(d), w, true); return (unsigned)w; }
__device__ __forceinline__ unsigned pk4_fp8(float a, float b, float c, float d) { int w = 0; w = __builtin_amdgcn_cvt_pk_fp8_f32(a, b, w, false); w = __builtin_amdgcn_cvt_pk_fp8_f32(c, d, w, true); return (unsigned)w; }
constexpr float FP8_SX = 8.f, FP8_SH = 8.f, FP8_SWGU = 32.f, FP8_SWDN = 64.f;
__device__ __forceinline__ float wave_max(float v) {
    v = fmaxf(v, swz_xor<1>(v)); v = fmaxf(v, swz_xor<2>(v)); v = fmaxf(v, swz_xor<4>(v)); v = fmaxf(v, swz_xor<8>(v)); v = fmaxf(v, swz_xor<16>(v));
    const float lo = __builtin_bit_cast(float, __builtin_amdgcn_readlane(__builtin_bit_cast(int, v), 0)), hi = __builtin_bit_cast(float, __builtin_amdgcn_readlane(__builtin_bit_cast(int, v), 32));
    return fmaxf(lo, hi);
}
__device__ __forceinline__ unsigned pk4_i8(float a, float b, float c, float d) {
    const int ia = (int)__builtin_rintf(__builtin_amdgcn_fmed3f(a, -127.f, 127.f)), ib = (int)__builtin_rintf(__builtin_amdgcn_fmed3f(b, -127.f, 127.f)),
              ic = (int)__builtin_rintf(__builtin_amdgcn_fmed3f(c, -127.f, 127.f)), id = (int)__builtin_rintf(__builtin_amdgcn_fmed3f(d, -127.f, 127.f));
    return (unsigned)(ia & 0xff) | ((unsigned)(ib & 0xff) << 8) | ((unsigned)(ic & 0xff) << 16) | ((unsigned)id << 24);
}
__device__ __forceinline__ void quant_row_i8(const f32x4 (&uu)[4], unsigned char* qrow, float* as_slot, int lane) {
    float am = 0.f;
#pragma unroll
    for (int j = 0; j < 4; ++j) am = fmaxf(fmaxf(am, fmaxf(__builtin_fabsf(uu[j].x), __builtin_fabsf(uu[j].y))), fmaxf(__builtin_fabsf(uu[j].z), __builtin_fabsf(uu[j].w)));
    am = fmaxf(wave_max(am), 1e-20f);
    const float inv = 127.0f / am;
    unsigned* o4 = (unsigned*)qrow + lane;
#pragma unroll
    for (int j = 0; j < 4; ++j) o4[64 * j] = pk4_i8(uu[j].x * inv, uu[j].y * inv, uu[j].z * inv, uu[j].w * inv);
    if (lane == 0) *as_slot = am * (1.0f / 127.0f);
}
__device__ __forceinline__ int crow(int r, int hi) { return (r & 3) + 8 * (r >> 2) + 4 * hi; }
#define LDS_WAIT() asm volatile("s_waitcnt lgkmcnt(0)" ::: "memory")
#define VM_WAIT() asm volatile("s_waitcnt vmcnt(0)" ::: "memory")
#define LDS_BARRIER() do { asm volatile("s_waitcnt lgkmcnt(0)" ::: "memory"); __builtin_amdgcn_s_barrier(); asm volatile("" ::: "memory"); } while (0)

namespace pg8 {
#define PG8_LAS __attribute__((address_space(3)))
constexpr int BM = 256, BK = 64, HALF = 128, HTB = HALF * BK * 2, STAGE_BYTES = 8 * HTB, NXCD = 8, WGM = 4;
__host__ __device__ __forceinline__ int lds_byte(int r, int c) { const int st = (r >> 4) * 2 + (c >> 5), rr = r & 15, cc = c & 31, ob = rr * 64 + cc * 2; return st * 1024 + (ob ^ (((ob >> 9) & 1) << 5)); }
__host__ __device__ __forceinline__ void stage_rc(int b, int& R, int& C) { const int st = b / 1024, sb = b % 1024, swz = sb ^ (((sb >> 9) & 1) << 5); R = (st >> 1) * 16 + swz / 64; C = (st & 1) * 32 + (swz % 64) / 2; }
__host__ __device__ __forceinline__ int perm32(int rho) { const int n = rho >> 4, i = rho & 15; return 8 * (i >> 2) + 4 * n + (i & 3); }

struct Unit { int pm, pn, pb; };
struct Gemm { const bf16_t* A; const bf16_t* Bt; int M, N, K; };

struct StaticOrder {
    int nM, nN, nwg, G, c;
    int ts[NEXP];
    int moe;
    int ext_n, ext_pm0, ext_pn0;
    __device__ void init(int M, int N, int G_, int c_) { nM = M / BM; nN = N / BM; nwg = nM * nN; G = G_; c = c_; moe = 0; ext_n = 0; ext_pm0 = 0; ext_pn0 = 0;
#pragma unroll
        for (int e = 0; e < NEXP; ++e) ts[e] = 0; }
    __device__ bool next(int i, Unit& u) const {
        const long L = (long)i * G + c; if (L >= nwg + ext_n) return false;
        if (L >= nwg) { const int j = (int)L - nwg; u.pm = ext_pm0 + (j >> 2); u.pn = ext_pn0 + (j & 3); u.pb = u.pn; return true; }
        int wgid = (int)L; { const int q = nwg / NXCD, r = nwg % NXCD, xcd = wgid % NXCD, off = wgid / NXCD; wgid = (xcd < r ? xcd * (q + 1) : r * (q + 1) + (xcd - r) * q) + off; }
        const int nig = WGM * nN, gid = wgid / nig, fm = gid * WGM, gsz = (nM - fm) < WGM ? (nM - fm) : WGM;
        u.pm = fm + ((wgid % nig) % gsz); u.pn = (wgid % nig) / gsz; u.pb = u.pn;
        if (moe) { int e = 0;
#pragma unroll
            for (int j = 1; j < NEXP; ++j) e += (u.pm >= ts[j]) ? 1 : 0;
            u.pb = e * nN + u.pn; }
        return true;
    }
    __device__ __forceinline__ void a_ready(const Unit&) const {}
    __device__ __forceinline__ void done(const Unit&) const {}
};

struct EpiStore {
    static constexpr bool PERM = true, AFTER_DRAIN = false;
    bf16_t* O; int ldc; float sc;
    bf16_t* O2; int ldc2, pm2, pn2;
    __device__ __forceinline__ void operator()(const f32x4 (&acc)[2][2][4][2], const Unit& u, int wr, int wc, int fr, int fq) const {
        int row0 = u.pm * BM + wr * 64 + fr; int col0 = u.pn * BM + wc * 32 + 8 * fq; bf16_t* Ob = O; int ld = ldc;
        if (pm2 > 0 && u.pm >= pm2) { row0 -= pm2 * BM; col0 -= pn2 * BM; Ob = O2; ld = ldc2; }
#pragma unroll
        for (int ai = 0; ai < 2; ++ai)
#pragma unroll
            for (int m = 0; m < 4; ++m) { bf16_t* rowp = Ob + (size_t)(row0 + ai * HALF + m * 16) * ld + col0;
#pragma unroll
                for (int bj = 0; bj < 2; ++bj) { const f32x4 v0 = acc[ai][bj][m][0] * sc, v1 = acc[ai][bj][m][1] * sc;
                    u32x4 w; w.x = pk2(v0[0], v0[1]); w.y = pk2(v0[2], v0[3]); w.z = pk2(v1[0], v1[1]); w.w = pk2(v1[2], v1[3]);
                    *(u32x4*)(rowp + bj * HALF) = w; } }
    }
};
struct EpiSwiGLU {
    static constexpr bool PERM = true, AFTER_DRAIN = false;
    bf16_t* O; int ldc;
    __device__ __forceinline__ void operator()(const f32x4 (&acc)[2][2][4][2], const Unit& u, int wr, int wc, int fr, int fq) const {
        const int row0 = u.pm * BM + wr * 64 + fr; const int col0 = u.pn * HALF + wc * 32 + 8 * fq;
#pragma unroll
        for (int ai = 0; ai < 2; ++ai)
#pragma unroll
            for (int m = 0; m < 4; ++m) { bf16_t* rowp = O + (size_t)(row0 + ai * HALF + m * 16) * ldc + col0;
                float h[8];
#pragma unroll
                for (int n = 0; n < 2; ++n)
#pragma unroll
                    for (int i = 0; i < 4; ++i) { const float g = acc[ai][0][m][n][i], up = acc[ai][1][m][n][i]; h[4 * n + i] = (g * up) * frcp(1.0f + fexp2(-1.4426950408889634f * g)); }
                u32x4 w; w.x = pk2(h[0], h[1]); w.y = pk2(h[2], h[3]); w.z = pk2(h[4], h[5]); w.w = pk2(h[6], h[7]);
                *(u32x4*)rowp = w; }
    }
};

struct EpiStoreQ {
    static constexpr bool PERM = true, AFTER_DRAIN = false;
    bf16_t* O; int ldc; const float* as; const float* ws;
    bf16_t* O2; int ldc2, pm2, pn2;
    __device__ __forceinline__ void operator()(const f32x4 (&acc)[2][2][4][2], const Unit& u, int wr, int wc, int fr, int fq) const {
        const int arow0 = u.pm * BM + wr * 64 + fr, bcol0 = u.pb * BM + wc * 32 + 8 * fq;
        int row0 = arow0, col0 = u.pn * BM + wc * 32 + 8 * fq; bf16_t* Ob = O; int ld = ldc;
        if (pm2 > 0 && u.pm >= pm2) { row0 -= pm2 * BM; col0 -= pn2 * BM; Ob = O2; ld = ldc2; }
        f32x4 wsv[2][2];
#pragma unroll
        for (int bj = 0; bj < 2; ++bj) { wsv[bj][0] = *(const f32x4*)(ws + bcol0 + bj * HALF); wsv[bj][1] = *(const f32x4*)(ws + bcol0 + bj * HALF + 4); }
#pragma unroll
        for (int ai = 0; ai < 2; ++ai)
#pragma unroll
            for (int m = 0; m < 4; ++m) { const float a = as[arow0 + ai * HALF + m * 16]; bf16_t* rowp = Ob + (size_t)(row0 + ai * HALF + m * 16) * ld + col0;
#pragma unroll
                for (int bj = 0; bj < 2; ++bj) { const i32x4 i0 = __builtin_bit_cast(i32x4, acc[ai][bj][m][0]), i1 = __builtin_bit_cast(i32x4, acc[ai][bj][m][1]);
                    const f32x4 v0 = __builtin_convertvector(i0, f32x4) * wsv[bj][0] * a, v1 = __builtin_convertvector(i1, f32x4) * wsv[bj][1] * a;
                    u32x4 w; w.x = pk2(v0[0], v0[1]); w.y = pk2(v0[2], v0[3]); w.z = pk2(v1[0], v1[1]); w.w = pk2(v1[2], v1[3]);
                    *(u32x4*)(rowp + bj * HALF) = w; } }
    }
};
struct EpiSwiGLUQ {
    static constexpr bool PERM = true, AFTER_DRAIN = false;
    bf16_t* O; int ldc; const float* as; const float* ws;
    __device__ __forceinline__ void operator()(const f32x4 (&acc)[2][2][4][2], const Unit& u, int wr, int wc, int fr, int fq) const {
        const int row0 = u.pm * BM + wr * 64 + fr; const int col0 = u.pn * HALF + wc * 32 + 8 * fq, bcol0 = u.pb * BM + wc * 32 + 8 * fq;
        f32x4 wsv[2][2];
#pragma unroll
        for (int bj = 0; bj < 2; ++bj) { wsv[bj][0] = *(const f32x4*)(ws + bcol0 + bj * HALF); wsv[bj][1] = *(const f32x4*)(ws + bcol0 + bj * HALF + 4); }
#pragma unroll
        for (int ai = 0; ai < 2; ++ai)
#pragma unroll
            for (int m = 0; m < 4; ++m) { const float a = as[row0 + ai * HALF + m * 16]; bf16_t* rowp = O + (size_t)(row0 + ai * HALF + m * 16) * ldc + col0;
                float h[8];
#pragma unroll
                for (int n = 0; n < 2; ++n) { const f32x4 gv = __builtin_convertvector(__builtin_bit_cast(i32x4, acc[ai][0][m][n]), f32x4) * wsv[0][n] * a, uv = __builtin_convertvector(__builtin_bit_cast(i32x4, acc[ai][1][m][n]), f32x4) * wsv[1][n] * a;
#pragma unroll
                    for (int i = 0; i < 4; ++i) h[4 * n + i] = (gv[i] * uv[i]) * frcp(1.0f + fexp2(-1.4426950408889634f * gv[i])); }
                u32x4 w; w.x = pk2(h[0], h[1]); w.y = pk2(h[2], h[3]); w.z = pk2(h[4], h[5]); w.w = pk2(h[6], h[7]);
                *(u32x4*)rowp = w; }
    }
};
struct EpiSwiGLU8 {
    static constexpr bool PERM = true, AFTER_DRAIN = false;
    unsigned char* O; int ldc; float ds;
    __device__ __forceinline__ void operator()(const f32x4 (&acc)[2][2][4][2], const Unit& u, int wr, int wc, int fr, int fq) const {
        const float c1 = -1.4426950408889634f * ds, c2 = ds * ds * FP8_SH;
        const int row0 = u.pm * BM + wr * 64 + fr; const int col0 = u.pn * HALF + wc * 32 + 8 * fq;
#pragma unroll
        for (int ai = 0; ai < 2; ++ai)
#pragma unroll
            for (int m = 0; m < 4; ++m) { unsigned char* rowp = O + (size_t)(row0 + ai * HALF + m * 16) * ldc + col0;
                float h[8];
#pragma unroll
                for (int n = 0; n < 2; ++n)
#pragma unroll
                    for (int i = 0; i < 4; ++i) { const float ga = acc[ai][0][m][n][i], ua = acc[ai][1][m][n][i];
                        h[4 * n + i] = (ga * ua) * (c2 * frcp(1.0f + fexp2(ga * c1))); }
                u32x2 w; w.x = pk4_fp8s(h[0], h[1], h[2], h[3]); w.y = pk4_fp8s(h[4], h[5], h[6], h[7]);
                *(u32x2*)rowp = w; }
    }
};

template <class Epi, class Sched, bool ALIGN_EPI = false, bool SP2 = false, int FP8 = 0>
__device__ __forceinline__ void gemm_phase(PG8_LAS unsigned char* lds, const Gemm g, const Sched& S, const Epi& E) {
    int tid_ = threadIdx.x; asm volatile("" : "+v"(tid_));
    const int tid = tid_, wid = __builtin_amdgcn_readfirstlane(tid >> 6), lane = tid & 63, wr = wid >> 2, wc = wid & 3, fr = lane & 15, fq = lane >> 4;
    const int K = g.K, nt = K / BK;
    unsigned voffA[2], voffB[2];
#pragma unroll
    for (int i = 0; i < 2; ++i) { int R, C; stage_rc(tid * 16 + i * 8192, R, C); const int Rb = Epi::PERM ? ((R & ~31) + perm32(R & 31)) : R;
        voffA[i] = (unsigned)(R * K + C) * 2u; voffB[i] = (unsigned)(Rb * K + C) * 2u; }
    const size_t kstep = (size_t)(BK * 2);
    const size_t hstep = (size_t)HALF * K * 2;
    const size_t tstep = 2 * hstep;
    const unsigned ldsw = (unsigned)wid * 1024u;
    const int aoff = lds_byte(wr * 64 + fr, fq * 8), boff = lds_byte(wc * 32 + fr, fq * 8);
#define PG8_SA(b, h) (((b) * 2 + (h)) * HTB)
#define PG8_SB(b, h) ((4 + (b) * 2 + (h)) * HTB)
#define PG8_STAGE(bufoff, gbase, voff) do { _Pragma("unroll") for (int _i = 0; _i < 2; ++_i) \
        __builtin_amdgcn_global_load_lds((const unsigned*)((const char*)(gbase) + (voff)[_i]), (PG8_LAS unsigned*)(lds + (bufoff) + ldsw + _i * 8192), 16, 0, 0); } while (0)
#define PG8_LD8(p) __builtin_shufflevector(*(const PG8_LAS i32x4*)(p), *(const PG8_LAS i32x4*)((p) + 1024), 0, 1, 2, 3, 4, 5, 6, 7)
#define PG8_LDA(dst, b, h) do { if constexpr (FP8 == 1) { _Pragma("unroll") for (int m = 0; m < 4; ++m) dst##8[m] = PG8_LD8(lds + PG8_SA(b, h) + aoff + m * 2048); } \
        else { _Pragma("unroll") for (int m = 0; m < 4; ++m) _Pragma("unroll") for (int k = 0; k < 2; ++k) dst[m][k] = *(const PG8_LAS bf16x8*)(lds + PG8_SA(b, h) + aoff + m * 2048 + k * 1024); } } while (0)
#define PG8_LDB(dst, b, h) do { if constexpr (FP8 == 1) { _Pragma("unroll") for (int n = 0; n < 2; ++n) dst##8[n] = PG8_LD8(lds + PG8_SB(b, h) + boff + n * 2048); } \
        else { _Pragma("unroll") for (int n = 0; n < 2; ++n) _Pragma("unroll") for (int k = 0; k < 2; ++k) dst[n][k] = *(const PG8_LAS bf16x8*)(lds + PG8_SB(b, h) + boff + n * 2048 + k * 1024); } } while (0)
#define PG8_CAT(x, y) __builtin_shufflevector(__builtin_bit_cast(i32x4, x), __builtin_bit_cast(i32x4, y), 0, 1, 2, 3, 4, 5, 6, 7)
#define PG8_MMA(ai, bj, At, Bt) do { __builtin_amdgcn_s_setprio(1); \
        if constexpr (FP8 == 1) { _Pragma("unroll") for (int m = 0; m < 4; ++m) _Pragma("unroll") for (int n = 0; n < 2; ++n) \
            asm volatile("v_mfma_scale_f32_16x16x128_f8f6f4 %0, %1, %2, %0, %3, %3 op_sel_hi:[0,0,0]" : "+v"(acc[ai][bj][m][n]) : "v"(Bt##8[n]), "v"(At##8[m]), "v"(sc1)); } \
        else if constexpr (FP8 == 2) { _Pragma("unroll") for (int m = 0; m < 4; ++m) _Pragma("unroll") for (int n = 0; n < 2; ++n) _Pragma("unroll") for (int k = 0; k < 2; ++k) \
            acc[ai][bj][m][n] = __builtin_bit_cast(f32x4, __builtin_amdgcn_mfma_i32_16x16x64_i8(__builtin_bit_cast(i32x4, Bt[n][k]), __builtin_bit_cast(i32x4, At[m][k]), __builtin_bit_cast(i32x4, acc[ai][bj][m][n]), 0, 0, 0)); } \
        else { _Pragma("unroll") for (int m = 0; m < 4; ++m) _Pragma("unroll") for (int n = 0; n < 2; ++n) _Pragma("unroll") for (int k = 0; k < 2; ++k) \
            acc[ai][bj][m][n] = __builtin_amdgcn_mfma_f32_16x16x32_bf16(Bt[n][k], At[m][k], acc[ai][bj][m][n], 0, 0, 0); } \
        __builtin_amdgcn_s_setprio(0); } while (0)
#define PG8_WAIT_V(n) asm volatile("s_waitcnt vmcnt(" #n ")" ::: "memory")
#define PG8_WAIT_L(n) asm volatile("s_waitcnt lgkmcnt(" #n ")" ::: "memory")
#define PG8_BAR __builtin_amdgcn_s_barrier()
#define PG8_SCHED __builtin_amdgcn_sched_barrier(0)
    Unit cur, nxt; int ui = 0;
    if (!S.next(0, cur)) return;
    f32x4 acc[2][2][4][2];
#pragma unroll
    for (int a = 0; a < 2; ++a)
#pragma unroll
        for (int b = 0; b < 2; ++b)
#pragma unroll
            for (int m = 0; m < 4; ++m)
#pragma unroll
                for (int n = 0; n < 2; ++n) acc[a][b][m][n] = (f32x4){0.f, 0.f, 0.f, 0.f};
    bf16x8 At[4][2], B0[2][2], B1[2][2];
    i32x8 At8[4], B08[2], B18[2];
    int sc1 = 0x7F7F7F7F; asm volatile("" : "+v"(sc1));
    const char* cA = (const char*)g.A + (size_t)cur.pm * tstep; const char* cB = (const char*)g.Bt + (size_t)cur.pb * tstep;
    S.a_ready(cur);
    if constexpr (SP2) {
        PG8_STAGE(PG8_SB(0, 0), cB, voffB); PG8_STAGE(PG8_SB(0, 1), cB + hstep, voffB); PG8_STAGE(PG8_SA(0, 0), cA, voffA); PG8_STAGE(PG8_SA(0, 1), cA + hstep, voffA);
        if (wr == 1) PG8_BAR;
        PG8_WAIT_V(2); PG8_BAR;
        PG8_STAGE(PG8_SB(1, 0), cB + kstep, voffB); PG8_STAGE(PG8_SA(1, 0), cA + kstep, voffA); PG8_STAGE(PG8_SB(1, 1), cB + hstep + kstep, voffB);
        PG8_WAIT_V(6); PG8_BAR;
    } else {
        PG8_STAGE(PG8_SB(0, 0), cB, voffB); PG8_STAGE(PG8_SA(0, 0), cA, voffA); PG8_STAGE(PG8_SB(0, 1), cB + hstep, voffB); PG8_STAGE(PG8_SA(0, 1), cA + hstep, voffA);
        if (wr == 1) PG8_BAR;
        PG8_WAIT_V(4); PG8_BAR;
        PG8_STAGE(PG8_SB(1, 0), cB + kstep, voffB); PG8_STAGE(PG8_SA(1, 0), cA + kstep, voffA); PG8_STAGE(PG8_SB(1, 1), cB + hstep + kstep, voffB);
        PG8_WAIT_V(6); PG8_BAR;
    }
    for (;;) {
        const bool has_next = S.next(ui + 1, nxt);
        const char* nA = has_next ? (const char*)g.A + (size_t)nxt.pm * tstep : cA; const char* nB = has_next ? (const char*)g.Bt + (size_t)nxt.pb * tstep : cB;
        for (int t = 0; t < nt; t += 2) {
            const bool last = (t == nt - 2);
            const char* a1 = cA + (size_t)(t + 1) * kstep;
            const char* a2 = last ? nA : cA + (size_t)(t + 2) * kstep; const char* b2 = last ? nB : cB + (size_t)(t + 2) * kstep;
            const char* a3 = a2 + kstep; const char* b3 = b2 + kstep;
            if (last && has_next) S.a_ready(nxt);
            if constexpr (SP2) {
            PG8_LDB(B0, 0, 0); PG8_LDB(B1, 0, 1); PG8_SCHED; PG8_LDA(At, 0, 0); PG8_STAGE(PG8_SA(1, 1), a1 + hstep, voffA);
            PG8_WAIT_V(8); PG8_WAIT_L(0); PG8_BAR; PG8_MMA(0, 0, At, B0); PG8_MMA(0, 1, At, B1); PG8_BAR; PG8_SCHED;
            PG8_LDA(At, 0, 1); PG8_STAGE(PG8_SB(0, 0), b2, voffB); PG8_STAGE(PG8_SB(0, 1), b2 + hstep, voffB); PG8_STAGE(PG8_SA(0, 0), a2, voffA);
            PG8_WAIT_V(8); PG8_WAIT_L(0); PG8_BAR; PG8_MMA(1, 0, At, B0); PG8_MMA(1, 1, At, B1); PG8_BAR; PG8_SCHED;
            PG8_LDB(B0, 1, 0); PG8_LDB(B1, 1, 1); PG8_SCHED; PG8_LDA(At, 1, 0); PG8_STAGE(PG8_SA(0, 1), a2 + hstep, voffA);
            PG8_WAIT_V(8); PG8_WAIT_L(0); PG8_BAR; PG8_MMA(0, 0, At, B0); PG8_MMA(0, 1, At, B1); PG8_BAR; PG8_SCHED;
            PG8_LDA(At, 1, 1); PG8_STAGE(PG8_SB(1, 0), b3, voffB); PG8_STAGE(PG8_SB(1, 1), b3 + hstep, voffB); PG8_STAGE(PG8_SA(1, 0), a3, voffA);
            PG8_WAIT_V(8); PG8_WAIT_L(0); PG8_BAR; PG8_MMA(1, 0, At, B0); PG8_MMA(1, 1, At, B1); PG8_BAR; PG8_SCHED;
            } else {
            PG8_LDB(B0, 0, 0); PG8_SCHED; PG8_LDA(At, 0, 0); PG8_STAGE(PG8_SA(1, 1), a1 + hstep, voffA);
            PG8_WAIT_L(8); PG8_BAR; PG8_WAIT_L(0); PG8_MMA(0, 0, At, B0); PG8_BAR; PG8_SCHED;
            PG8_LDB(B1, 0, 1); PG8_STAGE(PG8_SB(0, 0), b2, voffB);
            PG8_BAR; PG8_WAIT_L(0); PG8_MMA(0, 1, At, B1); PG8_BAR;
            PG8_LDA(At, 0, 1); PG8_STAGE(PG8_SA(0, 0), a2, voffA);
            PG8_BAR; PG8_WAIT_L(0); PG8_MMA(1, 0, At, B0); PG8_BAR; PG8_SCHED;
            PG8_STAGE(PG8_SB(0, 1), b2 + hstep, voffB);
            PG8_WAIT_V(6); PG8_BAR; PG8_MMA(1, 1, At, B1); PG8_BAR;
            PG8_LDB(B0, 1, 0); PG8_SCHED; PG8_LDA(At, 1, 0); PG8_STAGE(PG8_SA(0, 1), a2 + hstep, voffA);
            PG8_WAIT_L(8); PG8_BAR; PG8_WAIT_L(0); PG8_MMA(0, 0, At, B0); PG8_BAR; PG8_SCHED;
            PG8_LDB(B1, 1, 1); PG8_STAGE(PG8_SB(1, 0), b3, voffB);
            PG8_BAR; PG8_WAIT_L(0); PG8_MMA(0, 1, At, B1); PG8_BAR;
            PG8_LDA(At, 1, 1); PG8_STAGE(PG8_SA(1, 0), a3, voffA);
            PG8_BAR; PG8_WAIT_L(0); PG8_MMA(1, 0, At, B0); PG8_BAR; PG8_SCHED;
            PG8_STAGE(PG8_SB(1, 1), b3 + hstep, voffB);
            PG8_WAIT_V(6); PG8_BAR; PG8_MMA(1, 1, At, B1); PG8_BAR;
            }
        }
        if constexpr (ALIGN_EPI) { if (wr == 0) PG8_BAR; }
        if constexpr (FP8 == 1) asm volatile("s_nop 15\n\ts_nop 15\n\ts_nop 15\n\ts_nop 15\n\ts_nop 15" ::: "memory");
        if constexpr (!Epi::AFTER_DRAIN) { E(acc, cur, wr, wc, fr, fq); S.done(cur); }
        if (!has_next) break;
#pragma unroll
        for (int a = 0; a < 2; ++a)
#pragma unroll
            for (int b = 0; b < 2; ++b)
#pragma unroll
                for (int m = 0; m < 4; ++m)
#pragma unroll
                    for (int n = 0; n < 2; ++n) acc[a][b][m][n] = (f32x4){0.f, 0.f, 0.f, 0.f};
        cur = nxt; cA = nA; cB = nB; ++ui;
        if constexpr (ALIGN_EPI) { if (wr == 1) PG8_BAR; }
    }
    PG8_WAIT_V(0);
    if constexpr (!ALIGN_EPI) { if (wr == 0) PG8_BAR; }
    PG8_BAR;
#undef PG8_SA
#undef PG8_SB
#undef PG8_STAGE
#undef PG8_LDA
#undef PG8_LD8
#undef PG8_LDB
#undef PG8_MMA
#undef PG8_CAT
#undef PG8_WAIT_V
#undef PG8_WAIT_L
#undef PG8_BAR
#undef PG8_SCHED
}
}

#define XB_TMO      128
#define XB_XCNT(j)  (256  + 64 * (j))
#define XB_XSUB(j)  (1280 + 64 * (j))
#define XB_XGEN(j)  (2304 + 64 * (j))
#define XB_TOP      3328
#define XB_TOPGEN   3392
#define XCD_BAR_WORDS 3456
#define XB_SPIN_CAP (1u << 22)
__device__ __forceinline__ unsigned xb_ld(unsigned* p)              { return __hip_atomic_load(p, __ATOMIC_RELAXED, __HIP_MEMORY_SCOPE_AGENT); }
__device__ __forceinline__ unsigned xb_add(unsigned* p, unsigned v) { return __hip_atomic_fetch_add(p, v, __ATOMIC_RELAXED, __HIP_MEMORY_SCOPE_AGENT); }
__device__ __forceinline__ unsigned xb_xcc_id() { return (unsigned)__builtin_amdgcn_s_getreg((3 << 11) | 20) & 0xFu; }
#define XB_SPIN(cond, bar) do { unsigned _sp = 0; while (cond) { __builtin_amdgcn_s_sleep(1); \
    if ((++_sp & 255u) == 0u) { if (xb_ld(&(bar)[XB_TMO])) break; if (_sp > XB_SPIN_CAP) { atomicAdd(&(bar)[XB_TMO], 1u); break; } } } } while (0)
struct XcdBarrier { unsigned* bar; unsigned x; volatile LAS unsigned* st; };
__device__ __forceinline__ XcdBarrier xcd_barrier_post(unsigned* bar, volatile LAS unsigned* st) {
    XcdBarrier b; b.bar = bar; b.x = xb_xcc_id(); b.st = st;
    if (threadIdx.x == 0) (void)xb_add(&bar[XB_XCNT(b.x)], 1u);
    return b;
}
__device__ __forceinline__ void xcd_barrier_complete(unsigned* bar, unsigned x, unsigned& nloc, unsigned& nx) {
    const unsigned G = gridDim.x * gridDim.y * gridDim.z;
    unsigned sum, cnt, mine, sp = 0u;
    for (;;) {
        sum = 0u; cnt = 0u; mine = 0u;
#pragma unroll
        for (unsigned j = 0; j < 16; ++j) { const unsigned c = xb_ld(&bar[XB_XCNT(j)]); sum += c; cnt += (c > 0u) ? 1u : 0u; mine = (j == x) ? c : mine; }
        if (sum == G) break;
        __builtin_amdgcn_s_sleep(1);
        if ((++sp & 255u) == 0u) { if (xb_ld(&bar[XB_TMO])) break; if (sp > XB_SPIN_CAP) { atomicAdd(&bar[XB_TMO], 1u); break; } }
    }
    nloc = mine > 0u ? mine : 1u; nx = cnt > 0u ? cnt : 1u;
}
__device__ __forceinline__ void xcd_barrier(const XcdBarrier& b) {
    asm volatile("s_waitcnt vmcnt(0)" ::: "memory");
    __syncthreads();
    if (threadIdx.x == 0) {
        unsigned* bar = b.bar;
        __builtin_amdgcn_s_waitcnt(0);
        unsigned nloc = b.st[0], nx = b.st[1];
        if (nloc == 0u) { xcd_barrier_complete(bar, b.x, nloc, nx); b.st[0] = nloc; b.st[1] = nx; }
        const unsigned old = xb_add(&bar[XB_XSUB(b.x)], 1u);
        const unsigned gen = old / nloc;
        if (old + 1u == (gen + 1u) * nloc) {
            __builtin_amdgcn_fence(__ATOMIC_RELEASE, "agent");
            asm volatile("s_waitcnt vmcnt(0)" ::: "memory");
            const unsigned og = xb_add(&bar[XB_TOP], 1u);
            const unsigned tg = og / nx;
            if (og + 1u == (tg + 1u) * nx) xb_add(&bar[XB_TOPGEN], 1u);
            else XB_SPIN(xb_ld(&bar[XB_TOPGEN]) == tg, bar);
            __builtin_amdgcn_fence(__ATOMIC_ACQUIRE, "agent");
            xb_add(&bar[XB_XGEN(b.x)], 1u);
            asm volatile("s_waitcnt vmcnt(0)" ::: "memory");
        } else {
            XB_SPIN(xb_ld(&bar[XB_XGEN(b.x)]) == gen, bar);
            __builtin_amdgcn_fence(__ATOMIC_ACQUIRE, "agent");
            asm volatile("s_waitcnt vmcnt(0)" ::: "memory");
        }
    }
    __syncthreads();
}

struct Frame {
    LAS unsigned char* lds;
    int tid, lane, wave, G, bx;
};
__device__ __forceinline__ Frame phase_frame(const Frame& F) { Frame R = F; int t = threadIdx.x; asm volatile("" : "+v"(t)); R.tid = t; R.lane = t & 63; R.wave = __builtin_amdgcn_readfirstlane(t >> 6); return R; }

struct TrDesc { const float* W; unsigned char* WT; const float* kgain; float nscale; int K, N, drow0, k0, n0, f8; };
__device__ __forceinline__ void tr_load(const TrDesc& d, float (&tv)[32], int lane) {
    const float* wp = d.W + (size_t)(d.k0 + (lane >> 5)) * d.N + d.n0 + (lane & 31);
#pragma unroll
    for (int i = 0; i < 32; ++i) tv[i] = wp[(size_t)(2 * i) * d.N];
}
__device__ __forceinline__ void tr_finish(const TrDesc& d, const float (&tv)[32], LAS float* scr, int lane) {
#pragma unroll
    for (int i = 0; i < 32; ++i) { float v = tv[i] * d.nscale; if (d.kgain) v *= d.kgain[d.k0 + 2 * i + (lane >> 5)]; scr[(2 * i + (lane >> 5)) * 33 + (lane & 31)] = v; }
    LDS_WAIT(); asm volatile("" ::: "memory");
    const int c = lane & 7;
#pragma unroll
    for (int j = 0; j < 4; ++j) { const int n = (lane >> 3) + 8 * j; const LAS float* s = scr + (8 * c) * 33 + n;
        if (d.f8) { u32x2 o; o.x = pk4_fp8(s[0 * 33], s[1 * 33], s[2 * 33], s[3 * 33]); o.y = pk4_fp8(s[4 * 33], s[5 * 33], s[6 * 33], s[7 * 33]);
            *(u32x2*)(d.WT + (size_t)(d.drow0 + n) * d.K + d.k0 + 8 * c) = o; }
        else { u32x4 o; o.x = pk2(s[0 * 33], s[1 * 33]); o.y = pk2(s[2 * 33], s[3 * 33]); o.z = pk2(s[4 * 33], s[5 * 33]); o.w = pk2(s[6 * 33], s[7 * 33]);
            *(u32x4*)(d.WT + ((size_t)(d.drow0 + n) * d.K + d.k0 + 8 * c) * 2) = o; } }
    LDS_WAIT(); asm volatile("" ::: "memory");
}
__device__ __forceinline__ int gu_row(int n0, int Fh) { return n0 < Fh ? ((n0 >> 7) * 256 + (n0 & 127)) : (((n0 - Fh) >> 7) * 256 + 128 + ((n0 - Fh) & 127)); }

struct Ptrs {
    const float *x, *mem, *anpre, *anpost, *fnpre, *fnpost, *w_in_a, *hlb, *hon, *w_in_b, *kvn, *w_kv, *memn, *w_mem_kv, *w_out, *w_gu, *w_dn, *w_router, *w_egu, *w_edn;
    float* out; unsigned char* ws;
};

__device__ __forceinline__ float row_rstd(const f32x4 (&a)[4]);
__device__ __forceinline__ void rms_row_to_bf16(const float* xrow, bf16_t* orow, const float* gain, int lane) {
    const f32x4* xr = (const f32x4*)xrow + lane;
    f32x4 v[4]; float s = 0.f;
#pragma unroll
    for (int j = 0; j < 4; ++j) { v[j] = xr[64 * j]; s += (v[j].x * v[j].x + v[j].y * v[j].y) + (v[j].z * v[j].z + v[j].w * v[j].w); }
    const float rstd = frsq(wave_sum(s) * (1.f / DM) + RMS_EPS);
    u32x2* o8 = (u32x2*)orow + lane;
#pragma unroll
    for (int j = 0; j < 4; ++j) { f32x4 gg = gain ? ((const f32x4*)gain)[lane + 64 * j] : (f32x4){1.f, 1.f, 1.f, 1.f};
        u32x2 w; w.x = pk2(v[j].x * rstd * gg.x, v[j].y * rstd * gg.y); w.y = pk2(v[j].z * rstd * gg.z, v[j].w * rstd * gg.w); o8[64 * j] = w; }
}

struct TrCounts {
    static constexpr int I_INA = (DM / 64) * (AW / 32), I_MKV = (DM / 64) * (512 / 32), I_OUT = (DM / 64) * (DM / 32), I_GU = (DM / 64) * (2 * DFF / 32), I_DN = (DFF / 64) * (DM / 32),
                         I_KV = (DM / 64) * (1536 / 32), I_INB = (DM / 64) * (DM / 32), I_EGU = (DM / 64) * (2 * DFE / 32), I_EDN = (DFE / 64) * (DM / 32);
    static constexpr int NEARLY = I_INA + 2 * I_MKV + 2 * I_OUT + I_GU + I_DN + I_KV + I_INB;
    static constexpr int NITEMS = NEARLY + NEXP * I_EGU + NEXP * I_EDN;
};
__device__ __forceinline__ TrDesc tr_decode(const Ptrs& P, int it) {
    using T = TrCounts; unsigned char* ws = P.ws; TrDesc d; d.kgain = nullptr; d.nscale = 1.f; d.f8 = 0;
    int r = it - (T::I_INA + 2 * T::I_MKV);
    if (r < 2 * T::I_OUT) { const int l = r / T::I_OUT; r -= l * T::I_OUT; const int nb = DM / 32; d.k0 = 64 * (r / nb); d.n0 = 32 * (r % nb);
        d.W = P.w_out + (size_t)l * DM * DM; d.K = DM; d.N = DM; d.WT = ws + (l ? WS_WOUT1 : WS_WOUT0); d.drow0 = d.n0; return d; } r -= 2 * T::I_OUT + T::I_GU;
    if (r < T::I_DN) { const int nb = DM / 32; d.k0 = 64 * (r / nb); d.n0 = 32 * (r % nb); d.W = P.w_dn; d.K = DFF; d.N = DM; d.WT = ws + WS_WDN; d.drow0 = d.n0; return d; } r -= T::I_DN + T::I_KV + T::I_INB;
    d.f8 = 1;
    if (r < NEXP * T::I_EGU) { const int e = r / T::I_EGU; r -= e * T::I_EGU; const int nb = 2 * DFE / 32; d.k0 = 64 * (r / nb); d.n0 = 32 * (r % nb);
        d.W = P.w_egu + (size_t)e * DM * 2 * DFE; d.K = DM; d.N = 2 * DFE; d.WT = ws + WS_WEGU + (size_t)e * 2 * DFE * DM; d.drow0 = gu_row(d.n0, DFE); d.nscale = FP8_SWGU; return d; } r -= NEXP * T::I_EGU;
    { const int e = r / T::I_EDN; r -= e * T::I_EDN; const int nb = DM / 32; d.k0 = 64 * (r / nb); d.n0 = 32 * (r % nb);
        d.W = P.w_edn + (size_t)e * DFE * DM; d.K = DFE; d.N = DM; d.WT = ws + WS_WEDN + (size_t)e * DM * DFE; d.drow0 = d.n0; d.nscale = FP8_SWDN; return d; }
}
__device__ __forceinline__ void convert_weights(const Frame& F, const Ptrs& P, int gw, int NGW) {
    LAS float* scr = (LAS float*)(F.lds + F.wave * 16384);
    const int it_lo = TrCounts::NEARLY, it_hi = TrCounts::NITEMS;
    for (int it = it_lo + gw; it < it_hi; it += 2 * NGW) {
        const bool two = it + NGW < it_hi;
        const TrDesc a = tr_decode(P, it), b = tr_decode(P, two ? it + NGW : it);
        float ta[32], tb[32];
        tr_load(a, ta, F.lane); if (two) tr_load(b, tb, F.lane);
        tr_finish(a, ta, scr, F.lane); if (two) tr_finish(b, tb, scr, F.lane);
    }
}
struct Q8Desc { const float* W; unsigned char* WT; const float* kgain; float nscale; int N, n0, drow0; float* wsc; };
constexpr int Q8_INA = AW / 32, Q8_MKV = 512 / 32, Q8_GU = 2 * DFF / 32, Q8_KV = 1536 / 32, Q8_INB = DM / 32, Q8_ITEMS = Q8_INA + 2 * Q8_MKV + Q8_GU + Q8_KV + Q8_INB;
__device__ __forceinline__ Q8Desc q8_decode(const Ptrs& P, int r) {
    unsigned char* ws = P.ws; float* const WSCp = (float*)(ws + WS_WSC); Q8Desc d; d.kgain = nullptr; d.nscale = 1.f;
    if (r < Q8_INA) { d.n0 = 32 * r; d.W = P.w_in_a; d.N = AW; d.WT = ws + WS_WINA; d.drow0 = d.n0; d.nscale = d.n0 >= 3072 ? C2 : 1.f; d.wsc = WSCp + WSC_INA; return d; } r -= Q8_INA;
    if (r < 2 * Q8_MKV) { const int l = r / Q8_MKV; r -= l * Q8_MKV; d.n0 = 32 * r; d.W = P.w_mem_kv + (size_t)l * DM * 512; d.N = 512; d.WT = ws + WS_WINA; d.drow0 = AW + l * 512 + d.n0; d.kgain = P.memn + l * DM; d.wsc = WSCp + WSC_INA; return d; } r -= 2 * Q8_MKV;
    if (r < Q8_GU) { d.n0 = 32 * r; d.W = P.w_gu; d.N = 2 * DFF; d.WT = ws + WS_WGU; d.drow0 = gu_row(d.n0, DFF); d.wsc = WSCp + WSC_GU; return d; } r -= Q8_GU;
    if (r < Q8_KV) { d.n0 = 32 * r; d.W = P.w_kv; d.N = 1536; d.WT = ws + WS_WKVB; d.drow0 = d.n0; d.kgain = P.kvn; d.wsc = WSCp + WSC_KVB; return d; } r -= Q8_KV;
    { d.n0 = 32 * r; d.W = P.w_in_b; d.N = DM; d.WT = ws + WS_WKVB; d.drow0 = 1536 + d.n0; d.kgain = P.anpre + DM; d.nscale = C2; d.wsc = WSCp + WSC_KVB; return d; }
}
__device__ __forceinline__ void q8_finish(const Q8Desc& q, const float (&tv)[32], int kbase, LAS float* scr, const LAS float* cfin, int lane) {
#pragma unroll
    for (int i = 0; i < 32; ++i) scr[(2 * i + (lane >> 5)) * 33 + (lane & 31)] = tv[i];
    LDS_WAIT(); asm volatile("" ::: "memory");
    const int c = lane & 7;
#pragma unroll
    for (int j = 0; j < 4; ++j) { const int n = (lane >> 3) + 8 * j; const LAS float* s = scr + (8 * c) * 33 + n; const float inv = 127.0f / cfin[n];
        u32x2 o; o.x = pk4_i8(s[0 * 33] * inv, s[1 * 33] * inv, s[2 * 33] * inv, s[3 * 33] * inv); o.y = pk4_i8(s[4 * 33] * inv, s[5 * 33] * inv, s[6 * 33] * inv, s[7 * 33] * inv);
        *(u32x2*)(q.WT + (size_t)(q.drow0 + n) * DM + kbase + 8 * c) = o; }
    LDS_WAIT(); asm volatile("" ::: "memory");
}
__device__ __forceinline__ void q8_item(const Frame& F, const Q8Desc& q, int parity) {
    const int lane = F.lane, kp = lane >> 5, nl = lane & 31, k0 = F.wave * 128;
    LAS float* scr = (LAS float*)(F.lds + F.wave * 16384);
    const float* wp = q.W + (size_t)(k0 + kp) * q.N + q.n0 + nl;
    float ga[32], gb[32];
    if (q.kgain) {
#pragma unroll
        for (int i = 0; i < 32; ++i) { ga[i] = q.kgain[k0 + 2 * i + kp]; gb[i] = q.kgain[k0 + 64 + 2 * i + kp]; }
    } else {
#pragma unroll
        for (int i = 0; i < 32; ++i) { ga[i] = 1.f; gb[i] = 1.f; }
    }
    float ta[32], tb[32];
#pragma unroll
    for (int i = 0; i < 32; ++i) ta[i] = wp[(size_t)(2 * i) * q.N];
#pragma unroll
    for (int i = 0; i < 32; ++i) tb[i] = wp[(size_t)(64 + 2 * i) * q.N];
    float m = 0.f;
#pragma unroll
    for (int i = 0; i < 32; ++i) { const float v = ta[i] * q.nscale * ga[i]; ta[i] = v; m = fmaxf(m, __builtin_fabsf(v)); }
#pragma unroll
    for (int i = 0; i < 32; ++i) { const float v = tb[i] * q.nscale * gb[i]; tb[i] = v; m = fmaxf(m, __builtin_fabsf(v)); }
    ((LAS float*)(F.lds + F.wave * 16384 + 12288 + parity * 256))[lane] = m;
    __syncthreads();
    float cm = 1e-30f;
#pragma unroll
    for (int w = 0; w < NWAVES; ++w) { const LAS float* cp = (const LAS float*)(F.lds + w * 16384 + 12288 + parity * 256); cm = fmaxf(cm, fmaxf(cp[nl], cp[nl + 32])); }
    LAS float* cfin = (LAS float*)(F.lds + F.wave * 16384 + 12288 + 512);
    if (lane < 32) cfin[lane] = cm;
    if (F.wave == 0 && lane < 32) q.wsc[q.drow0 + lane] = cm * (1.0f / 127.0f);
    q8_finish(q, ta, k0, scr, cfin, lane);
    q8_finish(q, tb, k0 + 64, scr, cfin, lane);
}
__device__ __forceinline__ void p0_rows4_load(const float* src, int m0, int lane, f32x4 (&v)[4][4]) {
#pragma unroll
    for (int r = 0; r < 4; ++r)
#pragma unroll
        for (int j = 0; j < 4; ++j) v[r][j] = ((const f32x4*)(src + (size_t)(m0 + r) * DM))[lane + 64 * j];
}
template <bool GAIN>
__device__ __forceinline__ void p0_rows4_finish(const f32x4 (&v)[4][4], const f32x4 (&gx)[4], unsigned char* dst, float* as, int m0, int lane) {
#pragma unroll
    for (int r = 0; r < 4; ++r) {
        const float rstd = row_rstd(v[r]);
        f32x4 uu[4];
#pragma unroll
        for (int j = 0; j < 4; ++j) { uu[j] = v[r][j] * rstd; if constexpr (GAIN) uu[j] = uu[j] * gx[j]; }
        quant_row_i8(uu, dst + (size_t)(m0 + r) * DM, as + m0 + r, lane);
    }
}
constexpr int P0_NB16 = 2 * TrCounts::I_OUT + TrCounts::I_DN, P0_G16 = P0_NB16 / 16, P0_XCH = MTOK / 32, P0_MCH = MROWS / 32, P0_WITEMS = Q8_ITEMS + P0_G16, P0_ITEMS = P0_WITEMS + P0_XCH + P0_MCH;
static_assert(P0_NB16 % 16 == 0, "bf16 wave items in groups of 16");
__device__ __forceinline__ void p0_prologue(const Frame& F, const Ptrs& P) {
    unsigned char* ws = P.ws;
    float* const ASA = (float*)(ws + WS_AS);
    int parity = 0, L = F.bx;
    for (; L < P0_WITEMS; L += F.G) {
        if (L < Q8_ITEMS) { const Q8Desc q = q8_decode(P, L); q8_item(F, q, parity); parity ^= 1; continue; }
        const int r = L - Q8_ITEMS;
        LAS float* scr = (LAS float*)(F.lds + F.wave * 16384);
        const int ia = r * 16 + F.wave, ib = ia + 8;
        const int base = TrCounts::I_INA + 2 * TrCounts::I_MKV;
        const TrDesc a = tr_decode(P, base + (ia < 2 * TrCounts::I_OUT ? ia : ia + TrCounts::I_GU)), b = tr_decode(P, base + (ib < 2 * TrCounts::I_OUT ? ib : ib + TrCounts::I_GU));
        float ta[32], tb[32];
        tr_load(a, ta, F.lane); tr_load(b, tb, F.lane);
        tr_finish(a, ta, scr, F.lane); tr_finish(b, tb, scr, F.lane);
    }
    f32x4 v[4][4], vn[4][4];
#define P0_LOAD(dst, LL) do { const int c_ = (LL) - P0_WITEMS; const bool isx_ = c_ < P0_XCH; p0_rows4_load(isx_ ? P.x : P.mem, 32 * (isx_ ? c_ : c_ - P0_XCH) + 4 * F.wave, F.lane, dst); } while (0)
#define P0_FIN(src, LL) do { const int c_ = (LL) - P0_WITEMS; const bool isx_ = c_ < P0_XCH; const int m0_ = 32 * (isx_ ? c_ : c_ - P0_XCH) + 4 * F.wave; \
        if (isx_) p0_rows4_finish<true>(src, gx, ws + WS_U, ASA, m0_, F.lane); else p0_rows4_finish<false>(src, gx, ws + WS_MEMN, ASA + MTOK, m0_, F.lane); } while (0)
    if (L < P0_ITEMS) {
        f32x4 gx[4];
#pragma unroll
        for (int j = 0; j < 4; ++j) gx[j] = ((const f32x4*)P.anpre)[F.lane + 64 * j];
        P0_LOAD(v, L);
        for (;;) {
            const int L1 = L + F.G; if (L1 < P0_ITEMS) P0_LOAD(vn, L1);
            P0_FIN(v, L);
            if (L1 >= P0_ITEMS) break;
            const int L2 = L1 + F.G; if (L2 < P0_ITEMS) P0_LOAD(v, L2);
            P0_FIN(vn, L1);
            if (L2 >= P0_ITEMS) break;
            L = L2;
        }
    }
#undef P0_LOAD
#undef P0_FIN
}

__device__ __forceinline__ void load_bf16_row(const bf16_t* arow, int lane, f32x4 (&a)[4]) {
    const u32x2* ar = (const u32x2*)arow + lane;
#pragma unroll
    for (int j = 0; j < 4; ++j) { const u32x2 w = ar[64 * j]; a[j] = (f32x4){bflo(w.x), bfhi(w.x), bflo(w.y), bfhi(w.y)}; }
}
__device__ __forceinline__ float row_rstd(const f32x4 (&a)[4]) {
    float s = 0.f;
#pragma unroll
    for (int j = 0; j < 4; ++j) s += (a[j].x * a[j].x + a[j].y * a[j].y) + (a[j].z * a[j].z + a[j].w * a[j].w);
    return frsq(wave_sum(s) * (1.f / DM) + RMS_EPS);
}
template <bool BASE16, bool Q8OUT>
__device__ __forceinline__ void norm_phase(const Frame& F, const bf16_t* A, const void* base, bf16_t* H, const float* g1, bf16_t* U, const float* g2, float* as_out) {
    for (int i0 = 0; i0 < 16; i0 += 4) {
        const int m0 = F.bx * 128 + F.wave * 16 + i0;
        u32x2 ar[4][4]; f32x4 bs[4][4]; u32x2 bh[4][4];
#pragma unroll
        for (int r = 0; r < 4; ++r)
#pragma unroll
            for (int j = 0; j < 4; ++j) { ar[r][j] = ((const u32x2*)(A + (size_t)(m0 + r) * DM))[F.lane + 64 * j];
                if constexpr (BASE16) bh[r][j] = ((const u32x2*)((const bf16_t*)base + (size_t)(m0 + r) * DM))[F.lane + 64 * j];
                else bs[r][j] = ((const f32x4*)((const float*)base + (size_t)(m0 + r) * DM))[F.lane + 64 * j]; }
#pragma unroll
        for (int r = 0; r < 4; ++r) {
            const int m = m0 + r;
            f32x4 a[4];
#pragma unroll
            for (int j = 0; j < 4; ++j) a[j] = (f32x4){bflo(ar[r][j].x), bfhi(ar[r][j].x), bflo(ar[r][j].y), bfhi(ar[r][j].y)};
            const float rs = row_rstd(a);
            f32x4 h[4];
            u32x2* h8 = (u32x2*)(H + (size_t)m * DM) + F.lane;
#pragma unroll
            for (int j = 0; j < 4; ++j) { const f32x4 gg = ((const f32x4*)g1)[F.lane + 64 * j];
                f32x4 b; if constexpr (BASE16) b = (f32x4){bflo(bh[r][j].x), bfhi(bh[r][j].x), bflo(bh[r][j].y), bfhi(bh[r][j].y)}; else b = bs[r][j];
                h[j] = b + a[j] * rs * gg; u32x2 w; w.x = pk2(h[j].x, h[j].y); w.y = pk2(h[j].z, h[j].w); h8[64 * j] = w; }
            const float rh = row_rstd(h);
            if constexpr (Q8OUT) {
                f32x4 uu[4];
#pragma unroll
                for (int j = 0; j < 4; ++j) { const f32x4 gg = g2 ? ((const f32x4*)g2)[F.lane + 64 * j] : (f32x4){1.f, 1.f, 1.f, 1.f}; uu[j] = h[j] * rh * gg; }
                quant_row_i8(uu, (unsigned char*)U + (size_t)m * DM, as_out + m, F.lane);
            } else {
                u32x2* o8 = (u32x2*)(U + (size_t)m * DM) + F.lane;
#pragma unroll
                for (int j = 0; j < 4; ++j) { const f32x4 gg = g2 ? ((const f32x4*)g2)[F.lane + 64 * j] : (f32x4){1.f, 1.f, 1.f, 1.f};
                    u32x2 w; w.x = pk2(h[j].x * rh * gg.x, h[j].y * rh * gg.y); w.y = pk2(h[j].z * rh * gg.z, h[j].w * rh * gg.w); o8[64 * j] = w; }
            }
        }
    }
}

constexpr float HG_US = 4.f;
constexpr int HG_RAWQ = 0, HG_RAWF = 18432, HG_RAWV = 36864;
constexpr int HG_OT = 0;
constexpr int HG_SC = 33792;
constexpr int HG_QD = 55296, HG_KI = 72704;
constexpr int HG_KST = 90112, HG_VT = 108544;
constexpr int HG_DEC = 126976;
typedef short s16x4 __attribute__((ext_vector_type(4)));
__device__ __forceinline__ s16x4 lds_tr16(const LAS unsigned char* p) { return __builtin_bit_cast(s16x4, __builtin_amdgcn_ds_read_tr16_b64_v4i16((LAS s16x4*)p)); }
constexpr int PA_GH = 0, PA_GL = 17408, PA_KH = 34816, PA_QH = 52224, PA_V = 69632;
__device__ __forceinline__ bf16x8 pa_trfrag(const LAS unsigned char* p) {
    const s16x4 lo = lds_tr16(p), hi = lds_tr16(p + 4 * 272);
    return (bf16x8){lo[0], lo[1], lo[2], lo[3], hi[0], hi[1], hi[2], hi[3]};
}
__device__ __forceinline__ void hgrnA_phase(const Frame& F, const Ptrs& P) {
    const int tid = F.tid, lane = F.lane, w = F.wave;
    LAS unsigned char* L = F.lds;
    const int sc0 = tid >> 4, sch = tid & 15;
    const int fr = lane & 15, g = lane >> 4;
    bf16_t* const GQD = (bf16_t*)(P.ws + WS_HGQD); bf16_t* const GOI = (bf16_t*)(P.ws + WS_HGOI); unsigned char* const GU = P.ws + WS_HGU; float* const GDEC = (float*)(P.ws + WS_HGDEC);
    const int NU = NB * 6 * 64;
    bf16x8 tri0, tri16, ones;
#pragma unroll
    for (int j = 0; j < 8; ++j) { tri0[j] = (8 * g + j <= fr) ? (short)0x3F80 : (short)0; tri16[j] = (8 * g + j <= fr + 16) ? (short)0x3F80 : (short)0; ones[j] = (short)0x3F80; }
    const int trl = (8 * g + ((lane & 15) >> 2)) * 272 + (lane & 3) * 8;
    u32x4 rq[2], rf[2], rv[2];
    {
        const int unit = F.bx; const int bh = unit >> 6, n = unit & 63, b = bh / 6, h = bh % 6;
        const bf16_t* PR = (const bf16_t*)(P.ws + WS_R1) + (size_t)(b * SEQ + n * 64) * AW;
#pragma unroll
        for (int i = 0; i < 2; ++i) { const bf16_t* rp = PR + (size_t)(sc0 + 32 * i) * AW + sch * 8;
            rq[i] = *(const u32x4*)(rp + h * 128); rf[i] = *(const u32x4*)(rp + 768 + h * 128); rv[i] = *(const u32x4*)(rp + 1536 + h * 128); }
    }
    for (int unit = F.bx; unit < NU; unit += F.G) {
        const int bh = unit >> 6, h = bh % 6;
        {
            float lb[8];
            { const f32x4 a00 = *(const f32x4*)(P.hlb + h * 128 + 8 * sch), a01 = *(const f32x4*)(P.hlb + h * 128 + 8 * sch + 4), a10 = *(const f32x4*)(P.hlb + HF + h * 128 + 8 * sch), a11 = *(const f32x4*)(P.hlb + HF + h * 128 + 8 * sch + 4);
#pragma unroll
              for (int e = 0; e < 4; ++e) { lb[e] = frcp(1.0f + fexp2(1.4426950408889634f * (a10[e] - a00[e]))); lb[4 + e] = frcp(1.0f + fexp2(1.4426950408889634f * (a11[e] - a01[e]))); } }
#pragma unroll
            for (int i = 0; i < 2; ++i) {
                const unsigned fw[4] = {rf[i].x, rf[i].y, rf[i].z, rf[i].w}, qw[4] = {rq[i].x, rq[i].y, rq[i].z, rq[i].w};
                unsigned gh[4], gl[4], kh[4], qh[4];
#pragma unroll
                for (int e2 = 0; e2 < 4; ++e2) {
                    float gg[2], kk[2], qq[2];
#pragma unroll
                    for (int o = 0; o < 2; ++o) {
                        const float fl = o ? bfhi(fw[e2]) : bflo(fw[e2]), ql = o ? bfhi(qw[e2]) : bflo(qw[e2]);
                        const float sg = sigmoidf_(fl); const float lbk = lb[2 * e2 + o];
                        gg[o] = flog2(lbk + (1.0f - lbk) * sg); kk[o] = (1.0f - lbk) * (1.0f - sg); qq[o] = ql * sigmoidf_(ql);
                    }
                    gh[e2] = pk2(gg[0], gg[1]);
                    gl[e2] = pk2(gg[0] - bflo(gh[e2]), gg[1] - bfhi(gh[e2]));
                    kh[e2] = pk2(kk[0], kk[1]); qh[e2] = pk2(qq[0], qq[1]);
                }
                const int off = (sc0 + 32 * i) * 272 + sch * 16;
                *(LAS u32x4*)(L + PA_GH + off) = (u32x4){gh[0], gh[1], gh[2], gh[3]}; *(LAS u32x4*)(L + PA_GL + off) = (u32x4){gl[0], gl[1], gl[2], gl[3]};
                *(LAS u32x4*)(L + PA_KH + off) = (u32x4){kh[0], kh[1], kh[2], kh[3]}; *(LAS u32x4*)(L + PA_QH + off) = (u32x4){qh[0], qh[1], qh[2], qh[3]};
                *(LAS u32x4*)(L + PA_V + off) = rv[i];
            }
        }
        LDS_BARRIER();
        if (unit + F.G < NU) {
            const int u2 = unit + F.G; const int bh2 = u2 >> 6, n2 = u2 & 63, b2 = bh2 / 6, h2 = bh2 % 6;
            const bf16_t* PR = (const bf16_t*)(P.ws + WS_R1) + (size_t)(b2 * SEQ + n2 * 64) * AW;
#pragma unroll
            for (int i = 0; i < 2; ++i) { const bf16_t* rp = PR + (size_t)(sc0 + 32 * i) * AW + sch * 8;
                rq[i] = *(const u32x4*)(rp + h2 * 128); rf[i] = *(const u32x4*)(rp + 768 + h2 * 128); rv[i] = *(const u32x4*)(rp + 1536 + h2 * 128); }
        }
        f32x4 bc[4];
        {
            bf16x8 gfh[2], gfl[2];
#pragma unroll
            for (int ks = 0; ks < 2; ++ks) { gfh[ks] = pa_trfrag(L + PA_GH + (32 * ks) * 272 + (16 * w) * 2 + trl); gfl[ks] = pa_trfrag(L + PA_GL + (32 * ks) * 272 + (16 * w) * 2 + trl); }
#pragma unroll
            for (int ct = 0; ct < 4; ++ct) bc[ct] = (f32x4){0.f, 0.f, 0.f, 0.f};
            bc[0] = __builtin_amdgcn_mfma_f32_16x16x32_bf16(gfh[0], tri0, bc[0], 0, 0, 0);  bc[0] = __builtin_amdgcn_mfma_f32_16x16x32_bf16(gfl[0], tri0, bc[0], 0, 0, 0);
            bc[1] = __builtin_amdgcn_mfma_f32_16x16x32_bf16(gfh[0], tri16, bc[1], 0, 0, 0); bc[1] = __builtin_amdgcn_mfma_f32_16x16x32_bf16(gfl[0], tri16, bc[1], 0, 0, 0);
            bc[2] = __builtin_amdgcn_mfma_f32_16x16x32_bf16(gfh[0], ones, bc[2], 0, 0, 0);  bc[2] = __builtin_amdgcn_mfma_f32_16x16x32_bf16(gfl[0], ones, bc[2], 0, 0, 0);
            bc[2] = __builtin_amdgcn_mfma_f32_16x16x32_bf16(gfh[1], tri0, bc[2], 0, 0, 0);  bc[2] = __builtin_amdgcn_mfma_f32_16x16x32_bf16(gfl[1], tri0, bc[2], 0, 0, 0);
            bc[3] = __builtin_amdgcn_mfma_f32_16x16x32_bf16(gfh[0], ones, bc[3], 0, 0, 0);  bc[3] = __builtin_amdgcn_mfma_f32_16x16x32_bf16(gfl[0], ones, bc[3], 0, 0, 0);
            bc[3] = __builtin_amdgcn_mfma_f32_16x16x32_bf16(gfh[1], tri16, bc[3], 0, 0, 0); bc[3] = __builtin_amdgcn_mfma_f32_16x16x32_bf16(gfl[1], tri16, bc[3], 0, 0, 0);
        }
        {
            f32x4 dec;
#pragma unroll
            for (int r = 0; r < 4; ++r) dec[r] = fexp2(__shfl(bc[3][r], (lane & 48) | 15));
            if (fr == 0) *(f32x4*)(GDEC + (size_t)unit * 128 + 16 * w + 4 * g) = dec;
#pragma unroll
            for (int ct = 0; ct < 4; ++ct) {
                const int off = (16 * ct + fr) * 272 + (16 * w + 4 * g) * 2;
                const u32x2 qh = *(const LAS u32x2*)(L + PA_QH + off), kh = *(const LAS u32x2*)(L + PA_KH + off);
                const float qv[4] = {bflo(qh.x), bfhi(qh.x), bflo(qh.y), bfhi(qh.y)}, kv[4] = {bflo(kh.x), bfhi(kh.x), bflo(kh.y), bfhi(kh.y)};
                float qd[4], ki[4], ks[4];
#pragma unroll
                for (int r = 0; r < 4; ++r) { const float e1 = fexp2(bc[ct][r]), e2 = fexp2(-bc[ct][r]); qd[r] = qv[r] * e1; ki[r] = kv[r] * e2; ks[r] = ki[r] * dec[r]; }
                *(LAS u32x2*)(L + PA_QH + off) = (u32x2){pk2(qd[0], qd[1]), pk2(qd[2], qd[3])};
                *(LAS u32x2*)(L + PA_KH + off) = (u32x2){pk2(ki[0], ki[1]), pk2(ki[2], ki[3])};
                *(LAS u32x2*)(L + PA_GH + off) = (u32x2){pk2(ks[0], ks[1]), pk2(ks[2], ks[3])};
            }
        }
        LDS_BARRIER();
#pragma unroll
        for (int i = 0; i < 2; ++i) { const int c = sc0 + 32 * i; *(u32x4*)(GQD + ((size_t)unit * 64 + c) * 128 + sch * 8) = *(const LAS u32x4*)(L + PA_QH + c * 272 + sch * 16); }
        {
            const int ci = w >> 1;
#pragma unroll
            for (int q = 0; q < 2; ++q) { const int si = 2 * (w & 1) + q;
                if (si <= ci) {
                    f32x4 d = (f32x4){0.f, 0.f, 0.f, 0.f};
#pragma unroll
                    for (int ks = 0; ks < 4; ++ks) {
                        const bf16x8 a = *(const LAS bf16x8*)(L + PA_KH + (16 * si + fr) * 272 + ks * 64 + g * 16);
                        const bf16x8 bb = *(const LAS bf16x8*)(L + PA_QH + (16 * ci + fr) * 272 + ks * 64 + g * 16);
                        d = __builtin_amdgcn_mfma_f32_16x16x32_bf16(a, bb, d, 0, 0, 0);
                    }
                    const int c = 16 * ci + fr, s0 = 16 * si + 4 * g;
#pragma unroll
                    for (int r = 0; r < 4; ++r) if (s0 + r > c) d[r] = 0.f;
                    *(LAS u32x2*)(L + PA_GL + c * 144 + s0 * 2) = (u32x2){pk2(d[0], d[1]), pk2(d[2], d[3])};
                } else {
                    const int c = 16 * ci + fr, s0 = 16 * si + 4 * g;
                    *(LAS u32x2*)(L + PA_GL + c * 144 + s0 * 2) = (u32x2){0u, 0u};
                }
            }
        }
        LDS_BARRIER();
        {
            const int j0 = 16 * w;
            bf16x8 vfrag[2];
#pragma unroll
            for (int ks = 0; ks < 2; ++ks) vfrag[ks] = pa_trfrag(L + PA_V + (32 * ks) * 272 + j0 * 2 + trl);
#pragma unroll
            for (int ct = 0; ct < 4; ++ct) {
                f32x4 o = (f32x4){0.f, 0.f, 0.f, 0.f};
#pragma unroll
                for (int ks = 0; ks < 2; ++ks) if (32 * ks <= 16 * ct + 15) {
                    const bf16x8 sc = *(const LAS bf16x8*)(L + PA_GL + (16 * ct + fr) * 144 + ks * 64 + g * 16);
                    o = __builtin_amdgcn_mfma_f32_16x16x32_bf16(vfrag[ks], sc, o, 0, 0, 0);
                }
                *(u32x2*)(GOI + ((size_t)unit * 64 + 16 * ct + fr) * 128 + j0 + 4 * g) = (u32x2){pk2(o[0], o[1]), pk2(o[2], o[3])};
            }
            unsigned uw[8];
#pragma unroll
            for (int kt = 0; kt < 8; ++kt) {
                f32x4 acc = (f32x4){0.f, 0.f, 0.f, 0.f};
#pragma unroll
                for (int cs = 0; cs < 2; ++cs) {
                    const bf16x8 a = pa_trfrag(L + PA_GH + (32 * cs) * 272 + (16 * kt) * 2 + trl);
                    acc = __builtin_amdgcn_mfma_f32_16x16x32_bf16(a, vfrag[cs], acc, 0, 0, 0);
                }
                uw[kt] = pk4_fp8s(acc[0] * HG_US, acc[1] * HG_US, acc[2] * HG_US, acc[3] * HG_US);
            }
            u32x4* up = (u32x4*)(GU + (((size_t)unit * 8 + w) * 64 + lane) * 32);
#pragma unroll
            for (int q = 0; q < 2; ++q) up[q] = (u32x4){uw[4 * q], uw[4 * q + 1], uw[4 * q + 2], uw[4 * q + 3]};
        }
        LDS_BARRIER();
    }
}

constexpr int HC_QD = 0;
constexpr int HC_DEC = 26112;
constexpr int HC_OT = 27648;
constexpr int HC_NG = 44544;
struct HcSet { u32x4 qp; float dp; u32x4 ur[2], oi, og; };
struct HcCtx { __amdgpu_buffer_rsrc_t rQD, rOI, rU, rDEC, rPR; bf16_t* MIX; unsigned vQD, vOI, vU, vDEC, vPR; int bh, b, h, r0, sc0, sch, c5, sub, fr, g, j0, tid, lane, w; };
__device__ __forceinline__ void abl16(u32x4& d, unsigned voff, __amdgpu_buffer_rsrc_t r, unsigned soff) { asm volatile("buffer_load_dwordx4 %0, %1, %2, %3 offen" : "=v"(d) : "v"(voff), "s"(r), "s"(soff) : "memory"); }
__device__ __forceinline__ void abl4(float& d, unsigned voff, __amdgpu_buffer_rsrc_t r, unsigned soff) { asm volatile("buffer_load_dword %0, %1, %2, %3 offen" : "=v"(d) : "v"(voff), "s"(r), "s"(soff) : "memory"); }
__device__ __forceinline__ void hc_load(const HcCtx& C, HcSet& d, int n) {
    const unsigned unit = (unsigned)(C.bh * 64 + n);
    abl16(d.qp, C.vQD, C.rQD, unit * 16384u);
    if (C.w < 2) abl4(d.dp, C.vDEC, C.rDEC, unit * 512u);
    abl16(d.ur[0], C.vU, C.rU, unit * 16384u); abl16(d.ur[1], C.vU + 16u, C.rU, unit * 16384u);
    abl16(d.oi, C.vOI, C.rOI, unit * 16384u);
    { const unsigned so = (unsigned)((C.b * SEQ + n * 64) * AW * 2); abl16(d.og, C.vPR, C.rPR, so); }
}
#define HC_PIN(d) "+v"((d).qp), "+v"((d).dp), "+v"((d).ur[0]), "+v"((d).ur[1]), "+v"((d).oi), "+v"((d).og)
__device__ __forceinline__ void hc_stage(const HcCtx& C, LAS unsigned char* L, const HcSet& d, int slot) {
    *(LAS u32x4*)(L + HC_QD + slot * 8704 + C.sc0 * 272 + C.sch * 16) = d.qp;
    if (C.w < 2) *(LAS float*)(L + HC_DEC + slot * 512 + C.tid * 4) = d.dp;
}
__device__ __forceinline__ void hc_step(const HcCtx& C, LAS unsigned char* L, f32x4 (&S)[8], int n, HcSet& cur, HcSet& nxt, HcSet& nx2, int slot, int slot_nxt) {
    if (n >= 64) return;
    if (n + 2 < 64) { hc_load(C, nx2, n + 2); asm volatile("s_waitcnt vmcnt(12)" : HC_PIN(cur)); }
    else asm volatile("s_waitcnt vmcnt(0)" : HC_PIN(cur));
    const int fr = C.fr, g = C.g, j0 = C.j0;
    {
        f32x4 o[2];
#pragma unroll
        for (int ct = 0; ct < 2; ++ct) o[ct] = (f32x4){0.f, 0.f, 0.f, 0.f};
#pragma unroll
        for (int ks = 0; ks < 4; ++ks) {
            u32x4 sa; sa.x = pk2(S[2 * ks][0], S[2 * ks][1]); sa.y = pk2(S[2 * ks][2], S[2 * ks][3]); sa.z = pk2(S[2 * ks + 1][0], S[2 * ks + 1][1]); sa.w = pk2(S[2 * ks + 1][2], S[2 * ks + 1][3]);
            const bf16x8 sfrag = __builtin_bit_cast(bf16x8, sa);
#pragma unroll
            for (int ct = 0; ct < 2; ++ct) {
                const u32x2 q0 = *(const LAS u32x2*)(L + HC_QD + slot * 8704 + (16 * ct + fr) * 272 + (32 * ks + 4 * g) * 2);
                const u32x2 q1 = *(const LAS u32x2*)(L + HC_QD + slot * 8704 + (16 * ct + fr) * 272 + (32 * ks + 16 + 4 * g) * 2);
                const bf16x8 qf = __builtin_bit_cast(bf16x8, (u32x4){q0.x, q0.y, q1.x, q1.y});
                o[ct] = __builtin_amdgcn_mfma_f32_16x16x32_bf16(sfrag, qf, o[ct], 0, 0, 0);
            }
        }
#pragma unroll
        for (int ct = 0; ct < 2; ++ct) *(LAS f32x4*)(L + HC_OT + (16 * ct + fr) * 528 + (j0 + 4 * g) * 4) = o[ct];
#pragma unroll
        for (int kt = 0; kt < 8; ++kt) {
            const f32x4 dc = *(const LAS f32x4*)(L + HC_DEC + slot * 512 + (16 * kt + 4 * g) * 4);
            const unsigned uu = (kt & 3) == 0 ? cur.ur[kt >> 2].x : (kt & 3) == 1 ? cur.ur[kt >> 2].y : (kt & 3) == 2 ? cur.ur[kt >> 2].z : cur.ur[kt >> 2].w;
            const f32x2 ulo = __builtin_amdgcn_cvt_pk_f32_fp8((int)uu, false), uhi = __builtin_amdgcn_cvt_pk_f32_fp8((int)uu, true);
            S[kt] = S[kt] * dc + (f32x4){ulo.x, ulo.y, uhi.x, uhi.y} * (1.0f / HG_US);
        }
    }
    LDS_BARRIER();
    {
        f32x4 ov[2]; float ss = 0.f;
        const unsigned oiw[4] = {cur.oi.x, cur.oi.y, cur.oi.z, cur.oi.w};
#pragma unroll
        for (int j = 0; j < 2; ++j) { ov[j] = *(const LAS f32x4*)(L + HC_OT + C.c5 * 528 + (8 * C.sub + 4 * j) * 4);
            ov[j] = ov[j] + (f32x4){bflo(oiw[2 * j]), bfhi(oiw[2 * j]), bflo(oiw[2 * j + 1]), bfhi(oiw[2 * j + 1])};
            ss += (ov[j].x * ov[j].x + ov[j].y * ov[j].y) + (ov[j].z * ov[j].z + ov[j].w * ov[j].w); }
        ss += swz_xor<1>(ss); ss += swz_xor<2>(ss); ss += swz_xor<4>(ss); ss += swz_xor<8>(ss);
        const float rs = frsq(ss * (1.f / 128.f) + RMS_EPS);
        const unsigned ogw[4] = {cur.og.x, cur.og.y, cur.og.z, cur.og.w};
        float r[8]; f32x4 ngv[2];
#pragma unroll
        for (int j = 0; j < 2; ++j) ngv[j] = *(const LAS f32x4*)(L + HC_NG + (8 * C.sub + 4 * j) * 4);
#pragma unroll
        for (int j = 0; j < 2; ++j)
#pragma unroll
            for (int e = 0; e < 4; ++e) { const unsigned wv = ogw[2 * j + (e >> 1)]; const float gg = (e & 1) ? bfhi(wv) : bflo(wv); r[4 * j + e] = ov[j][e] * rs * ngv[j][e] * gg * sigmoidf_(gg); }
        bf16_t* op = C.MIX + (size_t)(n * 64 + C.r0 + C.c5) * DM + C.h * 128 + 8 * C.sub;
        *(u32x4*)op = (u32x4){pk2(r[0], r[1]), pk2(r[2], r[3]), pk2(r[4], r[5]), pk2(r[6], r[7])};
    }
    if (n + 1 < 64) {
        if (n + 2 < 64) asm volatile("s_waitcnt vmcnt(7)" : HC_PIN(nxt)); else asm volatile("s_waitcnt vmcnt(0)" : HC_PIN(nxt));
        hc_stage(C, L, nxt, slot_nxt);
    }
    LDS_BARRIER();
}
__device__ __forceinline__ void hgrn_chain(const Frame& F, const Ptrs& P, int wgi) {
    HcCtx C;
    const int bh = wgi >> 1; const int b = bh / 6; C.bh = bh; C.b = b; C.h = bh % 6; C.r0 = 32 * (wgi & 1);
    C.tid = F.tid; C.lane = F.lane; C.w = F.wave;
    LAS unsigned char* L = F.lds;
    C.MIX = (bf16_t*)(P.ws + WS_MIX) + (size_t)b * SEQ * DM;
    C.rQD = __builtin_amdgcn_make_buffer_rsrc(P.ws + WS_HGQD, 0, 3072 * 16384, 0x00020000);
    C.rOI = __builtin_amdgcn_make_buffer_rsrc(P.ws + WS_HGOI, 0, 3072 * 16384, 0x00020000);
    C.rU = __builtin_amdgcn_make_buffer_rsrc(P.ws + WS_HGU, 0, 3072 * 16384, 0x00020000);
    C.rDEC = __builtin_amdgcn_make_buffer_rsrc(P.ws + WS_HGDEC, 0, 3072 * 512, 0x00020000);
    C.rPR = __builtin_amdgcn_make_buffer_rsrc(P.ws + WS_R1, 0, MTOK * AW * 2, 0x00020000);
    C.sc0 = C.tid >> 4; C.sch = C.tid & 15; C.c5 = C.tid >> 4; C.sub = C.tid & 15;
    C.fr = C.lane & 15; C.g = C.lane >> 4; C.j0 = 16 * C.w;
    C.vQD = (unsigned)(((C.r0 + C.sc0) * 128 + C.sch * 8) * 2); C.vOI = (unsigned)(((C.r0 + C.c5) * 128 + 8 * C.sub) * 2); C.vU = (unsigned)((C.w * 64 + C.lane) * 32); C.vDEC = (unsigned)(C.tid * 4);
    C.vPR = (unsigned)(((C.r0 + C.c5) * AW + 2304 + C.h * 128 + 8 * C.sub) * 2);
    if (C.tid < 128) *(LAS float*)(L + HC_NG + C.tid * 4) = P.hon[C.tid];
    f32x4 S[8];
#pragma unroll
    for (int kt = 0; kt < 8; ++kt) S[kt] = (f32x4){0.f, 0.f, 0.f, 0.f};
    HcSet d0, d1, d2;
    d0.dp = d1.dp = d2.dp = 0.f;
    d0.qp = d1.qp = d2.qp = (u32x4){0u, 0u, 0u, 0u};
    VM_WAIT();
    hc_load(C, d0, 0); hc_load(C, d1, 1);
    asm volatile("s_waitcnt vmcnt(5)" : HC_PIN(d0));
    hc_stage(C, L, d0, 0);
    LDS_BARRIER();
    for (int n = 0; n < 66; n += 6) {
        hc_step(C, L, S, n, d0, d1, d2, 0, 1);
        hc_step(C, L, S, n + 1, d1, d2, d0, 1, 2);
        hc_step(C, L, S, n + 2, d2, d0, d1, 2, 0);
        hc_step(C, L, S, n + 3, d0, d1, d2, 0, 1);
        hc_step(C, L, S, n + 4, d1, d2, d0, 1, 2);
        hc_step(C, L, S, n + 5, d2, d0, d1, 2, 0);
        asm volatile("s_waitcnt vmcnt(0)" : HC_PIN(d0), HC_PIN(d1), HC_PIN(d2));
    }
    VM_WAIT();
}

constexpr int MA_K = 0;
constexpr int MA_VT = 36864;
__device__ __forceinline__ void memattn_unit(const Frame& F, const bf16_t* Q, int qpitch, int qcol, const bf16_t* MKV, int kvcol, bf16_t* MIXo, int unit) {
    const int tb = unit >> 2, mh = unit & 3, b = tb >> 4;
    const int tid = F.tid, lane = F.lane, w = F.wave, r32 = lane & 31, hi = lane >> 5;
    LAS unsigned char* L = F.lds;
#pragma unroll
    for (int i = 0; i < 4; ++i) { const int p = tid + 512 * i, key = p >> 3, chn = p & 7;
        const bf16_t* src = MKV + (size_t)(b * MEML + key) * DM + kvcol + mh * 64 + chn * 8;
        const u32x4 kk = *(const u32x4*)src; const u32x4 vv = *(const u32x4*)(src + 256);
        *(LAS u32x4*)(L + MA_K + key * 144 + chn * 16) = kk;
        const unsigned vw[4] = {vv.x, vv.y, vv.z, vv.w};
#pragma unroll
        for (int e = 0; e < 4; ++e) { *(LAS unsigned short*)(L + MA_VT + (chn * 8 + 2 * e) * 520 + key * 2) = (unsigned short)(vw[e] & 0xffffu);
            *(LAS unsigned short*)(L + MA_VT + (chn * 8 + 2 * e + 1) * 520 + key * 2) = (unsigned short)(vw[e] >> 16); } }
    const int tok0 = tb * 256 + w * 32;
    bf16x8 qr[4];
#pragma unroll
    for (int s = 0; s < 4; ++s) qr[s] = *(const bf16x8*)(Q + (size_t)(tok0 + r32) * qpitch + qcol + mh * 64 + 16 * s + 8 * hi);
    LDS_BARRIER();
    f32x16 p[8];
#pragma unroll
    for (int kt = 0; kt < 8; ++kt) { p[kt] = f32x16{};
#pragma unroll
        for (int s = 0; s < 4; ++s) { const bf16x8 a = *(const LAS bf16x8*)(L + MA_K + (32 * kt + r32) * 144 + s * 32 + hi * 16);
            p[kt] = __builtin_amdgcn_mfma_f32_32x32x16_bf16(a, qr[s], p[kt], 0, 0, 0); } }
    float mx = -3.0e38f;
#pragma unroll
    for (int kt = 0; kt < 8; ++kt)
#pragma unroll
        for (int r = 0; r < 16; ++r) mx = fmaxf(mx, p[kt][r]);
    mx = fmaxf(mx, __shfl_xor(mx, 32));
    float sum = 0.f;
#pragma unroll
    for (int kt = 0; kt < 8; ++kt)
#pragma unroll
        for (int r = 0; r < 16; ++r) { p[kt][r] = fexp2(p[kt][r] - mx); sum += p[kt][r]; }
    sum += __shfl_xor(sum, 32);
    const float inv = frcp(sum);
    f32x16 o[2]; o[0] = f32x16{}; o[1] = f32x16{};
#pragma unroll
    for (int kt = 0; kt < 8; ++kt)
#pragma unroll
        for (int s2 = 0; s2 < 2; ++s2) {
            u32x4 pw; pw.x = pk2(p[kt][8 * s2 + 0] * inv, p[kt][8 * s2 + 1] * inv); pw.y = pk2(p[kt][8 * s2 + 2] * inv, p[kt][8 * s2 + 3] * inv);
            pw.z = pk2(p[kt][8 * s2 + 4] * inv, p[kt][8 * s2 + 5] * inv); pw.w = pk2(p[kt][8 * s2 + 6] * inv, p[kt][8 * s2 + 7] * inv);
            const bf16x8 pa = __builtin_bit_cast(bf16x8, pw);
#pragma unroll
            for (int dt = 0; dt < 2; ++dt) {
                const u32x2 v0 = *(const LAS u32x2*)(L + MA_VT + (32 * dt + r32) * 520 + (32 * kt + 16 * s2 + 4 * hi) * 2);
                const u32x2 v1 = *(const LAS u32x2*)(L + MA_VT + (32 * dt + r32) * 520 + (32 * kt + 16 * s2 + 8 + 4 * hi) * 2);
                const bf16x8 vb = __builtin_bit_cast(bf16x8, (u32x4){v0.x, v0.y, v1.x, v1.y});
                o[dt] = __builtin_amdgcn_mfma_f32_32x32x16_bf16(pa, vb, o[dt], 0, 0, 0);
            }
        }
#pragma unroll
    for (int dt = 0; dt < 2; ++dt)
#pragma unroll
        for (int r = 0; r < 16; ++r) MIXo[(size_t)(tok0 + crow(r, hi)) * DM + 768 + mh * 64 + 32 * dt + r32] = (bf16_t)f2bf(o[dt][r]);
    LDS_BARRIER();
}

constexpr int SB_SLOT = 19456;
constexpr int SB_VOFF = 9216;
constexpr int SB_NSLOT = 6;
constexpr int SB_FLAG = SB_NSLOT * SB_SLOT;
__device__ __forceinline__ int sb_unit_of(int L) { return (L >> 4) * 16 + (15 - (L & 15)); }
__device__ __forceinline__ void sb_prefetch_q(const Frame& F, const bf16_t* KVQ, int unit, bf16x8 (&q)[4]) {
    const int qb = unit & 15, hh = (unit >> 4) % 12, b = unit / 192;
    const int r32 = F.lane & 31, hi = F.lane >> 5;
    const bf16_t* base = KVQ + (size_t)b * SEQ * KVQW;
    const int tq = qb * 256 + F.wave * 32 + r32;
#pragma unroll
    for (int s = 0; s < 4; ++s) q[s] = *(const bf16x8*)(base + (size_t)tq * KVQW + 1536 + hh * 64 + 16 * s + 8 * hi);
}
__device__ __forceinline__ int sb_unit(const Frame& F, const bf16_t* KVQ, bf16_t* MIXo, int unit, const bf16x8 (&qpre)[4], int have_lo, int have_hi) {
    const int qb = unit & 15, hh = (unit >> 4) % 12, b = unit / 192;
    const int tid = F.tid, lane = F.lane, w = F.wave, r32 = lane & 31, hi = lane >> 5;
    LAS unsigned char* L = F.lds;
    const bf16_t* base = KVQ + (size_t)b * SEQ * KVQW;
    const int q0 = qb * 256 + w * 32;
    const int tq = q0 + r32;
    bf16x8 qr[4];
#pragma unroll
    for (int s = 0; s < 4; ++s) qr[s] = qpre[s];
    bf16x8 tri[2], ones;
#pragma unroll
    for (int s2 = 0; s2 < 2; ++s2)
#pragma unroll
        for (int j = 0; j < 8; ++j) { const int k = 16 * s2 + 8 * (j >> 2) + 4 * hi + (j & 3); tri[s2][j] = (k > r32) ? (short)0x3F80 : (short)0; }
#pragma unroll
    for (int j = 0; j < 8; ++j) ones[j] = (short)0x3F80;
    f32x16 o[2]; o[0] = f32x16{}; o[1] = f32x16{};
    float R = 0.f;
    const int skey = tid >> 3, schn = tid & 7;
    const bf16_t* srcb = base + (size_t)skey * KVQW + hh * 64 + schn * 8;
    const int kwr = skey * 144 + schn * 16, vwr = SB_VOFF + skey * 160 + schn * 16;
    const int vlane = SB_VOFF + (4 * hi + ((lane & 15) >> 2)) * 160 + ((lane >> 4) & 1) * 32 + (lane & 3) * 8;
    {
        u32x4 kk[4], vv[4];
#pragma unroll
        for (int i = 0; i < 4; ++i) { const int tt = 4 * qb + i; if (tt < have_lo || tt > have_hi) { const bf16_t* src = srcb + (size_t)(tt * 64) * KVQW; kk[i] = *(const u32x4*)src; vv[i] = *(const u32x4*)(src + 768); } }
#pragma unroll
        for (int i = 0; i < 4; ++i) { const int tt = 4 * qb + i; if (tt < have_lo || tt > have_hi) { const int sl = tt % SB_NSLOT; *(LAS u32x4*)(L + sl * SB_SLOT + kwr) = kk[i]; *(LAS u32x4*)(L + sl * SB_SLOT + vwr) = vv[i]; } }
    }
    LDS_BARRIER();
    const int jd = 4 * qb + (w >> 1);
    int slot = jd % SB_NSLOT;
    int pslot = (4 * qb + SB_NSLOT - 1) % SB_NSLOT;
    bool mydone = false;
    int lo_loaded = (have_lo <= have_hi && have_lo < 4 * qb) ? have_lo : 4 * qb;
    for (int st = 0; ; ++st) {
        const int tpre = 4 * qb - st - 1;
        u32x4 kreg, vreg;
        const bool need_pre = tpre >= 0 && (tpre < have_lo || tpre > have_hi);
        if (need_pre) { const bf16_t* src = srcb + (size_t)(tpre * 64) * KVQW; kreg = *(const u32x4*)src; vreg = *(const u32x4*)(src + 768); }
        const int t = jd - st;
        if (t >= 0 && !mydone) {
            const int k0 = 64 * t;
            const LAS unsigned char* Kb = L + slot * SB_SLOT;
            f32x16 p0 = f32x16{}, p1 = f32x16{};
#pragma unroll
            for (int s = 0; s < 4; ++s) {
                const bf16x8 a0 = *(const LAS bf16x8*)(Kb + r32 * 144 + s * 32 + hi * 16);
                const bf16x8 a1 = *(const LAS bf16x8*)(Kb + (32 + r32) * 144 + s * 32 + hi * 16);
                p0 = __builtin_amdgcn_mfma_f32_32x32x16_bf16(a0, qr[s], p0, 0, 0, 0);
                p1 = __builtin_amdgcn_mfma_f32_32x32x16_bf16(a1, qr[s], p1, 0, 0, 0);
            }
            float l0[16], l1[16];
            float csum = 0.f;
#pragma unroll
            for (int r = 0; r < 16; ++r) {
                const float z0 = fminf(p0[r], 80.f), z1 = fminf(p1[r], 80.f);
                const float sp0 = flog2(1.0f + fexp2(z0)), sp1 = flog2(1.0f + fexp2(z1));
                float a = -sp0, bq = -sp1, lb0 = z0 - sp0, lb1 = z1 - sp1;
                if (st == 0) { const int key0 = k0 + crow(r, hi); if (key0 >= tq) { a = 0.f; lb0 = -INFINITY; } if (key0 + 32 >= tq) { bq = 0.f; lb1 = -INFINITY; } }
                l0[r] = a; l1[r] = bq; p0[r] = lb0; p1[r] = lb1; csum += a + bq;
            }
            csum += __shfl_xor(csum, 32);
            bf16x8 x0[2], x1[2];
#pragma unroll
            for (int s2 = 0; s2 < 2; ++s2) {
                u32x4 t0, t1;
                t0.x = pk2(l0[8 * s2 + 0], l0[8 * s2 + 1]); t0.y = pk2(l0[8 * s2 + 2], l0[8 * s2 + 3]); t0.z = pk2(l0[8 * s2 + 4], l0[8 * s2 + 5]); t0.w = pk2(l0[8 * s2 + 6], l0[8 * s2 + 7]);
                t1.x = pk2(l1[8 * s2 + 0], l1[8 * s2 + 1]); t1.y = pk2(l1[8 * s2 + 2], l1[8 * s2 + 3]); t1.z = pk2(l1[8 * s2 + 4], l1[8 * s2 + 5]); t1.w = pk2(l1[8 * s2 + 6], l1[8 * s2 + 7]);
                x0[s2] = __builtin_bit_cast(bf16x8, t0); x1[s2] = __builtin_bit_cast(bf16x8, t1);
            }
            f32x16 y0, y1;
#pragma unroll
            for (int r = 0; r < 16; ++r) { y0[r] = R; y1[r] = R; }
            y0 = __builtin_amdgcn_mfma_f32_32x32x16_bf16(tri[0], x0[0], y0, 0, 0, 0);
            y0 = __builtin_amdgcn_mfma_f32_32x32x16_bf16(tri[1], x0[1], y0, 0, 0, 0);
            y0 = __builtin_amdgcn_mfma_f32_32x32x16_bf16(ones, x1[0], y0, 0, 0, 0);
            y0 = __builtin_amdgcn_mfma_f32_32x32x16_bf16(ones, x1[1], y0, 0, 0, 0);
            y1 = __builtin_amdgcn_mfma_f32_32x32x16_bf16(tri[0], x1[0], y1, 0, 0, 0);
            y1 = __builtin_amdgcn_mfma_f32_32x32x16_bf16(tri[1], x1[1], y1, 0, 0, 0);
#pragma unroll
            for (int r = 0; r < 16; ++r) { p0[r] = fexp2(p0[r] + y0[r]); p1[r] = fexp2(p1[r] + y1[r]); }
            R += csum;
            const LAS unsigned char* Vl = Kb + vlane;
#pragma unroll
            for (int half = 0; half < 2; ++half)
#pragma unroll
                for (int s2 = 0; s2 < 2; ++s2) {
                    u32x4 pw;
                    if (half == 0) { pw.x = pk2(p0[8 * s2 + 0], p0[8 * s2 + 1]); pw.y = pk2(p0[8 * s2 + 2], p0[8 * s2 + 3]); pw.z = pk2(p0[8 * s2 + 4], p0[8 * s2 + 5]); pw.w = pk2(p0[8 * s2 + 6], p0[8 * s2 + 7]); }
                    else { pw.x = pk2(p1[8 * s2 + 0], p1[8 * s2 + 1]); pw.y = pk2(p1[8 * s2 + 2], p1[8 * s2 + 3]); pw.z = pk2(p1[8 * s2 + 4], p1[8 * s2 + 5]); pw.w = pk2(p1[8 * s2 + 6], p1[8 * s2 + 7]); }
                    const bf16x8 pa = __builtin_bit_cast(bf16x8, pw);
#pragma unroll
                    for (int dt = 0; dt < 2; ++dt) {
                        const int kb = 32 * half + 16 * s2;
                        const s16x4 vlo = lds_tr16(Vl + kb * 160 + dt * 64), vhi = lds_tr16(Vl + (kb + 8) * 160 + dt * 64);
                        const bf16x8 vb = (bf16x8){vlo[0], vlo[1], vlo[2], vlo[3], vhi[0], vhi[1], vhi[2], vhi[3]};
                        o[dt] = __builtin_amdgcn_mfma_f32_32x32x16_bf16(pa, vb, o[dt], 0, 0, 0);
                    }
                }
        }
        if (t <= 0 || __all(R <= -150.f) != 0) mydone = true;
        if (lane == 0) *(LAS unsigned*)(L + SB_FLAG + ((st & 1) * 8 + w) * 4) = mydone ? 1u : 0u;
        if (need_pre) { *(LAS u32x4*)(L + pslot * SB_SLOT + kwr) = kreg; *(LAS u32x4*)(L + pslot * SB_SLOT + vwr) = vreg; }
        if (tpre >= 0 && tpre < lo_loaded) lo_loaded = tpre;
        LDS_BARRIER();
        { const u32x4 f0 = *(const LAS u32x4*)(L + SB_FLAG + (st & 1) * 32), f1 = *(const LAS u32x4*)(L + SB_FLAG + (st & 1) * 32 + 16);
          if ((f0.x & f0.y & f0.z & f0.w & f1.x & f1.y & f1.z & f1.w) != 0u) break; }
        slot = (slot == 0) ? SB_NSLOT - 1 : slot - 1;
        pslot = (pslot == 0) ? SB_NSLOT - 1 : pslot - 1;
    }
#pragma unroll
    for (int dt = 0; dt < 2; ++dt)
#pragma unroll
        for (int r = 0; r < 16; ++r) MIXo[(size_t)(b * SEQ + q0 + crow(r, hi)) * DM + hh * 64 + 32 * dt + r32] = (bf16_t)f2bf(o[dt][r]);
    LDS_BARRIER();
    return lo_loaded;
}
__device__ __forceinline__ void sb_phase(const Frame& F, const bf16_t* KVQ, bf16_t* MIXo) {
    bf16x8 qa[4], qb_[4];
    const int L0 = 6 * F.bx;
    sb_prefetch_q(F, KVQ, sb_unit_of(L0), qa);
    int have_lo = 1, have_hi = 0;
    for (int j = 0; j < 6; j += 2) {
        const int Lc = L0 + j;
        sb_prefetch_q(F, KVQ, sb_unit_of(Lc + 1), qb_);
        { const int u = sb_unit_of(Lc); const int lo = sb_unit(F, KVQ, MIXo, u, qa, have_lo, have_hi);
          if (((Lc + 1) >> 4) == (Lc >> 4)) { have_lo = lo; have_hi = lo + SB_NSLOT - 1; } else { have_lo = 1; have_hi = 0; } }
        if (j + 2 < 6) sb_prefetch_q(F, KVQ, sb_unit_of(Lc + 2), qa);
        { const int u = sb_unit_of(Lc + 1); const int lo = sb_unit(F, KVQ, MIXo, u, qb_, have_lo, have_hi);
          if (((Lc + 2) >> 4) == ((Lc + 1) >> 4)) { have_lo = lo; have_hi = lo + SB_NSLOT - 1; } else { have_lo = 1; have_hi = 0; } }
    }
}

struct Args { const float* in[20]; float* out; unsigned char* ws; };

__global__ void __launch_bounds__(NTHR, 2) yoco_fwd(Args args) {
    extern __shared__ __attribute__((aligned(16))) unsigned char lds_raw[];
    Frame F;
    F.lds = (LAS unsigned char*)lds_raw;
    F.tid = threadIdx.x; F.lane = F.tid & 63; F.wave = __builtin_amdgcn_readfirstlane(F.tid >> 6);
    F.G = gridDim.x; F.bx = blockIdx.x;
    Ptrs P;
    P.x = args.in[0]; P.mem = args.in[1]; P.anpre = args.in[2]; P.anpost = args.in[3]; P.fnpre = args.in[4]; P.fnpost = args.in[5];
    P.w_in_a = args.in[6]; P.hlb = args.in[7]; P.hon = args.in[8]; P.w_in_b = args.in[9]; P.kvn = args.in[10]; P.w_kv = args.in[11];
    P.memn = args.in[12]; P.w_mem_kv = args.in[13]; P.w_out = args.in[14]; P.w_gu = args.in[15]; P.w_dn = args.in[16]; P.w_router = args.in[17];
    P.w_egu = args.in[18]; P.w_edn = args.in[19]; P.out = args.out; P.ws = args.ws;
    unsigned char* ws = args.ws;
    unsigned* ctl = (unsigned*)(ws + WS_CTL);
    volatile LAS unsigned* MISC = (volatile LAS unsigned*)(F.lds + MISC_OFF);
    for (int u = F.tid; u < (LDS_BYTES - LDSCTL_OFF) / 4; u += NTHR) ((LAS unsigned*)(F.lds + LDSCTL_OFF))[u] = 0u;
    __syncthreads();
    XcdBarrier bar = xcd_barrier_post(ctl + CW_BAR, MISC + 8);
    {
        if (F.tid == 0) { const unsigned xcc = xb_xcc_id(); const unsigned rk = xb_add((unsigned*)ctl + CW_XRANK + xcc, 1u); MISC[12] = (xcc < 8u && rk < (unsigned)(F.G >> 3) && (F.G & 7) == 0) ? rk * 8u + xcc : 0xffffffffu; }
        __syncthreads();
        if (F.tid == 0 && MISC[12] == 0xffffffffu) __hip_atomic_store((unsigned*)ctl + CW_XRANK + 15, 1u, __ATOMIC_RELAXED, __HIP_MEMORY_SCOPE_AGENT);
    }
#define GRID_BAR() xcd_barrier(bar)

    bf16_t* const U = (bf16_t*)(ws + WS_U);
    bf16_t* const R1 = (bf16_t*)(ws + WS_R1);
    bf16_t* const MIX = (bf16_t*)(ws + WS_MIX);
    bf16_t* const MIXED = (bf16_t*)(ws + WS_MIXED);
    bf16_t* const MKV = (bf16_t*)(ws + WS_MKV);
    bf16_t* const H16 = (bf16_t*)(ws + WS_H16);

    { const Frame Fp = phase_frame(F); p0_prologue(Fp, P); }
    GRID_BAR();
    if (__hip_atomic_load((unsigned*)ctl + CW_XRANK + 15, __ATOMIC_RELAXED, __HIP_MEMORY_SCOPE_AGENT) == 0u) F.bx = (int)MISC[12];
    {
        pg8::Gemm g{U, (const bf16_t*)(ws + WS_WINA), MTOK, AW, DM / 2}; pg8::StaticOrder S; S.init(MTOK, AW, F.G, F.bx);
        S.ext_n = 32; S.ext_pm0 = MTOK / 256; S.ext_pn0 = AW / 256;
        pg8::EpiStoreQ E{R1, AW, (const float*)(ws + WS_AS), (const float*)(ws + WS_WSC) + WSC_INA, MKV, DM, MTOK / 256, AW / 256};
        pg8::gemm_phase<pg8::EpiStoreQ, pg8::StaticOrder, true, true, 2>(F.lds, g, S, E);
    }
    GRID_BAR();
    { const Frame Fp = phase_frame(F); hgrnA_phase(Fp, P); }
    { const Frame Fp = phase_frame(F); for (int u = F.bx; u < 512; u += F.G) memattn_unit(Fp, R1, AW, 3072, MKV, 0, MIX, u); }
    GRID_BAR();
    { const Frame Fp = phase_frame(F); if (F.bx < 96) hgrn_chain(Fp, P, ((((F.bx >> 4) << 3) | (F.bx & 7)) << 1) | ((F.bx >> 3) & 1));
      else convert_weights(Fp, P, (F.bx - 96) * NWAVES + Fp.wave, (F.G - 96) * NWAVES); }
    GRID_BAR();
    {
        pg8::Gemm g{MIX, (const bf16_t*)(ws + WS_WOUT0), MTOK, DM, DM}; pg8::StaticOrder S; S.init(MTOK, DM, F.G, F.bx);
        pg8::EpiStore E{MIXED, DM, 1.f, nullptr, 0, 0, 0};
        pg8::gemm_phase<pg8::EpiStore, pg8::StaticOrder, true, true>(F.lds, g, S, E);
    }
    GRID_BAR();
    { const Frame Fp = phase_frame(F); norm_phase<false, true>(Fp, MIXED, P.x, H16, P.anpost, U, P.fnpre, (float*)(ws + WS_AS + 256 * 1024)); }
#if STOP_AFTER >= 5
    GRID_BAR();
    {
        pg8::Gemm g{U, (const bf16_t*)(ws + WS_WGU), MTOK, 2 * DFF, DM / 2}; pg8::StaticOrder S; S.init(MTOK, 2 * DFF, F.G, F.bx);
        pg8::EpiSwiGLUQ E{R1, DFF, (const float*)(ws + WS_AS + 256 * 1024), (const float*)(ws + WS_WSC) + WSC_GU};
        pg8::gemm_phase<pg8::EpiSwiGLUQ, pg8::StaticOrder, true, true, 2>(F.lds, g, S, E);
    }
    GRID_BAR();
    {
        pg8::Gemm g{R1, (const bf16_t*)(ws + WS_WDN), MTOK, DM, DFF}; pg8::StaticOrder S; S.init(MTOK, DM, F.G, F.bx);
        pg8::EpiStore E{MIXED, DM, 1.f, nullptr, 0, 0, 0};
        pg8::gemm_phase<pg8::EpiStore, pg8::StaticOrder, true, true>(F.lds, g, S, E);
    }
    GRID_BAR();
    { const Frame Fp = phase_frame(F); norm_phase<true, true>(Fp, MIXED, H16, H16, P.fnpost, U, nullptr, (float*)(ws + WS_AS + 512 * 1024)); }
#endif
#if STOP_AFTER >= 8
    GRID_BAR();
    {
        pg8::Gemm g{U, (const bf16_t*)(ws + WS_WKVB), MTOK, KVQW, DM / 2}; pg8::StaticOrder S; S.init(MTOK, KVQW, F.G, F.bx);
        pg8::EpiStoreQ E{R1, KVQW, (const float*)(ws + WS_AS + 512 * 1024), (const float*)(ws + WS_WSC) + WSC_KVB, nullptr, 0, 0, 0};
        pg8::gemm_phase<pg8::EpiStoreQ, pg8::StaticOrder, true, true, 2>(F.lds, g, S, E);
    }
    GRID_BAR();
    {
        { const Frame Fp = phase_frame(F); sb_phase(Fp, R1, MIX); }
        { const Frame Fp = phase_frame(F); for (int u = F.bx; u < 512; u += F.G) memattn_unit(Fp, R1, KVQW, 2304, MKV, 512, MIX, u); }
    }
    GRID_BAR();
    {
        pg8::Gemm g{MIX, (const bf16_t*)(ws + WS_WOUT1), MTOK, DM, DM}; pg8::StaticOrder S; S.init(MTOK, DM, F.G, F.bx);
        pg8::EpiStore E{MIXED, DM, 1.f, nullptr, 0, 0, 0};
        pg8::gemm_phase<pg8::EpiStore, pg8::StaticOrder, true, true>(F.lds, g, S, E);
    }
    GRID_BAR();
    {
        const Frame Fq = phase_frame(F);
        LAS unsigned* lcnt = (LAS unsigned*)(F.lds + 32768);
        LAS float* WRt = (LAS float*)(F.lds);
        if (Fq.tid < 8) lcnt[Fq.tid] = 0u;
        for (int idx = Fq.tid; idx < DM * NEXP; idx += NTHR) WRt[(idx & 7) * DM + (idx >> 3)] = P.w_router[idx];
        __syncthreads();
        const float* g1 = P.anpost + DM; const float* g2 = P.fnpre + DM;
        for (int i0 = 0; i0 < 16; i0 += 4) {
          const int m0 = F.bx * 128 + Fq.wave * 16 + i0;
          u32x2 ar[4][4], bs[4][4];
#pragma unroll
          for (int r = 0; r < 4; ++r)
#pragma unroll
            for (int j = 0; j < 4; ++j) { ar[r][j] = ((const u32x2*)(MIXED + (size_t)(m0 + r) * DM))[Fq.lane + 64 * j]; bs[r][j] = ((const u32x2*)(H16 + (size_t)(m0 + r) * DM))[Fq.lane + 64 * j]; }
#pragma unroll
          for (int r = 0; r < 4; ++r) {
            const int m = m0 + r;
            f32x4 a[4];
#pragma unroll
            for (int j = 0; j < 4; ++j) a[j] = (f32x4){bflo(ar[r][j].x), bfhi(ar[r][j].x), bflo(ar[r][j].y), bfhi(ar[r][j].y)};
            const float rs = row_rstd(a);
            f32x4 h[4];
#pragma unroll
            for (int j = 0; j < 4; ++j) { const f32x4 gg = ((const f32x4*)g1)[Fq.lane + 64 * j];
                h[j] = (f32x4){bflo(bs[r][j].x), bfhi(bs[r][j].x), bflo(bs[r][j].y), bfhi(bs[r][j].y)} + a[j] * rs * gg;
                u32x2 hw; hw.x = pk2(h[j].x, h[j].y); hw.y = pk2(h[j].z, h[j].w); ((u32x2*)(H16 + (size_t)m * DM))[Fq.lane + 64 * j] = hw; }
            const float rh = row_rstd(h);
            unsigned* o4 = (unsigned*)((unsigned char*)U + (size_t)m * DM) + Fq.lane;
            float lg[8];
#pragma unroll
            for (int e = 0; e < 8; ++e) lg[e] = 0.f;
#pragma unroll
            for (int j = 0; j < 4; ++j) { const f32x4 gg = ((const f32x4*)g2)[Fq.lane + 64 * j];
                const f32x4 uu = h[j] * rh * gg;
                o4[64 * j] = pk4_fp8s(uu.x * FP8_SX, uu.y * FP8_SX, uu.z * FP8_SX, uu.w * FP8_SX);
#pragma unroll
                for (int e = 0; e < 8; ++e) { const f32x4 w4 = *(const LAS f32x4*)(WRt + e * DM + 4 * Fq.lane + 256 * j); lg[e] += uu.x * w4.x + uu.y * w4.y + uu.z * w4.z + uu.w * w4.w; } }
#pragma unroll
            for (int e = 0; e < 8; ++e) lg[e] = wave_sum(lg[e]);
            int i0 = 0; float l0 = lg[0];
#pragma unroll
            for (int e = 1; e < 8; ++e) if (lg[e] > l0) { l0 = lg[e]; i0 = e; }
            int i1 = -1; float l1 = -3.0e38f;
#pragma unroll
            for (int e = 0; e < 8; ++e) if (e != i0 && lg[e] > l1) { l1 = lg[e]; i1 = e; }
            const float g0 = 1.0f / (1.0f + __expf(l1 - l0));
            if (Fq.lane == 0) {
                const unsigned r0 = __hip_atomic_fetch_add(lcnt + i0, 1u, __ATOMIC_RELAXED, __HIP_MEMORY_SCOPE_WORKGROUP);
                const unsigned r1 = __hip_atomic_fetch_add(lcnt + i1, 1u, __ATOMIC_RELAXED, __HIP_MEMORY_SCOPE_WORKGROUP);
                ((int4*)(ws + WS_META))[m] = make_int4(i0, i1, (int)r0, (int)r1);
                ((float2*)(ws + WS_GATE))[m] = make_float2(g0, 1.0f - g0);
            }
          }
        }
        __syncthreads();
        if (Fq.tid < 8) { const unsigned base = __hip_atomic_fetch_add(ctl + CW_GCNT + Fq.tid, lcnt[Fq.tid], __ATOMIC_RELAXED, __HIP_MEMORY_SCOPE_AGENT); ((unsigned*)(ws + WS_WGB))[F.bx * 8 + Fq.tid] = base; }
    }
#endif
#if STOP_AFTER >= 12
    GRID_BAR();
    int ts[NEXP + 1];
    {
        const Frame Fq = phase_frame(F);
        ts[0] = 0;
#pragma unroll
        for (int e = 0; e < NEXP; ++e) { const unsigned c = __hip_atomic_load(ctl + CW_GCNT + e, __ATOMIC_RELAXED, __HIP_MEMORY_SCOPE_AGENT); ts[e + 1] = ts[e] + (int)((c + 255u) >> 8); }
        bf16_t* XS = R1;
        for (int i0 = 0; i0 < 16; i0 += 4) {
            const int m0 = F.bx * 128 + Fq.wave * 16 + i0;
            int4 mt[4]; u32x4 v0[4];
#pragma unroll
            for (int r = 0; r < 4; ++r) { mt[r] = ((const int4*)(ws + WS_META))[m0 + r]; v0[r] = *((const u32x4*)((const unsigned char*)U + (size_t)(m0 + r) * DM) + Fq.lane); }
#pragma unroll
            for (int r = 0; r < 4; ++r) {
                int d0 = 0, d1 = 0;
#pragma unroll
                for (int e = 0; e < NEXP; ++e) { if (mt[r].x == e) d0 = ts[e] * 256; if (mt[r].y == e) d1 = ts[e] * 256; }
                d0 += (int)((const unsigned*)(ws + WS_WGB))[F.bx * 8 + mt[r].x] + mt[r].z;
                d1 += (int)((const unsigned*)(ws + WS_WGB))[F.bx * 8 + mt[r].y] + mt[r].w;
                *((u32x4*)((unsigned char*)XS + (size_t)d0 * DM) + Fq.lane) = v0[r]; *((u32x4*)((unsigned char*)XS + (size_t)d1 * DM) + Fq.lane) = v0[r];
                if (Fq.lane == 0) ((int2*)(ws + WS_DEST))[m0 + r] = make_int2(d0, d1);
            }
        }
    }
    GRID_BAR();
    {
        pg8::Gemm g{R1, (const bf16_t*)(ws + WS_WEGU), 0, 2 * DFE, DM / 2}; pg8::StaticOrder S; S.init(256, 2 * DFE, F.G, F.bx);
        S.nM = ts[NEXP]; S.nwg = S.nM * S.nN; S.moe = 1;
#pragma unroll
        for (int e = 0; e < NEXP; ++e) S.ts[e] = ts[e];
        pg8::EpiSwiGLU8 E{(unsigned char*)(ws + WS_EH), DFE, 1.0f / (FP8_SX * FP8_SWGU)};
        pg8::gemm_phase<pg8::EpiSwiGLU8, pg8::StaticOrder, true, true, 1>(F.lds, g, S, E);
    }
    GRID_BAR();
    {
        pg8::Gemm g{(const bf16_t*)(ws + WS_EH), (const bf16_t*)(ws + WS_WEDN), 0, DM, DFE / 2}; pg8::StaticOrder S; S.init(256, DM, F.G, F.bx);
        S.nM = ts[NEXP]; S.nwg = S.nM * S.nN; S.moe = 1;
#pragma unroll
        for (int e = 0; e < NEXP; ++e) S.ts[e] = ts[e];
        pg8::EpiStore E{R1 + (size_t)XS_ROWS * DM / 2, DM, 1.0f / (FP8_SH * FP8_SWDN), nullptr, 0, 0, 0};
        pg8::gemm_phase<pg8::EpiStore, pg8::StaticOrder, true, true, 1>(F.lds, g, S, E);
    }
    GRID_BAR();
    {
        const Frame Fq = phase_frame(F);
        const float* g1 = P.fnpost + DM;
        const bf16_t* YS = R1 + (size_t)XS_ROWS * DM / 2;
        for (int i0 = 0; i0 < 16; i0 += 4) {
            const int m0 = F.bx * 128 + Fq.wave * 16 + i0;
            int2 d[4]; float2 gt[4];
#pragma unroll
            for (int r = 0; r < 4; ++r) { d[r] = ((const int2*)(ws + WS_DEST))[m0 + r]; gt[r] = ((const float2*)(ws + WS_GATE))[m0 + r]; }
            u32x2 ya[4][4], yb[4][4], bs[4][4];
#pragma unroll
            for (int r = 0; r < 4; ++r)
#pragma unroll
                for (int j = 0; j < 4; ++j) { ya[r][j] = ((const u32x2*)(YS + (size_t)d[r].x * DM))[Fq.lane + 64 * j]; yb[r][j] = ((const u32x2*)(YS + (size_t)d[r].y * DM))[Fq.lane + 64 * j];
                    bs[r][j] = ((const u32x2*)(H16 + (size_t)(m0 + r) * DM))[Fq.lane + 64 * j]; }
#pragma unroll
            for (int r = 0; r < 4; ++r) {
                f32x4 a[4];
#pragma unroll
                for (int j = 0; j < 4; ++j) a[j] = (f32x4){bflo(ya[r][j].x), bfhi(ya[r][j].x), bflo(ya[r][j].y), bfhi(ya[r][j].y)} * gt[r].x + (f32x4){bflo(yb[r][j].x), bfhi(yb[r][j].x), bflo(yb[r][j].y), bfhi(yb[r][j].y)} * gt[r].y;
                const float rs = row_rstd(a);
#pragma unroll
                for (int j = 0; j < 4; ++j) { const f32x4 gg = ((const f32x4*)g1)[Fq.lane + 64 * j];
                    ((f32x4*)(P.out + (size_t)(m0 + r) * DM))[Fq.lane + 64 * j] = (f32x4){bflo(bs[r][j].x), bfhi(bs[r][j].x), bflo(bs[r][j].y), bfhi(bs[r][j].y)} + a[j] * rs * gg; }
            }
        }
    }
#endif
}

extern "C" void kernel_launch(void* const* d_in, const int* in_sizes, int n_in, void* d_out, int out_size, void* d_ws, size_t ws_size, hipStream_t stream) {
    static int grid = 0;
    if (grid == 0) {
        if (n_in != 20 || out_size != MTOK * DM || ws_size < WS_END) { fprintf(stderr, "kernel_launch: unexpected shapes (n_in %d out %d ws %zu)\n", n_in, out_size, ws_size); grid = -1; return; }
        int dev = 0, cus = 0, per_cu = 0;
        if (hipGetDevice(&dev) != hipSuccess || hipDeviceGetAttribute(&cus, hipDeviceAttributeMultiprocessorCount, dev) != hipSuccess) { grid = -1; return; }
        if (hipFuncSetAttribute((const void*)yoco_fwd, hipFuncAttributeMaxDynamicSharedMemorySize, LDS_BYTES) != hipSuccess) { fprintf(stderr, "kernel_launch: hipFuncSetAttribute failed\n"); grid = -1; return; }
        if (hipOccupancyMaxActiveBlocksPerMultiprocessor(&per_cu, (const void*)yoco_fwd, NTHR, LDS_BYTES) != hipSuccess || per_cu < 1) { fprintf(stderr, "kernel_launch: occupancy query says %d\n", per_cu); }
        (void)hipGetLastError();
        if (cus < 256) { fprintf(stderr, "kernel_launch: need 256 CUs, have %d\n", cus); grid = -1; return; }
        grid = 256;
    }
    if (grid < 0) return;
    if (hipMemsetAsync((char*)d_ws + WS_CTL, 0, CTL_ZERO_BYTES, stream) != hipSuccess) return;
    Args a{};
    for (int i = 0; i < 20; ++i) a.in[i] = (const float*)d_in[i];
    a.out = (float*)d_out; a.ws = (unsigned char*)d_ws;
    hipLaunchKernelGGL(yoco_fwd, dim3(grid), dim3(NTHR), LDS_BYTES, stream, a);
}
```

```cpp
#include <hip/hip_runtime.h>
#include <cstdio>
#include <cstdint>

#ifndef STOP_AFTER
#define STOP_AFTER 99
#endif

#define LAS __attribute__((address_space(3)))
#define GAS __attribute__((address_space(1)))
typedef unsigned short bf16_t;
typedef short bf16x8 __attribute__((ext_vector_type(8)));
typedef float f32x4 __attribute__((ext_vector_type(4)));
typedef float f32x16 __attribute__((ext_vector_type(16)));
typedef float f32x2 __attribute__((ext_vector_type(2)));
typedef unsigned u32x4 __attribute__((ext_vector_type(4)));
typedef unsigned u32x2 __attribute__((ext_vector_type(2)));
typedef __bf16 bf16x2_t __attribute__((ext_vector_type(2)));

constexpr int NB = 8, SEQ = 4096, DM = 1024, MTOK = NB * SEQ;
constexpr int MEML = 256, MROWS = NB * MEML;
constexpr int AW = 3328, HF = 768, DFF = 2816, NEXP = 8, DFE = 3584;
constexpr int KVQW = 2560;
constexpr int XS_ROWS = 2 * MTOK + NEXP * 256;
constexpr float RMS_EPS = 1e-6f;
constexpr float C2 = 0.125f * 1.4426950408889634f;
constexpr int NWAVES = 8, NTHR = 512;

constexpr size_t MiB = 1u << 20;
constexpr size_t WS_CTL = 0, CTL_ZERO_BYTES = 128 * 1024;
constexpr size_t WS_MEMN = 395 * MiB + 32 * MiB;
constexpr size_t WS_MEMN_OLD_UNUSED = 459 * MiB;
constexpr size_t WS_AS = 1 * MiB;
constexpr size_t WS_WSC = 2 * MiB;
constexpr int WSC_INA = 0, WSC_GU = 4352, WSC_KVB = 9984, WSC_N = 12544;
constexpr size_t WS_MKV = 5 * MiB;
constexpr size_t WS_META = 9 * MiB;
constexpr size_t WS_GATE = WS_META + 512 * 1024, WS_DEST = WS_GATE + 256 * 1024, WS_WGB = WS_DEST + 256 * 1024;
constexpr size_t WS_WOUT1 = 12 * MiB;
constexpr size_t WS_WKVB = 14 * MiB;
constexpr size_t WS_WEGU = 19 * MiB;
constexpr size_t WS_WEDN = 131 * MiB;
constexpr size_t WS_R1 = 187 * MiB;
constexpr size_t WS_EH = 395 * MiB;
constexpr size_t WS_U = 395 * MiB;
constexpr size_t WS_MIX = 459 * MiB;
constexpr size_t WS_MIXED = 523 * MiB;
constexpr size_t WS_WINA = 587 * MiB;
constexpr size_t WS_WMKV = 587 * MiB + (size_t)3328 * 1024;
constexpr size_t WS_WMKV_OLD_UNUSED = 587 * MiB + (size_t)3328 * 1024 * 2;
constexpr size_t WS_WOUT0 = 596 * MiB;
constexpr size_t WS_WGU = 598 * MiB;
constexpr size_t WS_WDN = 609 * MiB;
constexpr size_t WS_HGQD = 640 * MiB;
constexpr size_t WS_HGOI = 688 * MiB;
constexpr size_t WS_HGU = 736 * MiB;
constexpr size_t WS_HGDEC = 832 * MiB;
constexpr size_t WS_H16 = 640 * MiB;
constexpr size_t WS_END = 857 * MiB;
static_assert(WS_EH + (size_t)XS_ROWS * DFE * 2 <= WS_END, "EH fits");
static_assert(WS_R1 + (size_t)MTOK * AW * 2 <= WS_EH, "R1 fits");
constexpr int CW_BAR = 4096;
constexpr int CW_GCNT = 16384;
constexpr int CW_XRANK = 16448;
static_assert((CW_XRANK + 16) * 4 <= (int)CTL_ZERO_BYTES, "control words inside the zeroed region");

constexpr int RING_BYTES = 131072;
constexpr int LDSCTL_OFF = RING_BYTES, MISC_OFF = LDSCTL_OFF + 320;
constexpr int LDS_BYTES = 147456;

__device__ __forceinline__ unsigned f2bf(float f) { unsigned u = __builtin_bit_cast(unsigned, f); return (u + 0x7fffu + ((u >> 16) & 1u)) >> 16; }
__device__ __forceinline__ unsigned pk2(float lo, float hi) { f32x2 v = {lo, hi}; bf16x2_t b = __builtin_convertvector(v, bf16x2_t); return __builtin_bit_cast(unsigned, b); }
__device__ __forceinline__ float bflo(unsigned w) { return __builtin_bit_cast(float, w << 16); }
__device__ __forceinline__ float bfhi(unsigned w) { return __builtin_bit_cast(float, w & 0xffff0000u); }
__device__ __forceinline__ float bf1(unsigned short s) { return __builtin_bit_cast(float, (unsigned)s << 16); }
__device__ __forceinline__ float wave_sum(float v);
__device__ __forceinline__ float fexp2(float x) { return __builtin_amdgcn_exp2f(x); }
__device__ __forceinline__ float flog2(float x) { return __builtin_amdgcn_logf(x); }
__device__ __forceinline__ float frcp(float x) { return __builtin_amdgcn_rcpf(x); }
__device__ __forceinline__ float frsq(float x) { return __builtin_amdgcn_rsqf(x); }
template <int X> __device__ __forceinline__ float swz_xor(float v) { return __builtin_bit_cast(float, __builtin_amdgcn_ds_swizzle(__builtin_bit_cast(int, v), (X << 10) | 0x1F)); }
__device__ __forceinline__ float wave_sum(float v) {
    v += swz_xor<1>(v); v += swz_xor<2>(v); v += swz_xor<4>(v); v += swz_xor<8>(v); v += swz_xor<16>(v);
    const float lo = __builtin_bit_cast(float, __builtin_amdgcn_readlane(__builtin_bit_cast(int, v), 0)), hi = __builtin_bit_cast(float, __builtin_amdgcn_readlane(__builtin_bit_cast(int, v), 32));
    return lo + hi;
}
__device__ __forceinline__ float sigmoidf_(float x) { return frcp(1.0f + fexp2(-1.4426950408889634f * x)); }
typedef int i32x4 __attribute__((ext_vector_type(4)));
typedef int i32x8 __attribute__((ext_vector_type(8)));
__device__ __forceinline__ float sat8(float x) { return __builtin_amdgcn_fmed3f(x, -448.f, 448.f); }
__device__ __forceinline__ unsigned pk4_fp8s(float a, float b, float c, float d) { int w = 0; w = __builtin_amdgcn_cvt_pk_fp8_f32(sat8(a), sat8(b), w, false); w = __builtin_amdgcn_cvt_pk_fp8_f32(sat8(c), sat8(d), w, true); return (unsigned)w; }
__device__ __forceinline__ unsigned pk4_fp8(float a, float b, float c, float d) { int w = 0; w = __builtin_amdgcn_cvt_pk_fp8_f32(a, b, w, false); w = __builtin_amdgcn_cvt_pk_fp8_f32(c, d, w, true); return (unsigned)w; }
constexpr float FP8_SX = 8.f, FP8_SH = 8.f, FP8_SWGU = 32.f, FP8_SWDN = 64.f, FP8_SHD = 8.f, FP8_SWDD = 64.f;
__device__ __forceinline__ float wave_max(float v) {
    v = fmaxf(v, swz_xor<1>(v)); v = fmaxf(v, swz_xor<2>(v)); v = fmaxf(v, swz_xor<4>(v)); v = fmaxf(v, swz_xor<8>(v)); v = fmaxf(v, swz_xor<16>(v));
    const float lo = __builtin_bit_cast(float, __builtin_amdgcn_readlane(__builtin_bit_cast(int, v), 0)), hi = __builtin_bit_cast(float, __builtin_amdgcn_readlane(__builtin_bit_cast(int, v), 32));
    return fmaxf(lo, hi);
}
__device__ __forceinline__ unsigned pk4_i8(float a, float b, float c, float d) {
    const int ia = (int)__builtin_rintf(__builtin_amdgcn_fmed3f(a, -127.f, 127.f)), ib = (int)__builtin_rintf(__builtin_amdgcn_fmed3f(b, -127.f, 127.f)),
              ic = (int)__builtin_rintf(__builtin_amdgcn_fmed3f(c, -127.f, 127.f)), id = (int)__builtin_rintf(__builtin_amdgcn_fmed3f(d, -127.f, 127.f));
    return (unsigned)(ia & 0xff) | ((unsigned)(ib & 0xff) << 8) | ((unsigned)(ic & 0xff) << 16) | ((unsigned)id << 24);
}
__device__ __forceinline__ void quant_row_i8(const f32x4 (&uu)[4], unsigned char* qrow, float* as_slot, int lane) {
    float am = 0.f;
#pragma unroll
    for (int j = 0; j < 4; ++j) am = fmaxf(fmaxf(am, fmaxf(__builtin_fabsf(uu[j].x), __builtin_fabsf(uu[j].y))), fmaxf(__builtin_fabsf(uu[j].z), __builtin_fabsf(uu[j].w)));
    am = fmaxf(wave_max(am), 1e-20f);
    const float inv = 127.0f / am;
    unsigned* o4 = (unsigned*)qrow + lane;
#pragma unroll
    for (int j = 0; j < 4; ++j) o4[64 * j] = pk4_i8(uu[j].x * inv, uu[j].y * inv, uu[j].z * inv, uu[j].w * inv);
    if (lane == 0) *as_slot = am * (1.0f / 127.0f);
}
__device__ __forceinline__ int crow(int r, int hi) { return (r & 3) + 8 * (r >> 2) + 4 * hi; }
#define LDS_WAIT() asm volatile("s_waitcnt lgkmcnt(0)" ::: "memory")
#define VM_WAIT() asm volatile("s_waitcnt vmcnt(0)" ::: "memory")
#define LDS_BARRIER() do { asm volatile("s_waitcnt lgkmcnt(0)" ::: "memory"); __builtin_amdgcn_s_barrier(); asm volatile("" ::: "memory"); } while (0)

namespace pg8 {
#define PG8_LAS __attribute__((address_space(3)))
constexpr int BM = 256, BK = 64, HALF = 128, HTB = HALF * BK * 2, STAGE_BYTES = 8 * HTB, NXCD = 8, WGM = 4;
__host__ __device__ __forceinline__ int lds_byte(int r, int c) { const int st = (r >> 4) * 2 + (c >> 5), rr = r & 15, cc = c & 31, ob = rr * 64 + cc * 2; return st * 1024 + (ob ^ (((ob >> 9) & 1) << 5)); }
__host__ __device__ __forceinline__ void stage_rc(int b, int& R, int& C) { const int st = b / 1024, sb = b % 1024, swz = sb ^ (((sb >> 9) & 1) << 5); R = (st >> 1) * 16 + swz / 64; C = (st & 1) * 32 + (swz % 64) / 2; }
__host__ __device__ __forceinline__ int perm32(int rho) { const int n = rho >> 4, i = rho & 15; return 8 * (i >> 2) + 4 * n + (i & 3); }

struct Unit { int pm, pn, pb; };
struct Gemm { const bf16_t* A; const bf16_t* Bt; int M, N, K; };

struct StaticOrder {
    int nM, nN, nwg, G, c;
    int ts[NEXP];
    int moe;
    int ext_n, ext_pm0, ext_pn0;
    __device__ void init(int M, int N, int G_, int c_) { nM = M / BM; nN = N / BM; nwg = nM * nN; G = G_; c = c_; moe = 0; ext_n = 0; ext_pm0 = 0; ext_pn0 = 0;
#pragma unroll
        for (int e = 0; e < NEXP; ++e) ts[e] = 0; }
    __device__ bool next(int i, Unit& u) const {
        const long L = (long)i * G + c; if (L >= nwg + ext_n) return false;
        if (L >= nwg) { const int j = (int)L - nwg; u.pm = ext_pm0 + (j >> 2); u.pn = ext_pn0 + (j & 3); u.pb = u.pn; return true; }
        int wgid = (int)L; { const int q = nwg / NXCD, r = nwg % NXCD, xcd = wgid % NXCD, off = wgid / NXCD; wgid = (xcd < r ? xcd * (q + 1) : r * (q + 1) + (xcd - r) * q) + off; }
        const int nig = WGM * nN, gid = wgid / nig, fm = gid * WGM, gsz = (nM - fm) < WGM ? (nM - fm) : WGM;
        u.pm = fm + ((wgid % nig) % gsz); u.pn = (wgid % nig) / gsz; u.pb = u.pn;
        if (moe) { int e = 0;
#pragma unroll
            for (int j = 1; j < NEXP; ++j) e += (u.pm >= ts[j]) ? 1 : 0;
            u.pb = e * nN + u.pn; }
        return true;
    }
    __device__ __forceinline__ void a_ready(const Unit&) const {}
    __device__ __forceinline__ void done(const Unit&) const {}
};

struct EpiStore {
    static constexpr bool PERM = true, AFTER_DRAIN = false;
    bf16_t* O; int ldc; float sc;
    bf16_t* O2; int ldc2, pm2, pn2;
    __device__ __forceinline__ void operator()(const f32x4 (&acc)[2][2][4][2], const Unit& u, int wr, int wc, int fr, int fq) const {
        int row0 = u.pm * BM + wr * 64 + fr; int col0 = u.pn * BM + wc * 32 + 8 * fq; bf16_t* Ob = O; int ld = ldc;
        if (pm2 > 0 && u.pm >= pm2) { row0 -= pm2 * BM; col0 -= pn2 * BM; Ob = O2; ld = ldc2; }
#pragma unroll
        for (int ai = 0; ai < 2; ++ai)
#pragma unroll
            for (int m = 0; m < 4; ++m) { bf16_t* rowp = Ob + (size_t)(row0 + ai * HALF + m * 16) * ld + col0;
#pragma unroll
                for (int bj = 0; bj < 2; ++bj) { const f32x4 v0 = acc[ai][bj][m][0] * sc, v1 = acc[ai][bj][m][1] * sc;
                    u32x4 w; w.x = pk2(v0[0], v0[1]); w.y = pk2(v0[2], v0[3]); w.z = pk2(v1[0], v1[1]); w.w = pk2(v1[2], v1[3]);
                    *(u32x4*)(rowp + bj * HALF) = w; } }
    }
};
struct EpiSwiGLU {
    static constexpr bool PERM = true, AFTER_DRAIN = false;
    bf16_t* O; int ldc;
    __device__ __forceinline__ void operator()(const f32x4 (&acc)[2][2][4][2], const Unit& u, int wr, int wc, int fr, int fq) const {
        const int row0 = u.pm * BM + wr * 64 + fr; const int col0 = u.pn * HALF + wc * 32 + 8 * fq;
#pragma unroll
        for (int ai = 0; ai < 2; ++ai)
#pragma unroll
            for (int m = 0; m < 4; ++m) { bf16_t* rowp = O + (size_t)(row0 + ai * HALF + m * 16) * ldc + col0;
                float h[8];
#pragma unroll
                for (int n = 0; n < 2; ++n)
#pragma unroll
                    for (int i = 0; i < 4; ++i) { const float g = acc[ai][0][m][n][i], up = acc[ai][1][m][n][i]; h[4 * n + i] = (g * up) * frcp(1.0f + fexp2(-1.4426950408889634f * g)); }
                u32x4 w; w.x = pk2(h[0], h[1]); w.y = pk2(h[2], h[3]); w.z = pk2(h[4], h[5]); w.w = pk2(h[6], h[7]);
                *(u32x4*)rowp = w; }
    }
};

struct EpiStoreQ {
    static constexpr bool PERM = true, AFTER_DRAIN = false;
    bf16_t* O; int ldc; const float* as; const float* ws;
    bf16_t* O2; int ldc2, pm2, pn2;
    __device__ __forceinline__ void operator()(const f32x4 (&acc)[2][2][4][2], const Unit& u, int wr, int wc, int fr, int fq) const {
        const int arow0 = u.pm * BM + wr * 64 + fr, bcol0 = u.pb * BM + wc * 32 + 8 * fq;
        int row0 = arow0, col0 = u.pn * BM + wc * 32 + 8 * fq; bf16_t* Ob = O; int ld = ldc;
        if (pm2 > 0 && u.pm >= pm2) { row0 -= pm2 * BM; col0 -= pn2 * BM; Ob = O2; ld = ldc2; }
        f32x4 wsv[2][2];
#pragma unroll
        for (int bj = 0; bj < 2; ++bj) { wsv[bj][0] = *(const f32x4*)(ws + bcol0 + bj * HALF); wsv[bj][1] = *(const f32x4*)(ws + bcol0 + bj * HALF + 4); }
#pragma unroll
        for (int ai = 0; ai < 2; ++ai)
#pragma unroll
            for (int m = 0; m < 4; ++m) { const float a = as[arow0 + ai * HALF + m * 16]; bf16_t* rowp = Ob + (size_t)(row0 + ai * HALF + m * 16) * ld + col0;
#pragma unroll
                for (int bj = 0; bj < 2; ++bj) { const i32x4 i0 = __builtin_bit_cast(i32x4, acc[ai][bj][m][0]), i1 = __builtin_bit_cast(i32x4, acc[ai][bj][m][1]);
                    const f32x4 v0 = __builtin_convertvector(i0, f32x4) * wsv[bj][0] * a, v1 = __builtin_convertvector(i1, f32x4) * wsv[bj][1] * a;
                    u32x4 w; w.x = pk2(v0[0], v0[1]); w.y = pk2(v0[2], v0[3]); w.z = pk2(v1[0], v1[1]); w.w = pk2(v1[2], v1[3]);
                    *(u32x4*)(rowp + bj * HALF) = w; } }
    }
};
struct EpiSwiGLUQ {
    static constexpr bool PERM = true, AFTER_DRAIN = false;
    bf16_t* O; int ldc; const float* as; const float* ws;
    __device__ __forceinline__ void operator()(const f32x4 (&acc)[2][2][4][2], const Unit& u, int wr, int wc, int fr, int fq) const {
        const int row0 = u.pm * BM + wr * 64 + fr; const int col0 = u.pn * HALF + wc * 32 + 8 * fq, bcol0 = u.pb * BM + wc * 32 + 8 * fq;
        f32x4 wsv[2][2];
#pragma unroll
        for (int bj = 0; bj < 2; ++bj) { wsv[bj][0] = *(const f32x4*)(ws + bcol0 + bj * HALF); wsv[bj][1] = *(const f32x4*)(ws + bcol0 + bj * HALF + 4); }
#pragma unroll
        for (int ai = 0; ai < 2; ++ai)
#pragma unroll
            for (int m = 0; m < 4; ++m) { const float a = as[row0 + ai * HALF + m * 16]; bf16_t* rowp = O + (size_t)(row0 + ai * HALF + m * 16) * ldc + col0;
                float h[8];
#pragma unroll
                for (int n = 0; n < 2; ++n) { const f32x4 gv = __builtin_convertvector(__builtin_bit_cast(i32x4, acc[ai][0][m][n]), f32x4) * wsv[0][n] * a, uv = __builtin_convertvector(__builtin_bit_cast(i32x4, acc[ai][1][m][n]), f32x4) * wsv[1][n] * a;
#pragma unroll
                    for (int i = 0; i < 4; ++i) h[4 * n + i] = (gv[i] * uv[i]) * frcp(1.0f + fexp2(-1.4426950408889634f * gv[i])); }
                u32x4 w; w.x = pk2(h[0], h[1]); w.y = pk2(h[2], h[3]); w.z = pk2(h[4], h[5]); w.w = pk2(h[6], h[7]);
                *(u32x4*)rowp = w; }
    }
};
struct EpiSwiGLUQ8 {
    static constexpr bool PERM = true, AFTER_DRAIN = false;
    static constexpr int NST = 8;
    unsigned char* O; int ldc; const float* as; const float* ws;
    __device__ __forceinline__ void operator()(const f32x4 (&acc)[2][2][4][2], const Unit& u, int wr, int wc, int fr, int fq) const {
        const int row0 = u.pm * BM + wr * 64 + fr; const int col0 = u.pn * HALF + wc * 32 + 8 * fq, bcol0 = u.pb * BM + wc * 32 + 8 * fq;
        f32x4 wsv[2][2];
#pragma unroll
        for (int bj = 0; bj < 2; ++bj) { wsv[bj][0] = *(const f32x4*)(ws + bcol0 + bj * HALF); wsv[bj][1] = *(const f32x4*)(ws + bcol0 + bj * HALF + 4); }
#pragma unroll
        for (int ai = 0; ai < 2; ++ai)
#pragma unroll
            for (int m = 0; m < 4; ++m) { const float a = as[row0 + ai * HALF + m * 16]; unsigned char* rowp = O + (size_t)(row0 + ai * HALF + m * 16) * ldc + col0;
                float h[8];
#pragma unroll
                for (int n = 0; n < 2; ++n) { const f32x4 gv = __builtin_convertvector(__builtin_bit_cast(i32x4, acc[ai][0][m][n]), f32x4) * wsv[0][n] * a, uv = __builtin_convertvector(__builtin_bit_cast(i32x4, acc[ai][1][m][n]), f32x4) * wsv[1][n] * (a * FP8_SHD);
#pragma unroll
                    for (int i = 0; i < 4; ++i) h[4 * n + i] = (gv[i] * uv[i]) * frcp(1.0f + fexp2(-1.4426950408889634f * gv[i])); }
                u32x2 w; w.x = pk4_fp8s(h[0], h[1], h[2], h[3]); w.y = pk4_fp8s(h[4], h[5], h[6], h[7]);
                *(u32x2*)rowp = w; }
    }
};
struct EpiSwiGLU8 {
    static constexpr bool PERM = true, AFTER_DRAIN = false;
    unsigned char* O; int ldc; float ds;
    __device__ __forceinline__ void operator()(const f32x4 (&acc)[2][2][4][2], const Unit& u, int wr, int wc, int fr, int fq) const {
        const float c1 = -1.4426950408889634f * ds, c2 = ds * ds * FP8_SH;
        const int row0 = u.pm * BM + wr * 64 + fr; const int col0 = u.pn * HALF + wc * 32 + 8 * fq;
#pragma unroll
        for (int ai = 0; ai < 2; ++ai)
#pragma unroll
            for (int m = 0; m < 4; ++m) { unsigned char* rowp = O + (size_t)(row0 + ai * HALF + m * 16) * ldc + col0;
                float h[8];
#pragma unroll
                for (int n = 0; n < 2; ++n)
#pragma unroll
                    for (int i = 0; i < 4; ++i) { const float ga = acc[ai][0][m][n][i], ua = acc[ai][1][m][n][i];
                        h[4 * n + i] = (ga * ua) * (c2 * frcp(1.0f + fexp2(ga * c1))); }
                u32x2 w; w.x = pk4_fp8s(h[0], h[1], h[2], h[3]); w.y = pk4_fp8s(h[4], h[5], h[6], h[7]);
                *(u32x2*)rowp = w; }
    }
};

template <class Epi, class Sched, bool ALIGN_EPI = false, bool SP2 = false, int FP8 = 0>
__device__ __forceinline__ void gemm_phase(PG8_LAS unsigned char* lds, const Gemm g, const Sched& S, const Epi& E) {
    int tid_ = threadIdx.x; asm volatile("" : "+v"(tid_));
    const int tid = tid_, wid = __builtin_amdgcn_readfirstlane(tid >> 6), lane = tid & 63, wr = wid >> 2, wc = wid & 3, fr = lane & 15, fq = lane >> 4;
    const int K = g.K, nt = K / BK;
    unsigned voffA[2], voffB[2];
#pragma unroll
    for (int i = 0; i < 2; ++i) { int R, C; stage_rc(tid * 16 + i * 8192, R, C); const int Rb = Epi::PERM ? ((R & ~31) + perm32(R & 31)) : R;
        voffA[i] = (unsigned)(R * K + C) * 2u; voffB[i] = (unsigned)(Rb * K + C) * 2u; }
    const size_t kstep = (size_t)(BK * 2);
    const size_t hstep = (size_t)HALF * K * 2;
    const size_t tstep = 2 * hstep;
    const unsigned ldsw = (unsigned)wid * 1024u;
    const int aoff = lds_byte(wr * 64 + fr, fq * 8), boff = lds_byte(wc * 32 + fr, fq * 8);
#define PG8_SA(b, h) (((b) * 2 + (h)) * HTB)
#define PG8_SB(b, h) ((4 + (b) * 2 + (h)) * HTB)
#define PG8_STAGE(bufoff, gbase, voff) do { _Pragma("unroll") for (int _i = 0; _i < 2; ++_i) \
        __builtin_amdgcn_global_load_lds((const unsigned*)((const char*)(gbase) + (voff)[_i]), (PG8_LAS unsigned*)(lds + (bufoff) + ldsw + _i * 8192), 16, 0, 0); } while (0)
#define PG8_LD8(p) __builtin_shufflevector(*(const PG8_LAS i32x4*)(p), *(const PG8_LAS i32x4*)((p) + 1024), 0, 1, 2, 3, 4, 5, 6, 7)
#define PG8_LDA(dst, b, h) do { if constexpr (FP8 == 1) { _Pragma("unroll") for (int m = 0; m < 4; ++m) dst##8[m] = PG8_LD8(lds + PG8_SA(b, h) + aoff + m * 2048); } \
        else { _Pragma("unroll") for (int m = 0; m < 4; ++m) _Pragma("unroll") for (int k = 0; k < 2; ++k) dst[m][k] = *(const PG8_LAS bf16x8*)(lds + PG8_SA(b, h) + aoff + m * 2048 + k * 1024); } } while (0)
#define PG8_LDB(dst, b, h) do { if constexpr (FP8 == 1) { _Pragma("unroll") for (int n = 0; n < 2; ++n) dst##8[n] = PG8_LD8(lds + PG8_SB(b, h) + boff + n * 2048); } \
        else { _Pragma("unroll") for (int n = 0; n < 2; ++n) _Pragma("unroll") for (int k = 0; k < 2; ++k) dst[n][k] = *(const PG8_LAS bf16x8*)(lds + PG8_SB(b, h) + boff + n * 2048 + k * 1024); } } while (0)
#define PG8_CAT(x, y) __builtin_shufflevector(__builtin_bit_cast(i32x4, x), __builtin_bit_cast(i32x4, y), 0, 1, 2, 3, 4, 5, 6, 7)
#define PG8_MMA(ai, bj, At, Bt) do { __builtin_amdgcn_s_setprio(1); \
        if constexpr (FP8 == 1) { _Pragma("unroll") for (int m = 0; m < 4; ++m) _Pragma("unroll") for (int n = 0; n < 2; ++n) \
            asm volatile("v_mfma_scale_f32_16x16x128_f8f6f4 %0, %1, %2, %0, %3, %3 op_sel_hi:[0,0,0]" : "+v"(acc[ai][bj][m][n]) : "v"(Bt##8[n]), "v"(At##8[m]), "v"(sc1)); } \
        else if constexpr (FP8 == 2) { _Pragma("unroll") for (int m = 0; m < 4; ++m) _Pragma("unroll") for (int n = 0; n < 2; ++n) _Pragma("unroll") for (int k = 0; k < 2; ++k) \
            acc[ai][bj][m][n] = __builtin_bit_cast(f32x4, __builtin_amdgcn_mfma_i32_16x16x64_i8(__builtin_bit_cast(i32x4, Bt[n][k]), __builtin_bit_cast(i32x4, At[m][k]), __builtin_bit_cast(i32x4, acc[ai][bj][m][n]), 0, 0, 0)); } \
        else { _Pragma("unroll") for (int m = 0; m < 4; ++m) _Pragma("unroll") for (int n = 0; n < 2; ++n) _Pragma("unroll") for (int k = 0; k < 2; ++k) \
            acc[ai][bj][m][n] = __builtin_amdgcn_mfma_f32_16x16x32_bf16(Bt[n][k], At[m][k], acc[ai][bj][m][n], 0, 0, 0); } \
        __builtin_amdgcn_s_setprio(0); } while (0)
#define PG8_WAIT_V(n) asm volatile("s_waitcnt vmcnt(" #n ")" ::: "memory")
#define PG8_WAIT_L(n) asm volatile("s_waitcnt lgkmcnt(" #n ")" ::: "memory")
#define PG8_BAR __builtin_amdgcn_s_barrier()
#define PG8_SCHED __builtin_amdgcn_sched_barrier(0)
    Unit cur, nxt; int ui = 0;
    if (!S.next(0, cur)) return;
    f32x4 acc[2][2][4][2];
#pragma unroll
    for (int a = 0; a < 2; ++a)
#pragma unroll
        for (int b = 0; b < 2; ++b)
#pragma unroll
            for (int m = 0; m < 4; ++m)
#pragma unroll
                for (int n = 0; n < 2; ++n) acc[a][b][m][n] = (f32x4){0.f, 0.f, 0.f, 0.f};
    bf16x8 At[4][2], B0[2][2], B1[2][2];
    i32x8 At8[4], B08[2], B18[2];
    int sc1 = 0x7F7F7F7F; asm volatile("" : "+v"(sc1));
    const char* cA = (const char*)g.A + (size_t)cur.pm * tstep; const char* cB = (const char*)g.Bt + (size_t)cur.pb * tstep;
    S.a_ready(cur);
    if constexpr (SP2) {
        PG8_STAGE(PG8_SB(0, 0), cB, voffB); PG8_STAGE(PG8_SB(0, 1), cB + hstep, voffB); PG8_STAGE(PG8_SA(0, 0), cA, voffA); PG8_STAGE(PG8_SA(0, 1), cA + hstep, voffA);
        if (wr == 1) PG8_BAR;
        PG8_WAIT_V(2); PG8_BAR;
        PG8_STAGE(PG8_SB(1, 0), cB + kstep, voffB); PG8_STAGE(PG8_SA(1, 0), cA + kstep, voffA); PG8_STAGE(PG8_SB(1, 1), cB + hstep + kstep, voffB);
        PG8_WAIT_V(6); PG8_BAR;
    } else {
        PG8_STAGE(PG8_SB(0, 0), cB, voffB); PG8_STAGE(PG8_SA(0, 0), cA, voffA); PG8_STAGE(PG8_SB(0, 1), cB + hstep, voffB); PG8_STAGE(PG8_SA(0, 1), cA + hstep, voffA);
        if (wr == 1) PG8_BAR;
        PG8_WAIT_V(4); PG8_BAR;
        PG8_STAGE(PG8_SB(1, 0), cB + kstep, voffB); PG8_STAGE(PG8_SA(1, 0), cA + kstep, voffA); PG8_STAGE(PG8_SB(1, 1), cB + hstep + kstep, voffB);
        PG8_WAIT_V(6); PG8_BAR;
    }
    for (;;) {
        const bool has_next = S.next(ui + 1, nxt);
        const char* nA = has_next ? (const char*)g.A + (size_t)nxt.pm * tstep : cA; const char* nB = has_next ? (const char*)g.Bt + (size_t)nxt.pb * tstep : cB;
        for (int t = 0; t < nt; t += 2) {
            const bool last = (t == nt - 2);
            const char* a1 = cA + (size_t)(t + 1) * kstep;
            const char* a2 = last ? nA : cA + (size_t)(t + 2) * kstep; const char* b2 = last ? nB : cB + (size_t)(t + 2) * kstep;
            const char* a3 = a2 + kstep; const char* b3 = b2 + kstep;
            if (last && has_next) S.a_ready(nxt);
            if constexpr (SP2) {
            PG8_LDB(B0, 0, 0); PG8_LDB(B1, 0, 1); PG8_SCHED; PG8_LDA(At, 0, 0); PG8_STAGE(PG8_SA(1, 1), a1 + hstep, voffA);
            PG8_WAIT_V(8); PG8_WAIT_L(0); PG8_BAR; PG8_MMA(0, 0, At, B0); PG8_MMA(0, 1, At, B1); PG8_BAR; PG8_SCHED;
            PG8_LDA(At, 0, 1); PG8_STAGE(PG8_SB(0, 0), b2, voffB); PG8_STAGE(PG8_SB(0, 1), b2 + hstep, voffB); PG8_STAGE(PG8_SA(0, 0), a2, voffA);
            PG8_WAIT_V(8); PG8_WAIT_L(0); PG8_BAR; PG8_MMA(1, 0, At, B0); PG8_MMA(1, 1, At, B1); PG8_BAR; PG8_SCHED;
            PG8_LDB(B0, 1, 0); PG8_LDB(B1, 1, 1); PG8_SCHED; PG8_LDA(At, 1, 0); PG8_STAGE(PG8_SA(0, 1), a2 + hstep, voffA);
            PG8_WAIT_V(8); PG8_WAIT_L(0); PG8_BAR; PG8_MMA(0, 0, At, B0); PG8_MMA(0, 1, At, B1); PG8_BAR; PG8_SCHED;
            PG8_LDA(At, 1, 1); PG8_STAGE(PG8_SB(1, 0), b3, voffB); PG8_STAGE(PG8_SB(1, 1), b3 + hstep, voffB); PG8_STAGE(PG8_SA(1, 0), a3, voffA);
            PG8_WAIT_V(8); PG8_WAIT_L(0); PG8_BAR; PG8_MMA(1, 0, At, B0); PG8_MMA(1, 1, At, B1); PG8_BAR; PG8_SCHED;
            } else {
            PG8_LDB(B0, 0, 0); PG8_SCHED; PG8_LDA(At, 0, 0); PG8_STAGE(PG8_SA(1, 1), a1 + hstep, voffA);
            PG8_WAIT_L(8); PG8_BAR; PG8_WAIT_L(0); PG8_MMA(0, 0, At, B0); PG8_BAR; PG8_SCHED;
            PG8_LDB(B1, 0, 1); PG8_STAGE(PG8_SB(0, 0), b2, voffB);
            PG8_BAR; PG8_WAIT_L(0); PG8_MMA(0, 1, At, B1); PG8_BAR;
            PG8_LDA(At, 0, 1); PG8_STAGE(PG8_SA(0, 0), a2, voffA);
            PG8_BAR; PG8_WAIT_L(0); PG8_MMA(1, 0, At, B0); PG8_BAR; PG8_SCHED;
            PG8_STAGE(PG8_SB(0, 1), b2 + hstep, voffB);
            PG8_WAIT_V(6); PG8_BAR; PG8_MMA(1, 1, At, B1); PG8_BAR;
            PG8_LDB(B0, 1, 0); PG8_SCHED; PG8_LDA(At, 1, 0); PG8_STAGE(PG8_SA(0, 1), a2 + hstep, voffA);
            PG8_WAIT_L(8); PG8_BAR; PG8_WAIT_L(0); PG8_MMA(0, 0, At, B0); PG8_BAR; PG8_SCHED;
            PG8_LDB(B1, 1, 1); PG8_STAGE(PG8_SB(1, 0), b3, voffB);
            PG8_BAR; PG8_WAIT_L(0); PG8_MMA(0, 1, At, B1); PG8_BAR;
            PG8_LDA(At, 1, 1); PG8_STAGE(PG8_SA(1, 0), a3, voffA);
            PG8_BAR; PG8_WAIT_L(0); PG8_MMA(1, 0, At, B0); PG8_BAR; PG8_SCHED;
            PG8_STAGE(PG8_SB(1, 1), b3 + hstep, voffB);
            PG8_WAIT_V(6); PG8_BAR; PG8_MMA(1, 1, At, B1); PG8_BAR;
            }
        }
        if constexpr (ALIGN_EPI) { if (wr == 0) PG8_BAR; }
        if constexpr (FP8 == 1) asm volatile("s_nop 15\n\ts_nop 15\n\ts_nop 15\n\ts_nop 15\n\ts_nop 15" ::: "memory");
        if constexpr (!Epi::AFTER_DRAIN) { E(acc, cur, wr, wc, fr, fq); S.done(cur); }
        if (!has_next) break;
#pragma unroll
        for (int a = 0; a < 2; ++a)
#pragma unroll
            for (int b = 0; b < 2; ++b)
#pragma unroll
                for (int m = 0; m < 4; ++m)
#pragma unroll
                    for (int n = 0; n < 2; ++n) acc[a][b][m][n] = (f32x4){0.f, 0.f, 0.f, 0.f};
        cur = nxt; cA = nA; cB = nB; ++ui;
        if constexpr (ALIGN_EPI) { if (wr == 1) PG8_BAR; }
    }
    PG8_WAIT_V(0);
    if constexpr (!ALIGN_EPI) { if (wr == 0) PG8_BAR; }
    PG8_BAR;
#undef PG8_SA
#undef PG8_SB
#undef PG8_STAGE
#undef PG8_LDA
#undef PG8_LD8
#undef PG8_LDB
#undef PG8_MMA
#undef PG8_CAT
#undef PG8_WAIT_V
#undef PG8_WAIT_L
#undef PG8_BAR
#undef PG8_SCHED
}
}

#define XB_TMO      128
#define XB_XCNT(j)  (256  + 64 * (j))
#define XB_XSUB(j)  (1280 + 64 * (j))
#define XB_XGEN(j)  (2304 + 64 * (j))
#define XB_TOP      3328
#define XB_TOPGEN   3392
#define XCD_BAR_WORDS 3456
#define XB_SPIN_CAP (1u << 22)
__device__ __forceinline__ unsigned xb_ld(unsigned* p)              { return __hip_atomic_load(p, __ATOMIC_RELAXED, __HIP_MEMORY_SCOPE_AGENT); }
__device__ __forceinline__ unsigned xb_add(unsigned* p, unsigned v) { return __hip_atomic_fetch_add(p, v, __ATOMIC_RELAXED, __HIP_MEMORY_SCOPE_AGENT); }
__device__ __forceinline__ unsigned xb_xcc_id() { return (unsigned)__builtin_amdgcn_s_getreg((3 << 11) | 20) & 0xFu; }
#define XB_SPIN(cond, bar) do { unsigned _sp = 0; while (cond) { __builtin_amdgcn_s_sleep(1); \
    if ((++_sp & 255u) == 0u) { if (xb_ld(&(bar)[XB_TMO])) break; if (_sp > XB_SPIN_CAP) { atomicAdd(&(bar)[XB_TMO], 1u); break; } } } } while (0)
struct XcdBarrier { unsigned* bar; unsigned x; volatile LAS unsigned* st; };
__device__ __forceinline__ XcdBarrier xcd_barrier_post(unsigned* bar, volatile LAS unsigned* st) {
    XcdBarrier b; b.bar = bar; b.x = xb_xcc_id(); b.st = st;
    if (threadIdx.x == 0) (void)xb_add(&bar[XB_XCNT(b.x)], 1u);
    return b;
}
__device__ __forceinline__ void xcd_barrier_complete(unsigned* bar, unsigned x, unsigned& nloc, unsigned& nx) {
    const unsigned G = gridDim.x * gridDim.y * gridDim.z;
    unsigned sum, cnt, mine, sp = 0u;
    for (;;) {
        sum = 0u; cnt = 0u; mine = 0u;
#pragma unroll
        for (unsigned j = 0; j < 16; ++j) { const unsigned c = xb_ld(&bar[XB_XCNT(j)]); sum += c; cnt += (c > 0u) ? 1u : 0u; mine = (j == x) ? c : mine; }
        if (sum == G) break;
        __builtin_amdgcn_s_sleep(1);
        if ((++sp & 255u) == 0u) { if (xb_ld(&bar[XB_TMO])) break; if (sp > XB_SPIN_CAP) { atomicAdd(&bar[XB_TMO], 1u); break; } }
    }
    nloc = mine > 0u ? mine : 1u; nx = cnt > 0u ? cnt : 1u;
}
__device__ __forceinline__ void xcd_barrier(const XcdBarrier& b) {
    asm volatile("s_waitcnt vmcnt(0)" ::: "memory");
    __syncthreads();
    if (threadIdx.x == 0) {
        unsigned* bar = b.bar;
        __builtin_amdgcn_s_waitcnt(0);
        unsigned nloc = b.st[0], nx = b.st[1];
        if (nloc == 0u) { xcd_barrier_complete(bar, b.x, nloc, nx); b.st[0] = nloc; b.st[1] = nx; }
        const unsigned old = xb_add(&bar[XB_XSUB(b.x)], 1u);
        const unsigned gen = old / nloc;
        if (old + 1u == (gen + 1u) * nloc) {
            __builtin_amdgcn_fence(__ATOMIC_RELEASE, "agent");
            asm volatile("s_waitcnt vmcnt(0)" ::: "memory");
            const unsigned og = xb_add(&bar[XB_TOP], 1u);
            const unsigned tg = og / nx;
            if (og + 1u == (tg + 1u) * nx) xb_add(&bar[XB_TOPGEN], 1u);
            else XB_SPIN(xb_ld(&bar[XB_TOPGEN]) == tg, bar);
            __builtin_amdgcn_fence(__ATOMIC_ACQUIRE, "agent");
            xb_add(&bar[XB_XGEN(b.x)], 1u);
            asm volatile("s_waitcnt vmcnt(0)" ::: "memory");
        } else {
            XB_SPIN(xb_ld(&bar[XB_XGEN(b.x)]) == gen, bar);
            __builtin_amdgcn_fence(__ATOMIC_ACQUIRE, "agent");
            asm volatile("s_waitcnt vmcnt(0)" ::: "memory");
        }
    }
    __syncthreads();
}

struct Frame {
    LAS unsigned char* lds;
    int tid, lane, wave, G, bx;
};
__device__ __forceinline__ Frame phase_frame(const Frame& F) { Frame R = F; int t = threadIdx.x; asm volatile("" : "+v"(t)); R.tid = t; R.lane = t & 63; R.wave = __builtin_amdgcn_readfirstlane(t >> 6); return R; }

struct TrDesc { const float* W; unsigned char* WT; const float* kgain; float nscale; int K, N, drow0, k0, n0, f8; };
__device__ __forceinline__ void tr_load(const TrDesc& d, float (&tv)[32], int lane) {
    const float* wp = d.W + (size_t)(d.k0 + (lane >> 5)) * d.N + d.n0 + (lane & 31);
#pragma unroll
    for (int i = 0; i < 32; ++i) tv[i] = wp[(size_t)(2 * i) * d.N];
}
__device__ __forceinline__ void tr_finish(const TrDesc& d, const float (&tv)[32], LAS float* scr, int lane) {
#pragma unroll
    for (int i = 0; i < 32; ++i) { float v = tv[i] * d.nscale; if (d.kgain) v *= d.kgain[d.k0 + 2 * i + (lane >> 5)]; scr[(2 * i + (lane >> 5)) * 33 + (lane & 31)] = v; }
    LDS_WAIT(); asm volatile("" ::: "memory");
    const int c = lane & 7;
#pragma unroll
    for (int j = 0; j < 4; ++j) { const int n = (lane >> 3) + 8 * j; const LAS float* s = scr + (8 * c) * 33 + n;
        if (d.f8) { u32x2 o; o.x = pk4_fp8(s[0 * 33], s[1 * 33], s[2 * 33], s[3 * 33]); o.y = pk4_fp8(s[4 * 33], s[5 * 33], s[6 * 33], s[7 * 33]);
            *(u32x2*)(d.WT + (size_t)(d.drow0 + n) * d.K + d.k0 + 8 * c) = o; }
        else { u32x4 o; o.x = pk2(s[0 * 33], s[1 * 33]); o.y = pk2(s[2 * 33], s[3 * 33]); o.z = pk2(s[4 * 33], s[5 * 33]); o.w = pk2(s[6 * 33], s[7 * 33]);
            *(u32x4*)(d.WT + ((size_t)(d.drow0 + n) * d.K + d.k0 + 8 * c) * 2) = o; } }
    LDS_WAIT(); asm volatile("" ::: "memory");
}
__device__ __forceinline__ int gu_row(int n0, int Fh) { return n0 < Fh ? ((n0 >> 7) * 256 + (n0 & 127)) : (((n0 - Fh) >> 7) * 256 + 128 + ((n0 - Fh) & 127)); }

struct Ptrs {
    const float *x, *mem, *anpre, *anpost, *fnpre, *fnpost, *w_in_a, *hlb, *hon, *w_in_b, *kvn, *w_kv, *memn, *w_mem_kv, *w_out, *w_gu, *w_dn, *w_router, *w_egu, *w_edn;
    float* out; unsigned char* ws;
};

__device__ __forceinline__ float row_rstd(const f32x4 (&a)[4]);
__device__ __forceinline__ void rms_row_to_bf16(const float* xrow, bf16_t* orow, const float* gain, int lane) {
    const f32x4* xr = (const f32x4*)xrow + lane;
    f32x4 v[4]; float s = 0.f;
#pragma unroll
    for (int j = 0; j < 4; ++j) { v[j] = xr[64 * j]; s += (v[j].x * v[j].x + v[j].y * v[j].y) + (v[j].z * v[j].z + v[j].w * v[j].w); }
    const float rstd = frsq(wave_sum(s) * (1.f / DM) + RMS_EPS);
    u32x2* o8 = (u32x2*)orow + lane;
#pragma unroll
    for (int j = 0; j < 4; ++j) { f32x4 gg = gain ? ((const f32x4*)gain)[lane + 64 * j] : (f32x4){1.f, 1.f, 1.f, 1.f};
        u32x2 w; w.x = pk2(v[j].x * rstd * gg.x, v[j].y * rstd * gg.y); w.y = pk2(v[j].z * rstd * gg.z, v[j].w * rstd * gg.w); o8[64 * j] = w; }
}

struct TrCounts {
    static constexpr int I_INA = (DM / 64) * (AW / 32), I_MKV = (DM / 64) * (512 / 32), I_OUT = (DM / 64) * (DM / 32), I_GU = (DM / 64) * (2 * DFF / 32), I_DN = (DFF / 64) * (DM / 32),
                         I_KV = (DM / 64) * (1536 / 32), I_INB = (DM / 64) * (DM / 32), I_EGU = (DM / 64) * (2 * DFE / 32), I_EDN = (DFE / 64) * (DM / 32);
    static constexpr int NEARLY = I_INA + 2 * I_MKV + 2 * I_OUT + I_GU + I_DN + I_KV + I_INB;
    static constexpr int NITEMS = NEARLY + NEXP * I_EGU + NEXP * I_EDN;
};
__device__ __forceinline__ TrDesc tr_decode(const Ptrs& P, int it) {
    using T = TrCounts; unsigned char* ws = P.ws; TrDesc d; d.kgain = nullptr; d.nscale = 1.f; d.f8 = 0;
    int r = it - (T::I_INA + 2 * T::I_MKV);
    if (r < 2 * T::I_OUT) { const int l = r / T::I_OUT; r -= l * T::I_OUT; const int nb = DM / 32; d.k0 = 64 * (r / nb); d.n0 = 32 * (r % nb);
        d.W = P.w_out + (size_t)l * DM * DM; d.K = DM; d.N = DM; d.WT = ws + (l ? WS_WOUT1 : WS_WOUT0); d.drow0 = d.n0; return d; } r -= 2 * T::I_OUT + T::I_GU;
    if (r < T::I_DN) { const int nb = DM / 32; d.k0 = 64 * (r / nb); d.n0 = 32 * (r % nb); d.W = P.w_dn; d.K = DFF; d.N = DM; d.WT = ws + WS_WDN; d.drow0 = d.n0; d.f8 = 1; d.nscale = FP8_SWDD; return d; } r -= T::I_DN + T::I_KV + T::I_INB;
    d.f8 = 1;
    if (r < NEXP * T::I_EGU) { const int e = r / T::I_EGU; r -= e * T::I_EGU; const int nb = 2 * DFE / 32; d.k0 = 64 * (r / nb); d.n0 = 32 * (r % nb);
        d.W = P.w_egu + (size_t)e * DM * 2 * DFE; d.K = DM; d.N = 2 * DFE; d.WT = ws + WS_WEGU + (size_t)e * 2 * DFE * DM; d.drow0 = gu_row(d.n0, DFE); d.nscale = FP8_SWGU; return d; } r -= NEXP * T::I_EGU;
    { const int e = r / T::I_EDN; r -= e * T::I_EDN; const int nb = DM / 32; d.k0 = 64 * (r / nb); d.n0 = 32 * (r % nb);
        d.W = P.w_edn + (size_t)e * DFE * DM; d.K = DFE; d.N = DM; d.WT = ws + WS_WEDN + (size_t)e * DM * DFE; d.drow0 = d.n0; d.nscale = FP8_SWDN; return d; }
}
__device__ __forceinline__ void convert_weights(const Frame& F, const Ptrs& P, int gw, int NGW) {
    LAS float* scr = (LAS float*)(F.lds + F.wave * 16384);
    const int it_lo = TrCounts::NEARLY, it_hi = TrCounts::NITEMS;
    for (int it = it_lo + gw; it < it_hi; it += 2 * NGW) {
        const bool two = it + NGW < it_hi;
        const TrDesc a = tr_decode(P, it), b = tr_decode(P, two ? it + NGW : it);
        float ta[32], tb[32];
        tr_load(a, ta, F.lane); if (two) tr_load(b, tb, F.lane);
        tr_finish(a, ta, scr, F.lane); if (two) tr_finish(b, tb, scr, F.lane);
    }
}
struct Q8Desc { const float* W; unsigned char* WT; const float* kgain; float nscale; int N, n0, drow0; float* wsc; };
constexpr int Q8_INA = AW / 32, Q8_MKV = 512 / 32, Q8_GU = 2 * DFF / 32, Q8_KV = 1536 / 32, Q8_INB = DM / 32, Q8_ITEMS = Q8_INA + 2 * Q8_MKV + Q8_GU + Q8_KV + Q8_INB;
__device__ __forceinline__ Q8Desc q8_decode(const Ptrs& P, int r) {
    unsigned char* ws = P.ws; float* const WSCp = (float*)(ws + WS_WSC); Q8Desc d; d.kgain = nullptr; d.nscale = 1.f;
    if (r < Q8_INA) { d.n0 = 32 * r; d.W = P.w_in_a; d.N = AW; d.WT = ws + WS_WINA; d.drow0 = d.n0; d.nscale = d.n0 >= 3072 ? C2 : 1.f; d.wsc = WSCp + WSC_INA; return d; } r -= Q8_INA;
    if (r < 2 * Q8_MKV) { const int l = r / Q8_MKV; r -= l * Q8_MKV; d.n0 = 32 * r; d.W = P.w_mem_kv + (size_t)l * DM * 512; d.N = 512; d.WT = ws + WS_WINA; d.drow0 = AW + l * 512 + d.n0; d.kgain = P.memn + l * DM; d.wsc = WSCp + WSC_INA; return d; } r -= 2 * Q8_MKV;
    if (r < Q8_GU) { d.n0 = 32 * r; d.W = P.w_gu; d.N = 2 * DFF; d.WT = ws + WS_WGU; d.drow0 = gu_row(d.n0, DFF); d.wsc = WSCp + WSC_GU; return d; } r -= Q8_GU;
    if (r < Q8_KV) { d.n0 = 32 * r; d.W = P.w_kv; d.N = 1536; d.WT = ws + WS_WKVB; d.drow0 = d.n0; d.kgain = P.kvn; d.wsc = WSCp + WSC_KVB; return d; } r -= Q8_KV;
    { d.n0 = 32 * r; d.W = P.w_in_b; d.N = DM; d.WT = ws + WS_WKVB; d.drow0 = 1536 + d.n0; d.kgain = P.anpre + DM; d.nscale = C2; d.wsc = WSCp + WSC_KVB; return d; }
}
__device__ __forceinline__ void q8_finish(const Q8Desc& q, const float (&tv)[32], int kbase, LAS float* scr, const LAS float* cfin, int lane) {
#pragma unroll
    for (int i = 0; i < 32; ++i) scr[(2 * i + (lane >> 5)) * 33 + (lane & 31)] = tv[i];
    LDS_WAIT(); asm volatile("" ::: "memory");
    const int c = lane & 7;
#pragma unroll
    for (int j = 0; j < 4; ++j) { const int n = (lane >> 3) + 8 * j; const LAS float* s = scr + (8 * c) * 33 + n; const float inv = 127.0f / cfin[n];
        u32x2 o; o.x = pk4_i8(s[0 * 33] * inv, s[1 * 33] * inv, s[2 * 33] * inv, s[3 * 33] * inv); o.y = pk4_i8(s[4 * 33] * inv, s[5 * 33] * inv, s[6 * 33] * inv, s[7 * 33] * inv);
        *(u32x2*)(q.WT + (size_t)(q.drow0 + n) * DM + kbase + 8 * c) = o; }
    LDS_WAIT(); asm volatile("" ::: "memory");
}
__device__ __forceinline__ void q8_item(const Frame& F, const Q8Desc& q, int parity) {
    const int lane = F.lane, kp = lane >> 5, nl = lane & 31, k0 = F.wave * 128;
    LAS float* scr = (LAS float*)(F.lds + F.wave * 16384);
    const float* wp = q.W + (size_t)(k0 + kp) * q.N + q.n0 + nl;
    float ga[32], gb[32];
    if (q.kgain) {
#pragma unroll
        for (int i = 0; i < 32; ++i) { ga[i] = q.kgain[k0 + 2 * i + kp]; gb[i] = q.kgain[k0 + 64 + 2 * i + kp]; }
    } else {
#pragma unroll
        for (int i = 0; i < 32; ++i) { ga[i] = 1.f; gb[i] = 1.f; }
    }
    float ta[32], tb[32];
#pragma unroll
    for (int i = 0; i < 32; ++i) ta[i] = wp[(size_t)(2 * i) * q.N];
#pragma unroll
    for (int i = 0; i < 32; ++i) tb[i] = wp[(size_t)(64 + 2 * i) * q.N];
    float m = 0.f;
#pragma unroll
    for (int i = 0; i < 32; ++i) { const float v = ta[i] * q.nscale * ga[i]; ta[i] = v; m = fmaxf(m, __builtin_fabsf(v)); }
#pragma unroll
    for (int i = 0; i < 32; ++i) { const float v = tb[i] * q.nscale * gb[i]; tb[i] = v; m = fmaxf(m, __builtin_fabsf(v)); }
    ((LAS float*)(F.lds + F.wave * 16384 + 12288 + parity * 256))[lane] = m;
    __syncthreads();
    float cm = 1e-30f;
#pragma unroll
    for (int w = 0; w < NWAVES; ++w) { const LAS float* cp = (const LAS float*)(F.lds + w * 16384 + 12288 + parity * 256); cm = fmaxf(cm, fmaxf(cp[nl], cp[nl + 32])); }
    LAS float* cfin = (LAS float*)(F.lds + F.wave * 16384 + 12288 + 512);
    if (lane < 32) cfin[lane] = cm;
    if (F.wave == 0 && lane < 32) q.wsc[q.drow0 + lane] = cm * (1.0f / 127.0f);
    q8_finish(q, ta, k0, scr, cfin, lane);
    q8_finish(q, tb, k0 + 64, scr, cfin, lane);
}
__device__ __forceinline__ void p0_rows4_load(const float* src, int m0, int lane, f32x4 (&v)[4][4]) {
#pragma unroll
    for (int r = 0; r < 4; ++r)
#pragma unroll
        for (int j = 0; j < 4; ++j) v[r][j] = ((const f32x4*)(src + (size_t)(m0 + r) * DM))[lane + 64 * j];
}
template <bool GAIN>
__device__ __forceinline__ void p0_rows4_finish(const f32x4 (&v)[4][4], const f32x4 (&gx)[4], unsigned char* dst, float* as, int m0, int lane) {
#pragma unroll
    for (int r = 0; r < 4; ++r) {
        const float rstd = row_rstd(v[r]);
        f32x4 uu[4];
#pragma unroll
        for (int j = 0; j < 4; ++j) { uu[j] = v[r][j] * rstd; if constexpr (GAIN) uu[j] = uu[j] * gx[j]; }
        quant_row_i8(uu, dst + (size_t)(m0 + r) * DM, as + m0 + r, lane);
    }
}
constexpr int P0_NB16 = 2 * TrCounts::I_OUT + TrCounts::I_DN, P0_G16 = P0_NB16 / 16, P0_XCH = MTOK / 32, P0_MCH = MROWS / 32, P0_WITEMS = Q8_ITEMS + P0_G16, P0_ITEMS = P0_WITEMS + P0_XCH + P0_MCH;
static_assert(P0_NB16 % 16 == 0, "bf16 wave items in groups of 16");
__device__ __forceinline__ void p0_prologue(const Frame& F, const Ptrs& P) {
    unsigned char* ws = P.ws;
    float* const ASA = (float*)(ws + WS_AS);
    int parity = 0, L = F.bx;
    for (; L < P0_WITEMS; L += F.G) {
        if (L < Q8_ITEMS) { const Q8Desc q = q8_decode(P, L); q8_item(F, q, parity); parity ^= 1; continue; }
        const int r = L - Q8_ITEMS;
        LAS float* scr = (LAS float*)(F.lds + F.wave * 16384);
        const int ia = r * 16 + F.wave, ib = ia + 8;
        const int base = TrCounts::I_INA + 2 * TrCounts::I_MKV;
        const TrDesc a = tr_decode(P, base + (ia < 2 * TrCounts::I_OUT ? ia : ia + TrCounts::I_GU)), b = tr_decode(P, base + (ib < 2 * TrCounts::I_OUT ? ib : ib + TrCounts::I_GU));
        float ta[32], tb[32];
        tr_load(a, ta, F.lane); tr_load(b, tb, F.lane);
        tr_finish(a, ta, scr, F.lane); tr_finish(b, tb, scr, F.lane);
    }
    f32x4 v[4][4], vn[4][4];
#define P0_LOAD(dst, LL) do { const int c_ = (LL) - P0_WITEMS; const bool isx_ = c_ < P0_XCH; p0_rows4_load(isx_ ? P.x : P.mem, 32 * (isx_ ? c_ : c_ - P0_XCH) + 4 * F.wave, F.lane, dst); } while (0)
#define P0_FIN(src, LL) do { const int c_ = (LL) - P0_WITEMS; const bool isx_ = c_ < P0_XCH; const int m0_ = 32 * (isx_ ? c_ : c_ - P0_XCH) + 4 * F.wave; \
        if (isx_) p0_rows4_finish<true>(src, gx, ws + WS_U, ASA, m0_, F.lane); else p0_rows4_finish<false>(src, gx, ws + WS_MEMN, ASA + MTOK, m0_, F.lane); } while (0)
    if (L < P0_ITEMS) {
        f32x4 gx[4];
#pragma unroll
        for (int j = 0; j < 4; ++j) gx[j] = ((const f32x4*)P.anpre)[F.lane + 64 * j];
        P0_LOAD(v, L);
        for (;;) {
            const int L1 = L + F.G; if (L1 < P0_ITEMS) P0_LOAD(vn, L1);
            P0_FIN(v, L);
            if (L1 >= P0_ITEMS) break;
            const int L2 = L1 + F.G; if (L2 < P0_ITEMS) P0_LOAD(v, L2);
            P0_FIN(vn, L1);
            if (L2 >= P0_ITEMS) break;
            L = L2;
        }
    }
#undef P0_LOAD
#undef P0_FIN
}

__device__ __forceinline__ void load_bf16_row(const bf16_t* arow, int lane, f32x4 (&a)[4]) {
    const u32x2* ar = (const u32x2*)arow + lane;
#pragma unroll
    for (int j = 0; j < 4; ++j) { const u32x2 w = ar[64 * j]; a[j] = (f32x4){bflo(w.x), bfhi(w.x), bflo(w.y), bfhi(w.y)}; }
}
__device__ __forceinline__ float row_rstd(const f32x4 (&a)[4]) {
    float s = 0.f;
#pragma unroll
    for (int j = 0; j < 4; ++j) s += (a[j].x * a[j].x + a[j].y * a[j].y) + (a[j].z * a[j].z + a[j].w * a[j].w);
    return frsq(wave_sum(s) * (1.f / DM) + RMS_EPS);
}
template <bool BASE16, bool Q8OUT>
__device__ __forceinline__ void norm_phase(const Frame& F, const bf16_t* A, const void* base, bf16_t* H, const float* g1, bf16_t* U, const float* g2, float* as_out) {
    for (int i0 = 0; i0 < 16; i0 += 4) {
        const int m0 = F.bx * 128 + F.wave * 16 + i0;
        u32x2 ar[4][4]; f32x4 bs[4][4]; u32x2 bh[4][4];
#pragma unroll
        for (int r = 0; r < 4; ++r)
#pragma unroll
            for (int j = 0; j < 4; ++j) { ar[r][j] = ((const u32x2*)(A + (size_t)(m0 + r) * DM))[F.lane + 64 * j];
                if constexpr (BASE16) bh[r][j] = ((const u32x2*)((const bf16_t*)base + (size_t)(m0 + r) * DM))[F.lane + 64 * j];
                else bs[r][j] = ((const f32x4*)((const float*)base + (size_t)(m0 + r) * DM))[F.lane + 64 * j]; }
#pragma unroll
        for (int r = 0; r < 4; ++r) {
            const int m = m0 + r;
            f32x4 a[4];
#pragma unroll
            for (int j = 0; j < 4; ++j) a[j] = (f32x4){bflo(ar[r][j].x), bfhi(ar[r][j].x), bflo(ar[r][j].y), bfhi(ar[r][j].y)};
            const float rs = row_rstd(a);
            f32x4 h[4];
            u32x2* h8 = (u32x2*)(H + (size_t)m * DM) + F.lane;
#pragma unroll
            for (int j = 0; j < 4; ++j) { const f32x4 gg = ((const f32x4*)g1)[F.lane + 64 * j];
                f32x4 b; if constexpr (BASE16) b = (f32x4){bflo(bh[r][j].x), bfhi(bh[r][j].x), bflo(bh[r][j].y), bfhi(bh[r][j].y)}; else b = bs[r][j];
                h[j] = b + a[j] * rs * gg; u32x2 w; w.x = pk2(h[j].x, h[j].y); w.y = pk2(h[j].z, h[j].w); h8[64 * j] = w; }
            const float rh = row_rstd(h);
            if constexpr (Q8OUT) {
                f32x4 uu[4];
#pragma unroll
                for (int j = 0; j < 4; ++j) { const f32x4 gg = g2 ? ((const f32x4*)g2)[F.lane + 64 * j] : (f32x4){1.f, 1.f, 1.f, 1.f}; uu[j] = h[j] * rh * gg; }
                quant_row_i8(uu, (unsigned char*)U + (size_t)m * DM, as_out + m, F.lane);
            } else {
                u32x2* o8 = (u32x2*)(U + (size_t)m * DM) + F.lane;
#pragma unroll
                for (int j = 0; j < 4; ++j) { const f32x4 gg = g2 ? ((const f32x4*)g2)[F.lane + 64 * j] : (f32x4){1.f, 1.f, 1.f, 1.f};
                    u32x2 w; w.x = pk2(h[j].x * rh * gg.x, h[j].y * rh * gg.y); w.y = pk2(h[j].z * rh * gg.z, h[j].w * rh * gg.w); o8[64 * j] = w; }
            }
        }
    }
}

constexpr float HG_US = 4.f;
constexpr int HG_RAWQ = 0, HG_RAWF = 18432, HG_RAWV = 36864;
constexpr int HG_OT = 0;
constexpr int HG_SC = 33792;
constexpr int HG_QD = 55296, HG_KI = 72704;
constexpr int HG_KST = 90112, HG_VT = 108544;
constexpr int HG_DEC = 126976;
typedef short s16x4 __attribute__((ext_vector_type(4)));
__device__ __forceinline__ s16x4 lds_tr16(const LAS unsigned char* p) { return __builtin_bit_cast(s16x4, __builtin_amdgcn_ds_read_tr16_b64_v4i16((LAS s16x4*)p)); }
constexpr int PA_GH = 0, PA_GL = 17408, PA_KH = 34816, PA_QH = 52224, PA_V = 69632;
__device__ __forceinline__ bf16x8 pa_trfrag(const LAS unsigned char* p) {
    const s16x4 lo = lds_tr16(p), hi = lds_tr16(p + 4 * 272);
    return (bf16x8){lo[0], lo[1], lo[2], lo[3], hi[0], hi[1], hi[2], hi[3]};
}
__device__ __forceinline__ void hgrnA_phase(const Frame& F, const Ptrs& P) {
    const int tid = F.tid, lane = F.lane, w = F.wave;
    LAS unsigned char* L = F.lds;
    const int sc0 = tid >> 4, sch = tid & 15;
    const int fr = lane & 15, g = lane >> 4;
    bf16_t* const GQD = (bf16_t*)(P.ws + WS_HGQD); bf16_t* const GOI = (bf16_t*)(P.ws + WS_HGOI); unsigned char* const GU = P.ws + WS_HGU; float* const GDEC = (float*)(P.ws + WS_HGDEC);
    const int NU = NB * 6 * 64;
    bf16x8 tri0, tri16, ones;
#pragma unroll
    for (int j = 0; j < 8; ++j) { tri0[j] = (8 * g + j <= fr) ? (short)0x3F80 : (short)0; tri16[j] = (8 * g + j <= fr + 16) ? (short)0x3F80 : (short)0; ones[j] = (short)0x3F80; }
    const int trl = (8 * g + ((lane & 15) >> 2)) * 272 + (lane & 3) * 8;
    u32x4 rq[2], rf[2], rv[2];
    {
        const int unit = F.bx; const int bh = unit >> 6, n = unit & 63, b = bh / 6, h = bh % 6;
        const bf16_t* PR = (const bf16_t*)(P.ws + WS_R1) + (size_t)(b * SEQ + n * 64) * AW;
#pragma unroll
        for (int i = 0; i < 2; ++i) { const bf16_t* rp = PR + (size_t)(sc0 + 32 * i) * AW + sch * 8;
            rq[i] = *(const u32x4*)(rp + h * 128); rf[i] = *(const u32x4*)(rp + 768 + h * 128); rv[i] = *(const u32x4*)(rp + 1536 + h * 128); }
    }
    for (int unit = F.bx; unit < NU; unit += F.G) {
        const int bh = unit >> 6, h = bh % 6;
        {
            float lb[8];
            { const f32x4 a00 = *(const f32x4*)(P.hlb + h * 128 + 8 * sch), a01 = *(const f32x4*)(P.hlb + h * 128 + 8 * sch + 4), a10 = *(const f32x4*)(P.hlb + HF + h * 128 + 8 * sch), a11 = *(const f32x4*)(P.hlb + HF + h * 128 + 8 * sch + 4);
#pragma unroll
              for (int e = 0; e < 4; ++e) { lb[e] = frcp(1.0f + fexp2(1.4426950408889634f * (a10[e] - a00[e]))); lb[4 + e] = frcp(1.0f + fexp2(1.4426950408889634f * (a11[e] - a01[e]))); } }
#pragma unroll
            for (int i = 0; i < 2; ++i) {
                const unsigned fw[4] = {rf[i].x, rf[i].y, rf[i].z, rf[i].w}, qw[4] = {rq[i].x, rq[i].y, rq[i].z, rq[i].w};
                unsigned gh[4], gl[4], kh[4], qh[4];
#pragma unroll
                for (int e2 = 0; e2 < 4; ++e2) {
                    float gg[2], kk[2], qq[2];
#pragma unroll
                    for (int o = 0; o < 2; ++o) {
                        const float fl = o ? bfhi(fw[e2]) : bflo(fw[e2]), ql = o ? bfhi(qw[e2]) : bflo(qw[e2]);
                        const float sg = sigmoidf_(fl); const float lbk = lb[2 * e2 + o];
                        gg[o] = flog2(lbk + (1.0f - lbk) * sg); kk[o] = (1.0f - lbk) * (1.0f - sg); qq[o] = ql * sigmoidf_(ql);
                    }
                    gh[e2] = pk2(gg[0], gg[1]);
                    gl[e2] = pk2(gg[0] - bflo(gh[e2]), gg[1] - bfhi(gh[e2]));
                    kh[e2] = pk2(kk[0], kk[1]); qh[e2] = pk2(qq[0], qq[1]);
                }
                const int off = (sc0 + 32 * i) * 272 + sch * 16;
                *(LAS u32x4*)(L + PA_GH + off) = (u32x4){gh[0], gh[1], gh[2], gh[3]}; *(LAS u32x4*)(L + PA_GL + off) = (u32x4){gl[0], gl[1], gl[2], gl[3]};
                *(LAS u32x4*)(L + PA_KH + off) = (u32x4){kh[0], kh[1], kh[2], kh[3]}; *(LAS u32x4*)(L + PA_QH + off) = (u32x4){qh[0], qh[1], qh[2], qh[3]};
                *(LAS u32x4*)(L + PA_V + off) = rv[i];
            }
        }
        LDS_BARRIER();
        if (unit + F.G < NU) {
            const int u2 = unit + F.G; const int bh2 = u2 >> 6, n2 = u2 & 63, b2 = bh2 / 6, h2 = bh2 % 6;
            const bf16_t* PR = (const bf16_t*)(P.ws + WS_R1) + (size_t)(b2 * SEQ + n2 * 64) * AW;
#pragma unroll
            for (int i = 0; i < 2; ++i) { const bf16_t* rp = PR + (size_t)(sc0 + 32 * i) * AW + sch * 8;
                rq[i] = *(const u32x4*)(rp + h2 * 128); rf[i] = *(const u32x4*)(rp + 768 + h2 * 128); rv[i] = *(const u32x4*)(rp + 1536 + h2 * 128); }
        }
        f32x4 bc[4];
        {
            bf16x8 gfh[2], gfl[2];
#pragma unroll
            for (int ks = 0; ks < 2; ++ks) { gfh[ks] = pa_trfrag(L + PA_GH + (32 * ks) * 272 + (16 * w) * 2 + trl); gfl[ks] = pa_trfrag(L + PA_GL + (32 * ks) * 272 + (16 * w) * 2 + trl); }
#pragma unroll
            for (int ct = 0; ct < 4; ++ct) bc[ct] = (f32x4){0.f, 0.f, 0.f, 0.f};
            bc[0] = __builtin_amdgcn_mfma_f32_16x16x32_bf16(gfh[0], tri0, bc[0], 0, 0, 0);  bc[0] = __builtin_amdgcn_mfma_f32_16x16x32_bf16(gfl[0], tri0, bc[0], 0, 0, 0);
            bc[1] = __builtin_amdgcn_mfma_f32_16x16x32_bf16(gfh[0], tri16, bc[1], 0, 0, 0); bc[1] = __builtin_amdgcn_mfma_f32_16x16x32_bf16(gfl[0], tri16, bc[1], 0, 0, 0);
            bc[2] = __builtin_amdgcn_mfma_f32_16x16x32_bf16(gfh[0], ones, bc[2], 0, 0, 0);  bc[2] = __builtin_amdgcn_mfma_f32_16x16x32_bf16(gfl[0], ones, bc[2], 0, 0, 0);
            bc[2] = __builtin_amdgcn_mfma_f32_16x16x32_bf16(gfh[1], tri0, bc[2], 0, 0, 0);  bc[2] = __builtin_amdgcn_mfma_f32_16x16x32_bf16(gfl[1], tri0, bc[2], 0, 0, 0);
            bc[3] = __builtin_amdgcn_mfma_f32_16x16x32_bf16(gfh[0], ones, bc[3], 0, 0, 0);  bc[3] = __builtin_amdgcn_mfma_f32_16x16x32_bf16(gfl[0], ones, bc[3], 0, 0, 0);
            bc[3] = __builtin_amdgcn_mfma_f32_16x16x32_bf16(gfh[1], tri16, bc[3], 0, 0, 0); bc[3] = __builtin_amdgcn_mfma_f32_16x16x32_bf16(gfl[1], tri16, bc[3], 0, 0, 0);
        }
        {
            f32x4 dec;
#pragma unroll
            for (int r = 0; r < 4; ++r) dec[r] = fexp2(__shfl(bc[3][r], (lane & 48) | 15));
            if (fr == 0) *(f32x4*)(GDEC + (size_t)unit * 128 + 16 * w + 4 * g) = dec;
#pragma unroll
            for (int ct = 0; ct < 4; ++ct) {
                const int off = (16 * ct + fr) * 272 + (16 * w + 4 * g) * 2;
                const u32x2 qh = *(const LAS u32x2*)(L + PA_QH + off), kh = *(const LAS u32x2*)(L + PA_KH + off);
                const float qv[4] = {bflo(qh.x), bfhi(qh.x), bflo(qh.y), bfhi(qh.y)}, kv[4] = {bflo(kh.x), bfhi(kh.x), bflo(kh.y), bfhi(kh.y)};
                float qd[4], ki[4], ks[4];
#pragma unroll
                for (int r = 0; r < 4; ++r) { const float e1 = fexp2(bc[ct][r]), e2 = fexp2(-bc[ct][r]); qd[r] = qv[r] * e1; ki[r] = kv[r] * e2; ks[r] = ki[r] * dec[r]; }
                *(LAS u32x2*)(L + PA_QH + off) = (u32x2){pk2(qd[0], qd[1]), pk2(qd[2], qd[3])};
                *(LAS u32x2*)(L + PA_KH + off) = (u32x2){pk2(ki[0], ki[1]), pk2(ki[2], ki[3])};
                *(LAS u32x2*)(L + PA_GH + off) = (u32x2){pk2(ks[0], ks[1]), pk2(ks[2], ks[3])};
            }
        }
        LDS_BARRIER();
#pragma unroll
        for (int i = 0; i < 2; ++i) { const int c = sc0 + 32 * i; *(u32x4*)(GQD + ((size_t)unit * 64 + c) * 128 + sch * 8) = *(const LAS u32x4*)(L + PA_QH + c * 272 + sch * 16); }
        {
            const int ci = w >> 1;
#pragma unroll
            for (int q = 0; q < 2; ++q) { const int si = 2 * (w & 1) + q;
                if (si <= ci) {
                    f32x4 d = (f32x4){0.f, 0.f, 0.f, 0.f};
#pragma unroll
                    for (int ks = 0; ks < 4; ++ks) {
                        const bf16x8 a = *(const LAS bf16x8*)(L + PA_KH + (16 * si + fr) * 272 + ks * 64 + g * 16);
                        const bf16x8 bb = *(const LAS bf16x8*)(L + PA_QH + (16 * ci + fr) * 272 + ks * 64 + g * 16);
                        d = __builtin_amdgcn_mfma_f32_16x16x32_bf16(a, bb, d, 0, 0, 0);
                    }
                    const int c = 16 * ci + fr, s0 = 16 * si + 4 * g;
#pragma unroll
                    for (int r = 0; r < 4; ++r) if (s0 + r > c) d[r] = 0.f;
                    *(LAS u32x2*)(L + PA_GL + c * 144 + s0 * 2) = (u32x2){pk2(d[0], d[1]), pk2(d[2], d[3])};
                } else {
                    const int c = 16 * ci + fr, s0 = 16 * si + 4 * g;
                    *(LAS u32x2*)(L + PA_GL + c * 144 + s0 * 2) = (u32x2){0u, 0u};
                }
            }
        }
        LDS_BARRIER();
        {
            const int j0 = 16 * w;
            bf16x8 vfrag[2];
#pragma unroll
            for (int ks = 0; ks < 2; ++ks) vfrag[ks] = pa_trfrag(L + PA_V + (32 * ks) * 272 + j0 * 2 + trl);
#pragma unroll
            for (int ct = 0; ct < 4; ++ct) {
                f32x4 o = (f32x4){0.f, 0.f, 0.f, 0.f};
#pragma unroll
                for (int ks = 0; ks < 2; ++ks) if (32 * ks <= 16 * ct + 15) {
                    const bf16x8 sc = *(const LAS bf16x8*)(L + PA_GL + (16 * ct + fr) * 144 + ks * 64 + g * 16);
                    o = __builtin_amdgcn_mfma_f32_16x16x32_bf16(vfrag[ks], sc, o, 0, 0, 0);
                }
                *(u32x2*)(GOI + ((size_t)unit * 64 + 16 * ct + fr) * 128 + j0 + 4 * g) = (u32x2){pk2(o[0], o[1]), pk2(o[2], o[3])};
            }
            unsigned uw[8];
#pragma unroll
            for (int kt = 0; kt < 8; ++kt) {
                f32x4 acc = (f32x4){0.f, 0.f, 0.f, 0.f};
#pragma unroll
                for (int cs = 0; cs < 2; ++cs) {
                    const bf16x8 a = pa_trfrag(L + PA_GH + (32 * cs) * 272 + (16 * kt) * 2 + trl);
                    acc = __builtin_amdgcn_mfma_f32_16x16x32_bf16(a, vfrag[cs], acc, 0, 0, 0);
                }
                uw[kt] = pk4_fp8s(acc[0] * HG_US, acc[1] * HG_US, acc[2] * HG_US, acc[3] * HG_US);
            }
            u32x4* up = (u32x4*)(GU + (((size_t)unit * 8 + w) * 64 + lane) * 32);
#pragma unroll
            for (int q = 0; q < 2; ++q) up[q] = (u32x4){uw[4 * q], uw[4 * q + 1], uw[4 * q + 2], uw[4 * q + 3]};
        }
        LDS_BARRIER();
    }
}

constexpr int HC_QD = 0;
constexpr int HC_DEC = 26112;
constexpr int HC_OT = 27648;
constexpr int HC_NG = 44544;
struct HcSet { u32x4 qp; float dp; u32x4 ur[2], oi, og; };
struct HcCtx { __amdgpu_buffer_rsrc_t rQD, rOI, rU, rDEC, rPR; bf16_t* MIX; unsigned vQD, vOI, vU, vDEC, vPR; int bh, b, h, r0, sc0, sch, c5, sub, fr, g, j0, tid, lane, w; };
__device__ __forceinline__ void abl16(u32x4& d, unsigned voff, __amdgpu_buffer_rsrc_t r, unsigned soff) { asm volatile("buffer_load_dwordx4 %0, %1, %2, %3 offen" : "=v"(d) : "v"(voff), "s"(r), "s"(soff) : "memory"); }
__device__ __forceinline__ void abl4(float& d, unsigned voff, __amdgpu_buffer_rsrc_t r, unsigned soff) { asm volatile("buffer_load_dword %0, %1, %2, %3 offen" : "=v"(d) : "v"(voff), "s"(r), "s"(soff) : "memory"); }
__device__ __forceinline__ void hc_load(const HcCtx& C, HcSet& d, int n) {
    const unsigned unit = (unsigned)(C.bh * 64 + n);
    abl16(d.qp, C.vQD, C.rQD, unit * 16384u);
    if (C.w < 2) abl4(d.dp, C.vDEC, C.rDEC, unit * 512u);
    abl16(d.ur[0], C.vU, C.rU, unit * 16384u); abl16(d.ur[1], C.vU + 16u, C.rU, unit * 16384u);
    abl16(d.oi, C.vOI, C.rOI, unit * 16384u);
    { const unsigned so = (unsigned)((C.b * SEQ + n * 64) * AW * 2); abl16(d.og, C.vPR, C.rPR, so); }
}
#define HC_PIN(d) "+v"((d).qp), "+v"((d).dp), "+v"((d).ur[0]), "+v"((d).ur[1]), "+v"((d).oi), "+v"((d).og)
__device__ __forceinline__ void hc_stage(const HcCtx& C, LAS unsigned char* L, const HcSet& d, int slot) {
    *(LAS u32x4*)(L + HC_QD + slot * 8704 + C.sc0 * 272 + C.sch * 16) = d.qp;
    if (C.w < 2) *(LAS float*)(L + HC_DEC + slot * 512 + C.tid * 4) = d.dp;
}
__device__ __forceinline__ void hc_step(const HcCtx& C, LAS unsigned char* L, f32x4 (&S)[8], int n, HcSet& cur, HcSet& nxt, HcSet& nx2, int slot, int slot_nxt) {
    if (n >= 64) return;
    if (n + 2 < 64) { hc_load(C, nx2, n + 2); asm volatile("s_waitcnt vmcnt(12)" : HC_PIN(cur)); }
    else asm volatile("s_waitcnt vmcnt(0)" : HC_PIN(cur));
    const int fr = C.fr, g = C.g, j0 = C.j0;
    {
        f32x4 o[2];
#pragma unroll
        for (int ct = 0; ct < 2; ++ct) o[ct] = (f32x4){0.f, 0.f, 0.f, 0.f};
#pragma unroll
        for (int ks = 0; ks < 4; ++ks) {
            u32x4 sa; sa.x = pk2(S[2 * ks][0], S[2 * ks][1]); sa.y = pk2(S[2 * ks][2], S[2 * ks][3]); sa.z = pk2(S[2 * ks + 1][0], S[2 * ks + 1][1]); sa.w = pk2(S[2 * ks + 1][2], S[2 * ks + 1][3]);
            const bf16x8 sfrag = __builtin_bit_cast(bf16x8, sa);
#pragma unroll
            for (int ct = 0; ct < 2; ++ct) {
                const u32x2 q0 = *(const LAS u32x2*)(L + HC_QD + slot * 8704 + (16 * ct + fr) * 272 + (32 * ks + 4 * g) * 2);
                const u32x2 q1 = *(const LAS u32x2*)(L + HC_QD + slot * 8704 + (16 * ct + fr) * 272 + (32 * ks + 16 + 4 * g) * 2);
                const bf16x8 qf = __builtin_bit_cast(bf16x8, (u32x4){q0.x, q0.y, q1.x, q1.y});
                o[ct] = __builtin_amdgcn_mfma_f32_16x16x32_bf16(sfrag, qf, o[ct], 0, 0, 0);
            }
        }
#pragma unroll
        for (int ct = 0; ct < 2; ++ct) *(LAS f32x4*)(L + HC_OT + (16 * ct + fr) * 528 + (j0 + 4 * g) * 4) = o[ct];
#pragma unroll
        for (int kt = 0; kt < 8; ++kt) {
            const f32x4 dc = *(const LAS f32x4*)(L + HC_DEC + slot * 512 + (16 * kt + 4 * g) * 4);
            const unsigned uu = (kt & 3) == 0 ? cur.ur[kt >> 2].x : (kt & 3) == 1 ? cur.ur[kt >> 2].y : (kt & 3) == 2 ? cur.ur[kt >> 2].z : cur.ur[kt >> 2].w;
            const f32x2 ulo = __builtin_amdgcn_cvt_pk_f32_fp8((int)uu, false), uhi = __builtin_amdgcn_cvt_pk_f32_fp8((int)uu, true);
            S[kt] = S[kt] * dc + (f32x4){ulo.x, ulo.y, uhi.x, uhi.y} * (1.0f / HG_US);
        }
    }
    LDS_BARRIER();
    {
        f32x4 ov[2]; float ss = 0.f;
        const unsigned oiw[4] = {cur.oi.x, cur.oi.y, cur.oi.z, cur.oi.w};
#pragma unroll
        for (int j = 0; j < 2; ++j) { ov[j] = *(const LAS f32x4*)(L + HC_OT + C.c5 * 528 + (8 * C.sub + 4 * j) * 4);
            ov[j] = ov[j] + (f32x4){bflo(oiw[2 * j]), bfhi(oiw[2 * j]), bflo(oiw[2 * j + 1]), bfhi(oiw[2 * j + 1])};
            ss += (ov[j].x * ov[j].x + ov[j].y * ov[j].y) + (ov[j].z * ov[j].z + ov[j].w * ov[j].w); }
        ss += swz_xor<1>(ss); ss += swz_xor<2>(ss); ss += swz_xor<4>(ss); ss += swz_xor<8>(ss);
        const float rs = frsq(ss * (1.f / 128.f) + RMS_EPS);
        const unsigned ogw[4] = {cur.og.x, cur.og.y, cur.og.z, cur.og.w};
        float r[8]; f32x4 ngv[2];
#pragma unroll
        for (int j = 0; j < 2; ++j) ngv[j] = *(const LAS f32x4*)(L + HC_NG + (8 * C.sub + 4 * j) * 4);
#pragma unroll
        for (int j = 0; j < 2; ++j)
#pragma unroll
            for (int e = 0; e < 4; ++e) { const unsigned wv = ogw[2 * j + (e >> 1)]; const float gg = (e & 1) ? bfhi(wv) : bflo(wv); r[4 * j + e] = ov[j][e] * rs * ngv[j][e] * gg * sigmoidf_(gg); }
        bf16_t* op = C.MIX + (size_t)(n * 64 + C.r0 + C.c5) * DM + C.h * 128 + 8 * C.sub;
        *(u32x4*)op = (u32x4){pk2(r[0], r[1]), pk2(r[2], r[3]), pk2(r[4], r[5]), pk2(r[6], r[7])};
    }
    if (n + 1 < 64) {
        if (n + 2 < 64) asm volatile("s_waitcnt vmcnt(7)" : HC_PIN(nxt)); else asm volatile("s_waitcnt vmcnt(0)" : HC_PIN(nxt));
        hc_stage(C, L, nxt, slot_nxt);
    }
    LDS_BARRIER();
}
__device__ __forceinline__ void hgrn_chain(const Frame& F, const Ptrs& P, int wgi) {
    HcCtx C;
    const int bh = wgi >> 1; const int b = bh / 6; C.bh = bh; C.b = b; C.h = bh % 6; C.r0 = 32 * (wgi & 1);
    C.tid = F.tid; C.lane = F.lane; C.w = F.wave;
    LAS unsigned char* L = F.lds;
    C.MIX = (bf16_t*)(P.ws + WS_MIX) + (size_t)b * SEQ * DM;
    C.rQD = __builtin_amdgcn_make_buffer_rsrc(P.ws + WS_HGQD, 0, 3072 * 16384, 0x00020000);
    C.rOI = __builtin_amdgcn_make_buffer_rsrc(P.ws + WS_HGOI, 0, 3072 * 16384, 0x00020000);
    C.rU = __builtin_amdgcn_make_buffer_rsrc(P.ws + WS_HGU, 0, 3072 * 16384, 0x00020000);
    C.rDEC = __builtin_amdgcn_make_buffer_rsrc(P.ws + WS_HGDEC, 0, 3072 * 512, 0x00020000);
    C.rPR = __builtin_amdgcn_make_buffer_rsrc(P.ws + WS_R1, 0, MTOK * AW * 2, 0x00020000);
    C.sc0 = C.tid >> 4; C.sch = C.tid & 15; C.c5 = C.tid >> 4; C.sub = C.tid & 15;
    C.fr = C.lane & 15; C.g = C.lane >> 4; C.j0 = 16 * C.w;
    C.vQD = (unsigned)(((C.r0 + C.sc0) * 128 + C.sch * 8) * 2); C.vOI = (unsigned)(((C.r0 + C.c5) * 128 + 8 * C.sub) * 2); C.vU = (unsigned)((C.w * 64 + C.lane) * 32); C.vDEC = (unsigned)(C.tid * 4);
    C.vPR = (unsigned)(((C.r0 + C.c5) * AW + 2304 + C.h * 128 + 8 * C.sub) * 2);
    if (C.tid < 128) *(LAS float*)(L + HC_NG + C.tid * 4) = P.hon[C.tid];
    f32x4 S[8];
#pragma unroll
    for (int kt = 0; kt < 8; ++kt) S[kt] = (f32x4){0.f, 0.f, 0.f, 0.f};
    HcSet d0, d1, d2;
    d0.dp = d1.dp = d2.dp = 0.f;
    d0.qp = d1.qp = d2.qp = (u32x4){0u, 0u, 0u, 0u};
    VM_WAIT();
    hc_load(C, d0, 0); hc_load(C, d1, 1);
    asm volatile("s_waitcnt vmcnt(5)" : HC_PIN(d0));
    hc_stage(C, L, d0, 0);
    LDS_BARRIER();
    for (int n = 0; n < 66; n += 6) {
        hc_step(C, L, S, n, d0, d1, d2, 0, 1);
        hc_step(C, L, S, n + 1, d1, d2, d0, 1, 2);
        hc_step(C, L, S, n + 2, d2, d0, d1, 2, 0);
        hc_step(C, L, S, n + 3, d0, d1, d2, 0, 1);
        hc_step(C, L, S, n + 4, d1, d2, d0, 1, 2);
        hc_step(C, L, S, n + 5, d2, d0, d1, 2, 0);
        asm volatile("s_waitcnt vmcnt(0)" : HC_PIN(d0), HC_PIN(d1), HC_PIN(d2));
    }
    VM_WAIT();
}

constexpr int MA_K = 0;
constexpr int MA_VT = 36864;
__device__ __forceinline__ void memattn_unit(const Frame& F, const bf16_t* Q, int qpitch, int qcol, const bf16_t* MKV, int kvcol, bf16_t* MIXo, int unit) {
    const int tb = unit >> 2, mh = unit & 3, b = tb >> 4;
    const int tid = F.tid, lane = F.lane, w = F.wave, r32 = lane & 31, hi = lane >> 5;
    LAS unsigned char* L = F.lds;
#pragma unroll
    for (int i = 0; i < 4; ++i) { const int p = tid + 512 * i, key = p >> 3, chn = p & 7;
        const bf16_t* src = MKV + (size_t)(b * MEML + key) * DM + kvcol + mh * 64 + chn * 8;
        const u32x4 kk = *(const u32x4*)src; const u32x4 vv = *(const u32x4*)(src + 256);
        *(LAS u32x4*)(L + MA_K + key * 144 + chn * 16) = kk;
        const unsigned vw[4] = {vv.x, vv.y, vv.z, vv.w};
#pragma unroll
        for (int e = 0; e < 4; ++e) { *(LAS unsigned short*)(L + MA_VT + (chn * 8 + 2 * e) * 520 + key * 2) = (unsigned short)(vw[e] & 0xffffu);
            *(LAS unsigned short*)(L + MA_VT + (chn * 8 + 2 * e + 1) * 520 + key * 2) = (unsigned short)(vw[e] >> 16); } }
    const int tok0 = tb * 256 + w * 32;
    bf16x8 qr[4];
#pragma unroll
    for (int s = 0; s < 4; ++s) qr[s] = *(const bf16x8*)(Q + (size_t)(tok0 + r32) * qpitch + qcol + mh * 64 + 16 * s + 8 * hi);
    LDS_BARRIER();
    f32x16 p[8];
#pragma unroll
    for (int kt = 0; kt < 8; ++kt) { p[kt] = f32x16{};
#pragma unroll
        for (int s = 0; s < 4; ++s) { const bf16x8 a = *(const LAS bf16x8*)(L + MA_K + (32 * kt + r32) * 144 + s * 32 + hi * 16);
            p[kt] = __builtin_amdgcn_mfma_f32_32x32x16_bf16(a, qr[s], p[kt], 0, 0, 0); } }
    float mx = -3.0e38f;
#pragma unroll
    for (int kt = 0; kt < 8; ++kt)
#pragma unroll
        for (int r = 0; r < 16; ++r) mx = fmaxf(mx, p[kt][r]);
    mx = fmaxf(mx, __shfl_xor(mx, 32));
    float sum = 0.f;
#pragma unroll
    for (int kt = 0; kt < 8; ++kt)
#pragma unroll
        for (int r = 0; r < 16; ++r) { p[kt][r] = fexp2(p[kt][r] - mx); sum += p[kt][r]; }
    sum += __shfl_xor(sum, 32);
    const float inv = frcp(sum);
    f32x16 o[2]; o[0] = f32x16{}; o[1] = f32x16{};
#pragma unroll
    for (int kt = 0; kt < 8; ++kt)
#pragma unroll
        for (int s2 = 0; s2 < 2; ++s2) {
            u32x4 pw; pw.x = pk2(p[kt][8 * s2 + 0] * inv, p[kt][8 * s2 + 1] * inv); pw.y = pk2(p[kt][8 * s2 + 2] * inv, p[kt][8 * s2 + 3] * inv);
            pw.z = pk2(p[kt][8 * s2 + 4] * inv, p[kt][8 * s2 + 5] * inv); pw.w = pk2(p[kt][8 * s2 + 6] * inv, p[kt][8 * s2 + 7] * inv);
            const bf16x8 pa = __builtin_bit_cast(bf16x8, pw);
#pragma unroll
            for (int dt = 0; dt < 2; ++dt) {
                const u32x2 v0 = *(const LAS u32x2*)(L + MA_VT + (32 * dt + r32) * 520 + (32 * kt + 16 * s2 + 4 * hi) * 2);
                const u32x2 v1 = *(const LAS u32x2*)(L + MA_VT + (32 * dt + r32) * 520 + (32 * kt + 16 * s2 + 8 + 4 * hi) * 2);
                const bf16x8 vb = __builtin_bit_cast(bf16x8, (u32x4){v0.x, v0.y, v1.x, v1.y});
                o[dt] = __builtin_amdgcn_mfma_f32_32x32x16_bf16(pa, vb, o[dt], 0, 0, 0);
            }
        }
#pragma unroll
    for (int dt = 0; dt < 2; ++dt)
#pragma unroll
        for (int r = 0; r < 16; ++r) MIXo[(size_t)(tok0 + crow(r, hi)) * DM + 768 + mh * 64 + 32 * dt + r32] = (bf16_t)f2bf(o[dt][r]);
    LDS_BARRIER();
}

constexpr int SB_SLOT = 19456;
constexpr int SB_VOFF = 9216;
constexpr int SB_NSLOT = 6;
constexpr int SB_FLAG = SB_NSLOT * SB_SLOT;
__device__ __forceinline__ int sb_unit_of(int L) { return (L >> 4) * 16 + (15 - (L & 15)); }
__device__ __forceinline__ void sb_prefetch_q(const Frame& F, const bf16_t* KVQ, int unit, bf16x8 (&q)[4]) {
    const int qb = unit & 15, hh = (unit >> 4) % 12, b = unit / 192;
    const int r32 = F.lane & 31, hi = F.lane >> 5;
    const bf16_t* base = KVQ + (size_t)b * SEQ * KVQW;
    const int tq = qb * 256 + F.wave * 32 + r32;
#pragma unroll
    for (int s = 0; s < 4; ++s) q[s] = *(const bf16x8*)(base + (size_t)tq * KVQW + 1536 + hh * 64 + 16 * s + 8 * hi);
}
__device__ __forceinline__ int sb_unit(const Frame& F, const bf16_t* KVQ, bf16_t* MIXo, int unit, const bf16x8 (&qpre)[4], int have_lo, int have_hi) {
    const int qb = unit & 15, hh = (unit >> 4) % 12, b = unit / 192;
    const int tid = F.tid, lane = F.lane, w = F.wave, r32 = lane & 31, hi = lane >> 5;
    LAS unsigned char* L = F.lds;
    const bf16_t* base = KVQ + (size_t)b * SEQ * KVQW;
    const int q0 = qb * 256 + w * 32;
    const int tq = q0 + r32;
    bf16x8 qr[4];
#pragma unroll
    for (int s = 0; s < 4; ++s) qr[s] = qpre[s];
    bf16x8 tri[2], ones;
#pragma unroll
    for (int s2 = 0; s2 < 2; ++s2)
#pragma unroll
        for (int j = 0; j < 8; ++j) { const int k = 16 * s2 + 8 * (j >> 2) + 4 * hi + (j & 3); tri[s2][j] = (k > r32) ? (short)0x3F80 : (short)0; }
#pragma unroll
    for (int j = 0; j < 8; ++j) ones[j] = (short)0x3F80;
    f32x16 o[2]; o[0] = f32x16{}; o[1] = f32x16{};
    float R = 0.f;
    const int skey = tid >> 3, schn = tid & 7;
    const bf16_t* srcb = base + (size_t)skey * KVQW + hh * 64 + schn * 8;
    const int kwr = skey * 144 + schn * 16, vwr = SB_VOFF + skey * 160 + schn * 16;
    const int vlane = SB_VOFF + (4 * hi + ((lane & 15) >> 2)) * 160 + ((lane >> 4) & 1) * 32 + (lane & 3) * 8;
    {
        u32x4 kk[4], vv[4];
#pragma unroll
        for (int i = 0; i < 4; ++i) { const int tt = 4 * qb + i; if (tt < have_lo || tt > have_hi) { const bf16_t* src = srcb + (size_t)(tt * 64) * KVQW; kk[i] = *(const u32x4*)src; vv[i] = *(const u32x4*)(src + 768); } }
#pragma unroll
        for (int i = 0; i < 4; ++i) { const int tt = 4 * qb + i; if (tt < have_lo || tt > have_hi) { const int sl = tt % SB_NSLOT; *(LAS u32x4*)(L + sl * SB_SLOT + kwr) = kk[i]; *(LAS u32x4*)(L + sl * SB_SLOT + vwr) = vv[i]; } }
    }
    LDS_BARRIER();
    const int jd = 4 * qb + (w >> 1);
    int slot = jd % SB_NSLOT;
    int pslot = (4 * qb + SB_NSLOT - 1) % SB_NSLOT;
    bool mydone = false;
    int lo_loaded = (have_lo <= have_hi && have_lo < 4 * qb) ? have_lo : 4 * qb;
    for (int st = 0; ; ++st) {
        const int tpre = 4 * qb - st - 1;
        u32x4 kreg, vreg;
        const bool need_pre = tpre >= 0 && (tpre < have_lo || tpre > have_hi);
        if (need_pre) { const bf16_t* src = srcb + (size_t)(tpre * 64) * KVQW; kreg = *(const u32x4*)src; vreg = *(const u32x4*)(src + 768); }
        const int t = jd - st;
        if (t >= 0 && !mydone) {
            const int k0 = 64 * t;
            const LAS unsigned char* Kb = L + slot * SB_SLOT;
            f32x16 p0 = f32x16{}, p1 = f32x16{};
#pragma unroll
            for (int s = 0; s < 4; ++s) {
                const bf16x8 a0 = *(const LAS bf16x8*)(Kb + r32 * 144 + s * 32 + hi * 16);
                const bf16x8 a1 = *(const LAS bf16x8*)(Kb + (32 + r32) * 144 + s * 32 + hi * 16);
                p0 = __builtin_amdgcn_mfma_f32_32x32x16_bf16(a0, qr[s], p0, 0, 0, 0);
                p1 = __builtin_amdgcn_mfma_f32_32x32x16_bf16(a1, qr[s], p1, 0, 0, 0);
            }
            float l0[16], l1[16];
            float csum = 0.f;
#pragma unroll
            for (int r = 0; r < 16; ++r) {
                const float z0 = fminf(p0[r], 80.f), z1 = fminf(p1[r], 80.f);
                const float sp0 = flog2(1.0f + fexp2(z0)), sp1 = flog2(1.0f + fexp2(z1));
                float a = -sp0, bq = -sp1, lb0 = z0 - sp0, lb1 = z1 - sp1;
                if (st == 0) { const int key0 = k0 + crow(r, hi); if (key0 >= tq) { a = 0.f; lb0 = -INFINITY; } if (key0 + 32 >= tq) { bq = 0.f; lb1 = -INFINITY; } }
                l0[r] = a; l1[r] = bq; p0[r] = lb0; p1[r] = lb1; csum += a + bq;
            }
            csum += __shfl_xor(csum, 32);
            bf16x8 x0[2], x1[2];
#pragma unroll
            for (int s2 = 0; s2 < 2; ++s2) {
                u32x4 t0, t1;
                t0.x = pk2(l0[8 * s2 + 0], l0[8 * s2 + 1]); t0.y = pk2(l0[8 * s2 + 2], l0[8 * s2 + 3]); t0.z = pk2(l0[8 * s2 + 4], l0[8 * s2 + 5]); t0.w = pk2(l0[8 * s2 + 6], l0[8 * s2 + 7]);
                t1.x = pk2(l1[8 * s2 + 0], l1[8 * s2 + 1]); t1.y = pk2(l1[8 * s2 + 2], l1[8 * s2 + 3]); t1.z = pk2(l1[8 * s2 + 4], l1[8 * s2 + 5]); t1.w = pk2(l1[8 * s2 + 6], l1[8 * s2 + 7]);
                x0[s2] = __builtin_bit_cast(bf16x8, t0); x1[s2] = __builtin_bit_cast(bf16x8, t1);
            }
            f32x16 y0, y1;
#pragma unroll
            for (int r = 0; r < 16; ++r) { y0[r] = R; y1[r] = R; }
            y0 = __builtin_amdgcn_mfma_f32_32x32x16_bf16(tri[0], x0[0], y0, 0, 0, 0);
            y0 = __builtin_amdgcn_mfma_f32_32x32x16_bf16(tri[1], x0[1], y0, 0, 0, 0);
            y0 = __builtin_amdgcn_mfma_f32_32x32x16_bf16(ones, x1[0], y0, 0, 0, 0);
            y0 = __builtin_amdgcn_mfma_f32_32x32x16_bf16(ones, x1[1], y0, 0, 0, 0);
            y1 = __builtin_amdgcn_mfma_f32_32x32x16_bf16(tri[0], x1[0], y1, 0, 0, 0);
            y1 = __builtin_amdgcn_mfma_f32_32x32x16_bf16(tri[1], x1[1], y1, 0, 0, 0);
#pragma unroll
            for (int r = 0; r < 16; ++r) { p0[r] = fexp2(p0[r] + y0[r]); p1[r] = fexp2(p1[r] + y1[r]); }
            R += csum;
            const LAS unsigned char* Vl = Kb + vlane;
#pragma unroll
            for (int half = 0; half < 2; ++half)
#pragma unroll
                for (int s2 = 0; s2 < 2; ++s2) {
                    u32x4 pw;
                    if (half == 0) { pw.x = pk2(p0[8 * s2 + 0], p0[8 * s2 + 1]); pw.y = pk2(p0[8 * s2 + 2], p0[8 * s2 + 3]); pw.z = pk2(p0[8 * s2 + 4], p0[8 * s2 + 5]); pw.w = pk2(p0[8 * s2 + 6], p0[8 * s2 + 7]); }
                    else { pw.x = pk2(p1[8 * s2 + 0], p1[8 * s2 + 1]); pw.y = pk2(p1[8 * s2 + 2], p1[8 * s2 + 3]); pw.z = pk2(p1[8 * s2 + 4], p1[8 * s2 + 5]); pw.w = pk2(p1[8 * s2 + 6], p1[8 * s2 + 7]); }
                    const bf16x8 pa = __builtin_bit_cast(bf16x8, pw);
#pragma unroll
                    for (int dt = 0; dt < 2; ++dt) {
                        const int kb = 32 * half + 16 * s2;
                        const s16x4 vlo = lds_tr16(Vl + kb * 160 + dt * 64), vhi = lds_tr16(Vl + (kb + 8) * 160 + dt * 64);
                        const bf16x8 vb = (bf16x8){vlo[0], vlo[1], vlo[2], vlo[3], vhi[0], vhi[1], vhi[2], vhi[3]};
                        o[dt] = __builtin_amdgcn_mfma_f32_32x32x16_bf16(pa, vb, o[dt], 0, 0, 0);
                    }
                }
        }
        if (t <= 0 || __all(R <= -150.f) != 0) mydone = true;
        if (lane == 0) *(LAS unsigned*)(L + SB_FLAG + ((st & 1) * 8 + w) * 4) = mydone ? 1u : 0u;
        if (need_pre) { *(LAS u32x4*)(L + pslot * SB_SLOT + kwr) = kreg; *(LAS u32x4*)(L + pslot * SB_SLOT + vwr) = vreg; }
        if (tpre >= 0 && tpre < lo_loaded) lo_loaded = tpre;
        LDS_BARRIER();
        { const u32x4 f0 = *(const LAS u32x4*)(L + SB_FLAG + (st & 1) * 32), f1 = *(const LAS u32x4*)(L + SB_FLAG + (st & 1) * 32 + 16);
          if ((f0.x & f0.y & f0.z & f0.w & f1.x & f1.y & f1.z & f1.w) != 0u) break; }
        slot = (slot == 0) ? SB_NSLOT - 1 : slot - 1;
        pslot = (pslot == 0) ? SB_NSLOT - 1 : pslot - 1;
    }
#pragma unroll
    for (int dt = 0; dt < 2; ++dt)
#pragma unroll
        for (int r = 0; r < 16; ++r) MIXo[(size_t)(b * SEQ + q0 + crow(r, hi)) * DM + hh * 64 + 32 * dt + r32] = (bf16_t)f2bf(o[dt][r]);
    LDS_BARRIER();
    return lo_loaded;
}
__device__ __forceinline__ void sb_phase(const Frame& F, const bf16_t* KVQ, bf16_t* MIXo) {
    bf16x8 qa[4], qb_[4];
    const int L0 = 6 * F.bx;
    sb_prefetch_q(F, KVQ, sb_unit_of(L0), qa);
    int have_lo = 1, have_hi = 0;
    for (int j = 0; j < 6; j += 2) {
        const int Lc = L0 + j;
        sb_prefetch_q(F, KVQ, sb_unit_of(Lc + 1), qb_);
        { const int u = sb_unit_of(Lc); const int lo = sb_unit(F, KVQ, MIXo, u, qa, have_lo, have_hi);
          if (((Lc + 1) >> 4) == (Lc >> 4)) { have_lo = lo; have_hi = lo + SB_NSLOT - 1; } else { have_lo = 1; have_hi = 0; } }
        if (j + 2 < 6) sb_prefetch_q(F, KVQ, sb_unit_of(Lc + 2), qa);
        { const int u = sb_unit_of(Lc + 1); const int lo = sb_unit(F, KVQ, MIXo, u, qb_, have_lo, have_hi);
          if (((Lc + 2) >> 4) == ((Lc + 1) >> 4)) { have_lo = lo; have_hi = lo + SB_NSLOT - 1; } else { have_lo = 1; have_hi = 0; } }
    }
}

struct Args { const float* in[20]; float* out; unsigned char* ws; };

__global__ void __launch_bounds__(NTHR, 2) yoco_fwd(Args args) {
    extern __shared__ __attribute__((aligned(16))) unsigned char lds_raw[];
    Frame F;
    F.lds = (LAS unsigned char*)lds_raw;
    F.tid = threadIdx.x; F.lane = F.tid & 63; F.wave = __builtin_amdgcn_readfirstlane(F.tid >> 6);
    F.G = gridDim.x; F.bx = blockIdx.x;
    Ptrs P;
    P.x = args.in[0]; P.mem = args.in[1]; P.anpre = args.in[2]; P.anpost = args.in[3]; P.fnpre = args.in[4]; P.fnpost = args.in[5];
    P.w_in_a = args.in[6]; P.hlb = args.in[7]; P.hon = args.in[8]; P.w_in_b = args.in[9]; P.kvn = args.in[10]; P.w_kv = args.in[11];
    P.memn = args.in[12]; P.w_mem_kv = args.in[13]; P.w_out = args.in[14]; P.w_gu = args.in[15]; P.w_dn = args.in[16]; P.w_router = args.in[17];
    P.w_egu = args.in[18]; P.w_edn = args.in[19]; P.out = args.out; P.ws = args.ws;
    unsigned char* ws = args.ws;
    unsigned* ctl = (unsigned*)(ws + WS_CTL);
    volatile LAS unsigned* MISC = (volatile LAS unsigned*)(F.lds + MISC_OFF);
    for (int u = F.tid; u < (LDS_BYTES - LDSCTL_OFF) / 4; u += NTHR) ((LAS unsigned*)(F.lds + LDSCTL_OFF))[u] = 0u;
    __syncthreads();
    XcdBarrier bar = xcd_barrier_post(ctl + CW_BAR, MISC + 8);
    {
        if (F.tid == 0) { const unsigned xcc = xb_xcc_id(); const unsigned rk = xb_add((unsigned*)ctl + CW_XRANK + xcc, 1u); MISC[12] = (xcc < 8u && rk < (unsigned)(F.G >> 3) && (F.G & 7) == 0) ? rk * 8u + xcc : 0xffffffffu; }
        __syncthreads();
        if (F.tid == 0 && MISC[12] == 0xffffffffu) __hip_atomic_store((unsigned*)ctl + CW_XRANK + 15, 1u, __ATOMIC_RELAXED, __HIP_MEMORY_SCOPE_AGENT);
    }
#define GRID_BAR() xcd_barrier(bar)

    bf16_t* const U = (bf16_t*)(ws + WS_U);
    bf16_t* const R1 = (bf16_t*)(ws + WS_R1);
    bf16_t* const MIX = (bf16_t*)(ws + WS_MIX);
    bf16_t* const MIXED = (bf16_t*)(ws + WS_MIXED);
    bf16_t* const MKV = (bf16_t*)(ws + WS_MKV);
    bf16_t* const H16 = (bf16_t*)(ws + WS_H16);

    { const Frame Fp = phase_frame(F); p0_prologue(Fp, P); }
    GRID_BAR();
    if (__hip_atomic_load((unsigned*)ctl + CW_XRANK + 15, __ATOMIC_RELAXED, __HIP_MEMORY_SCOPE_AGENT) == 0u) F.bx = (int)MISC[12];
    {
        pg8::Gemm g{U, (const bf16_t*)(ws + WS_WINA), MTOK, AW, DM / 2}; pg8::StaticOrder S; S.init(MTOK, AW, F.G, F.bx);
        S.ext_n = 32; S.ext_pm0 = MTOK / 256; S.ext_pn0 = AW / 256;
        pg8::EpiStoreQ E{R1, AW, (const float*)(ws + WS_AS), (const float*)(ws + WS_WSC) + WSC_INA, MKV, DM, MTOK / 256, AW / 256};
        pg8::gemm_phase<pg8::EpiStoreQ, pg8::StaticOrder, true, true, 2>(F.lds, g, S, E);
    }
    GRID_BAR();
    { const Frame Fp = phase_frame(F); hgrnA_phase(Fp, P); }
    { const Frame Fp = phase_frame(F); for (int u = F.bx; u < 512; u += F.G) memattn_unit(Fp, R1, AW, 3072, MKV, 0, MIX, u); }
    GRID_BAR();
    { const Frame Fp = phase_frame(F); if (F.bx < 96) hgrn_chain(Fp, P, ((((F.bx >> 4) << 3) | (F.bx & 7)) << 1) | ((F.bx >> 3) & 1));
      else convert_weights(Fp, P, (F.bx - 96) * NWAVES + Fp.wave, (F.G - 96) * NWAVES); }
    GRID_BAR();
    {
        pg8::Gemm g{MIX, (const bf16_t*)(ws + WS_WOUT0), MTOK, DM, DM}; pg8::StaticOrder S; S.init(MTOK, DM, F.G, F.bx);
        pg8::EpiStore E{MIXED, DM, 1.f, nullptr, 0, 0, 0};
        pg8::gemm_phase<pg8::EpiStore, pg8::StaticOrder, true, true>(F.lds, g, S, E);
    }
    GRID_BAR();
    { const Frame Fp = phase_frame(F); norm_phase<false, true>(Fp, MIXED, P.x, H16, P.anpost, U, P.fnpre, (float*)(ws + WS_AS + 256 * 1024)); }
#if STOP_AFTER >= 5
    GRID_BAR();
    {
        pg8::Gemm g{U, (const bf16_t*)(ws + WS_WGU), MTOK, 2 * DFF, DM / 2}; pg8::StaticOrder S; S.init(MTOK, 2 * DFF, F.G, F.bx);
        pg8::EpiSwiGLUQ8 E{(unsigned char*)R1, DFF, (const float*)(ws + WS_AS + 256 * 1024), (const float*)(ws + WS_WSC) + WSC_GU};
        pg8::gemm_phase<pg8::EpiSwiGLUQ8, pg8::StaticOrder, true, true, 2>(F.lds, g, S, E);
    }
    GRID_BAR();
    {
        pg8::Gemm g{R1, (const bf16_t*)(ws + WS_WDN), MTOK, DM, DFF / 2}; pg8::StaticOrder S; S.init(MTOK, DM, F.G, F.bx);
        pg8::EpiStore E{MIXED, DM, 1.0f / (FP8_SHD * FP8_SWDD), nullptr, 0, 0, 0};
        pg8::gemm_phase<pg8::EpiStore, pg8::StaticOrder, true, true, 1>(F.lds, g, S, E);
    }
    GRID_BAR();
    { const Frame Fp = phase_frame(F); norm_phase<true, true>(Fp, MIXED, H16, H16, P.fnpost, U, nullptr, (float*)(ws + WS_AS + 512 * 1024)); }
#endif
#if STOP_AFTER >= 8
    GRID_BAR();
    {
        pg8::Gemm g{U, (const bf16_t*)(ws + WS_WKVB), MTOK, KVQW, DM / 2}; pg8::StaticOrder S; S.init(MTOK, KVQW, F.G, F.bx);
        pg8::EpiStoreQ E{R1, KVQW, (const float*)(ws + WS_AS + 512 * 1024), (const float*)(ws + WS_WSC) + WSC_KVB, nullptr, 0, 0, 0};
        pg8::gemm_phase<pg8::EpiStoreQ, pg8::StaticOrder, true, true, 2>(F.lds, g, S, E);
    }
    GRID_BAR();
    {
        { const Frame Fp = phase_frame(F); sb_phase(Fp, R1, MIX); }
        { const Frame Fp = phase_frame(F); for (int u = F.bx; u < 512; u += F.G) memattn_unit(Fp, R1, KVQW, 2304, MKV, 512, MIX, u); }
    }
    GRID_BAR();
    {
        pg8::Gemm g{MIX, (const bf16_t*)(ws + WS_WOUT1), MTOK, DM, DM}; pg8::StaticOrder S; S.init(MTOK, DM, F.G, F.bx);
        pg8::EpiStore E{MIXED, DM, 1.f, nullptr, 0, 0, 0};
        pg8::gemm_phase<pg8::EpiStore, pg8::StaticOrder, true, true>(F.lds, g, S, E);
    }
    GRID_BAR();
    {
        const Frame Fq = phase_frame(F);
        LAS unsigned* lcnt = (LAS unsigned*)(F.lds + 32768);
        LAS float* WRt = (LAS float*)(F.lds);
        if (Fq.tid < 8) lcnt[Fq.tid] = 0u;
        for (int idx = Fq.tid; idx < DM * NEXP; idx += NTHR) WRt[(idx & 7) * DM + (idx >> 3)] = P.w_router[idx];
        __syncthreads();
        const float* g1 = P.anpost + DM; const float* g2 = P.fnpre + DM;
        for (int i0 = 0; i0 < 16; i0 += 4) {
          const int m0 = F.bx * 128 + Fq.wave * 16 + i0;
          u32x2 ar[4][4], bs[4][4];
#pragma unroll
          for (int r = 0; r < 4; ++r)
#pragma unroll
            for (int j = 0; j < 4; ++j) { ar[r][j] = ((const u32x2*)(MIXED + (size_t)(m0 + r) * DM))[Fq.lane + 64 * j]; bs[r][j] = ((const u32x2*)(H16 + (size_t)(m0 + r) * DM))[Fq.lane + 64 * j]; }
#pragma unroll
          for (int r = 0; r < 4; ++r) {
            const int m = m0 + r;
            f32x4 a[4];
#pragma unroll
            for (int j = 0; j < 4; ++j) a[j] = (f32x4){bflo(ar[r][j].x), bfhi(ar[r][j].x), bflo(ar[r][j].y), bfhi(ar[r][j].y)};
            const float rs = row_rstd(a);
            f32x4 h[4];
#pragma unroll
            for (int j = 0; j < 4; ++j) { const f32x4 gg = ((const f32x4*)g1)[Fq.lane + 64 * j];
                h[j] = (f32x4){bflo(bs[r][j].x), bfhi(bs[r][j].x), bflo(bs[r][j].y), bfhi(bs[r][j].y)} + a[j] * rs * gg;
                u32x2 hw; hw.x = pk2(h[j].x, h[j].y); hw.y = pk2(h[j].z, h[j].w); ((u32x2*)(H16 + (size_t)m * DM))[Fq.lane + 64 * j] = hw; }
            const float rh = row_rstd(h);
            unsigned* o4 = (unsigned*)((unsigned char*)U + (size_t)m * DM) + Fq.lane;
            float lg[8];
#pragma unroll
            for (int e = 0; e < 8; ++e) lg[e] = 0.f;
#pragma unroll
            for (int j = 0; j < 4; ++j) { const f32x4 gg = ((const f32x4*)g2)[Fq.lane + 64 * j];
                const f32x4 uu = h[j] * rh * gg;
                o4[64 * j] = pk4_fp8s(uu.x * FP8_SX, uu.y * FP8_SX, uu.z * FP8_SX, uu.w * FP8_SX);
#pragma unroll
                for (int e = 0; e < 8; ++e) { const f32x4 w4 = *(const LAS f32x4*)(WRt + e * DM + 4 * Fq.lane + 256 * j); lg[e] += uu.x * w4.x + uu.y * w4.y + uu.z * w4.z + uu.w * w4.w; } }
#pragma unroll
            for (int e = 0; e < 8; ++e) lg[e] = wave_sum(lg[e]);
            int i0 = 0; float l0 = lg[0];
#pragma unroll
            for (int e = 1; e < 8; ++e) if (lg[e] > l0) { l0 = lg[e]; i0 = e; }
            int i1 = -1; float l1 = -3.0e38f;
#pragma unroll
            for (int e = 0; e < 8; ++e) if (e != i0 && lg[e] > l1) { l1 = lg[e]; i1 = e; }
            const float g0 = 1.0f / (1.0f + __expf(l1 - l0));
            if (Fq.lane == 0) {
                const unsigned r0 = __hip_atomic_fetch_add(lcnt + i0, 1u, __ATOMIC_RELAXED, __HIP_MEMORY_SCOPE_WORKGROUP);
                const unsigned r1 = __hip_atomic_fetch_add(lcnt + i1, 1u, __ATOMIC_RELAXED, __HIP_MEMORY_SCOPE_WORKGROUP);
                ((int4*)(ws + WS_META))[m] = make_int4(i0, i1, (int)r0, (int)r1);
                ((float2*)(ws + WS_GATE))[m] = make_float2(g0, 1.0f - g0);
            }
          }
        }
        __syncthreads();
        if (Fq.tid < 8) { const unsigned base = __hip_atomic_fetch_add(ctl + CW_GCNT + Fq.tid, lcnt[Fq.tid], __ATOMIC_RELAXED, __HIP_MEMORY_SCOPE_AGENT); ((unsigned*)(ws + WS_WGB))[F.bx * 8 + Fq.tid] = base; }
    }
#endif
#if STOP_AFTER >= 12
    GRID_BAR();
    int ts[NEXP + 1];
    {
        const Frame Fq = phase_frame(F);
        ts[0] = 0;
#pragma unroll
        for (int e = 0; e < NEXP; ++e) { const unsigned c = __hip_atomic_load(ctl + CW_GCNT + e, __ATOMIC_RELAXED, __HIP_MEMORY_SCOPE_AGENT); ts[e + 1] = ts[e] + (int)((c + 255u) >> 8); }
        bf16_t* XS = R1;
        for (int i0 = 0; i0 < 16; i0 += 4) {
            const int m0 = F.bx * 128 + Fq.wave * 16 + i0;
            int4 mt[4]; u32x4 v0[4];
#pragma unroll
            for (int r = 0; r < 4; ++r) { mt[r] = ((const int4*)(ws + WS_META))[m0 + r]; v0[r] = *((const u32x4*)((const unsigned char*)U + (size_t)(m0 + r) * DM) + Fq.lane); }
#pragma unroll
            for (int r = 0; r < 4; ++r) {
                int d0 = 0, d1 = 0;
#pragma unroll
                for (int e = 0; e < NEXP; ++e) { if (mt[r].x == e) d0 = ts[e] * 256; if (mt[r].y == e) d1 = ts[e] * 256; }
                d0 += (int)((const unsigned*)(ws + WS_WGB))[F.bx * 8 + mt[r].x] + mt[r].z;
                d1 += (int)((const unsigned*)(ws + WS_WGB))[F.bx * 8 + mt[r].y] + mt[r].w;
                *((u32x4*)((unsigned char*)XS + (size_t)d0 * DM) + Fq.lane) = v0[r]; *((u32x4*)((unsigned char*)XS + (size_t)d1 * DM) + Fq.lane) = v0[r];
                if (Fq.lane == 0) ((int2*)(ws + WS_DEST))[m0 + r] = make_int2(d0, d1);
            }
        }
    }
    GRID_BAR();
    {
        pg8::Gemm g{R1, (const bf16_t*)(ws + WS_WEGU), 0, 2 * DFE, DM / 2}; pg8::StaticOrder S; S.init(256, 2 * DFE, F.G, F.bx);
        S.nM = ts[NEXP]; S.nwg = S.nM * S.nN; S.moe = 1;
#pragma unroll
        for (int e = 0; e < NEXP; ++e) S.ts[e] = ts[e];
        pg8::EpiSwiGLU8 E{(unsigned char*)(ws + WS_EH), DFE, 1.0f / (FP8_SX * FP8_SWGU)};
        pg8::gemm_phase<pg8::EpiSwiGLU8, pg8::StaticOrder, true, true, 1>(F.lds, g, S, E);
    }
    GRID_BAR();
    {
        pg8::Gemm g{(const bf16_t*)(ws + WS_EH), (const bf16_t*)(ws + WS_WEDN), 0, DM, DFE / 2}; pg8::StaticOrder S; S.init(256, DM, F.G, F.bx);
        S.nM = ts[NEXP]; S.nwg = S.nM * S.nN; S.moe = 1;
#pragma unroll
        for (int e = 0; e < NEXP; ++e) S.ts[e] = ts[e];
        pg8::EpiStore E{R1 + (size_t)XS_ROWS * DM / 2, DM, 1.0f / (FP8_SH * FP8_SWDN), nullptr, 0, 0, 0};
        pg8::gemm_phase<pg8::EpiStore, pg8::StaticOrder, true, true, 1>(F.lds, g, S, E);
    }
    GRID_BAR();
    {
        const Frame Fq = phase_frame(F);
        const float* g1 = P.fnpost + DM;
        const bf16_t* YS = R1 + (size_t)XS_ROWS * DM / 2;
        for (int i0 = 0; i0 < 16; i0 += 4) {
            const int m0 = F.bx * 128 + Fq.wave * 16 + i0;
            int2 d[4]; float2 gt[4];
#pragma unroll
            for (int r = 0; r < 4; ++r) { d[r] = ((const int2*)(ws + WS_DEST))[m0 + r]; gt[r] = ((const float2*)(ws + WS_GATE))[m0 + r]; }
            u32x2 ya[4][4], yb[4][4], bs[4][4];
#pragma unroll
            for (int r = 0; r < 4; ++r)
#pragma unroll
                for (int j = 0; j < 4; ++j) { ya[r][j] = ((const u32x2*)(YS + (size_t)d[r].x * DM))[Fq.lane + 64 * j]; yb[r][j] = ((const u32x2*)(YS + (size_t)d[r].y * DM))[Fq.lane + 64 * j];
                    bs[r][j] = ((const u32x2*)(H16 + (size_t)(m0 + r) * DM))[Fq.lane + 64 * j]; }
#pragma unroll
            for (int r = 0; r < 4; ++r) {
                f32x4 a[4];
#pragma unroll
                for (int j = 0; j < 4; ++j) a[j] = (f32x4){bflo(ya[r][j].x), bfhi(ya[r][j].x), bflo(ya[r][j].y), bfhi(ya[r][j].y)} * gt[r].x + (f32x4){bflo(yb[r][j].x), bfhi(yb[r][j].x), bflo(yb[r][j].y), bfhi(yb[r][j].y)} * gt[r].y;
                const float rs = row_rstd(a);
#pragma unroll
                for (int j = 0; j < 4; ++j) { const f32x4 gg = ((const f32x4*)g1)[Fq.lane + 64 * j];
                    ((f32x4*)(P.out + (size_t)(m0 + r) * DM))[Fq.lane + 64 * j] = (f32x4){bflo(bs[r][j].x), bfhi(bs[r][j].x), bflo(bs[r][j].y), bfhi(bs[r][j].y)} + a[j] * rs * gg; }
            }
        }
    }
#endif
}

extern "C" void kernel_launch(void* const* d_in, const int* in_sizes, int n_in, void* d_out, int out_size, void* d_ws, size_t ws_size, hipStream_t stream) {
    static int grid = 0;
    if (grid == 0) {
        if (n_in != 20 || out_size != MTOK * DM || ws_size < WS_END) { fprintf(stderr, "kernel_launch: unexpected shapes (n_in %d out %d ws %zu)\n", n_in, out_size, ws_size); grid = -1; return; }
        int dev = 0, cus = 0, per_cu = 0;
        if (hipGetDevice(&dev) != hipSuccess || hipDeviceGetAttribute(&cus, hipDeviceAttributeMultiprocessorCount, dev) != hipSuccess) { grid = -1; return; }
        if (hipFuncSetAttribute((const void*)yoco_fwd, hipFuncAttributeMaxDynamicSharedMemorySize, LDS_BYTES) != hipSuccess) { fprintf(stderr, "kernel_launch: hipFuncSetAttribute failed\n"); grid = -1; return; }
        if (hipOccupancyMaxActiveBlocksPerMultiprocessor(&per_cu, (const void*)yoco_fwd, NTHR, LDS_BYTES) != hipSuccess || per_cu < 1) { fprintf(stderr, "kernel_launch: occupancy query says %d\n", per_cu); }
        (void)hipGetLastError();
        if (cus < 256) { fprintf(stderr, "kernel_launch: need 256 CUs, have %d\n", cus); grid = -1; return; }
        grid = 256;
    }
    if (grid < 0) return;
    if (hipMemsetAsync((char*)d_ws + WS_CTL, 0, CTL_ZERO_BYTES, stream) != hipSuccess) return;
    Args a{};
    for (int i = 0; i < 20; ++i) a.in[i] = (const float*)d_in[i];
    a.out = (float*)d_out; a.ws = (unsigned char*)d_ws;
    hipLaunchKernelGGL(yoco_fwd, dim3(grid), dim3(NTHR), LDS_BYTES, stream, a);
}
```

```cpp
#include <hip/hip_runtime.h>
#include <cstdio>
#include <cstdint>

#ifndef STOP_AFTER
#define STOP_AFTER 99
#endif

#define LAS __attribute__((address_space(3)))
#define GAS __attribute__((address_space(1)))
typedef unsigned short bf16_t;
typedef short bf16x8 __attribute__((ext_vector_type(8)));
typedef float f32x4 __attribute__((ext_vector_type(4)));
typedef float f32x16 __attribute__((ext_vector_type(16)));
typedef float f32x2 __attribute__((ext_vector_type(2)));
typedef unsigned u32x4 __attribute__((ext_vector_type(4)));
typedef unsigned u32x2 __attribute__((ext_vector_type(2)));
typedef __bf16 bf16x2_t __attribute__((ext_vector_type(2)));

constexpr int NB = 8, SEQ = 4096, DM = 1024, MTOK = NB * SEQ;
constexpr int MEML = 256, MROWS = NB * MEML;
constexpr int AW = 3328, HF = 768, DFF = 2816, NEXP = 8, DFE = 3584;
constexpr int KVQW = 2560;
constexpr int XS_ROWS = 2 * MTOK + NEXP * 256;
constexpr float RMS_EPS = 1e-6f;
constexpr float C2 = 0.125f * 1.4426950408889634f;
constexpr int NWAVES = 8, NTHR = 512;

constexpr size_t MiB = 1u << 20;
constexpr size_t WS_CTL = 0, CTL_ZERO_BYTES = 128 * 1024;
constexpr size_t WS_MEMN = 395 * MiB + 32 * MiB;
constexpr size_t WS_MEMN_OLD_UNUSED = 459 * MiB;
constexpr size_t WS_AS = 1 * MiB;
constexpr size_t WS_WSC = 2 * MiB;
constexpr int WSC_INA = 0, WSC_GU = 4352, WSC_KVB = 9984, WSC_N = 12544;
constexpr size_t WS_MKV = 5 * MiB;
constexpr size_t WS_META = 9 * MiB;
constexpr size_t WS_GATE = WS_META + 512 * 1024, WS_DEST = WS_GATE + 256 * 1024, WS_WGB = WS_DEST + 256 * 1024;
constexpr size_t WS_WOUT1 = 12 * MiB;
constexpr size_t WS_WKVB = 14 * MiB;
constexpr size_t WS_WEGU = 19 * MiB;
constexpr size_t WS_WEDN = 131 * MiB;
constexpr size_t WS_R1 = 187 * MiB;
constexpr size_t WS_EH = 395 * MiB;
constexpr size_t WS_U = 395 * MiB;
constexpr size_t WS_MIX = 459 * MiB;
constexpr size_t WS_MIXED = 523 * MiB;
constexpr size_t WS_WINA = 587 * MiB;
constexpr size_t WS_WMKV = 587 * MiB + (size_t)3328 * 1024;
constexpr size_t WS_WMKV_OLD_UNUSED = 587 * MiB + (size_t)3328 * 1024 * 2;
constexpr size_t WS_WOUT0 = 596 * MiB;
constexpr size_t WS_WGU = 598 * MiB;
constexpr size_t WS_WDN = 609 * MiB;
constexpr size_t WS_HGQD = 640 * MiB;
constexpr size_t WS_HGOI = 688 * MiB;
constexpr size_t WS_HGU = 736 * MiB;
constexpr size_t WS_HGDEC = 832 * MiB;
constexpr size_t WS_H16 = 640 * MiB;
constexpr size_t WS_END = 857 * MiB;
static_assert(WS_EH + (size_t)XS_ROWS * DFE * 2 <= WS_END, "EH fits");
static_assert(WS_R1 + (size_t)MTOK * AW * 2 <= WS_EH, "R1 fits");
constexpr int CW_BAR = 4096;
constexpr int CW_GCNT = 16384;
constexpr int CW_XRANK = 16448;
static_assert((CW_XRANK + 16) * 4 <= (int)CTL_ZERO_BYTES, "control words inside the zeroed region");

constexpr int RING_BYTES = 131072;
constexpr int LDSCTL_OFF = RING_BYTES, MISC_OFF = LDSCTL_OFF + 320;
constexpr int LDS_BYTES = 147456;

__device__ __forceinline__ unsigned f2bf(float f) { unsigned u = __builtin_bit_cast(unsigned, f); return (u + 0x7fffu + ((u >> 16) & 1u)) >> 16; }
__device__ __forceinline__ unsigned pk2(float lo, float hi) { f32x2 v = {lo, hi}; bf16x2_t b = __builtin_convertvector(v, bf16x2_t); return __builtin_bit_cast(unsigned, b); }
__device__ __forceinline__ float bflo(unsigned w) { return __builtin_bit_cast(float, w << 16); }
__device__ __forceinline__ float bfhi(unsigned w) { return __builtin_bit_cast(float, w & 0xffff0000u); }
__device__ __forceinline__ float bf1(unsigned short s) { return __builtin_bit_cast(float, (unsigned)s << 16); }
__device__ __forceinline__ float wave_sum(float v);
__device__ __forceinline__ float fexp2(float x) { return __builtin_amdgcn_exp2f(x); }
__device__ __forceinline__ float flog2(float x) { return __builtin_amdgcn_logf(x); }
__device__ __forceinline__ float frcp(float x) { return __builtin_amdgcn_rcpf(x); }
__device__ __forceinline__ float frsq(float x) { return __builtin_amdgcn_rsqf(x); }
template <int X> __device__ __forceinline__ float swz_xor(float v) { return __builtin_bit_cast(float, __builtin_amdgcn_ds_swizzle(__builtin_bit_cast(int, v), (X << 10) | 0x1F)); }
__device__ __forceinline__ float wave_sum(float v) {
    v += swz_xor<1>(v); v += swz_xor<2>(v); v += swz_xor<4>(v); v += swz_xor<8>(v); v += swz_xor<16>(v);
    const float lo = __builtin_bit_cast(float, __builtin_amdgcn_readlane(__builtin_bit_cast(int, v), 0)), hi = __builtin_bit_cast(float, __builtin_amdgcn_readlane(__builtin_bit_cast(int, v), 32));
    return lo + hi;
}
__device__ __forceinline__ float sigmoidf_(float x) { return frcp(1.0f + fexp2(-1.4426950408889634f * x)); }
typedef int i32x4 __attribute__((ext_vector_type(4)));
typedef int i32x8 __attribute__((ext_vector_type(8)));
__device__ __forceinline__ float sat8(float x) { return __builtin_amdgcn_fmed3f(x, -448.f, 448.f); }
__device__ __forceinline__ unsigned pk4_fp8s(float a, float b, float c, float d) { int w = 0; w = __builtin_amdgcn_cvt_pk_fp8_f32(sat8(a), sat8(b), w, false); w = __builtin_amdgcn_cvt_pk_fp8_f32(sat8(c), sat8(d), w, true); return (unsigned)w; }
__device__ __forceinline__ unsigned pk4_fp8(float a, float b, float c, float d) { int w = 0; w = __builtin_amdgcn_cvt_pk_fp8_f32(a, b, w, false); w = __builtin_amdgcn_cvt_pk_fp8_f32(c, d, w, true); return (unsigned)w; }
constexpr float FP8_SX = 8.f, FP8_SH = 8.f, FP8_SWGU = 32.f, FP8_SWDN = 64.f, FP8_SHD = 8.f, FP8_SWDD = 64.f;
__device__ __forceinline__ float wave_max(float v) {
    v = fmaxf(v, swz_xor<1>(v)); v = fmaxf(v, swz_xor<2>(v)); v = fmaxf(v, swz_xor<4>(v)); v = fmaxf(v, swz_xor<8>(v)); v = fmaxf(v, swz_xor<16>(v));
    const float lo = __builtin_bit_cast(float, __builtin_amdgcn_readlane(__builtin_bit_cast(int, v), 0)), hi = __builtin_bit_cast(float, __builtin_amdgcn_readlane(__builtin_bit_cast(int, v), 32));
    return fmaxf(lo, hi);
}
__device__ __forceinline__ unsigned pk4_i8(float a, float b, float c, float d) {
    const int ia = (int)__builtin_rintf(__builtin_amdgcn_fmed3f(a, -127.f, 127.f)), ib = (int)__builtin_rintf(__builtin_amdgcn_fmed3f(b, -127.f, 127.f)),
              ic = (int)__builtin_rintf(__builtin_amdgcn_fmed3f(c, -127.f, 127.f)), id = (int)__builtin_rintf(__builtin_amdgcn_fmed3f(d, -127.f, 127.f));
    return (unsigned)(ia & 0xff) | ((unsigned)(ib & 0xff) << 8) | ((unsigned)(ic & 0xff) << 16) | ((unsigned)id << 24);
}
__device__ __forceinline__ void quant_row_i8(const f32x4 (&uu)[4], unsigned char* qrow, float* as_slot, int lane) {
    float am = 0.f;
#pragma unroll
    for (int j = 0; j < 4; ++j) am = fmaxf(fmaxf(am, fmaxf(__builtin_fabsf(uu[j].x), __builtin_fabsf(uu[j].y))), fmaxf(__builtin_fabsf(uu[j].z), __builtin_fabsf(uu[j].w)));
    am = fmaxf(wave_max(am), 1e-20f);
    const float inv = 127.0f / am;
    unsigned* o4 = (unsigned*)qrow + lane;
#pragma unroll
    for (int j = 0; j < 4; ++j) o4[64 * j] = pk4_i8(uu[j].x * inv, uu[j].y * inv, uu[j].z * inv, uu[j].w * inv);
    if (lane == 0) *as_slot = am * (1.0f / 127.0f);
}
__device__ __forceinline__ int crow(int r, int hi) { return (r & 3) + 8 * (r >> 2) + 4 * hi; }
#define LDS_WAIT() asm volatile("s_waitcnt lgkmcnt(0)" ::: "memory")
#define VM_WAIT() asm volatile("s_waitcnt vmcnt(0)" ::: "memory")
#define LDS_BARRIER() do { asm volatile("s_waitcnt lgkmcnt(0)" ::: "memory"); __builtin_amdgcn_s_barrier(); asm volatile("" ::: "memory"); } while (0)

namespace pg8 {
#define PG8_LAS __attribute__((address_space(3)))
constexpr int BM = 256, BK = 64, HALF = 128, HTB = HALF * BK * 2, STAGE_BYTES = 8 * HTB, NXCD = 8, WGM = 4;
__host__ __device__ __forceinline__ int lds_byte(int r, int c) { const int st = (r >> 4) * 2 + (c >> 5), rr = r & 15, cc = c & 31, ob = rr * 64 + cc * 2; return st * 1024 + (ob ^ (((ob >> 9) & 1) << 5)); }
__host__ __device__ __forceinline__ void stage_rc(int b, int& R, int& C) { const int st = b / 1024, sb = b % 1024, swz = sb ^ (((sb >> 9) & 1) << 5); R = (st >> 1) * 16 + swz / 64; C = (st & 1) * 32 + (swz % 64) / 2; }
__host__ __device__ __forceinline__ int perm32(int rho) { const int n = rho >> 4, i = rho & 15; return 8 * (i >> 2) + 4 * n + (i & 3); }

struct Unit { int pm, pn, pb; };
struct Gemm { const bf16_t* A; const bf16_t* Bt; int M, N, K; };

struct StaticOrder {
    int nM, nN, nwg, G, c;
    int ts[NEXP];
    int moe;
    int ext_n, ext_pm0, ext_pn0;
    __device__ void init(int M, int N, int G_, int c_) { nM = M / BM; nN = N / BM; nwg = nM * nN; G = G_; c = c_; moe = 0; ext_n = 0; ext_pm0 = 0; ext_pn0 = 0;
#pragma unroll
        for (int e = 0; e < NEXP; ++e) ts[e] = 0; }
    __device__ bool next(int i, Unit& u) const {
        const long L = (long)i * G + c; if (L >= nwg + ext_n) return false;
        if (L >= nwg) { const int j = (int)L - nwg; u.pm = ext_pm0 + (j >> 2); u.pn = ext_pn0 + (j & 3); u.pb = u.pn; return true; }
        int wgid = (int)L; { const int q = nwg / NXCD, r = nwg % NXCD, xcd = wgid % NXCD, off = wgid / NXCD; wgid = (xcd < r ? xcd * (q + 1) : r * (q + 1) + (xcd - r) * q) + off; }
        const int nig = WGM * nN, gid = wgid / nig, fm = gid * WGM, gsz = (nM - fm) < WGM ? (nM - fm) : WGM;
        u.pm = fm + ((wgid % nig) % gsz); u.pn = (wgid % nig) / gsz; u.pb = u.pn;
        if (moe) { int e = 0;
#pragma unroll
            for (int j = 1; j < NEXP; ++j) e += (u.pm >= ts[j]) ? 1 : 0;
            u.pb = e * nN + u.pn; }
        return true;
    }
    __device__ __forceinline__ void a_ready(const Unit&) const {}
    __device__ __forceinline__ void done(const Unit&) const {}
};

struct EpiStore {
    static constexpr bool PERM = true, AFTER_DRAIN = false;
    bf16_t* O; int ldc; float sc;
    bf16_t* O2; int ldc2, pm2, pn2;
    __device__ __forceinline__ void operator()(const f32x4 (&acc)[2][2][4][2], const Unit& u, int wr, int wc, int fr, int fq) const {
        int row0 = u.pm * BM + wr * 64 + fr; int col0 = u.pn * BM + wc * 32 + 8 * fq; bf16_t* Ob = O; int ld = ldc;
        if (pm2 > 0 && u.pm >= pm2) { row0 -= pm2 * BM; col0 -= pn2 * BM; Ob = O2; ld = ldc2; }
#pragma unroll
        for (int ai = 0; ai < 2; ++ai)
#pragma unroll
            for (int m = 0; m < 4; ++m) { bf16_t* rowp = Ob + (size_t)(row0 + ai * HALF + m * 16) * ld + col0;
#pragma unroll
                for (int bj = 0; bj < 2; ++bj) { const f32x4 v0 = acc[ai][bj][m][0] * sc, v1 = acc[ai][bj][m][1] * sc;
                    u32x4 w; w.x = pk2(v0[0], v0[1]); w.y = pk2(v0[2], v0[3]); w.z = pk2(v1[0], v1[1]); w.w = pk2(v1[2], v1[3]);
                    *(u32x4*)(rowp + bj * HALF) = w; } }
    }
};
struct EpiSwiGLU {
    static constexpr bool PERM = true, AFTER_DRAIN = false;
    bf16_t* O; int ldc;
    __device__ __forceinline__ void operator()(const f32x4 (&acc)[2][2][4][2], const Unit& u, int wr, int wc, int fr, int fq) const {
        const int row0 = u.pm * BM + wr * 64 + fr; const int col0 = u.pn * HALF + wc * 32 + 8 * fq;
#pragma unroll
        for (int ai = 0; ai < 2; ++ai)
#pragma unroll
            for (int m = 0; m < 4; ++m) { bf16_t* rowp = O + (size_t)(row0 + ai * HALF + m * 16) * ldc + col0;
                float h[8];
#pragma unroll
                for (int n = 0; n < 2; ++n)
#pragma unroll
                    for (int i = 0; i < 4; ++i) { const float g = acc[ai][0][m][n][i], up = acc[ai][1][m][n][i]; h[4 * n + i] = (g * up) * frcp(1.0f + fexp2(-1.4426950408889634f * g)); }
                u32x4 w; w.x = pk2(h[0], h[1]); w.y = pk2(h[2], h[3]); w.z = pk2(h[4], h[5]); w.w = pk2(h[6], h[7]);
                *(u32x4*)rowp = w; }
    }
};

struct EpiStoreQ {
    static constexpr bool PERM = true, AFTER_DRAIN = false;
    bf16_t* O; int ldc; const float* as; const float* ws;
    bf16_t* O2; int ldc2, pm2, pn2;
    __device__ __forceinline__ void operator()(const f32x4 (&acc)[2][2][4][2], const Unit& u, int wr, int wc, int fr, int fq) const {
        const int arow0 = u.pm * BM + wr * 64 + fr, bcol0 = u.pb * BM + wc * 32 + 8 * fq;
        int row0 = arow0, col0 = u.pn * BM + wc * 32 + 8 * fq; bf16_t* Ob = O; int ld = ldc;
        if (pm2 > 0 && u.pm >= pm2) { row0 -= pm2 * BM; col0 -= pn2 * BM; Ob = O2; ld = ldc2; }
        f32x4 wsv[2][2];
#pragma unroll
        for (int bj = 0; bj < 2; ++bj) { wsv[bj][0] = *(const f32x4*)(ws + bcol0 + bj * HALF); wsv[bj][1] = *(const f32x4*)(ws + bcol0 + bj * HALF + 4); }
#pragma unroll
        for (int ai = 0; ai < 2; ++ai)
#pragma unroll
            for (int m = 0; m < 4; ++m) { const float a = as[arow0 + ai * HALF + m * 16]; bf16_t* rowp = Ob + (size_t)(row0 + ai * HALF + m * 16) * ld + col0;
#pragma unroll
                for (int bj = 0; bj < 2; ++bj) { const i32x4 i0 = __builtin_bit_cast(i32x4, acc[ai][bj][m][0]), i1 = __builtin_bit_cast(i32x4, acc[ai][bj][m][1]);
                    const f32x4 v0 = __builtin_convertvector(i0, f32x4) * wsv[bj][0] * a, v1 = __builtin_convertvector(i1, f32x4) * wsv[bj][1] * a;
                    u32x4 w; w.x = pk2(v0[0], v0[1]); w.y = pk2(v0[2], v0[3]); w.z = pk2(v1[0], v1[1]); w.w = pk2(v1[2], v1[3]);
                    *(u32x4*)(rowp + bj * HALF) = w; } }
    }
};
struct EpiSwiGLUQ {
    static constexpr bool PERM = true, AFTER_DRAIN = false;
    bf16_t* O; int ldc; const float* as; const float* ws;
    __device__ __forceinline__ void operator()(const f32x4 (&acc)[2][2][4][2], const Unit& u, int wr, int wc, int fr, int fq) const {
        const int row0 = u.pm * BM + wr * 64 + fr; const int col0 = u.pn * HALF + wc * 32 + 8 * fq, bcol0 = u.pb * BM + wc * 32 + 8 * fq;
        f32x4 wsv[2][2];
#pragma unroll
        for (int bj = 0; bj < 2; ++bj) { wsv[bj][0] = *(const f32x4*)(ws + bcol0 + bj * HALF); wsv[bj][1] = *(const f32x4*)(ws + bcol0 + bj * HALF + 4); }
#pragma unroll
        for (int ai = 0; ai < 2; ++ai)
#pragma unroll
            for (int m = 0; m < 4; ++m) { const float a = as[row0 + ai * HALF + m * 16]; bf16_t* rowp = O + (size_t)(row0 + ai * HALF + m * 16) * ldc + col0;
                float h[8];
#pragma unroll
                for (int n = 0; n < 2; ++n) { const f32x4 gv = __builtin_convertvector(__builtin_bit_cast(i32x4, acc[ai][0][m][n]), f32x4) * wsv[0][n] * a, uv = __builtin_convertvector(__builtin_bit_cast(i32x4, acc[ai][1][m][n]), f32x4) * wsv[1][n] * a;
#pragma unroll
                    for (int i = 0; i < 4; ++i) h[4 * n + i] = (gv[i] * uv[i]) * frcp(1.0f + fexp2(-1.4426950408889634f * gv[i])); }
                u32x4 w; w.x = pk2(h[0], h[1]); w.y = pk2(h[2], h[3]); w.z = pk2(h[4], h[5]); w.w = pk2(h[6], h[7]);
                *(u32x4*)rowp = w; }
    }
};
struct EpiSwiGLUQ8 {
    static constexpr bool PERM = true, AFTER_DRAIN = false;
    static constexpr int NST = 8;
    unsigned char* O; int ldc; const float* as; const float* ws;
    __device__ __forceinline__ void operator()(const f32x4 (&acc)[2][2][4][2], const Unit& u, int wr, int wc, int fr, int fq) const {
        const int row0 = u.pm * BM + wr * 64 + fr; const int col0 = u.pn * HALF + wc * 32 + 8 * fq, bcol0 = u.pb * BM + wc * 32 + 8 * fq;
        f32x4 wsv[2][2];
#pragma unroll
        for (int bj = 0; bj < 2; ++bj) { wsv[bj][0] = *(const f32x4*)(ws + bcol0 + bj * HALF); wsv[bj][1] = *(const f32x4*)(ws + bcol0 + bj * HALF + 4); }
#pragma unroll
        for (int ai = 0; ai < 2; ++ai)
#pragma unroll
            for (int m = 0; m < 4; ++m) { const float a = as[row0 + ai * HALF + m * 16]; unsigned char* rowp = O + (size_t)(row0 + ai * HALF + m * 16) * ldc + col0;
                float h[8];
#pragma unroll
                for (int n = 0; n < 2; ++n) { const f32x4 gv = __builtin_convertvector(__builtin_bit_cast(i32x4, acc[ai][0][m][n]), f32x4) * wsv[0][n] * a, uv = __builtin_convertvector(__builtin_bit_cast(i32x4, acc[ai][1][m][n]), f32x4) * wsv[1][n] * (a * FP8_SHD);
#pragma unroll
                    for (int i = 0; i < 4; ++i) h[4 * n + i] = (gv[i] * uv[i]) * frcp(1.0f + fexp2(-1.4426950408889634f * gv[i])); }
                u32x2 w; w.x = pk4_fp8s(h[0], h[1], h[2], h[3]); w.y = pk4_fp8s(h[4], h[5], h[6], h[7]);
                *(u32x2*)rowp = w; }
    }
};
struct EpiSwiGLU8 {
    static constexpr bool PERM = true, AFTER_DRAIN = false;
    unsigned char* O; int ldc; float ds;
    __device__ __forceinline__ void operator()(const f32x4 (&acc)[2][2][4][2], const Unit& u, int wr, int wc, int fr, int fq) const {
        const float c1 = -1.4426950408889634f * ds, c2 = ds * ds * FP8_SH;
        const int row0 = u.pm * BM + wr * 64 + fr; const int col0 = u.pn * HALF + wc * 32 + 8 * fq;
#pragma unroll
        for (int ai = 0; ai < 2; ++ai)
#pragma unroll
            for (int m = 0; m < 4; ++m) { unsigned char* rowp = O + (size_t)(row0 + ai * HALF + m * 16) * ldc + col0;
                float h[8];
#pragma unroll
                for (int n = 0; n < 2; ++n)
#pragma unroll
                    for (int i = 0; i < 4; ++i) { const float ga = acc[ai][0][m][n][i], ua = acc[ai][1][m][n][i];
                        h[4 * n + i] = (ga * ua) * (c2 * frcp(1.0f + fexp2(ga * c1))); }
                u32x2 w; w.x = pk4_fp8s(h[0], h[1], h[2], h[3]); w.y = pk4_fp8s(h[4], h[5], h[6], h[7]);
                *(u32x2*)rowp = w; }
    }
};

template <class Epi, class Sched, bool ALIGN_EPI = false, bool SP2 = false, int FP8 = 0>
__device__ __forceinline__ void gemm_phase(PG8_LAS unsigned char* lds, const Gemm g, const Sched& S, const Epi& E) {
    int tid_ = threadIdx.x; asm volatile("" : "+v"(tid_));
    const int tid = tid_, wid = __builtin_amdgcn_readfirstlane(tid >> 6), lane = tid & 63, wr = wid >> 2, wc = wid & 3, fr = lane & 15, fq = lane >> 4;
    const int K = g.K, nt = K / BK;
    unsigned voffA[2], voffB[2];
#pragma unroll
    for (int i = 0; i < 2; ++i) { int R, C; stage_rc(tid * 16 + i * 8192, R, C); const int Rb = Epi::PERM ? ((R & ~31) + perm32(R & 31)) : R;
        voffA[i] = (unsigned)(R * K + C) * 2u; voffB[i] = (unsigned)(Rb * K + C) * 2u; }
    const size_t kstep = (size_t)(BK * 2);
    const size_t hstep = (size_t)HALF * K * 2;
    const size_t tstep = 2 * hstep;
    const unsigned ldsw = (unsigned)wid * 1024u;
    const int aoff = lds_byte(wr * 64 + fr, fq * 8), boff = lds_byte(wc * 32 + fr, fq * 8);
#define PG8_SA(b, h) (((b) * 2 + (h)) * HTB)
#define PG8_SB(b, h) ((4 + (b) * 2 + (h)) * HTB)
#define PG8_STAGE(bufoff, gbase, voff) do { _Pragma("unroll") for (int _i = 0; _i < 2; ++_i) \
        __builtin_amdgcn_global_load_lds((const unsigned*)((const char*)(gbase) + (voff)[_i]), (PG8_LAS unsigned*)(lds + (bufoff) + ldsw + _i * 8192), 16, 0, 0); } while (0)
#define PG8_LD8(p) __builtin_shufflevector(*(const PG8_LAS i32x4*)(p), *(const PG8_LAS i32x4*)((p) + 1024), 0, 1, 2, 3, 4, 5, 6, 7)
#define PG8_LDA(dst, b, h) do { if constexpr (FP8 == 1) { _Pragma("unroll") for (int m = 0; m < 4; ++m) dst##8[m] = PG8_LD8(lds + PG8_SA(b, h) + aoff + m * 2048); } \
        else { _Pragma("unroll") for (int m = 0; m < 4; ++m) _Pragma("unroll") for (int k = 0; k < 2; ++k) dst[m][k] = *(const PG8_LAS bf16x8*)(lds + PG8_SA(b, h) + aoff + m * 2048 + k * 1024); } } while (0)
#define PG8_LDB(dst, b, h) do { if constexpr (FP8 == 1) { _Pragma("unroll") for (int n = 0; n < 2; ++n) dst##8[n] = PG8_LD8(lds + PG8_SB(b, h) + boff + n * 2048); } \
        else { _Pragma("unroll") for (int n = 0; n < 2; ++n) _Pragma("unroll") for (int k = 0; k < 2; ++k) dst[n][k] = *(const PG8_LAS bf16x8*)(lds + PG8_SB(b, h) + boff + n * 2048 + k * 1024); } } while (0)
#define PG8_CAT(x, y) __builtin_shufflevector(__builtin_bit_cast(i32x4, x), __builtin_bit_cast(i32x4, y), 0, 1, 2, 3, 4, 5, 6, 7)
#define PG8_MMA(ai, bj, At, Bt) do { __builtin_amdgcn_s_setprio(1); \
        if constexpr (FP8 == 1) { _Pragma("unroll") for (int m = 0; m < 4; ++m) _Pragma("unroll") for (int n = 0; n < 2; ++n) \
            asm volatile("v_mfma_scale_f32_16x16x128_f8f6f4 %0, %1, %2, %0, %3, %3 op_sel_hi:[0,0,0]" : "+v"(acc[ai][bj][m][n]) : "v"(Bt##8[n]), "v"(At##8[m]), "v"(sc1)); } \
        else if constexpr (FP8 == 2) { _Pragma("unroll") for (int m = 0; m < 4; ++m) _Pragma("unroll") for (int n = 0; n < 2; ++n) _Pragma("unroll") for (int k = 0; k < 2; ++k) \
            acc[ai][bj][m][n] = __builtin_bit_cast(f32x4, __builtin_amdgcn_mfma_i32_16x16x64_i8(__builtin_bit_cast(i32x4, Bt[n][k]), __builtin_bit_cast(i32x4, At[m][k]), __builtin_bit_cast(i32x4, acc[ai][bj][m][n]), 0, 0, 0)); } \
        else { _Pragma("unroll") for (int m = 0; m < 4; ++m) _Pragma("unroll") for (int n = 0; n < 2; ++n) _Pragma("unroll") for (int k = 0; k < 2; ++k) \
            acc[ai][bj][m][n] = __builtin_amdgcn_mfma_f32_16x16x32_bf16(Bt[n][k], At[m][k], acc[ai][bj][m][n], 0, 0, 0); } \
        __builtin_amdgcn_s_setprio(0); } while (0)
#define PG8_WAIT_V(n) asm volatile("s_waitcnt vmcnt(" #n ")" ::: "memory")
#define PG8_WAIT_L(n) asm volatile("s_waitcnt lgkmcnt(" #n ")" ::: "memory")
#define PG8_BAR __builtin_amdgcn_s_barrier()
#define PG8_SCHED __builtin_amdgcn_sched_barrier(0)
    Unit cur, nxt; int ui = 0;
    if (!S.next(0, cur)) return;
    f32x4 acc[2][2][4][2];
#pragma unroll
    for (int a = 0; a < 2; ++a)
#pragma unroll
        for (int b = 0; b < 2; ++b)
#pragma unroll
            for (int m = 0; m < 4; ++m)
#pragma unroll
                for (int n = 0; n < 2; ++n) acc[a][b][m][n] = (f32x4){0.f, 0.f, 0.f, 0.f};
    bf16x8 At[4][2], B0[2][2], B1[2][2];
    i32x8 At8[4], B08[2], B18[2];
    int sc1 = 0x7F7F7F7F; asm volatile("" : "+v"(sc1));
    const char* cA = (const char*)g.A + (size_t)cur.pm * tstep; const char* cB = (const char*)g.Bt + (size_t)cur.pb * tstep;
    S.a_ready(cur);
    if constexpr (SP2) {
        PG8_STAGE(PG8_SB(0, 0), cB, voffB); PG8_STAGE(PG8_SB(0, 1), cB + hstep, voffB); PG8_STAGE(PG8_SA(0, 0), cA, voffA); PG8_STAGE(PG8_SA(0, 1), cA + hstep, voffA);
        if (wr == 1) PG8_BAR;
        PG8_WAIT_V(2); PG8_BAR;
        PG8_STAGE(PG8_SB(1, 0), cB + kstep, voffB); PG8_STAGE(PG8_SA(1, 0), cA + kstep, voffA); PG8_STAGE(PG8_SB(1, 1), cB + hstep + kstep, voffB);
        PG8_WAIT_V(6); PG8_BAR;
    } else {
        PG8_STAGE(PG8_SB(0, 0), cB, voffB); PG8_STAGE(PG8_SA(0, 0), cA, voffA); PG8_STAGE(PG8_SB(0, 1), cB + hstep, voffB); PG8_STAGE(PG8_SA(0, 1), cA + hstep, voffA);
        if (wr == 1) PG8_BAR;
        PG8_WAIT_V(4); PG8_BAR;
        PG8_STAGE(PG8_SB(1, 0), cB + kstep, voffB); PG8_STAGE(PG8_SA(1, 0), cA + kstep, voffA); PG8_STAGE(PG8_SB(1, 1), cB + hstep + kstep, voffB);
        PG8_WAIT_V(6); PG8_BAR;
    }
    for (;;) {
        const bool has_next = S.next(ui + 1, nxt);
        const char* nA = has_next ? (const char*)g.A + (size_t)nxt.pm * tstep : cA; const char* nB = has_next ? (const char*)g.Bt + (size_t)nxt.pb * tstep : cB;
        for (int t = 0; t < nt; t += 2) {
            const bool last = (t == nt - 2);
            const char* a1 = cA + (size_t)(t + 1) * kstep;
            const char* a2 = last ? nA : cA + (size_t)(t + 2) * kstep; const char* b2 = last ? nB : cB + (size_t)(t + 2) * kstep;
            const char* a3 = a2 + kstep; const char* b3 = b2 + kstep;
            if (last && has_next) S.a_ready(nxt);
            if constexpr (SP2) {
            PG8_LDB(B0, 0, 0); PG8_LDB(B1, 0, 1); PG8_SCHED; PG8_LDA(At, 0, 0); PG8_STAGE(PG8_SA(1, 1), a1 + hstep, voffA);
            PG8_WAIT_V(8); PG8_WAIT_L(0); PG8_BAR; PG8_MMA(0, 0, At, B0); PG8_MMA(0, 1, At, B1); PG8_BAR; PG8_SCHED;
            PG8_LDA(At, 0, 1); PG8_STAGE(PG8_SB(0, 0), b2, voffB); PG8_STAGE(PG8_SB(0, 1), b2 + hstep, voffB); PG8_STAGE(PG8_SA(0, 0), a2, voffA);
            PG8_WAIT_V(8); PG8_WAIT_L(0); PG8_BAR; PG8_MMA(1, 0, At, B0); PG8_MMA(1, 1, At, B1); PG8_BAR; PG8_SCHED;
            PG8_LDB(B0, 1, 0); PG8_LDB(B1, 1, 1); PG8_SCHED; PG8_LDA(At, 1, 0); PG8_STAGE(PG8_SA(0, 1), a2 + hstep, voffA);
            PG8_WAIT_V(8); PG8_WAIT_L(0); PG8_BAR; PG8_MMA(0, 0, At, B0); PG8_MMA(0, 1, At, B1); PG8_BAR; PG8_SCHED;
            PG8_LDA(At, 1, 1); PG8_STAGE(PG8_SB(1, 0), b3, voffB); PG8_STAGE(PG8_SB(1, 1), b3 + hstep, voffB); PG8_STAGE(PG8_SA(1, 0), a3, voffA);
            PG8_WAIT_V(8); PG8_WAIT_L(0); PG8_BAR; PG8_MMA(1, 0, At, B0); PG8_MMA(1, 1, At, B1); PG8_BAR; PG8_SCHED;
            } else {
            PG8_LDB(B0, 0, 0); PG8_SCHED; PG8_LDA(At, 0, 0); PG8_STAGE(PG8_SA(1, 1), a1 + hstep, voffA);
            PG8_WAIT_L(8); PG8_BAR; PG8_WAIT_L(0); PG8_MMA(0, 0, At, B0); PG8_BAR; PG8_SCHED;
            PG8_LDB(B1, 0, 1); PG8_STAGE(PG8_SB(0, 0), b2, voffB);
            PG8_BAR; PG8_WAIT_L(0); PG8_MMA(0, 1, At, B1); PG8_BAR;
            PG8_LDA(At, 0, 1); PG8_STAGE(PG8_SA(0, 0), a2, voffA);
            PG8_BAR; PG8_WAIT_L(0); PG8_MMA(1, 0, At, B0); PG8_BAR; PG8_SCHED;
            PG8_STAGE(PG8_SB(0, 1), b2 + hstep, voffB);
            PG8_WAIT_V(6); PG8_BAR; PG8_MMA(1, 1, At, B1); PG8_BAR;
            PG8_LDB(B0, 1, 0); PG8_SCHED; PG8_LDA(At, 1, 0); PG8_STAGE(PG8_SA(0, 1), a2 + hstep, voffA);
            PG8_WAIT_L(8); PG8_BAR; PG8_WAIT_L(0); PG8_MMA(0, 0, At, B0); PG8_BAR; PG8_SCHED;
            PG8_LDB(B1, 1, 1); PG8_STAGE(PG8_SB(1, 0), b3, voffB);
            PG8_BAR; PG8_WAIT_L(0); PG8_MMA(0, 1, At, B1); PG8_BAR;
            PG8_LDA(At, 1, 1); PG8_STAGE(PG8_SA(1, 0), a3, voffA);
            PG8_BAR; PG8_WAIT_L(0); PG8_MMA(1, 0, At, B0); PG8_BAR; PG8_SCHED;
            PG8_STAGE(PG8_SB(1, 1), b3 + hstep, voffB);
            PG8_WAIT_V(6); PG8_BAR; PG8_MMA(1, 1, At, B1); PG8_BAR;
            }
        }
        if constexpr (ALIGN_EPI) { if (wr == 0) PG8_BAR; }
        if constexpr (FP8 == 1) asm volatile("s_nop 15\n\ts_nop 15\n\ts_nop 15\n\ts_nop 15\n\ts_nop 15" ::: "memory");
        if constexpr (!Epi::AFTER_DRAIN) { E(acc, cur, wr, wc, fr, fq); S.done(cur); }
        if (!has_next) break;
#pragma unroll
        for (int a = 0; a < 2; ++a)
#pragma unroll
            for (int b = 0; b < 2; ++b)
#pragma unroll
                for (int m = 0; m < 4; ++m)
#pragma unroll
                    for (int n = 0; n < 2; ++n) acc[a][b][m][n] = (f32x4){0.f, 0.f, 0.f, 0.f};
        cur = nxt; cA = nA; cB = nB; ++ui;
        if constexpr (ALIGN_EPI) { if (wr == 1) PG8_BAR; }
    }
    PG8_WAIT_V(0);
    if constexpr (!ALIGN_EPI) { if (wr == 0) PG8_BAR; }
    PG8_BAR;
#undef PG8_SA
#undef PG8_SB
#undef PG8_STAGE
#undef PG8_LDA
#undef PG8_LD8
#undef PG8_LDB
#undef PG8_MMA
#undef PG8_CAT
#undef PG8_WAIT_V
#undef PG8_WAIT_L
#undef PG8_BAR
#undef PG8_SCHED
}
}

#define XB_TMO      128
#define XB_XCNT(j)  (256  + 64 * (j))
#define XB_XSUB(j)  (1280 + 64 * (j))
#define XB_XGEN(j)  (2304 + 64 * (j))
#define XB_TOP      3328
#define XB_TOPGEN   3392
#define XCD_BAR_WORDS 3456
#define XB_SPIN_CAP (1u << 22)
__device__ __forceinline__ unsigned xb_ld(unsigned* p)              { return __hip_atomic_load(p, __ATOMIC_RELAXED, __HIP_MEMORY_SCOPE_AGENT); }
__device__ __forceinline__ unsigned xb_add(unsigned* p, unsigned v) { return __hip_atomic_fetch_add(p, v, __ATOMIC_RELAXED, __HIP_MEMORY_SCOPE_AGENT); }
__device__ __forceinline__ unsigned xb_xcc_id() { return (unsigned)__builtin_amdgcn_s_getreg((3 << 11) | 20) & 0xFu; }
#define XB_SPIN(cond, bar) do { unsigned _sp = 0; while (cond) { __builtin_amdgcn_s_sleep(1); \
    if ((++_sp & 255u) == 0u) { if (xb_ld(&(bar)[XB_TMO])) break; if (_sp > XB_SPIN_CAP) { atomicAdd(&(bar)[XB_TMO], 1u); break; } } } } while (0)
struct XcdBarrier { unsigned* bar; unsigned x; volatile LAS unsigned* st; };
__device__ __forceinline__ XcdBarrier xcd_barrier_post(unsigned* bar, volatile LAS unsigned* st) {
    XcdBarrier b; b.bar = bar; b.x = xb_xcc_id(); b.st = st;
    if (threadIdx.x == 0) (void)xb_add(&bar[XB_XCNT(b.x)], 1u);
    return b;
}
__device__ __forceinline__ void xcd_barrier_complete(unsigned* bar, unsigned x, unsigned& nloc, unsigned& nx) {
    const unsigned G = gridDim.x * gridDim.y * gridDim.z;
    unsigned sum, cnt, mine, sp = 0u;
    for (;;) {
        sum = 0u; cnt = 0u; mine = 0u;
#pragma unroll
        for (unsigned j = 0; j < 16; ++j) { const unsigned c = xb_ld(&bar[XB_XCNT(j)]); sum += c; cnt += (c > 0u) ? 1u : 0u; mine = (j == x) ? c : mine; }
        if (sum == G) break;
        __builtin_amdgcn_s_sleep(1);
        if ((++sp & 255u) == 0u) { if (xb_ld(&bar[XB_TMO])) break; if (sp > XB_SPIN_CAP) { atomicAdd(&bar[XB_TMO], 1u); break; } }
    }
    nloc = mine > 0u ? mine : 1u; nx = cnt > 0u ? cnt : 1u;
}
__device__ __forceinline__ void xcd_barrier(const XcdBarrier& b) {
    asm volatile("s_waitcnt vmcnt(0)" ::: "memory");
    __syncthreads();
    if (threadIdx.x == 0) {
        unsigned* bar = b.bar;
        __builtin_amdgcn_s_waitcnt(0);
        unsigned nloc = b.st[0], nx = b.st[1];
        if (nloc == 0u) { xcd_barrier_complete(bar, b.x, nloc, nx); b.st[0] = nloc; b.st[1] = nx; }
        const unsigned old = xb_add(&bar[XB_XSUB(b.x)], 1u);
        const unsigned gen = old / nloc;
        if (old + 1u == (gen + 1u) * nloc) {
            __builtin_amdgcn_fence(__ATOMIC_RELEASE, "agent");
            asm volatile("s_waitcnt vmcnt(0)" ::: "memory");
            const unsigned og = xb_add(&bar[XB_TOP], 1u);
            const unsigned tg = og / nx;
            if (og + 1u == (tg + 1u) * nx) xb_add(&bar[XB_TOPGEN], 1u);
            else XB_SPIN(xb_ld(&bar[XB_TOPGEN]) == tg, bar);
            __builtin_amdgcn_fence(__ATOMIC_ACQUIRE, "agent");
            xb_add(&bar[XB_XGEN(b.x)], 1u);
            asm volatile("s_waitcnt vmcnt(0)" ::: "memory");
        } else {
            XB_SPIN(xb_ld(&bar[XB_XGEN(b.x)]) == gen, bar);
            __builtin_amdgcn_fence(__ATOMIC_ACQUIRE, "agent");
            asm volatile("s_waitcnt vmcnt(0)" ::: "memory");
        }
    }
    __syncthreads();
}

struct Frame {
    LAS unsigned char* lds;
    int tid, lane, wave, G, bx;
};
__device__ __forceinline__ Frame phase_frame(const Frame& F) { Frame R = F; int t = threadIdx.x; asm volatile("" : "+v"(t)); R.tid = t; R.lane = t & 63; R.wave = __builtin_amdgcn_readfirstlane(t >> 6); return R; }

struct TrDesc { const float* W; unsigned char* WT; const float* kgain; float nscale; int K, N, drow0, k0, n0, f8; };
__device__ __forceinline__ void tr_load(const TrDesc& d, float (&tv)[32], int lane) {
    const float* wp = d.W + (size_t)(d.k0 + (lane >> 5)) * d.N + d.n0 + (lane & 31);
#pragma unroll
    for (int i = 0; i < 32; ++i) tv[i] = wp[(size_t)(2 * i) * d.N];
}
__device__ __forceinline__ void tr_finish(const TrDesc& d, const float (&tv)[32], LAS float* scr, int lane) {
#pragma unroll
    for (int i = 0; i < 32; ++i) { float v = tv[i] * d.nscale; if (d.kgain) v *= d.kgain[d.k0 + 2 * i + (lane >> 5)]; scr[(2 * i + (lane >> 5)) * 33 + (lane & 31)] = v; }
    LDS_WAIT(); asm volatile("" ::: "memory");
    const int c = lane & 7;
#pragma unroll
    for (int j = 0; j < 4; ++j) { const int n = (lane >> 3) + 8 * j; const LAS float* s = scr + (8 * c) * 33 + n;
        if (d.f8) { u32x2 o; o.x = pk4_fp8(s[0 * 33], s[1 * 33], s[2 * 33], s[3 * 33]); o.y = pk4_fp8(s[4 * 33], s[5 * 33], s[6 * 33], s[7 * 33]);
            *(u32x2*)(d.WT + (size_t)(d.drow0 + n) * d.K + d.k0 + 8 * c) = o; }
        else { u32x4 o; o.x = pk2(s[0 * 33], s[1 * 33]); o.y = pk2(s[2 * 33], s[3 * 33]); o.z = pk2(s[4 * 33], s[5 * 33]); o.w = pk2(s[6 * 33], s[7 * 33]);
            *(u32x4*)(d.WT + ((size_t)(d.drow0 + n) * d.K + d.k0 + 8 * c) * 2) = o; } }
    LDS_WAIT(); asm volatile("" ::: "memory");
}
__device__ __forceinline__ int gu_row(int n0, int Fh) { return n0 < Fh ? ((n0 >> 7) * 256 + (n0 & 127)) : (((n0 - Fh) >> 7) * 256 + 128 + ((n0 - Fh) & 127)); }

struct Ptrs {
    const float *x, *mem, *anpre, *anpost, *fnpre, *fnpost, *w_in_a, *hlb, *hon, *w_in_b, *kvn, *w_kv, *memn, *w_mem_kv, *w_out, *w_gu, *w_dn, *w_router, *w_egu, *w_edn;
    float* out; unsigned char* ws;
};

__device__ __forceinline__ float row_rstd(const f32x4 (&a)[4]);
__device__ __forceinline__ void rms_row_to_bf16(const float* xrow, bf16_t* orow, const float* gain, int lane) {
    const f32x4* xr = (const f32x4*)xrow + lane;
    f32x4 v[4]; float s = 0.f;
#pragma unroll
    for (int j = 0; j < 4; ++j) { v[j] = xr[64 * j]; s += (v[j].x * v[j].x + v[j].y * v[j].y) + (v[j].z * v[j].z + v[j].w * v[j].w); }
    const float rstd = frsq(wave_sum(s) * (1.f / DM) + RMS_EPS);
    u32x2* o8 = (u32x2*)orow + lane;
#pragma unroll
    for (int j = 0; j < 4; ++j) { f32x4 gg = gain ? ((const f32x4*)gain)[lane + 64 * j] : (f32x4){1.f, 1.f, 1.f, 1.f};
        u32x2 w; w.x = pk2(v[j].x * rstd * gg.x, v[j].y * rstd * gg.y); w.y = pk2(v[j].z * rstd * gg.z, v[j].w * rstd * gg.w); o8[64 * j] = w; }
}

struct TrCounts {
    static constexpr int I_INA = (DM / 64) * (AW / 32), I_MKV = (DM / 64) * (512 / 32), I_OUT = (DM / 64) * (DM / 32), I_GU = (DM / 64) * (2 * DFF / 32), I_DN = (DFF / 64) * (DM / 32),
                         I_KV = (DM / 64) * (1536 / 32), I_INB = (DM / 64) * (DM / 32), I_EGU = (DM / 64) * (2 * DFE / 32), I_EDN = (DFE / 64) * (DM / 32);
    static constexpr int NEARLY = I_INA + 2 * I_MKV + 2 * I_OUT + I_GU + I_DN + I_KV + I_INB;
    static constexpr int NITEMS = NEARLY + NEXP * I_EGU + NEXP * I_EDN;
};
__device__ __forceinline__ TrDesc tr_decode(const Ptrs& P, int it) {
    using T = TrCounts; unsigned char* ws = P.ws; TrDesc d; d.kgain = nullptr; d.nscale = 1.f; d.f8 = 0;
    int r = it - (T::I_INA + 2 * T::I_MKV);
    if (r < 2 * T::I_OUT) { const int l = r / T::I_OUT; r -= l * T::I_OUT; const int nb = DM / 32; d.k0 = 64 * (r / nb); d.n0 = 32 * (r % nb);
        d.W = P.w_out + (size_t)l * DM * DM; d.K = DM; d.N = DM; d.WT = ws + (l ? WS_WOUT1 : WS_WOUT0); d.drow0 = d.n0; return d; } r -= 2 * T::I_OUT + T::I_GU;
    if (r < T::I_DN) { const int nb = DM / 32; d.k0 = 64 * (r / nb); d.n0 = 32 * (r % nb); d.W = P.w_dn; d.K = DFF; d.N = DM; d.WT = ws + WS_WDN; d.drow0 = d.n0; d.f8 = 1; d.nscale = FP8_SWDD; return d; } r -= T::I_DN + T::I_KV + T::I_INB;
    d.f8 = 1;
    if (r < NEXP * T::I_EGU) { const int e = r / T::I_EGU; r -= e * T::I_EGU; const int nb = 2 * DFE / 32; d.k0 = 64 * (r / nb); d.n0 = 32 * (r % nb);
        d.W = P.w_egu + (size_t)e * DM * 2 * DFE; d.K = DM; d.N = 2 * DFE; d.WT = ws + WS_WEGU + (size_t)e * 2 * DFE * DM; d.drow0 = gu_row(d.n0, DFE); d.nscale = FP8_SWGU; return d; } r -= NEXP * T::I_EGU;
    { const int e = r / T::I_EDN; r -= e * T::I_EDN; const int nb = DM / 32; d.k0 = 64 * (r / nb); d.n0 = 32 * (r % nb);
        d.W = P.w_edn + (size_t)e * DFE * DM; d.K = DFE; d.N = DM; d.WT = ws + WS_WEDN + (size_t)e * DM * DFE; d.drow0 = d.n0; d.nscale = FP8_SWDN; return d; }
}
__device__ __forceinline__ void convert_weights(const Frame& F, const Ptrs& P, int gw, int NGW) {
    LAS float* scr = (LAS float*)(F.lds + F.wave * 16384);
    const int it_lo = TrCounts::NEARLY, it_hi = TrCounts::NITEMS;
    for (int it = it_lo + gw; it < it_hi; it += 2 * NGW) {
        const bool two = it + NGW < it_hi;
        const TrDesc a = tr_decode(P, it), b = tr_decode(P, two ? it + NGW : it);
        float ta[32], tb[32];
        tr_load(a, ta, F.lane); if (two) tr_load(b, tb, F.lane);
        tr_finish(a, ta, scr, F.lane); if (two) tr_finish(b, tb, scr, F.lane);
    }
}
struct Q8Desc { const float* W; unsigned char* WT; const float* kgain; float nscale; int N, n0, drow0; float* wsc; };
constexpr int Q8_INA = AW / 32, Q8_MKV = 512 / 32, Q8_GU = 2 * DFF / 32, Q8_KV = 1536 / 32, Q8_INB = DM / 32, Q8_ITEMS = Q8_INA + 2 * Q8_MKV + Q8_GU + Q8_KV + Q8_INB;
__device__ __forceinline__ Q8Desc q8_decode(const Ptrs& P, int r) {
    unsigned char* ws = P.ws; float* const WSCp = (float*)(ws + WS_WSC); Q8Desc d; d.kgain = nullptr; d.nscale = 1.f;
    if (r < Q8_INA) { d.n0 = 32 * r; d.W = P.w_in_a; d.N = AW; d.WT = ws + WS_WINA; d.drow0 = d.n0; d.nscale = d.n0 >= 3072 ? C2 : 1.f; d.wsc = WSCp + WSC_INA; return d; } r -= Q8_INA;
    if (r < 2 * Q8_MKV) { const int l = r / Q8_MKV; r -= l * Q8_MKV; d.n0 = 32 * r; d.W = P.w_mem_kv + (size_t)l * DM * 512; d.N = 512; d.WT = ws + WS_WINA; d.drow0 = AW + l * 512 + d.n0; d.kgain = P.memn + l * DM; d.wsc = WSCp + WSC_INA; return d; } r -= 2 * Q8_MKV;
    if (r < Q8_GU) { d.n0 = 32 * r; d.W = P.w_gu; d.N = 2 * DFF; d.WT = ws + WS_WGU; d.drow0 = gu_row(d.n0, DFF); d.wsc = WSCp + WSC_GU; return d; } r -= Q8_GU;
    if (r < Q8_KV) { d.n0 = 32 * r; d.W = P.w_kv; d.N = 1536; d.WT = ws + WS_WKVB; d.drow0 = d.n0; d.kgain = P.kvn; d.wsc = WSCp + WSC_KVB; return d; } r -= Q8_KV;
    { d.n0 = 32 * r; d.W = P.w_in_b; d.N = DM; d.WT = ws + WS_WKVB; d.drow0 = 1536 + d.n0; d.kgain = P.anpre + DM; d.nscale = C2; d.wsc = WSCp + WSC_KVB; return d; }
}
__device__ __forceinline__ void q8_finish(const Q8Desc& q, const float (&tv)[32], int kbase, LAS float* scr, const LAS float* cfin, int lane) {
#pragma unroll
    for (int i = 0; i < 32; ++i) scr[(2 * i + (lane >> 5)) * 33 + (lane & 31)] = tv[i];
    LDS_WAIT(); asm volatile("" ::: "memory");
    const int c = lane & 7;
#pragma unroll
    for (int j = 0; j < 4; ++j) { const int n = (lane >> 3) + 8 * j; const LAS float* s = scr + (8 * c) * 33 + n; const float inv = 127.0f / cfin[n];
        u32x2 o; o.x = pk4_i8(s[0 * 33] * inv, s[1 * 33] * inv, s[2 * 33] * inv, s[3 * 33] * inv); o.y = pk4_i8(s[4 * 33] * inv, s[5 * 33] * inv, s[6 * 33] * inv, s[7 * 33] * inv);
        *(u32x2*)(q.WT + (size_t)(q.drow0 + n) * DM + kbase + 8 * c) = o; }
    LDS_WAIT(); asm volatile("" ::: "memory");
}
__device__ __forceinline__ void q8_item(const Frame& F, const Q8Desc& q, int parity) {
    const int lane = F.lane, kp = lane >> 5, nl = lane & 31, k0 = F.wave * 128;
    LAS float* scr = (LAS float*)(F.lds + F.wave * 16384);
    const float* wp = q.W + (size_t)(k0 + kp) * q.N + q.n0 + nl;
    float ga[32], gb[32];
    if (q.kgain) {
#pragma unroll
        for (int i = 0; i < 32; ++i) { ga[i] = q.kgain[k0 + 2 * i + kp]; gb[i] = q.kgain[k0 + 64 + 2 * i + kp]; }
    } else {
#pragma unroll
        for (int i = 0; i < 32; ++i) { ga[i] = 1.f; gb[i] = 1.f; }
    }
    float ta[32], tb[32];
#pragma unroll
    for (int i = 0; i < 32; ++i) ta[i] = wp[(size_t)(2 * i) * q.N];
#pragma unroll
    for (int i = 0; i < 32; ++i) tb[i] = wp[(size_t)(64 + 2 * i) * q.N];
    float m = 0.f;
#pragma unroll
    for (int i = 0; i < 32; ++i) { const float v = ta[i] * q.nscale * ga[i]; ta[i] = v; m = fmaxf(m, __builtin_fabsf(v)); }
#pragma unroll
    for (int i = 0; i < 32; ++i) { const float v = tb[i] * q.nscale * gb[i]; tb[i] = v; m = fmaxf(m, __builtin_fabsf(v)); }
    ((LAS float*)(F.lds + F.wave * 16384 + 12288 + parity * 256))[lane] = m;
    __syncthreads();
    float cm = 1e-30f;
#pragma unroll
    for (int w = 0; w < NWAVES; ++w) { const LAS float* cp = (const LAS float*)(F.lds + w * 16384 + 12288 + parity * 256); cm = fmaxf(cm, fmaxf(cp[nl], cp[nl + 32])); }
    LAS float* cfin = (LAS float*)(F.lds + F.wave * 16384 + 12288 + 512);
    if (lane < 32) cfin[lane] = cm;
    if (F.wave == 0 && lane < 32) q.wsc[q.drow0 + lane] = cm * (1.0f / 127.0f);
    q8_finish(q, ta, k0, scr, cfin, lane);
    q8_finish(q, tb, k0 + 64, scr, cfin, lane);
}
__device__ __forceinline__ void p0_rows4_load(const float* src, int m0, int lane, f32x4 (&v)[4][4]) {
#pragma unroll
    for (int r = 0; r < 4; ++r)
#pragma unroll
        for (int j = 0; j < 4; ++j) v[r][j] = ((const f32x4*)(src + (size_t)(m0 + r) * DM))[lane + 64 * j];
}
template <bool GAIN>
__device__ __forceinline__ void p0_rows4_finish(const f32x4 (&v)[4][4], const f32x4 (&gx)[4], unsigned char* dst, float* as, int m0, int lane) {
#pragma unroll
    for (int r = 0; r < 4; ++r) {
        const float rstd = row_rstd(v[r]);
        f32x4 uu[4];
#pragma unroll
        for (int j = 0; j < 4; ++j) { uu[j] = v[r][j] * rstd; if constexpr (GAIN) uu[j] = uu[j] * gx[j]; }
        quant_row_i8(uu, dst + (size_t)(m0 + r) * DM, as + m0 + r, lane);
    }
}
constexpr int P0_NB16 = 2 * TrCounts::I_OUT + TrCounts::I_DN, P0_G16 = P0_NB16 / 16, P0_XCH = MTOK / 32, P0_MCH = MROWS / 32, P0_WITEMS = Q8_ITEMS + P0_G16, P0_ITEMS = P0_WITEMS + P0_XCH + P0_MCH;
static_assert(P0_NB16 % 16 == 0, "bf16 wave items in groups of 16");
__device__ __forceinline__ void p0_prologue(const Frame& F, const Ptrs& P) {
    unsigned char* ws = P.ws;
    float* const ASA = (float*)(ws + WS_AS);
    int parity = 0, L = F.bx;
    for (; L < P0_WITEMS; L += F.G) {
        if (L < Q8_ITEMS) { const Q8Desc q = q8_decode(P, L); q8_item(F, q, parity); parity ^= 1; continue; }
        const int r = L - Q8_ITEMS;
        LAS float* scr = (LAS float*)(F.lds + F.wave * 16384);
        const int ia = r * 16 + F.wave, ib = ia + 8;
        const int base = TrCounts::I_INA + 2 * TrCounts::I_MKV;
        const TrDesc a = tr_decode(P, base + (ia < 2 * TrCounts::I_OUT ? ia : ia + TrCounts::I_GU)), b = tr_decode(P, base + (ib < 2 * TrCounts::I_OUT ? ib : ib + TrCounts::I_GU));
        float ta[32], tb[32];
        tr_load(a, ta, F.lane); tr_load(b, tb, F.lane);
        tr_finish(a, ta, scr, F.lane); tr_finish(b, tb, scr, F.lane);
    }
    f32x4 v[4][4], vn[4][4];
#define P0_LOAD(dst, LL) do { const int c_ = (LL) - P0_WITEMS; const bool isx_ = c_ < P0_XCH; p0_rows4_load(isx_ ? P.x : P.mem, 32 * (isx_ ? c_ : c_ - P0_XCH) + 4 * F.wave, F.lane, dst); } while (0)
#define P0_FIN(src, LL) do { const int c_ = (LL) - P0_WITEMS; const bool isx_ = c_ < P0_XCH; const int m0_ = 32 * (isx_ ? c_ : c_ - P0_XCH) + 4 * F.wave; \
        if (isx_) p0_rows4_finish<true>(src, gx, ws + WS_U, ASA, m0_, F.lane); else p0_rows4_finish<false>(src, gx, ws + WS_MEMN, ASA + MTOK, m0_, F.lane); } while (0)
    if (L < P0_ITEMS) {
        f32x4 gx[4];
#pragma unroll
        for (int j = 0; j < 4; ++j) gx[j] = ((const f32x4*)P.anpre)[F.lane + 64 * j];
        P0_LOAD(v, L);
        for (;;) {
            const int L1 = L + F.G; if (L1 < P0_ITEMS) P0_LOAD(vn, L1);
            P0_FIN(v, L);
            if (L1 >= P0_ITEMS) break;
            const int L2 = L1 + F.G; if (L2 < P0_ITEMS) P0_LOAD(v, L2);
            P0_FIN(vn, L1);
            if (L2 >= P0_ITEMS) break;
            L = L2;
        }
    }
#undef P0_LOAD
#undef P0_FIN
}

__device__ __forceinline__ void load_bf16_row(const bf16_t* arow, int lane, f32x4 (&a)[4]) {
    const u32x2* ar = (const u32x2*)arow + lane;
#pragma unroll
    for (int j = 0; j < 4; ++j) { const u32x2 w = ar[64 * j]; a[j] = (f32x4){bflo(w.x), bfhi(w.x), bflo(w.y), bfhi(w.y)}; }
}
__device__ __forceinline__ float row_rstd(const f32x4 (&a)[4]) {
    float s = 0.f;
#pragma unroll
    for (int j = 0; j < 4; ++j) s += (a[j].x * a[j].x + a[j].y * a[j].y) + (a[j].z * a[j].z + a[j].w * a[j].w);
    return frsq(wave_sum(s) * (1.f / DM) + RMS_EPS);
}
template <bool BASE16, bool Q8OUT>
__device__ __forceinline__ void norm_phase(const Frame& F, const bf16_t* A, const void* base, bf16_t* H, const float* g1, bf16_t* U, const float* g2, float* as_out) {
    for (int i0 = 0; i0 < 16; i0 += 4) {
        const int m0 = F.bx * 128 + F.wave * 16 + i0;
        u32x2 ar[4][4]; f32x4 bs[4][4]; u32x2 bh[4][4];
#pragma unroll
        for (int r = 0; r < 4; ++r)
#pragma unroll
            for (int j = 0; j < 4; ++j) { ar[r][j] = ((const u32x2*)(A + (size_t)(m0 + r) * DM))[F.lane + 64 * j];
                if constexpr (BASE16) bh[r][j] = ((const u32x2*)((const bf16_t*)base + (size_t)(m0 + r) * DM))[F.lane + 64 * j];
                else bs[r][j] = ((const f32x4*)((const float*)base + (size_t)(m0 + r) * DM))[F.lane + 64 * j]; }
#pragma unroll
        for (int r = 0; r < 4; ++r) {
            const int m = m0 + r;
            f32x4 a[4];
#pragma unroll
            for (int j = 0; j < 4; ++j) a[j] = (f32x4){bflo(ar[r][j].x), bfhi(ar[r][j].x), bflo(ar[r][j].y), bfhi(ar[r][j].y)};
            const float rs = row_rstd(a);
            f32x4 h[4];
            u32x2* h8 = (u32x2*)(H + (size_t)m * DM) + F.lane;
#pragma unroll
            for (int j = 0; j < 4; ++j) { const f32x4 gg = ((const f32x4*)g1)[F.lane + 64 * j];
                f32x4 b; if constexpr (BASE16) b = (f32x4){bflo(bh[r][j].x), bfhi(bh[r][j].x), bflo(bh[r][j].y), bfhi(bh[r][j].y)}; else b = bs[r][j];
                h[j] = b + a[j] * rs * gg; u32x2 w; w.x = pk2(h[j].x, h[j].y); w.y = pk2(h[j].z, h[j].w); h8[64 * j] = w; }
            const float rh = row_rstd(h);
            if constexpr (Q8OUT) {
                f32x4 uu[4];
#pragma unroll
                for (int j = 0; j < 4; ++j) { const f32x4 gg = g2 ? ((const f32x4*)g2)[F.lane + 64 * j] : (f32x4){1.f, 1.f, 1.f, 1.f}; uu[j] = h[j] * rh * gg; }
                quant_row_i8(uu, (unsigned char*)U + (size_t)m * DM, as_out + m, F.lane);
            } else {
                u32x2* o8 = (u32x2*)(U + (size_t)m * DM) + F.lane;
#pragma unroll
                for (int j = 0; j < 4; ++j) { const f32x4 gg = g2 ? ((const f32x4*)g2)[F.lane + 64 * j] : (f32x4){1.f, 1.f, 1.f, 1.f};
                    u32x2 w; w.x = pk2(h[j].x * rh * gg.x, h[j].y * rh * gg.y); w.y = pk2(h[j].z * rh * gg.z, h[j].w * rh * gg.w); o8[64 * j] = w; }
            }
        }
    }
}

constexpr float HG_US = 4.f;
constexpr int HG_RAWQ = 0, HG_RAWF = 18432, HG_RAWV = 36864;
constexpr int HG_OT = 0;
constexpr int HG_SC = 33792;
constexpr int HG_QD = 55296, HG_KI = 72704;
constexpr int HG_KST = 90112, HG_VT = 108544;
constexpr int HG_DEC = 126976;
typedef short s16x4 __attribute__((ext_vector_type(4)));
__device__ __forceinline__ s16x4 lds_tr16(const LAS unsigned char* p) { return __builtin_bit_cast(s16x4, __builtin_amdgcn_ds_read_tr16_b64_v4i16((LAS s16x4*)p)); }
constexpr int PA_GH = 0, PA_GL = 17408, PA_KH = 34816, PA_QH = 52224, PA_V = 69632;
__device__ __forceinline__ bf16x8 pa_trfrag(const LAS unsigned char* p) {
    const s16x4 lo = lds_tr16(p), hi = lds_tr16(p + 4 * 272);
    return (bf16x8){lo[0], lo[1], lo[2], lo[3], hi[0], hi[1], hi[2], hi[3]};
}
__device__ __forceinline__ void hgrnA_phase(const Frame& F, const Ptrs& P) {
    const int tid = F.tid, lane = F.lane, w = F.wave;
    LAS unsigned char* L = F.lds;
    const int sc0 = tid >> 4, sch = tid & 15;
    const int fr = lane & 15, g = lane >> 4;
    bf16_t* const GQD = (bf16_t*)(P.ws + WS_HGQD); bf16_t* const GOI = (bf16_t*)(P.ws + WS_HGOI); unsigned char* const GU = P.ws + WS_HGU; float* const GDEC = (float*)(P.ws + WS_HGDEC);
    const int NU = NB * 6 * 64;
    bf16x8 tri0, tri16, ones;
#pragma unroll
    for (int j = 0; j < 8; ++j) { tri0[j] = (8 * g + j <= fr) ? (short)0x3F80 : (short)0; tri16[j] = (8 * g + j <= fr + 16) ? (short)0x3F80 : (short)0; ones[j] = (short)0x3F80; }
    const int trl = (8 * g + ((lane & 15) >> 2)) * 272 + (lane & 3) * 8;
    u32x4 rq[2], rf[2], rv[2];
    {
        const int unit = F.bx; const int bh = unit >> 6, n = unit & 63, b = bh / 6, h = bh % 6;
        const bf16_t* PR = (const bf16_t*)(P.ws + WS_R1) + (size_t)(b * SEQ + n * 64) * AW;
#pragma unroll
        for (int i = 0; i < 2; ++i) { const bf16_t* rp = PR + (size_t)(sc0 + 32 * i) * AW + sch * 8;
            rq[i] = *(const u32x4*)(rp + h * 128); rf[i] = *(const u32x4*)(rp + 768 + h * 128); rv[i] = *(const u32x4*)(rp + 1536 + h * 128); }
    }
    for (int unit = F.bx; unit < NU; unit += F.G) {
        const int bh = unit >> 6, h = bh % 6;
        {
            float lb[8];
            { const f32x4 a00 = *(const f32x4*)(P.hlb + h * 128 + 8 * sch), a01 = *(const f32x4*)(P.hlb + h * 128 + 8 * sch + 4), a10 = *(const f32x4*)(P.hlb + HF + h * 128 + 8 * sch), a11 = *(const f32x4*)(P.hlb + HF + h * 128 + 8 * sch + 4);
#pragma unroll
              for (int e = 0; e < 4; ++e) { lb[e] = frcp(1.0f + fexp2(1.4426950408889634f * (a10[e] - a00[e]))); lb[4 + e] = frcp(1.0f + fexp2(1.4426950408889634f * (a11[e] - a01[e]))); } }
#pragma unroll
            for (int i = 0; i < 2; ++i) {
                const unsigned fw[4] = {rf[i].x, rf[i].y, rf[i].z, rf[i].w}, qw[4] = {rq[i].x, rq[i].y, rq[i].z, rq[i].w};
                unsigned gh[4], gl[4], kh[4], qh[4];
#pragma unroll
                for (int e2 = 0; e2 < 4; ++e2) {
                    float gg[2], kk[2], qq[2];
#pragma unroll
                    for (int o = 0; o < 2; ++o) {
                        const float fl = o ? bfhi(fw[e2]) : bflo(fw[e2]), ql = o ? bfhi(qw[e2]) : bflo(qw[e2]);
                        const float sg = sigmoidf_(fl); const float lbk = lb[2 * e2 + o];
                        gg[o] = flog2(lbk + (1.0f - lbk) * sg); kk[o] = (1.0f - lbk) * (1.0f - sg); qq[o] = ql * sigmoidf_(ql);
                    }
                    gh[e2] = pk2(gg[0], gg[1]);
                    gl[e2] = pk2(gg[0] - bflo(gh[e2]), gg[1] - bfhi(gh[e2]));
                    kh[e2] = pk2(kk[0], kk[1]); qh[e2] = pk2(qq[0], qq[1]);
                }
                const int off = (sc0 + 32 * i) * 272 + sch * 16;
                *(LAS u32x4*)(L + PA_GH + off) = (u32x4){gh[0], gh[1], gh[2], gh[3]}; *(LAS u32x4*)(L + PA_GL + off) = (u32x4){gl[0], gl[1], gl[2], gl[3]};
                *(LAS u32x4*)(L + PA_KH + off) = (u32x4){kh[0], kh[1], kh[2], kh[3]}; *(LAS u32x4*)(L + PA_QH + off) = (u32x4){qh[0], qh[1], qh[2], qh[3]};
                *(LAS u32x4*)(L + PA_V + off) = rv[i];
            }
        }
        LDS_BARRIER();
        if (unit + F.G < NU) {
            const int u2 = unit + F.G; const int bh2 = u2 >> 6, n2 = u2 & 63, b2 = bh2 / 6, h2 = bh2 % 6;
            const bf16_t* PR = (const bf16_t*)(P.ws + WS_R1) + (size_t)(b2 * SEQ + n2 * 64) * AW;
#pragma unroll
            for (int i = 0; i < 2; ++i) { const bf16_t* rp = PR + (size_t)(sc0 + 32 * i) * AW + sch * 8;
                rq[i] = *(const u32x4*)(rp + h2 * 128); rf[i] = *(const u32x4*)(rp + 768 + h2 * 128); rv[i] = *(const u32x4*)(rp + 1536 + h2 * 128); }
        }
        f32x4 bc[4];
        {
            bf16x8 gfh[2], gfl[2];
#pragma unroll
            for (int ks = 0; ks < 2; ++ks) { gfh[ks] = pa_trfrag(L + PA_GH + (32 * ks) * 272 + (16 * w) * 2 + trl); gfl[ks] = pa_trfrag(L + PA_GL + (32 * ks) * 272 + (16 * w) * 2 + trl); }
#pragma unroll
            for (int ct = 0; ct < 4; ++ct) bc[ct] = (f32x4){0.f, 0.f, 0.f, 0.f};
            bc[0] = __builtin_amdgcn_mfma_f32_16x16x32_bf16(gfh[0], tri0, bc[0], 0, 0, 0);  bc[0] = __builtin_amdgcn_mfma_f32_16x16x32_bf16(gfl[0], tri0, bc[0], 0, 0, 0);
            bc[1] = __builtin_amdgcn_mfma_f32_16x16x32_bf16(gfh[0], tri16, bc[1], 0, 0, 0); bc[1] = __builtin_amdgcn_mfma_f32_16x16x32_bf16(gfl[0], tri16, bc[1], 0, 0, 0);
            bc[2] = __builtin_amdgcn_mfma_f32_16x16x32_bf16(gfh[0], ones, bc[2], 0, 0, 0);  bc[2] = __builtin_amdgcn_mfma_f32_16x16x32_bf16(gfl[0], ones, bc[2], 0, 0, 0);
            bc[2] = __builtin_amdgcn_mfma_f32_16x16x32_bf16(gfh[1], tri0, bc[2], 0, 0, 0);  bc[2] = __builtin_amdgcn_mfma_f32_16x16x32_bf16(gfl[1], tri0, bc[2], 0, 0, 0);
            bc[3] = __builtin_amdgcn_mfma_f32_16x16x32_bf16(gfh[0], ones, bc[3], 0, 0, 0);  bc[3] = __builtin_amdgcn_mfma_f32_16x16x32_bf16(gfl[0], ones, bc[3], 0, 0, 0);
            bc[3] = __builtin_amdgcn_mfma_f32_16x16x32_bf16(gfh[1], tri16, bc[3], 0, 0, 0); bc[3] = __builtin_amdgcn_mfma_f32_16x16x32_bf16(gfl[1], tri16, bc[3], 0, 0, 0);
        }
        {
            f32x4 dec;
#pragma unroll
            for (int r = 0; r < 4; ++r) dec[r] = fexp2(__shfl(bc[3][r], (lane & 48) | 15));
            if (fr == 0) *(f32x4*)(GDEC + (size_t)unit * 128 + 16 * w + 4 * g) = dec;
#pragma unroll
            for (int ct = 0; ct < 4; ++ct) {
                const int off = (16 * ct + fr) * 272 + (16 * w + 4 * g) * 2;
                const u32x2 qh = *(const LAS u32x2*)(L + PA_QH + off), kh = *(const LAS u32x2*)(L + PA_KH + off);
                const float qv[4] = {bflo(qh.x), bfhi(qh.x), bflo(qh.y), bfhi(qh.y)}, kv[4] = {bflo(kh.x), bfhi(kh.x), bflo(kh.y), bfhi(kh.y)};
                float qd[4], ki[4], ks[4];
#pragma unroll
                for (int r = 0; r < 4; ++r) { const float e1 = fexp2(bc[ct][r]), e2 = fexp2(-bc[ct][r]); qd[r] = qv[r] * e1; ki[r] = kv[r] * e2; ks[r] = ki[r] * dec[r]; }
                *(LAS u32x2*)(L + PA_QH + off) = (u32x2){pk2(qd[0], qd[1]), pk2(qd[2], qd[3])};
                *(LAS u32x2*)(L + PA_KH + off) = (u32x2){pk2(ki[0], ki[1]), pk2(ki[2], ki[3])};
                *(LAS u32x2*)(L + PA_GH + off) = (u32x2){pk2(ks[0], ks[1]), pk2(ks[2], ks[3])};
            }
        }
        LDS_BARRIER();
#pragma unroll
        for (int i = 0; i < 2; ++i) { const int c = sc0 + 32 * i; *(u32x4*)(GQD + ((size_t)unit * 64 + c) * 128 + sch * 8) = *(const LAS u32x4*)(L + PA_QH + c * 272 + sch * 16); }
        {
            const int ci = w >> 1;
#pragma unroll
            for (int q = 0; q < 2; ++q) { const int si = 2 * (w & 1) + q;
                if (si <= ci) {
                    f32x4 d = (f32x4){0.f, 0.f, 0.f, 0.f};
#pragma unroll
                    for (int ks = 0; ks < 4; ++ks) {
                        const bf16x8 a = *(const LAS bf16x8*)(L + PA_KH + (16 * si + fr) * 272 + ks * 64 + g * 16);
                        const bf16x8 bb = *(const LAS bf16x8*)(L + PA_QH + (16 * ci + fr) * 272 + ks * 64 + g * 16);
                        d = __builtin_amdgcn_mfma_f32_16x16x32_bf16(a, bb, d, 0, 0, 0);
                    }
                    const int c = 16 * ci + fr, s0 = 16 * si + 4 * g;
#pragma unroll
                    for (int r = 0; r < 4; ++r) if (s0 + r > c) d[r] = 0.f;
                    *(LAS u32x2*)(L + PA_GL + c * 144 + s0 * 2) = (u32x2){pk2(d[0], d[1]), pk2(d[2], d[3])};
                } else {
                    const int c = 16 * ci + fr, s0 = 16 * si + 4 * g;
                    *(LAS u32x2*)(L + PA_GL + c * 144 + s0 * 2) = (u32x2){0u, 0u};
                }
            }
        }
        LDS_BARRIER();
        {
            const int j0 = 16 * w;
            bf16x8 vfrag[2];
#pragma unroll
            for (int ks = 0; ks < 2; ++ks) vfrag[ks] = pa_trfrag(L + PA_V + (32 * ks) * 272 + j0 * 2 + trl);
#pragma unroll
            for (int ct = 0; ct < 4; ++ct) {
                f32x4 o = (f32x4){0.f, 0.f, 0.f, 0.f};
#pragma unroll
                for (int ks = 0; ks < 2; ++ks) if (32 * ks <= 16 * ct + 15) {
                    const bf16x8 sc = *(const LAS bf16x8*)(L + PA_GL + (16 * ct + fr) * 144 + ks * 64 + g * 16);
                    o = __builtin_amdgcn_mfma_f32_16x16x32_bf16(vfrag[ks], sc, o, 0, 0, 0);
                }
                *(u32x2*)(GOI + ((size_t)unit * 64 + 16 * ct + fr) * 128 + j0 + 4 * g) = (u32x2){pk2(o[0], o[1]), pk2(o[2], o[3])};
            }
            unsigned uw[8];
#pragma unroll
            for (int kt = 0; kt < 8; ++kt) {
                f32x4 acc = (f32x4){0.f, 0.f, 0.f, 0.f};
#pragma unroll
                for (int cs = 0; cs < 2; ++cs) {
                    const bf16x8 a = pa_trfrag(L + PA_GH + (32 * cs) * 272 + (16 * kt) * 2 + trl);
                    acc = __builtin_amdgcn_mfma_f32_16x16x32_bf16(a, vfrag[cs], acc, 0, 0, 0);
                }
                uw[kt] = pk4_fp8s(acc[0] * HG_US, acc[1] * HG_US, acc[2] * HG_US, acc[3] * HG_US);
            }
            u32x4* up = (u32x4*)(GU + (((size_t)unit * 8 + w) * 64 + lane) * 32);
#pragma unroll
            for (int q = 0; q < 2; ++q) up[q] = (u32x4){uw[4 * q], uw[4 * q + 1], uw[4 * q + 2], uw[4 * q + 3]};
        }
        LDS_BARRIER();
    }
}

constexpr int HC_QD = 0;
constexpr int HC_DEC = 26112;
constexpr int HC_OT = 27648;
constexpr int HC_NG = 44544;
struct HcSet { u32x4 qp; float dp; u32x4 ur[2], oi, og; };
struct HcCtx { __amdgpu_buffer_rsrc_t rQD, rOI, rU, rDEC, rPR; bf16_t* MIX; unsigned vQD, vOI, vU, vDEC, vPR; int bh, b, h, r0, sc0, sch, c5, sub, fr, g, j0, tid, lane, w; };
__device__ __forceinline__ void abl16(u32x4& d, unsigned voff, __amdgpu_buffer_rsrc_t r, unsigned soff) { asm volatile("buffer_load_dwordx4 %0, %1, %2, %3 offen" : "=v"(d) : "v"(voff), "s"(r), "s"(soff) : "memory"); }
__device__ __forceinline__ void abl4(float& d, unsigned voff, __amdgpu_buffer_rsrc_t r, unsigned soff) { asm volatile("buffer_load_dword %0, %1, %2, %3 offen" : "=v"(d) : "v"(voff), "s"(r), "s"(soff) : "memory"); }
__device__ __forceinline__ void hc_load(const HcCtx& C, HcSet& d, int n) {
    const unsigned unit = (unsigned)(C.bh * 64 + n);
    abl16(d.qp, C.vQD, C.rQD, unit * 16384u);
    if (C.w < 2) abl4(d.dp, C.vDEC, C.rDEC, unit * 512u);
    abl16(d.ur[0], C.vU, C.rU, unit * 16384u); abl16(d.ur[1], C.vU + 16u, C.rU, unit * 16384u);
    abl16(d.oi, C.vOI, C.rOI, unit * 16384u);
    { const unsigned so = (unsigned)((C.b * SEQ + n * 64) * AW * 2); abl16(d.og, C.vPR, C.rPR, so); }
}
#define HC_PIN(d) "+v"((d).qp), "+v"((d).dp), "+v"((d).ur[0]), "+v"((d).ur[1]), "+v"((d).oi), "+v"((d).og)
__device__ __forceinline__ void hc_stage(const HcCtx& C, LAS unsigned char* L, const HcSet& d, int slot) {
    *(LAS u32x4*)(L + HC_QD + slot * 8704 + C.sc0 * 272 + C.sch * 16) = d.qp;
    if (C.w < 2) *(LAS float*)(L + HC_DEC + slot * 512 + C.tid * 4) = d.dp;
}
__device__ __forceinline__ void hc_step(const HcCtx& C, LAS unsigned char* L, f32x4 (&S)[8], int n, HcSet& cur, HcSet& nxt, HcSet& nx2, int slot, int slot_nxt) {
    if (n >= 64) return;
    if (n + 2 < 64) { hc_load(C, nx2, n + 2); asm volatile("s_waitcnt vmcnt(12)" : HC_PIN(cur)); }
    else asm volatile("s_waitcnt vmcnt(0)" : HC_PIN(cur));
    const int fr = C.fr, g = C.g, j0 = C.j0;
    {
        f32x4 o[2];
#pragma unroll
        for (int ct = 0; ct < 2; ++ct) o[ct] = (f32x4){0.f, 0.f, 0.f, 0.f};
#pragma unroll
        for (int ks = 0; ks < 4; ++ks) {
            u32x4 sa; sa.x = pk2(S[2 * ks][0], S[2 * ks][1]); sa.y = pk2(S[2 * ks][2], S[2 * ks][3]); sa.z = pk2(S[2 * ks + 1][0], S[2 * ks + 1][1]); sa.w = pk2(S[2 * ks + 1][2], S[2 * ks + 1][3]);
            const bf16x8 sfrag = __builtin_bit_cast(bf16x8, sa);
#pragma unroll
            for (int ct = 0; ct < 2; ++ct) {
                const u32x2 q0 = *(const LAS u32x2*)(L + HC_QD + slot * 8704 + (16 * ct + fr) * 272 + (32 * ks + 4 * g) * 2);
                const u32x2 q1 = *(const LAS u32x2*)(L + HC_QD + slot * 8704 + (16 * ct + fr) * 272 + (32 * ks + 16 + 4 * g) * 2);
                const bf16x8 qf = __builtin_bit_cast(bf16x8, (u32x4){q0.x, q0.y, q1.x, q1.y});
                o[ct] = __builtin_amdgcn_mfma_f32_16x16x32_bf16(sfrag, qf, o[ct], 0, 0, 0);
            }
        }
#pragma unroll
        for (int ct = 0; ct < 2; ++ct) *(LAS f32x4*)(L + HC_OT + (16 * ct + fr) * 528 + (j0 + 4 * g) * 4) = o[ct];
#pragma unroll
        for (int kt = 0; kt < 8; ++kt) {
            const f32x4 dc = *(const LAS f32x4*)(L + HC_DEC + slot * 512 + (16 * kt + 4 * g) * 4);
            const unsigned uu = (kt & 3) == 0 ? cur.ur[kt >> 2].x : (kt & 3) == 1 ? cur.ur[kt >> 2].y : (kt & 3) == 2 ? cur.ur[kt >> 2].z : cur.ur[kt >> 2].w;
            const f32x2 ulo = __builtin_amdgcn_cvt_pk_f32_fp8((int)uu, false), uhi = __builtin_amdgcn_cvt_pk_f32_fp8((int)uu, true);
            S[kt] = S[kt] * dc + (f32x4){ulo.x, ulo.y, uhi.x, uhi.y} * (1.0f / HG_US);
        }
    }
    LDS_BARRIER();
    {
        f32x4 ov[2]; float ss = 0.f;
        const unsigned oiw[4] = {cur.oi.x, cur.oi.y, cur.oi.z, cur.oi.w};
#pragma unroll
        for (int j = 0; j < 2; ++j) { ov[j] = *(const LAS f32x4*)(L + HC_OT + C.c5 * 528 + (8 * C.sub + 4 * j) * 4);
            ov[j] = ov[j] + (f32x4){bflo(oiw[2 * j]), bfhi(oiw[2 * j]), bflo(oiw[2 * j + 1]), bfhi(oiw[2 * j + 1])};
            ss += (ov[j].x * ov[j].x + ov[j].y * ov[j].y) + (ov[j].z * ov[j].z + ov[j].w * ov[j].w); }
        ss += swz_xor<1>(ss); ss += swz_xor<2>(ss); ss += swz_xor<4>(ss); ss += swz_xor<8>(ss);
        const float rs = frsq(ss * (1.f / 128.f) + RMS_EPS);
        const unsigned ogw[4] = {cur.og.x, cur.og.y, cur.og.z, cur.og.w};
        float r[8]; f32x4 ngv[2];
#pragma unroll
        for (int j = 0; j < 2; ++j) ngv[j] = *(const LAS f32x4*)(L + HC_NG + (8 * C.sub + 4 * j) * 4);
#pragma unroll
        for (int j = 0; j < 2; ++j)
#pragma unroll
            for (int e = 0; e < 4; ++e) { const unsigned wv = ogw[2 * j + (e >> 1)]; const float gg = (e & 1) ? bfhi(wv) : bflo(wv); r[4 * j + e] = ov[j][e] * rs * ngv[j][e] * gg * sigmoidf_(gg); }
        bf16_t* op = C.MIX + (size_t)(n * 64 + C.r0 + C.c5) * DM + C.h * 128 + 8 * C.sub;
        *(u32x4*)op = (u32x4){pk2(r[0], r[1]), pk2(r[2], r[3]), pk2(r[4], r[5]), pk2(r[6], r[7])};
    }
    if (n + 1 < 64) {
        if (n + 2 < 64) asm volatile("s_waitcnt vmcnt(7)" : HC_PIN(nxt)); else asm volatile("s_waitcnt vmcnt(0)" : HC_PIN(nxt));
        hc_stage(C, L, nxt, slot_nxt);
    }
    LDS_BARRIER();
}
__device__ __forceinline__ void hgrn_chain(const Frame& F, const Ptrs& P, int wgi) {
    HcCtx C;
    const int bh = wgi >> 1; const int b = bh / 6; C.bh = bh; C.b = b; C.h = bh % 6; C.r0 = 32 * (wgi & 1);
    C.tid = F.tid; C.lane = F.lane; C.w = F.wave;
    LAS unsigned char* L = F.lds;
    C.MIX = (bf16_t*)(P.ws + WS_MIX) + (size_t)b * SEQ * DM;
    C.rQD = __builtin_amdgcn_make_buffer_rsrc(P.ws + WS_HGQD, 0, 3072 * 16384, 0x00020000);
    C.rOI = __builtin_amdgcn_make_buffer_rsrc(P.ws + WS_HGOI, 0, 3072 * 16384, 0x00020000);
    C.rU = __builtin_amdgcn_make_buffer_rsrc(P.ws + WS_HGU, 0, 3072 * 16384, 0x00020000);
    C.rDEC = __builtin_amdgcn_make_buffer_rsrc(P.ws + WS_HGDEC, 0, 3072 * 512, 0x00020000);
    C.rPR = __builtin_amdgcn_make_buffer_rsrc(P.ws + WS_R1, 0, MTOK * AW * 2, 0x00020000);
    C.sc0 = C.tid >> 4; C.sch = C.tid & 15; C.c5 = C.tid >> 4; C.sub = C.tid & 15;
    C.fr = C.lane & 15; C.g = C.lane >> 4; C.j0 = 16 * C.w;
    C.vQD = (unsigned)(((C.r0 + C.sc0) * 128 + C.sch * 8) * 2); C.vOI = (unsigned)(((C.r0 + C.c5) * 128 + 8 * C.sub) * 2); C.vU = (unsigned)((C.w * 64 + C.lane) * 32); C.vDEC = (unsigned)(C.tid * 4);
    C.vPR = (unsigned)(((C.r0 + C.c5) * AW + 2304 + C.h * 128 + 8 * C.sub) * 2);
    if (C.tid < 128) *(LAS float*)(L + HC_NG + C.tid * 4) = P.hon[C.tid];
    f32x4 S[8];
#pragma unroll
    for (int kt = 0; kt < 8; ++kt) S[kt] = (f32x4){0.f, 0.f, 0.f, 0.f};
    HcSet d0, d1, d2;
    d0.dp = d1.dp = d2.dp = 0.f;
    d0.qp = d1.qp = d2.qp = (u32x4){0u, 0u, 0u, 0u};
    VM_WAIT();
    hc_load(C, d0, 0); hc_load(C, d1, 1);
    asm volatile("s_waitcnt vmcnt(5)" : HC_PIN(d0));
    hc_stage(C, L, d0, 0);
    LDS_BARRIER();
    for (int n = 0; n < 66; n += 6) {
        hc_step(C, L, S, n, d0, d1, d2, 0, 1);
        hc_step(C, L, S, n + 1, d1, d2, d0, 1, 2);
        hc_step(C, L, S, n + 2, d2, d0, d1, 2, 0);
        hc_step(C, L, S, n + 3, d0, d1, d2, 0, 1);
        hc_step(C, L, S, n + 4, d1, d2, d0, 1, 2);
        hc_step(C, L, S, n + 5, d2, d0, d1, 2, 0);
        asm volatile("s_waitcnt vmcnt(0)" : HC_PIN(d0), HC_PIN(d1), HC_PIN(d2));
    }
    VM_WAIT();
}

constexpr int MA_K = 0;
constexpr int MA_VT = 36864;
__device__ __forceinline__ void memattn_unit(const Frame& F, const bf16_t* Q, int qpitch, int qcol, const bf16_t* MKV, int kvcol, bf16_t* MIXo, int unit) {
    const int tb = unit >> 2, mh = unit & 3, b = tb >> 4;
    const int tid = F.tid, lane = F.lane, w = F.wave, r32 = lane & 31, hi = lane >> 5;
    LAS unsigned char* L = F.lds;
#pragma unroll
    for (int i = 0; i < 4; ++i) { const int p = tid + 512 * i, key = p >> 3, chn = p & 7;
        const bf16_t* src = MKV + (size_t)(b * MEML + key) * DM + kvcol + mh * 64 + chn * 8;
        const u32x4 kk = *(const u32x4*)src; const u32x4 vv = *(const u32x4*)(src + 256);
        *(LAS u32x4*)(L + MA_K + key * 144 + chn * 16) = kk;
        const unsigned vw[4] = {vv.x, vv.y, vv.z, vv.w};
#pragma unroll
        for (int e = 0; e < 4; ++e) { *(LAS unsigned short*)(L + MA_VT + (chn * 8 + 2 * e) * 520 + key * 2) = (unsigned short)(vw[e] & 0xffffu);
            *(LAS unsigned short*)(L + MA_VT + (chn * 8 + 2 * e + 1) * 520 + key * 2) = (unsigned short)(vw[e] >> 16); } }
    const int tok0 = tb * 256 + w * 32;
    bf16x8 qr[4];
#pragma unroll
    for (int s = 0; s < 4; ++s) qr[s] = *(const bf16x8*)(Q + (size_t)(tok0 + r32) * qpitch + qcol + mh * 64 + 16 * s + 8 * hi);
    LDS_BARRIER();
    f32x16 p[8];
#pragma unroll
    for (int kt = 0; kt < 8; ++kt) { p[kt] = f32x16{};
#pragma unroll
        for (int s = 0; s < 4; ++s) { const bf16x8 a = *(const LAS bf16x8*)(L + MA_K + (32 * kt + r32) * 144 + s * 32 + hi * 16);
            p[kt] = __builtin_amdgcn_mfma_f32_32x32x16_bf16(a, qr[s], p[kt], 0, 0, 0); } }
    float mx = -3.0e38f;
#pragma unroll
    for (int kt = 0; kt < 8; ++kt)
#pragma unroll
        for (int r = 0; r < 16; ++r) mx = fmaxf(mx, p[kt][r]);
    mx = fmaxf(mx, __shfl_xor(mx, 32));
    float sum = 0.f;
#pragma unroll
    for (int kt = 0; kt < 8; ++kt)
#pragma unroll
        for (int r = 0; r < 16; ++r) { p[kt][r] = fexp2(p[kt][r] - mx); sum += p[kt][r]; }
    sum += __shfl_xor(sum, 32);
    const float inv = frcp(sum);
    f32x16 o[2]; o[0] = f32x16{}; o[1] = f32x16{};
#pragma unroll
    for (int kt = 0; kt < 8; ++kt)
#pragma unroll
        for (int s2 = 0; s2 < 2; ++s2) {
            u32x4 pw; pw.x = pk2(p[kt][8 * s2 + 0] * inv, p[kt][8 * s2 + 1] * inv); pw.y = pk2(p[kt][8 * s2 + 2] * inv, p[kt][8 * s2 + 3] * inv);
            pw.z = pk2(p[kt][8 * s2 + 4] * inv, p[kt][8 * s2 + 5] * inv); pw.w = pk2(p[kt][8 * s2 + 6] * inv, p[kt][8 * s2 + 7] * inv);
            const bf16x8 pa = __builtin_bit_cast(bf16x8, pw);
#pragma unroll
            for (int dt = 0; dt < 2; ++dt) {
                const u32x2 v0 = *(const LAS u32x2*)(L + MA_VT + (32 * dt + r32) * 520 + (32 * kt + 16 * s2 + 4 * hi) * 2);
                const u32x2 v1 = *(const LAS u32x2*)(L + MA_VT + (32 * dt + r32) * 520 + (32 * kt + 16 * s2 + 8 + 4 * hi) * 2);
                const bf16x8 vb = __builtin_bit_cast(bf16x8, (u32x4){v0.x, v0.y, v1.x, v1.y});
                o[dt] = __builtin_amdgcn_mfma_f32_32x32x16_bf16(pa, vb, o[dt], 0, 0, 0);
            }
        }
#pragma unroll
    for (int dt = 0; dt < 2; ++dt)
#pragma unroll
        for (int r = 0; r < 16; ++r) MIXo[(size_t)(tok0 + crow(r, hi)) * DM + 768 + mh * 64 + 32 * dt + r32] = (bf16_t)f2bf(o[dt][r]);
    LDS_BARRIER();
}

constexpr int SB_SLOT = 19456;
constexpr int SB_VOFF = 9216;
constexpr int SB_NSLOT = 6;
constexpr int SB_FLAG = SB_NSLOT * SB_SLOT;
__device__ __forceinline__ int sb_unit_of(int L) { return (L >> 4) * 16 + (15 - (L & 15)); }
__device__ __forceinline__ void sb_prefetch_q(const Frame& F, const bf16_t* KVQ, int unit, bf16x8 (&q)[4]) {
    const int qb = unit & 15, hh = (unit >> 4) % 12, b = unit / 192;
    const int r32 = F.lane & 31, hi = F.lane >> 5;
    const bf16_t* base = KVQ + (size_t)b * SEQ * KVQW;
    const int tq = qb * 256 + F.wave * 32 + r32;
#pragma unroll
    for (int s = 0; s < 4; ++s) q[s] = *(const bf16x8*)(base + (size_t)tq * KVQW + 1536 + hh * 64 + 16 * s + 8 * hi);
}
__device__ __forceinline__ int sb_unit(const Frame& F, const bf16_t* KVQ, bf16_t* MIXo, int unit, const bf16x8 (&qpre)[4], int have_lo, int have_hi) {
    const int qb = unit & 15, hh = (unit >> 4) % 12, b = unit / 192;
    const int tid = F.tid, lane = F.lane, w = F.wave, r32 = lane & 31, hi = lane >> 5;
    LAS unsigned char* L = F.lds;
    const bf16_t* base = KVQ + (size_t)b * SEQ * KVQW;
    const int q0 = qb * 256 + w * 32;
    const int tq = q0 + r32;
    bf16x8 qr[4];
#pragma unroll
    for (int s = 0; s < 4; ++s) qr[s] = qpre[s];
    bf16x8 tri[2], ones;
#pragma unroll
    for (int s2 = 0; s2 < 2; ++s2)
#pragma unroll
        for (int j = 0; j < 8; ++j) { const int k = 16 * s2 + 8 * (j >> 2) + 4 * hi + (j & 3); tri[s2][j] = (k > r32) ? (short)0x3F80 : (short)0; }
#pragma unroll
    for (int j = 0; j < 8; ++j) ones[j] = (short)0x3F80;
    f32x16 o[2]; o[0] = f32x16{}; o[1] = f32x16{};
    float R = 0.f;
    const int skey = tid >> 3, schn = tid & 7;
    const bf16_t* srcb = base + (size_t)skey * KVQW + hh * 64 + schn * 8;
    const int kwr = skey * 144 + schn * 16, vwr = SB_VOFF + skey * 160 + schn * 16;
    const int vlane = SB_VOFF + (4 * hi + ((lane & 15) >> 2)) * 160 + ((lane >> 4) & 1) * 32 + (lane & 3) * 8;
    {
        u32x4 kk[4], vv[4];
#pragma unroll
        for (int i = 0; i < 4; ++i) { const int tt = 4 * qb + i; if (tt < have_lo || tt > have_hi) { const bf16_t* src = srcb + (size_t)(tt * 64) * KVQW; kk[i] = *(const u32x4*)src; vv[i] = *(const u32x4*)(src + 768); } }
#pragma unroll
        for (int i = 0; i < 4; ++i) { const int tt = 4 * qb + i; if (tt < have_lo || tt > have_hi) { const int sl = tt % SB_NSLOT; *(LAS u32x4*)(L + sl * SB_SLOT + kwr) = kk[i]; *(LAS u32x4*)(L + sl * SB_SLOT + vwr) = vv[i]; } }
    }
    LDS_BARRIER();
    const int jd = 4 * qb + (w >> 1);
    int slot = jd % SB_NSLOT;
    int pslot = (4 * qb + SB_NSLOT - 1) % SB_NSLOT;
    bool mydone = false;
    int lo_loaded = (have_lo <= have_hi && have_lo < 4 * qb) ? have_lo : 4 * qb;
    for (int st = 0; ; ++st) {
        const int tpre = 4 * qb - st - 1;
        u32x4 kreg, vreg;
        const bool need_pre = tpre >= 0 && (tpre < have_lo || tpre > have_hi);
        if (need_pre) { const bf16_t* src = srcb + (size_t)(tpre * 64) * KVQW; kreg = *(const u32x4*)src; vreg = *(const u32x4*)(src + 768); }
        const int t = jd - st;
        if (t >= 0 && !mydone) {
            const int k0 = 64 * t;
            const LAS unsigned char* Kb = L + slot * SB_SLOT;
            f32x16 p0 = f32x16{}, p1 = f32x16{};
#pragma unroll
            for (int s = 0; s < 4; ++s) {
                const bf16x8 a0 = *(const LAS bf16x8*)(Kb + r32 * 144 + s * 32 + hi * 16);
                const bf16x8 a1 = *(const LAS bf16x8*)(Kb + (32 + r32) * 144 + s * 32 + hi * 16);
                p0 = __builtin_amdgcn_mfma_f32_32x32x16_bf16(a0, qr[s], p0, 0, 0, 0);
                p1 = __builtin_amdgcn_mfma_f32_32x32x16_bf16(a1, qr[s], p1, 0, 0, 0);
            }
            float l0[16], l1[16];
            float csum = 0.f;
#pragma unroll
            for (int r = 0; r < 16; ++r) {
                const float z0 = fminf(p0[r], 80.f), z1 = fminf(p1[r], 80.f);
                const float sp0 = flog2(1.0f + fexp2(z0)), sp1 = flog2(1.0f + fexp2(z1));
                float a = -sp0, bq = -sp1, lb0 = z0 - sp0, lb1 = z1 - sp1;
                if (st == 0) { const int key0 = k0 + crow(r, hi); if (key0 >= tq) { a = 0.f; lb0 = -INFINITY; } if (key0 + 32 >= tq) { bq = 0.f; lb1 = -INFINITY; } }
                l0[r] = a; l1[r] = bq; p0[r] = lb0; p1[r] = lb1; csum += a + bq;
            }
            csum += __shfl_xor(csum, 32);
            bf16x8 x0[2], x1[2];
#pragma unroll
            for (int s2 = 0; s2 < 2; ++s2) {
                u32x4 t0, t1;
                t0.x = pk2(l0[8 * s2 + 0], l0[8 * s2 + 1]); t0.y = pk2(l0[8 * s2 + 2], l0[8 * s2 + 3]); t0.z = pk2(l0[8 * s2 + 4], l0[8 * s2 + 5]); t0.w = pk2(l0[8 * s2 + 6], l0[8 * s2 + 7]);
                t1.x = pk2(l1[8 * s2 + 0], l1[8 * s2 + 1]); t1.y = pk2(l1[8 * s2 + 2], l1[8 * s2 + 3]); t1.z = pk2(l1[8 * s2 + 4], l1[8 * s2 + 5]); t1.w = pk2(l1[8 * s2 + 6], l1[8 * s2 + 7]);
                x0[s2] = __builtin_bit_cast(bf16x8, t0); x1[s2] = __builtin_bit_cast(bf16x8, t1);
            }
            f32x16 y0, y1;
#pragma unroll
            for (int r = 0; r < 16; ++r) { y0[r] = R; y1[r] = R; }
            y0 = __builtin_amdgcn_mfma_f32_32x32x16_bf16(tri[0], x0[0], y0, 0, 0, 0);
            y0 = __builtin_amdgcn_mfma_f32_32x32x16_bf16(tri[1], x0[1], y0, 0, 0, 0);
            y0 = __builtin_amdgcn_mfma_f32_32x32x16_bf16(ones, x1[0], y0, 0, 0, 0);
            y0 = __builtin_amdgcn_mfma_f32_32x32x16_bf16(ones, x1[1], y0, 0, 0, 0);
            y1 = __builtin_amdgcn_mfma_f32_32x32x16_bf16(tri[0], x1[0], y1, 0, 0, 0);
            y1 = __builtin_amdgcn_mfma_f32_32x32x16_bf16(tri[1], x1[1], y1, 0, 0, 0);
#pragma unroll
            for (int r = 0; r < 16; ++r) { p0[r] = fexp2(p0[r] + y0[r]); p1[r] = fexp2(p1[r] + y1[r]); }
            R += csum;
            const LAS unsigned char* Vl = Kb + vlane;
#pragma unroll
            for (int half = 0; half < 2; ++half)
#pragma unroll
                for (int s2 = 0; s2 < 2; ++s2) {
                    u32x4 pw;
                    if (half == 0) { pw.x = pk2(p0[8 * s2 + 0], p0[8 * s2 + 1]); pw.y = pk2(p0[8 * s2 + 2], p0[8 * s2 + 3]); pw.z = pk2(p0[8 * s2 + 4], p0[8 * s2 + 5]); pw.w = pk2(p0[8 * s2 + 6], p0[8 * s2 + 7]); }
                    else { pw.x = pk2(p1[8 * s2 + 0], p1[8 * s2 + 1]); pw.y = pk2(p1[8 * s2 + 2], p1[8 * s2 + 3]); pw.z = pk2(p1[8 * s2 + 4], p1[8 * s2 + 5]); pw.w = pk2(p1[8 * s2 + 6], p1[8 * s2 + 7]); }
                    const bf16x8 pa = __builtin_bit_cast(bf16x8, pw);
#pragma unroll
                    for (int dt = 0; dt < 2; ++dt) {
                        const int kb = 32 * half + 16 * s2;
                        const s16x4 vlo = lds_tr16(Vl + kb * 160 + dt * 64), vhi = lds_tr16(Vl + (kb + 8) * 160 + dt * 64);
                        const bf16x8 vb = (bf16x8){vlo[0], vlo[1], vlo[2], vlo[3], vhi[0], vhi[1], vhi[2], vhi[3]};
                        o[dt] = __builtin_amdgcn_mfma_f32_32x32x16_bf16(pa, vb, o[dt], 0, 0, 0);
                    }
                }
        }
        if (t <= 0 || __all(R <= -150.f) != 0) mydone = true;
        if (lane == 0) *(LAS unsigned*)(L + SB_FLAG + ((st & 1) * 8 + w) * 4) = mydone ? 1u : 0u;
        if (need_pre) { *(LAS u32x4*)(L + pslot * SB_SLOT + kwr) = kreg; *(LAS u32x4*)(L + pslot * SB_SLOT + vwr) = vreg; }
        if (tpre >= 0 && tpre < lo_loaded) lo_loaded = tpre;
        LDS_BARRIER();
        { const u32x4 f0 = *(const LAS u32x4*)(L + SB_FLAG + (st & 1) * 32), f1 = *(const LAS u32x4*)(L + SB_FLAG + (st & 1) * 32 + 16);
          if ((f0.x & f0.y & f0.z & f0.w & f1.x & f1.y & f1.z & f1.w) != 0u) break; }
        slot = (slot == 0) ? SB_NSLOT - 1 : slot - 1;
        pslot = (pslot == 0) ? SB_NSLOT - 1 : pslot - 1;
    }
#pragma unroll
    for (int dt = 0; dt < 2; ++dt)
#pragma unroll
        for (int r = 0; r < 16; ++r) MIXo[(size_t)(b * SEQ + q0 + crow(r, hi)) * DM + hh * 64 + 32 * dt + r32] = (bf16_t)f2bf(o[dt][r]);
    LDS_BARRIER();
    return lo_loaded;
}
__device__ __forceinline__ void sb_phase(const Frame& F, const bf16_t* KVQ, bf16_t* MIXo) {
    bf16x8 qa[4], qb_[4];
    const int L0 = 6 * F.bx;
    sb_prefetch_q(F, KVQ, sb_unit_of(L0), qa);
    int have_lo = 1, have_hi = 0;
    for (int j = 0; j < 6; j += 2) {
        const int Lc = L0 + j;
        sb_prefetch_q(F, KVQ, sb_unit_of(Lc + 1), qb_);
        { const int u = sb_unit_of(Lc); const int lo = sb_unit(F, KVQ, MIXo, u, qa, have_lo, have_hi);
          if (((Lc + 1) >> 4) == (Lc >> 4)) { have_lo = lo; have_hi = lo + SB_NSLOT - 1; } else { have_lo = 1; have_hi = 0; } }
        if (j + 2 < 6) sb_prefetch_q(F, KVQ, sb_unit_of(Lc + 2), qa);
        { const int u = sb_unit_of(Lc + 1); const int lo = sb_unit(F, KVQ, MIXo, u, qb_, have_lo, have_hi);
          if (((Lc + 2) >> 4) == ((Lc + 1) >> 4)) { have_lo = lo; have_hi = lo + SB_NSLOT - 1; } else { have_lo = 1; have_hi = 0; } }
    }
}

struct Args { const float* in[20]; float* out; unsigned char* ws; };

__global__ void __launch_bounds__(NTHR, 2) yoco_fwd(Args args) {
    extern __shared__ __attribute__((aligned(16))) unsigned char lds_raw[];
    Frame F;
    F.lds = (LAS unsigned char*)lds_raw;
    F.tid = threadIdx.x; F.lane = F.tid & 63; F.wave = __builtin_amdgcn_readfirstlane(F.tid >> 6);
    F.G = gridDim.x; F.bx = blockIdx.x;
    Ptrs P;
    P.x = args.in[0]; P.mem = args.in[1]; P.anpre = args.in[2]; P.anpost = args.in[3]; P.fnpre = args.in[4]; P.fnpost = args.in[5];
    P.w_in_a = args.in[6]; P.hlb = args.in[7]; P.hon = args.in[8]; P.w_in_b = args.in[9]; P.kvn = args.in[10]; P.w_kv = args.in[11];
    P.memn = args.in[12]; P.w_mem_kv = args.in[13]; P.w_out = args.in[14]; P.w_gu = args.in[15]; P.w_dn = args.in[16]; P.w_router = args.in[17];
    P.w_egu = args.in[18]; P.w_edn = args.in[19]; P.out = args.out; P.ws = args.ws;
    unsigned char* ws = args.ws;
    unsigned* ctl = (unsigned*)(ws + WS_CTL);
    volatile LAS unsigned* MISC = (volatile LAS unsigned*)(F.lds + MISC_OFF);
    for (int u = F.tid; u < (LDS_BYTES - LDSCTL_OFF) / 4; u += NTHR) ((LAS unsigned*)(F.lds + LDSCTL_OFF))[u] = 0u;
    __syncthreads();
    XcdBarrier bar = xcd_barrier_post(ctl + CW_BAR, MISC + 8);
    {
        if (F.tid == 0) { const unsigned xcc = xb_xcc_id(); const unsigned rk = xb_add((unsigned*)ctl + CW_XRANK + xcc, 1u); MISC[12] = (xcc < 8u && rk < (unsigned)(F.G >> 3) && (F.G & 7) == 0) ? rk * 8u + xcc : 0xffffffffu; }
        __syncthreads();
        if (F.tid == 0 && MISC[12] == 0xffffffffu) __hip_atomic_store((unsigned*)ctl + CW_XRANK + 15, 1u, __ATOMIC_RELAXED, __HIP_MEMORY_SCOPE_AGENT);
    }
#define GRID_BAR() xcd_barrier(bar)

    bf16_t* const U = (bf16_t*)(ws + WS_U);
    bf16_t* const R1 = (bf16_t*)(ws + WS_R1);
    bf16_t* const MIX = (bf16_t*)(ws + WS_MIX);
    bf16_t* const MIXED = (bf16_t*)(ws + WS_MIXED);
    bf16_t* const MKV = (bf16_t*)(ws + WS_MKV);
    bf16_t* const H16 = (bf16_t*)(ws + WS_H16);

    { const Frame Fp = phase_frame(F); p0_prologue(Fp, P); }
    GRID_BAR();
    if (__hip_atomic_load((unsigned*)ctl + CW_XRANK + 15, __ATOMIC_RELAXED, __HIP_MEMORY_SCOPE_AGENT) == 0u) F.bx = (int)MISC[12];
    {
        pg8::Gemm g{U, (const bf16_t*)(ws + WS_WINA), MTOK, AW, DM / 2}; pg8::StaticOrder S; S.init(MTOK, AW, F.G, F.bx);
        S.ext_n = 32; S.ext_pm0 = MTOK / 256; S.ext_pn0 = AW / 256;
        pg8::EpiStoreQ E{R1, AW, (const float*)(ws + WS_AS), (const float*)(ws + WS_WSC) + WSC_INA, MKV, DM, MTOK / 256, AW / 256};
        pg8::gemm_phase<pg8::EpiStoreQ, pg8::StaticOrder, true, true, 2>(F.lds, g, S, E);
    }
    GRID_BAR();
    { const Frame Fp = phase_frame(F); hgrnA_phase(Fp, P); }
    { const Frame Fp = phase_frame(F); for (int u = F.bx; u < 512; u += F.G) memattn_unit(Fp, R1, AW, 3072, MKV, 0, MIX, u); }
    GRID_BAR();
    { const Frame Fp = phase_frame(F); if (F.bx < 96) hgrn_chain(Fp, P, ((((F.bx >> 4) << 3) | (F.bx & 7)) << 1) | ((F.bx >> 3) & 1));
      else convert_weights(Fp, P, (F.bx - 96) * NWAVES + Fp.wave, (F.G - 96) * NWAVES); }
    GRID_BAR();
    {
        pg8::Gemm g{MIX, (const bf16_t*)(ws + WS_WOUT0), MTOK, DM, DM}; pg8::StaticOrder S; S.init(MTOK, DM, F.G, F.bx);
        pg8::EpiStore E{MIXED, DM, 1.f, nullptr, 0, 0, 0};
        pg8::gemm_phase<pg8::EpiStore, pg8::StaticOrder, true, true>(F.lds, g, S, E);
    }
    GRID_BAR();
    { const Frame Fp = phase_frame(F); norm_phase<false, true>(Fp, MIXED, P.x, H16, P.anpost, U, P.fnpre, (float*)(ws + WS_AS + 256 * 1024)); }
#if STOP_AFTER >= 5
    GRID_BAR();
    {
        pg8::Gemm g{U, (const bf16_t*)(ws + WS_WGU), MTOK, 2 * DFF, DM / 2}; pg8::StaticOrder S; S.init(MTOK, 2 * DFF, F.G, F.bx);
        pg8::EpiSwiGLUQ8 E{(unsigned char*)R1, DFF, (const float*)(ws + WS_AS + 256 * 1024), (const float*)(ws + WS_WSC) + WSC_GU};
        pg8::gemm_phase<pg8::EpiSwiGLUQ8, pg8::StaticOrder, true, true, 2>(F.lds, g, S, E);
    }
    GRID_BAR();
    {
        pg8::Gemm g{R1, (const bf16_t*)(ws + WS_WDN), MTOK, DM, DFF / 2}; pg8::StaticOrder S; S.init(MTOK, DM, F.G, F.bx);
        pg8::EpiStore E{MIXED, DM, 1.0f / (FP8_SHD * FP8_SWDD), nullptr, 0, 0, 0};
        pg8::gemm_phase<pg8::EpiStore, pg8::StaticOrder, true, true, 1>(F.lds, g, S, E);
    }
    GRID_BAR();
    { const Frame Fp = phase_frame(F); norm_phase<true, true>(Fp, MIXED, H16, H16, P.fnpost, U, nullptr, (float*)(ws + WS_AS + 512 * 1024)); }
#endif
#if STOP_AFTER >= 8
    GRID_BAR();
    {
        pg8::Gemm g{U, (const bf16_t*)(ws + WS_WKVB), MTOK, KVQW, DM / 2}; pg8::StaticOrder S; S.init(MTOK, KVQW, F.G, F.bx);
        pg8::EpiStoreQ E{R1, KVQW, (const float*)(ws + WS_AS + 512 * 1024), (const float*)(ws + WS_WSC) + WSC_KVB, nullptr, 0, 0, 0};
        pg8::gemm_phase<pg8::EpiStoreQ, pg8::StaticOrder, true, true, 2>(F.lds, g, S, E);
    }
    GRID_BAR();
    {
        { const Frame Fp = phase_frame(F); sb_phase(Fp, R1, MIX); }
        { const Frame Fp = phase_frame(F); for (int u = F.bx; u < 512; u += F.G) memattn_unit(Fp, R1, KVQW, 2304, MKV, 512, MIX, u); }
    }
    GRID_BAR();
    {
        pg8::Gemm g{MIX, (const bf16_t*)(ws + WS_WOUT1), MTOK, DM, DM}; pg8::StaticOrder S; S.init(MTOK, DM, F.G, F.bx);
        pg8::EpiStore E{MIXED, DM, 1.f, nullptr, 0, 0, 0};
        pg8::gemm_phase<pg8::EpiStore, pg8::StaticOrder, true, true>(F.lds, g, S, E);
    }
    GRID_BAR();
    {
        const Frame Fq = phase_frame(F);
        LAS unsigned* lcnt = (LAS unsigned*)(F.lds + 32768);
        LAS float* WRt = (LAS float*)(F.lds);
        if (Fq.tid < 8) lcnt[Fq.tid] = 0u;
        for (int idx = Fq.tid; idx < DM * NEXP; idx += NTHR) WRt[(idx & 7) * DM + (idx >> 3)] = P.w_router[idx];
        __syncthreads();
        f32x4 g1v[4], g2v[4];
#pragma unroll
        for (int j = 0; j < 4; ++j) { g1v[j] = ((const f32x4*)(P.anpost + DM))[Fq.lane + 64 * j]; g2v[j] = ((const f32x4*)(P.fnpre + DM))[Fq.lane + 64 * j]; }
        for (int i0 = 0; i0 < 16; i0 += 4) {
          const int m0 = F.bx * 128 + Fq.wave * 16 + i0;
          u32x2 ar[4][4], bs[4][4];
#pragma unroll
          for (int r = 0; r < 4; ++r)
#pragma unroll
            for (int j = 0; j < 4; ++j) { ar[r][j] = ((const u32x2*)(MIXED + (size_t)(m0 + r) * DM))[Fq.lane + 64 * j]; bs[r][j] = ((const u32x2*)(H16 + (size_t)(m0 + r) * DM))[Fq.lane + 64 * j]; }
          f32x4 uu[4][4];
#pragma unroll
          for (int r = 0; r < 4; ++r) {
            const int m = m0 + r;
            f32x4 a[4];
#pragma unroll
            for (int j = 0; j < 4; ++j) a[j] = (f32x4){bflo(ar[r][j].x), bfhi(ar[r][j].x), bflo(ar[r][j].y), bfhi(ar[r][j].y)};
            const float rs = row_rstd(a);
            f32x4 h[4];
#pragma unroll
            for (int j = 0; j < 4; ++j) {
                h[j] = (f32x4){bflo(bs[r][j].x), bfhi(bs[r][j].x), bflo(bs[r][j].y), bfhi(bs[r][j].y)} + a[j] * rs * g1v[j];
                u32x2 hw; hw.x = pk2(h[j].x, h[j].y); hw.y = pk2(h[j].z, h[j].w); ((u32x2*)(H16 + (size_t)m * DM))[Fq.lane + 64 * j] = hw; }
            const float rh = row_rstd(h);
            unsigned* o4 = (unsigned*)((unsigned char*)U + (size_t)m * DM) + Fq.lane;
#pragma unroll
            for (int j = 0; j < 4; ++j) { uu[r][j] = h[j] * rh * g2v[j];
                o4[64 * j] = pk4_fp8s(uu[r][j].x * FP8_SX, uu[r][j].y * FP8_SX, uu[r][j].z * FP8_SX, uu[r][j].w * FP8_SX); }
          }
          float lg[4][8];
#pragma unroll
          for (int r = 0; r < 4; ++r)
#pragma unroll
            for (int e = 0; e < 8; ++e) lg[r][e] = 0.f;
#pragma unroll
          for (int j = 0; j < 4; ++j)
#pragma unroll
            for (int e = 0; e < 8; ++e) { const f32x4 w4 = *(const LAS f32x4*)(WRt + e * DM + 4 * Fq.lane + 256 * j);
#pragma unroll
                for (int r = 0; r < 4; ++r) lg[r][e] += uu[r][j].x * w4.x + uu[r][j].y * w4.y + uu[r][j].z * w4.z + uu[r][j].w * w4.w; }
#pragma unroll
          for (int r = 0; r < 4; ++r) {
            const int m = m0 + r;
#pragma unroll
            for (int e = 0; e < 8; ++e) lg[r][e] = wave_sum(lg[r][e]);
            int i0 = 0; float l0 = lg[r][0];
#pragma unroll
            for (int e = 1; e < 8; ++e) if (lg[r][e] > l0) { l0 = lg[r][e]; i0 = e; }
            int i1 = -1; float l1 = -3.0e38f;
#pragma unroll
            for (int e = 0; e < 8; ++e) if (e != i0 && lg[r][e] > l1) { l1 = lg[r][e]; i1 = e; }
            const float g0 = 1.0f / (1.0f + __expf(l1 - l0));
            if (Fq.lane == 0) {
                const unsigned r0 = __hip_atomic_fetch_add(lcnt + i0, 1u, __ATOMIC_RELAXED, __HIP_MEMORY_SCOPE_WORKGROUP);
                const unsigned r1 = __hip_atomic_fetch_add(lcnt + i1, 1u, __ATOMIC_RELAXED, __HIP_MEMORY_SCOPE_WORKGROUP);
                ((int4*)(ws + WS_META))[m] = make_int4(i0, i1, (int)r0, (int)r1);
                ((float2*)(ws + WS_GATE))[m] = make_float2(g0, 1.0f - g0);
            }
          }
        }
        __syncthreads();
        if (Fq.tid < 8) { const unsigned base = __hip_atomic_fetch_add(ctl + CW_GCNT + Fq.tid, lcnt[Fq.tid], __ATOMIC_RELAXED, __HIP_MEMORY_SCOPE_AGENT); ((unsigned*)(ws + WS_WGB))[F.bx * 8 + Fq.tid] = base; }
    }
#endif
#if STOP_AFTER >= 12
    GRID_BAR();
    int ts[NEXP + 1];
    {
        const Frame Fq = phase_frame(F);
        ts[0] = 0;
#pragma unroll
        for (int e = 0; e < NEXP; ++e) { const unsigned c = __hip_atomic_load(ctl + CW_GCNT + e, __ATOMIC_RELAXED, __HIP_MEMORY_SCOPE_AGENT); ts[e + 1] = ts[e] + (int)((c + 255u) >> 8); }
        bf16_t* XS = R1;
        for (int i0 = 0; i0 < 16; i0 += 4) {
            const int m0 = F.bx * 128 + Fq.wave * 16 + i0;
            int4 mt[4]; u32x4 v0[4];
#pragma unroll
            for (int r = 0; r < 4; ++r) { mt[r] = ((const int4*)(ws + WS_META))[m0 + r]; v0[r] = *((const u32x4*)((const unsigned char*)U + (size_t)(m0 + r) * DM) + Fq.lane); }
#pragma unroll
            for (int r = 0; r < 4; ++r) {
                int d0 = 0, d1 = 0;
#pragma unroll
                for (int e = 0; e < NEXP; ++e) { if (mt[r].x == e) d0 = ts[e] * 256; if (mt[r].y == e) d1 = ts[e] * 256; }
                d0 += (int)((const unsigned*)(ws + WS_WGB))[F.bx * 8 + mt[r].x] + mt[r].z;
                d1 += (int)((const unsigned*)(ws + WS_WGB))[F.bx * 8 + mt[r].y] + mt[r].w;
                *((u32x4*)((unsigned char*)XS + (size_t)d0 * DM) + Fq.lane) = v0[r]; *((u32x4*)((unsigned char*)XS + (size_t)d1 * DM) + Fq.lane) = v0[r];
                if (Fq.lane == 0) ((int2*)(ws + WS_DEST))[m0 + r] = make_int2(d0, d1);
            }
        }
    }
    GRID_BAR();
    {
        pg8::Gemm g{R1, (const bf16_t*)(ws + WS_WEGU), 0, 2 * DFE, DM / 2}; pg8::StaticOrder S; S.init(256, 2 * DFE, F.G, F.bx);
        S.nM = ts[NEXP]; S.nwg = S.nM * S.nN; S.moe = 1;
#pragma unroll
        for (int e = 0; e < NEXP; ++e) S.ts[e] = ts[e];
        pg8::EpiSwiGLU8 E{(unsigned char*)(ws + WS_EH), DFE, 1.0f / (FP8_SX * FP8_SWGU)};
        pg8::gemm_phase<pg8::EpiSwiGLU8, pg8::StaticOrder, true, true, 1>(F.lds, g, S, E);
    }
    GRID_BAR();
    {
        pg8::Gemm g{(const bf16_t*)(ws + WS_EH), (const bf16_t*)(ws + WS_WEDN), 0, DM, DFE / 2}; pg8::StaticOrder S; S.init(256, DM, F.G, F.bx);
        S.nM = ts[NEXP]; S.nwg = S.nM * S.nN; S.moe = 1;
#pragma unroll
        for (int e = 0; e < NEXP; ++e) S.ts[e] = ts[e];
        pg8::EpiStore E{R1 + (size_t)XS_ROWS * DM / 2, DM, 1.0f / (FP8_SH * FP8_SWDN), nullptr, 0, 0, 0};
        pg8::gemm_phase<pg8::EpiStore, pg8::StaticOrder, true, true, 1>(F.lds, g, S, E);
    }
    GRID_BAR();
    {
        const Frame Fq = phase_frame(F);
        const float* g1 = P.fnpost + DM;
        const bf16_t* YS = R1 + (size_t)XS_ROWS * DM / 2;
        for (int i0 = 0; i0 < 16; i0 += 4) {
            const int m0 = F.bx * 128 + Fq.wave * 16 + i0;
            int2 d[4]; float2 gt[4];
#pragma unroll
            for (int r = 0; r < 4; ++r) { d[r] = ((const int2*)(ws + WS_DEST))[m0 + r]; gt[r] = ((const float2*)(ws + WS_GATE))[m0 + r]; }
            u32x2 ya[4][4], yb[4][4], bs[4][4];
#pragma unroll
            for (int r = 0; r < 4; ++r)
#pragma unroll
                for (int j = 0; j < 4; ++j) { ya[r][j] = ((const u32x2*)(YS + (size_t)d[r].x * DM))[Fq.lane + 64 * j]; yb[r][j] = ((const u32x2*)(YS + (size_t)d[r].y * DM))[Fq.lane + 64 * j];
                    bs[r][j] = ((const u32x2*)(H16 + (size_t)(m0 + r) * DM))[Fq.lane + 64 * j]; }
#pragma unroll
            for (int r = 0; r < 4; ++r) {
                f32x4 a[4];
#pragma unroll
                for (int j = 0; j < 4; ++j) a[j] = (f32x4){bflo(ya[r][j].x), bfhi(ya[r][j].x), bflo(ya[r][j].y), bfhi(ya[r][j].y)} * gt[r].x + (f32x4){bflo(yb[r][j].x), bfhi(yb[r][j].x), bflo(yb[r][j].y), bfhi(yb[r][j].y)} * gt[r].y;
                const float rs = row_rstd(a);
#pragma unroll
                for (int j = 0; j < 4; ++j) { const f32x4 gg = ((const f32x4*)g1)[Fq.lane + 64 * j];
                    ((f32x4*)(P.out + (size_t)(m0 + r) * DM))[Fq.lane + 64 * j] = (f32x4){bflo(bs[r][j].x), bfhi(bs[r][j].x), bflo(bs[r][j].y), bfhi(bs[r][j].y)} + a[j] * rs * gg; }
            }
        }
    }
#endif
}

extern "C" void kernel_launch(void* const* d_in, const int* in_sizes, int n_in, void* d_out, int out_size, void* d_ws, size_t ws_size, hipStream_t stream) {
    static int grid = 0;
    if (grid == 0) {
        if (n_in != 20 || out_size != MTOK * DM || ws_size < WS_END) { fprintf(stderr, "kernel_launch: unexpected shapes (n_in %d out %d ws %zu)\n", n_in, out_size, ws_size); grid = -1; return; }
        int dev = 0, cus = 0, per_cu = 0;
        if (hipGetDevice(&dev) != hipSuccess || hipDeviceGetAttribute(&cus, hipDeviceAttributeMultiprocessorCount, dev) != hipSuccess) { grid = -1; return; }
        if (hipFuncSetAttribute((const void*)yoco_fwd, hipFuncAttributeMaxDynamicSharedMemorySize, LDS_BYTES) != hipSuccess) { fprintf(stderr, "kernel_launch: hipFuncSetAttribute failed\n"); grid = -1; return; }
        if (hipOccupancyMaxActiveBlocksPerMultiprocessor(&per_cu, (const void*)yoco_fwd, NTHR, LDS_BYTES) != hipSuccess || per_cu < 1) { fprintf(stderr, "kernel_launch: occupancy query says %d\n", per_cu); }
        (void)hipGetLastError();
        if (cus < 256) { fprintf(stderr, "kernel_launch: need 256 CUs, have %d\n", cus); grid = -1; return; }
        grid = 256;
    }
    if (grid < 0) return;
    if (hipMemsetAsync((char*)d_ws + WS_CTL, 0, CTL_ZERO_BYTES, stream) != hipSuccess) return;
    Args a{};
    for (int i = 0; i < 20; ++i) a.in[i] = (const float*)d_in[i];
    a.out = (float*)d_out; a.ws = (unsigned char*)d_ws;
    hipLaunchKernelGGL(yoco_fwd, dim3(grid), dim3(NTHR), LDS_BYTES, stream, a);
}
```

```cpp
#include <hip/hip_runtime.h>
#include <cstdio>
#include <cstdint>

#ifndef STOP_AFTER
#define STOP_AFTER 99
#endif

#define LAS __attribute__((address_space(3)))
#define GAS __attribute__((address_space(1)))
typedef unsigned short bf16_t;
typedef short bf16x8 __attribute__((ext_vector_type(8)));
typedef float f32x4 __attribute__((ext_vector_type(4)));
typedef float f32x16 __attribute__((ext_vector_type(16)));
typedef float f32x2 __attribute__((ext_vector_type(2)));
typedef unsigned u32x4 __attribute__((ext_vector_type(4)));
typedef unsigned u32x2 __attribute__((ext_vector_type(2)));
typedef __bf16 bf16x2_t __attribute__((ext_vector_type(2)));

constexpr int NB = 8, SEQ = 4096, DM = 1024, MTOK = NB * SEQ;
constexpr int MEML = 256, MROWS = NB * MEML;
constexpr int AW = 3328, HF = 768, DFF = 2816, NEXP = 8, DFE = 3584;
constexpr int KVQW = 2560;
constexpr int XS_ROWS = 2 * MTOK + NEXP * 256;
constexpr float RMS_EPS = 1e-6f;
constexpr float C2 = 0.125f * 1.4426950408889634f;
constexpr int NWAVES = 8, NTHR = 512;

constexpr size_t MiB = 1u << 20;
constexpr size_t WS_CTL = 0, CTL_ZERO_BYTES = 128 * 1024;
constexpr size_t WS_MEMN = 395 * MiB + 32 * MiB;
constexpr size_t WS_MEMN_OLD_UNUSED = 459 * MiB;
constexpr size_t WS_AS = 1 * MiB;
constexpr size_t WS_WSC = 2 * MiB;
constexpr int WSC_INA = 0, WSC_GU = 4352, WSC_KVB = 9984, WSC_N = 12544;
constexpr size_t WS_MKV = 5 * MiB;
constexpr size_t WS_META = 9 * MiB;
constexpr size_t WS_GATE = WS_META + 512 * 1024, WS_DEST = WS_GATE + 256 * 1024, WS_WGB = WS_DEST + 256 * 1024;
constexpr size_t WS_WOUT1 = 12 * MiB;
constexpr size_t WS_WKVB = 14 * MiB;
constexpr size_t WS_WEGU = 19 * MiB;
constexpr size_t WS_WEDN = 131 * MiB;
constexpr size_t WS_R1 = 187 * MiB;
constexpr size_t WS_EH = 395 * MiB;
constexpr size_t WS_U = 395 * MiB;
constexpr size_t WS_MIX = 459 * MiB;
constexpr size_t WS_MIXED = 523 * MiB;
constexpr size_t WS_WINA = 587 * MiB;
constexpr size_t WS_WMKV = 587 * MiB + (size_t)3328 * 1024;
constexpr size_t WS_WMKV_OLD_UNUSED = 587 * MiB + (size_t)3328 * 1024 * 2;
constexpr size_t WS_WOUT0 = 596 * MiB;
constexpr size_t WS_WGU = 598 * MiB;
constexpr size_t WS_WDN = 609 * MiB;
constexpr size_t WS_HGQD = 640 * MiB;
constexpr size_t WS_HGOI = 688 * MiB;
constexpr size_t WS_HGU = 736 * MiB;
constexpr size_t WS_HGDEC = 832 * MiB;
constexpr size_t WS_H16 = 640 * MiB;
constexpr size_t WS_END = 857 * MiB;
static_assert(WS_EH + (size_t)XS_ROWS * DFE * 2 <= WS_END, "EH fits");
static_assert(WS_R1 + (size_t)MTOK * AW * 2 <= WS_EH, "R1 fits");
constexpr int CW_BAR = 4096;
constexpr int CW_GCNT = 16384;
constexpr int CW_XRANK = 16448;
static_assert((CW_XRANK + 16) * 4 <= (int)CTL_ZERO_BYTES, "control words inside the zeroed region");

constexpr int RING_BYTES = 131072;
constexpr int LDSCTL_OFF = RING_BYTES, MISC_OFF = LDSCTL_OFF + 320;
constexpr int LDS_BYTES = 147456;

__device__ __forceinline__ unsigned f2bf(float f) { unsigned u = __builtin_bit_cast(unsigned, f); return (u + 0x7fffu + ((u >> 16) & 1u)) >> 16; }
__device__ __forceinline__ unsigned pk2(float lo, float hi) { f32x2 v = {lo, hi}; bf16x2_t b = __builtin_convertvector(v, bf16x2_t); return __builtin_bit_cast(unsigned, b); }
__device__ __forceinline__ float bflo(unsigned w) { return __builtin_bit_cast(float, w << 16); }
__device__ __forceinline__ float bfhi(unsigned w) { return __builtin_bit_cast(float, w & 0xffff0000u); }
__device__ __forceinline__ float bf1(unsigned short s) { return __builtin_bit_cast(float, (unsigned)s << 16); }
__device__ __forceinline__ float wave_sum(float v);
__device__ __forceinline__ float fexp2(float x) { return __builtin_amdgcn_exp2f(x); }
__device__ __forceinline__ float flog2(float x) { return __builtin_amdgcn_logf(x); }
__device__ __forceinline__ float frcp(float x) { return __builtin_amdgcn_rcpf(x); }
__device__ __forceinline__ float frsq(float x) { return __builtin_amdgcn_rsqf(x); }
template <int X> __device__ __forceinline__ float swz_xor(float v) { return __builtin_bit_cast(float, __builtin_amdgcn_ds_swizzle(__builtin_bit_cast(int, v), (X << 10) | 0x1F)); }
__device__ __forceinline__ float wave_sum(float v) {
    v += swz_xor<1>(v); v += swz_xor<2>(v); v += swz_xor<4>(v); v += swz_xor<8>(v); v += swz_xor<16>(v);
    const float lo = __builtin_bit_cast(float, __builtin_amdgcn_readlane(__builtin_bit_cast(int, v), 0)), hi = __builtin_bit_cast(float, __builtin_amdgcn_readlane(__builtin_bit_cast(int, v), 32));
    return lo + hi;
}
__device__ __forceinline__ float sigmoidf_(float x) { return frcp(1.0f + fexp2(-1.4426950408889634f * x)); }
typedef int i32x4 __attribute__((ext_vector_type(4)));
typedef int i32x8 __attribute__((ext_vector_type(8)));
__device__ __forceinline__ float sat8(float x) { return __builtin_amdgcn_fmed3f(x, -448.f, 448.f); }
__device__ __forceinline__ unsigned pk4_fp8s(float a, float b, float c, float d) { int w = 0; w = __builtin_amdgcn_cvt_pk_fp8_f32(sat8(a), sat8(b), w, false); w = __builtin_amdgcn_cvt_pk_fp8_f32(sat8(c), sat8(d), w, true); return (unsigned)w; }
__device__ __forceinline__ unsigned pk4_fp8(float a, float b, float c, float d) { int w = 0; w = __builtin_amdgcn_cvt_pk_fp8_f32(a, b, w, false); w = __builtin_amdgcn_cvt_pk_fp8_f32(c, d, w, true); return (unsigned)w; }
constexpr float FP8_SX = 8.f, FP8_SH = 8.f, FP8_SWGU = 32.f, FP8_SWDN = 64.f, FP8_SHD = 8.f, FP8_SWDD = 64.f;
__device__ __forceinline__ float wave_max(float v) {
    v = fmaxf(v, swz_xor<1>(v)); v = fmaxf(v, swz_xor<2>(v)); v = fmaxf(v, swz_xor<4>(v)); v = fmaxf(v, swz_xor<8>(v)); v = fmaxf(v, swz_xor<16>(v));
    const float lo = __builtin_bit_cast(float, __builtin_amdgcn_readlane(__builtin_bit_cast(int, v), 0)), hi = __builtin_bit_cast(float, __builtin_amdgcn_readlane(__builtin_bit_cast(int, v), 32));
    return fmaxf(lo, hi);
}
__device__ __forceinline__ unsigned pk4_i8(float a, float b, float c, float d) {
    const int ia = (int)__builtin_rintf(__builtin_amdgcn_fmed3f(a, -127.f, 127.f)), ib = (int)__builtin_rintf(__builtin_amdgcn_fmed3f(b, -127.f, 127.f)),
              ic = (int)__builtin_rintf(__builtin_amdgcn_fmed3f(c, -127.f, 127.f)), id = (int)__builtin_rintf(__builtin_amdgcn_fmed3f(d, -127.f, 127.f));
    return (unsigned)(ia & 0xff) | ((unsigned)(ib & 0xff) << 8) | ((unsigned)(ic & 0xff) << 16) | ((unsigned)id << 24);
}
__device__ __forceinline__ void quant_row_i8(const f32x4 (&uu)[4], unsigned char* qrow, float* as_slot, int lane) {
    float am = 0.f;
#pragma unroll
    for (int j = 0; j < 4; ++j) am = fmaxf(fmaxf(am, fmaxf(__builtin_fabsf(uu[j].x), __builtin_fabsf(uu[j].y))), fmaxf(__builtin_fabsf(uu[j].z), __builtin_fabsf(uu[j].w)));
    am = fmaxf(wave_max(am), 1e-20f);
    const float inv = 127.0f / am;
    unsigned* o4 = (unsigned*)qrow + lane;
#pragma unroll
    for (int j = 0; j < 4; ++j) o4[64 * j] = pk4_i8(uu[j].x * inv, uu[j].y * inv, uu[j].z * inv, uu[j].w * inv);
    if (lane == 0) *as_slot = am * (1.0f / 127.0f);
}
__device__ __forceinline__ int crow(int r, int hi) { return (r & 3) + 8 * (r >> 2) + 4 * hi; }
#define LDS_WAIT() asm volatile("s_waitcnt lgkmcnt(0)" ::: "memory")
#define VM_WAIT() asm volatile("s_waitcnt vmcnt(0)" ::: "memory")
#define LDS_BARRIER() do { asm volatile("s_waitcnt lgkmcnt(0)" ::: "memory"); __builtin_amdgcn_s_barrier(); asm volatile("" ::: "memory"); } while (0)

namespace pg8 {
#define PG8_LAS __attribute__((address_space(3)))
constexpr int BM = 256, BK = 64, HALF = 128, HTB = HALF * BK * 2, STAGE_BYTES = 8 * HTB, NXCD = 8, WGM = 4;
__host__ __device__ __forceinline__ int lds_byte(int r, int c) { const int st = (r >> 4) * 2 + (c >> 5), rr = r & 15, cc = c & 31, ob = rr * 64 + cc * 2; return st * 1024 + (ob ^ (((ob >> 9) & 1) << 5)); }
__host__ __device__ __forceinline__ void stage_rc(int b, int& R, int& C) { const int st = b / 1024, sb = b % 1024, swz = sb ^ (((sb >> 9) & 1) << 5); R = (st >> 1) * 16 + swz / 64; C = (st & 1) * 32 + (swz % 64) / 2; }
__host__ __device__ __forceinline__ int perm32(int rho) { const int n = rho >> 4, i = rho & 15; return 8 * (i >> 2) + 4 * n + (i & 3); }

struct Unit { int pm, pn, pb; };
struct Gemm { const bf16_t* A; const bf16_t* Bt; int M, N, K; };

struct StaticOrder {
    int nM, nN, nwg, G, c;
    int ts[NEXP];
    int moe;
    int ext_n, ext_pm0, ext_pn0;
    __device__ void init(int M, int N, int G_, int c_) { nM = M / BM; nN = N / BM; nwg = nM * nN; G = G_; c = c_; moe = 0; ext_n = 0; ext_pm0 = 0; ext_pn0 = 0;
#pragma unroll
        for (int e = 0; e < NEXP; ++e) ts[e] = 0; }
    __device__ bool next(int i, Unit& u) const {
        const long L = (long)i * G + c; if (L >= nwg + ext_n) return false;
        if (L >= nwg) { const int j = (int)L - nwg; u.pm = ext_pm0 + (j >> 2); u.pn = ext_pn0 + (j & 3); u.pb = u.pn; return true; }
        int wgid = (int)L; { const int q = nwg / NXCD, r = nwg % NXCD, xcd = wgid % NXCD, off = wgid / NXCD; wgid = (xcd < r ? xcd * (q + 1) : r * (q + 1) + (xcd - r) * q) + off; }
        const int nig = WGM * nN, gid = wgid / nig, fm = gid * WGM, gsz = (nM - fm) < WGM ? (nM - fm) : WGM;
        u.pm = fm + ((wgid % nig) % gsz); u.pn = (wgid % nig) / gsz; u.pb = u.pn;
        if (moe) { int e = 0;
#pragma unroll
            for (int j = 1; j < NEXP; ++j) e += (u.pm >= ts[j]) ? 1 : 0;
            u.pb = e * nN + u.pn; }
        return true;
    }
    __device__ __forceinline__ void a_ready(const Unit&) const {}
    __device__ __forceinline__ void done(const Unit&) const {}
};

struct EpiStore {
    static constexpr bool PERM = true, AFTER_DRAIN = false;
    bf16_t* O; int ldc; float sc;
    bf16_t* O2; int ldc2, pm2, pn2;
    __device__ __forceinline__ void operator()(const f32x4 (&acc)[2][2][4][2], const Unit& u, int wr, int wc, int fr, int fq) const {
        int row0 = u.pm * BM + wr * 64 + fr; int col0 = u.pn * BM + wc * 32 + 8 * fq; bf16_t* Ob = O; int ld = ldc;
        if (pm2 > 0 && u.pm >= pm2) { row0 -= pm2 * BM; col0 -= pn2 * BM; Ob = O2; ld = ldc2; }
#pragma unroll
        for (int ai = 0; ai < 2; ++ai)
#pragma unroll
            for (int m = 0; m < 4; ++m) { bf16_t* rowp = Ob + (size_t)(row0 + ai * HALF + m * 16) * ld + col0;
#pragma unroll
                for (int bj = 0; bj < 2; ++bj) { const f32x4 v0 = acc[ai][bj][m][0] * sc, v1 = acc[ai][bj][m][1] * sc;
                    u32x4 w; w.x = pk2(v0[0], v0[1]); w.y = pk2(v0[2], v0[3]); w.z = pk2(v1[0], v1[1]); w.w = pk2(v1[2], v1[3]);
                    *(u32x4*)(rowp + bj * HALF) = w; } }
    }
};
struct EpiSwiGLU {
    static constexpr bool PERM = true, AFTER_DRAIN = false;
    bf16_t* O; int ldc;
    __device__ __forceinline__ void operator()(const f32x4 (&acc)[2][2][4][2], const Unit& u, int wr, int wc, int fr, int fq) const {
        const int row0 = u.pm * BM + wr * 64 + fr; const int col0 = u.pn * HALF + wc * 32 + 8 * fq;
#pragma unroll
        for (int ai = 0; ai < 2; ++ai)
#pragma unroll
            for (int m = 0; m < 4; ++m) { bf16_t* rowp = O + (size_t)(row0 + ai * HALF + m * 16) * ldc + col0;
                float h[8];
#pragma unroll
                for (int n = 0; n < 2; ++n)
#pragma unroll
                    for (int i = 0; i < 4; ++i) { const float g = acc[ai][0][m][n][i], up = acc[ai][1][m][n][i]; h[4 * n + i] = (g * up) * frcp(1.0f + fexp2(-1.4426950408889634f * g)); }
                u32x4 w; w.x = pk2(h[0], h[1]); w.y = pk2(h[2], h[3]); w.z = pk2(h[4], h[5]); w.w = pk2(h[6], h[7]);
                *(u32x4*)rowp = w; }
    }
};

struct EpiStoreQ {
    static constexpr bool PERM = true, AFTER_DRAIN = false;
    bf16_t* O; int ldc; const float* as; const float* ws;
    bf16_t* O2; int ldc2, pm2, pn2;
    __device__ __forceinline__ void operator()(const f32x4 (&acc)[2][2][4][2], const Unit& u, int wr, int wc, int fr, int fq) const {
        const int arow0 = u.pm * BM + wr * 64 + fr, bcol0 = u.pb * BM + wc * 32 + 8 * fq;
        int row0 = arow0, col0 = u.pn * BM + wc * 32 + 8 * fq; bf16_t* Ob = O; int ld = ldc;
        if (pm2 > 0 && u.pm >= pm2) { row0 -= pm2 * BM; col0 -= pn2 * BM; Ob = O2; ld = ldc2; }
        f32x4 wsv[2][2];
#pragma unroll
        for (int bj = 0; bj < 2; ++bj) { wsv[bj][0] = *(const f32x4*)(ws + bcol0 + bj * HALF); wsv[bj][1] = *(const f32x4*)(ws + bcol0 + bj * HALF + 4); }
#pragma unroll
        for (int ai = 0; ai < 2; ++ai)
#pragma unroll
            for (int m = 0; m < 4; ++m) { const float a = as[arow0 + ai * HALF + m * 16]; bf16_t* rowp = Ob + (size_t)(row0 + ai * HALF + m * 16) * ld + col0;
#pragma unroll
                for (int bj = 0; bj < 2; ++bj) { const i32x4 i0 = __builtin_bit_cast(i32x4, acc[ai][bj][m][0]), i1 = __builtin_bit_cast(i32x4, acc[ai][bj][m][1]);
                    const f32x4 v0 = __builtin_convertvector(i0, f32x4) * wsv[bj][0] * a, v1 = __builtin_convertvector(i1, f32x4) * wsv[bj][1] * a;
                    u32x4 w; w.x = pk2(v0[0], v0[1]); w.y = pk2(v0[2], v0[3]); w.z = pk2(v1[0], v1[1]); w.w = pk2(v1[2], v1[3]);
                    *(u32x4*)(rowp + bj * HALF) = w; } }
    }
};
struct EpiSwiGLUQ {
    static constexpr bool PERM = true, AFTER_DRAIN = false;
    bf16_t* O; int ldc; const float* as; const float* ws;
    __device__ __forceinline__ void operator()(const f32x4 (&acc)[2][2][4][2], const Unit& u, int wr, int wc, int fr, int fq) const {
        const int row0 = u.pm * BM + wr * 64 + fr; const int col0 = u.pn * HALF + wc * 32 + 8 * fq, bcol0 = u.pb * BM + wc * 32 + 8 * fq;
        f32x4 wsv[2][2];
#pragma unroll
        for (int bj = 0; bj < 2; ++bj) { wsv[bj][0] = *(const f32x4*)(ws + bcol0 + bj * HALF); wsv[bj][1] = *(const f32x4*)(ws + bcol0 + bj * HALF + 4); }
#pragma unroll
        for (int ai = 0; ai < 2; ++ai)
#pragma unroll
            for (int m = 0; m < 4; ++m) { const float a = as[row0 + ai * HALF + m * 16]; bf16_t* rowp = O + (size_t)(row0 + ai * HALF + m * 16) * ldc + col0;
                float h[8];
#pragma unroll
                for (int n = 0; n < 2; ++n) { const f32x4 gv = __builtin_convertvector(__builtin_bit_cast(i32x4, acc[ai][0][m][n]), f32x4) * wsv[0][n] * a, uv = __builtin_convertvector(__builtin_bit_cast(i32x4, acc[ai][1][m][n]), f32x4) * wsv[1][n] * a;
#pragma unroll
                    for (int i = 0; i < 4; ++i) h[4 * n + i] = (gv[i] * uv[i]) * frcp(1.0f + fexp2(-1.4426950408889634f * gv[i])); }
                u32x4 w; w.x = pk2(h[0], h[1]); w.y = pk2(h[2], h[3]); w.z = pk2(h[4], h[5]); w.w = pk2(h[6], h[7]);
                *(u32x4*)rowp = w; }
    }
};
struct EpiSwiGLUQ8 {
    static constexpr bool PERM = true, AFTER_DRAIN = false;
    static constexpr int NST = 8;
    unsigned char* O; int ldc; const float* as; const float* ws;
    __device__ __forceinline__ void operator()(const f32x4 (&acc)[2][2][4][2], const Unit& u, int wr, int wc, int fr, int fq) const {
        const int row0 = u.pm * BM + wr * 64 + fr; const int col0 = u.pn * HALF + wc * 32 + 8 * fq, bcol0 = u.pb * BM + wc * 32 + 8 * fq;
        f32x4 wsv[2][2];
#pragma unroll
        for (int bj = 0; bj < 2; ++bj) { wsv[bj][0] = *(const f32x4*)(ws + bcol0 + bj * HALF); wsv[bj][1] = *(const f32x4*)(ws + bcol0 + bj * HALF + 4); }
#pragma unroll
        for (int ai = 0; ai < 2; ++ai)
#pragma unroll
            for (int m = 0; m < 4; ++m) { const float a = as[row0 + ai * HALF + m * 16]; unsigned char* rowp = O + (size_t)(row0 + ai * HALF + m * 16) * ldc + col0;
                float h[8];
#pragma unroll
                for (int n = 0; n < 2; ++n) { const f32x4 gv = __builtin_convertvector(__builtin_bit_cast(i32x4, acc[ai][0][m][n]), f32x4) * wsv[0][n] * a, uv = __builtin_convertvector(__builtin_bit_cast(i32x4, acc[ai][1][m][n]), f32x4) * wsv[1][n] * (a * FP8_SHD);
#pragma unroll
                    for (int i = 0; i < 4; ++i) h[4 * n + i] = (gv[i] * uv[i]) * frcp(1.0f + fexp2(-1.4426950408889634f * gv[i])); }
                u32x2 w; w.x = pk4_fp8s(h[0], h[1], h[2], h[3]); w.y = pk4_fp8s(h[4], h[5], h[6], h[7]);
                *(u32x2*)rowp = w; }
    }
};
struct EpiSwiGLU8 {
    static constexpr bool PERM = true, AFTER_DRAIN = false;
    unsigned char* O; int ldc; float ds;
    __device__ __forceinline__ void operator()(const f32x4 (&acc)[2][2][4][2], const Unit& u, int wr, int wc, int fr, int fq) const {
        const float c1 = -1.4426950408889634f * ds, c2 = ds * ds * FP8_SH;
        const int row0 = u.pm * BM + wr * 64 + fr; const int col0 = u.pn * HALF + wc * 32 + 8 * fq;
#pragma unroll
        for (int ai = 0; ai < 2; ++ai)
#pragma unroll
            for (int m = 0; m < 4; ++m) { unsigned char* rowp = O + (size_t)(row0 + ai * HALF + m * 16) * ldc + col0;
                float h[8];
#pragma unroll
                for (int n = 0; n < 2; ++n)
#pragma unroll
                    for (int i = 0; i < 4; ++i) { const float ga = acc[ai][0][m][n][i], ua = acc[ai][1][m][n][i];
                        h[4 * n + i] = (ga * ua) * (c2 * frcp(1.0f + fexp2(ga * c1))); }
                u32x2 w; w.x = pk4_fp8s(h[0], h[1], h[2], h[3]); w.y = pk4_fp8s(h[4], h[5], h[6], h[7]);
                *(u32x2*)rowp = w; }
    }
};

template <class Epi, class Sched, bool ALIGN_EPI = false, bool SP2 = false, int FP8 = 0>
__device__ __forceinline__ void gemm_phase(PG8_LAS unsigned char* lds, const Gemm g, const Sched& S, const Epi& E) {
    int tid_ = threadIdx.x; asm volatile("" : "+v"(tid_));
    const int tid = tid_, wid = __builtin_amdgcn_readfirstlane(tid >> 6), lane = tid & 63, wr = wid >> 2, wc = wid & 3, fr = lane & 15, fq = lane >> 4;
    const int K = g.K, nt = K / BK;
    unsigned voffA[2], voffB[2];
#pragma unroll
    for (int i = 0; i < 2; ++i) { int R, C; stage_rc(tid * 16 + i * 8192, R, C); const int Rb = Epi::PERM ? ((R & ~31) + perm32(R & 31)) : R;
        voffA[i] = (unsigned)(R * K + C) * 2u; voffB[i] = (unsigned)(Rb * K + C) * 2u; }
    const size_t kstep = (size_t)(BK * 2);
    const size_t hstep = (size_t)HALF * K * 2;
    const size_t tstep = 2 * hstep;
    const unsigned ldsw = (unsigned)wid * 1024u;
    const int aoff = lds_byte(wr * 64 + fr, fq * 8), boff = lds_byte(wc * 32 + fr, fq * 8);
#define PG8_SA(b, h) (((b) * 2 + (h)) * HTB)
#define PG8_SB(b, h) ((4 + (b) * 2 + (h)) * HTB)
#define PG8_STAGE(bufoff, gbase, voff) do { _Pragma("unroll") for (int _i = 0; _i < 2; ++_i) \
        __builtin_amdgcn_global_load_lds((const unsigned*)((const char*)(gbase) + (voff)[_i]), (PG8_LAS unsigned*)(lds + (bufoff) + ldsw + _i * 8192), 16, 0, 0); } while (0)
#define PG8_LD8(p) __builtin_shufflevector(*(const PG8_LAS i32x4*)(p), *(const PG8_LAS i32x4*)((p) + 1024), 0, 1, 2, 3, 4, 5, 6, 7)
#define PG8_LDA(dst, b, h) do { if constexpr (FP8 == 1) { _Pragma("unroll") for (int m = 0; m < 4; ++m) dst##8[m] = PG8_LD8(lds + PG8_SA(b, h) + aoff + m * 2048); } \
        else { _Pragma("unroll") for (int m = 0; m < 4; ++m) _Pragma("unroll") for (int k = 0; k < 2; ++k) dst[m][k] = *(const PG8_LAS bf16x8*)(lds + PG8_SA(b, h) + aoff + m * 2048 + k * 1024); } } while (0)
#define PG8_LDB(dst, b, h) do { if constexpr (FP8 == 1) { _Pragma("unroll") for (int n = 0; n < 2; ++n) dst##8[n] = PG8_LD8(lds + PG8_SB(b, h) + boff + n * 2048); } \
        else { _Pragma("unroll") for (int n = 0; n < 2; ++n) _Pragma("unroll") for (int k = 0; k < 2; ++k) dst[n][k] = *(const PG8_LAS bf16x8*)(lds + PG8_SB(b, h) + boff + n * 2048 + k * 1024); } } while (0)
#define PG8_CAT(x, y) __builtin_shufflevector(__builtin_bit_cast(i32x4, x), __builtin_bit_cast(i32x4, y), 0, 1, 2, 3, 4, 5, 6, 7)
#define PG8_MMA(ai, bj, At, Bt) do { __builtin_amdgcn_s_setprio(1); \
        if constexpr (FP8 == 1) { _Pragma("unroll") for (int m = 0; m < 4; ++m) _Pragma("unroll") for (int n = 0; n < 2; ++n) \
            asm volatile("v_mfma_scale_f32_16x16x128_f8f6f4 %0, %1, %2, %0, %3, %3 op_sel_hi:[0,0,0]" : "+v"(acc[ai][bj][m][n]) : "v"(Bt##8[n]), "v"(At##8[m]), "v"(sc1)); } \
        else if constexpr (FP8 == 2) { _Pragma("unroll") for (int m = 0; m < 4; ++m) _Pragma("unroll") for (int n = 0; n < 2; ++n) _Pragma("unroll") for (int k = 0; k < 2; ++k) \
            acc[ai][bj][m][n] = __builtin_bit_cast(f32x4, __builtin_amdgcn_mfma_i32_16x16x64_i8(__builtin_bit_cast(i32x4, Bt[n][k]), __builtin_bit_cast(i32x4, At[m][k]), __builtin_bit_cast(i32x4, acc[ai][bj][m][n]), 0, 0, 0)); } \
        else { _Pragma("unroll") for (int m = 0; m < 4; ++m) _Pragma("unroll") for (int n = 0; n < 2; ++n) _Pragma("unroll") for (int k = 0; k < 2; ++k) \
            acc[ai][bj][m][n] = __builtin_amdgcn_mfma_f32_16x16x32_bf16(Bt[n][k], At[m][k], acc[ai][bj][m][n], 0, 0, 0); } \
        __builtin_amdgcn_s_setprio(0); } while (0)
#define PG8_WAIT_V(n) asm volatile("s_waitcnt vmcnt(" #n ")" ::: "memory")
#define PG8_WAIT_L(n) asm volatile("s_waitcnt lgkmcnt(" #n ")" ::: "memory")
#define PG8_BAR __builtin_amdgcn_s_barrier()
#define PG8_SCHED __builtin_amdgcn_sched_barrier(0)
    Unit cur, nxt; int ui = 0;
    if (!S.next(0, cur)) return;
    f32x4 acc[2][2][4][2];
#pragma unroll
    for (int a = 0; a < 2; ++a)
#pragma unroll
        for (int b = 0; b < 2; ++b)
#pragma unroll
            for (int m = 0; m < 4; ++m)
#pragma unroll
                for (int n = 0; n < 2; ++n) acc[a][b][m][n] = (f32x4){0.f, 0.f, 0.f, 0.f};
    bf16x8 At[4][2], B0[2][2], B1[2][2];
    i32x8 At8[4], B08[2], B18[2];
    int sc1 = 0x7F7F7F7F; asm volatile("" : "+v"(sc1));
    const char* cA = (const char*)g.A + (size_t)cur.pm * tstep; const char* cB = (const char*)g.Bt + (size_t)cur.pb * tstep;
    S.a_ready(cur);
    if constexpr (SP2) {
        PG8_STAGE(PG8_SB(0, 0), cB, voffB); PG8_STAGE(PG8_SB(0, 1), cB + hstep, voffB); PG8_STAGE(PG8_SA(0, 0), cA, voffA); PG8_STAGE(PG8_SA(0, 1), cA + hstep, voffA);
        if (wr == 1) PG8_BAR;
        PG8_WAIT_V(2); PG8_BAR;
        PG8_STAGE(PG8_SB(1, 0), cB + kstep, voffB); PG8_STAGE(PG8_SA(1, 0), cA + kstep, voffA); PG8_STAGE(PG8_SB(1, 1), cB + hstep + kstep, voffB);
        PG8_WAIT_V(6); PG8_BAR;
    } else {
        PG8_STAGE(PG8_SB(0, 0), cB, voffB); PG8_STAGE(PG8_SA(0, 0), cA, voffA); PG8_STAGE(PG8_SB(0, 1), cB + hstep, voffB); PG8_STAGE(PG8_SA(0, 1), cA + hstep, voffA);
        if (wr == 1) PG8_BAR;
        PG8_WAIT_V(4); PG8_BAR;
        PG8_STAGE(PG8_SB(1, 0), cB + kstep, voffB); PG8_STAGE(PG8_SA(1, 0), cA + kstep, voffA); PG8_STAGE(PG8_SB(1, 1), cB + hstep + kstep, voffB);
        PG8_WAIT_V(6); PG8_BAR;
    }
    for (;;) {
        const bool has_next = S.next(ui + 1, nxt);
        const char* nA = has_next ? (const char*)g.A + (size_t)nxt.pm * tstep : cA; const char* nB = has_next ? (const char*)g.Bt + (size_t)nxt.pb * tstep : cB;
        for (int t = 0; t < nt; t += 2) {
            const bool last = (t == nt - 2);
            const char* a1 = cA + (size_t)(t + 1) * kstep;
            const char* a2 = last ? nA : cA + (size_t)(t + 2) * kstep; const char* b2 = last ? nB : cB + (size_t)(t + 2) * kstep;
            const char* a3 = a2 + kstep; const char* b3 = b2 + kstep;
            if (last && has_next) S.a_ready(nxt);
            if constexpr (SP2) {
            PG8_LDB(B0, 0, 0); PG8_LDB(B1, 0, 1); PG8_SCHED; PG8_LDA(At, 0, 0); PG8_STAGE(PG8_SA(1, 1), a1 + hstep, voffA);
            PG8_WAIT_V(8); PG8_WAIT_L(0); PG8_BAR; PG8_MMA(0, 0, At, B0); PG8_MMA(0, 1, At, B1); PG8_BAR; PG8_SCHED;
            PG8_LDA(At, 0, 1); PG8_STAGE(PG8_SB(0, 0), b2, voffB); PG8_STAGE(PG8_SB(0, 1), b2 + hstep, voffB); PG8_STAGE(PG8_SA(0, 0), a2, voffA);
            PG8_WAIT_V(8); PG8_WAIT_L(0); PG8_BAR; PG8_MMA(1, 0, At, B0); PG8_MMA(1, 1, At, B1); PG8_BAR; PG8_SCHED;
            PG8_LDB(B0, 1, 0); PG8_LDB(B1, 1, 1); PG8_SCHED; PG8_LDA(At, 1, 0); PG8_STAGE(PG8_SA(0, 1), a2 + hstep, voffA);
            PG8_WAIT_V(8); PG8_WAIT_L(0); PG8_BAR; PG8_MMA(0, 0, At, B0); PG8_MMA(0, 1, At, B1); PG8_BAR; PG8_SCHED;
            PG8_LDA(At, 1, 1); PG8_STAGE(PG8_SB(1, 0), b3, voffB); PG8_STAGE(PG8_SB(1, 1), b3 + hstep, voffB); PG8_STAGE(PG8_SA(1, 0), a3, voffA);
            PG8_WAIT_V(8); PG8_WAIT_L(0); PG8_BAR; PG8_MMA(1, 0, At, B0); PG8_MMA(1, 1, At, B1); PG8_BAR; PG8_SCHED;
            } else {
            PG8_LDB(B0, 0, 0); PG8_SCHED; PG8_LDA(At, 0, 0); PG8_STAGE(PG8_SA(1, 1), a1 + hstep, voffA);
            PG8_WAIT_L(8); PG8_BAR; PG8_WAIT_L(0); PG8_MMA(0, 0, At, B0); PG8_BAR; PG8_SCHED;
            PG8_LDB(B1, 0, 1); PG8_STAGE(PG8_SB(0, 0), b2, voffB);
            PG8_BAR; PG8_WAIT_L(0); PG8_MMA(0, 1, At, B1); PG8_BAR;
            PG8_LDA(At, 0, 1); PG8_STAGE(PG8_SA(0, 0), a2, voffA);
            PG8_BAR; PG8_WAIT_L(0); PG8_MMA(1, 0, At, B0); PG8_BAR; PG8_SCHED;
            PG8_STAGE(PG8_SB(0, 1), b2 + hstep, voffB);
            PG8_WAIT_V(6); PG8_BAR; PG8_MMA(1, 1, At, B1); PG8_BAR;
            PG8_LDB(B0, 1, 0); PG8_SCHED; PG8_LDA(At, 1, 0); PG8_STAGE(PG8_SA(0, 1), a2 + hstep, voffA);
            PG8_WAIT_L(8); PG8_BAR; PG8_WAIT_L(0); PG8_MMA(0, 0, At, B0); PG8_BAR; PG8_SCHED;
            PG8_LDB(B1, 1, 1); PG8_STAGE(PG8_SB(1, 0), b3, voffB);
            PG8_BAR; PG8_WAIT_L(0); PG8_MMA(0, 1, At, B1); PG8_BAR;
            PG8_LDA(At, 1, 1); PG8_STAGE(PG8_SA(1, 0), a3, voffA);
            PG8_BAR; PG8_WAIT_L(0); PG8_MMA(1, 0, At, B0); PG8_BAR; PG8_SCHED;
            PG8_STAGE(PG8_SB(1, 1), b3 + hstep, voffB);
            PG8_WAIT_V(6); PG8_BAR; PG8_MMA(1, 1, At, B1); PG8_BAR;
            }
        }
        if constexpr (ALIGN_EPI) { if (wr == 0) PG8_BAR; }
        if constexpr (FP8 == 1) asm volatile("s_nop 15\n\ts_nop 15\n\ts_nop 15\n\ts_nop 15\n\ts_nop 15" ::: "memory");
        if constexpr (!Epi::AFTER_DRAIN) { E(acc, cur, wr, wc, fr, fq); S.done(cur); }
        if (!has_next) break;
#pragma unroll
        for (int a = 0; a < 2; ++a)
#pragma unroll
            for (int b = 0; b < 2; ++b)
#pragma unroll
                for (int m = 0; m < 4; ++m)
#pragma unroll
                    for (int n = 0; n < 2; ++n) acc[a][b][m][n] = (f32x4){0.f, 0.f, 0.f, 0.f};
        cur = nxt; cA = nA; cB = nB; ++ui;
        if constexpr (ALIGN_EPI) { if (wr == 1) PG8_BAR; }
    }
    PG8_WAIT_V(0);
    if constexpr (!ALIGN_EPI) { if (wr == 0) PG8_BAR; }
    PG8_BAR;
#undef PG8_SA
#undef PG8_SB
#undef PG8_STAGE
#undef PG8_LDA
#undef PG8_LD8
#undef PG8_LDB
#undef PG8_MMA
#undef PG8_CAT
#undef PG8_WAIT_V
#undef PG8_WAIT_L
#undef PG8_BAR
#undef PG8_SCHED
}
}

#define XB_TMO      128
#define XB_XCNT(j)  (256  + 64 * (j))
#define XB_XSUB(j)  (1280 + 64 * (j))
#define XB_XGEN(j)  (2304 + 64 * (j))
#define XB_TOP      3328
#define XB_TOPGEN   3392
#define XCD_BAR_WORDS 3456
#define XB_SPIN_CAP (1u << 22)
__device__ __forceinline__ unsigned xb_ld(unsigned* p)              { return __hip_atomic_load(p, __ATOMIC_RELAXED, __HIP_MEMORY_SCOPE_AGENT); }
__device__ __forceinline__ unsigned xb_add(unsigned* p, unsigned v) { return __hip_atomic_fetch_add(p, v, __ATOMIC_RELAXED, __HIP_MEMORY_SCOPE_AGENT); }
__device__ __forceinline__ unsigned xb_xcc_id() { return (unsigned)__builtin_amdgcn_s_getreg((3 << 11) | 20) & 0xFu; }
#define XB_SPIN(cond, bar) do { unsigned _sp = 0; while (cond) { __builtin_amdgcn_s_sleep(1); \
    if ((++_sp & 255u) == 0u) { if (xb_ld(&(bar)[XB_TMO])) break; if (_sp > XB_SPIN_CAP) { atomicAdd(&(bar)[XB_TMO], 1u); break; } } } } while (0)
struct XcdBarrier { unsigned* bar; unsigned x; volatile LAS unsigned* st; };
__device__ __forceinline__ XcdBarrier xcd_barrier_post(unsigned* bar, volatile LAS unsigned* st) {
    XcdBarrier b; b.bar = bar; b.x = xb_xcc_id(); b.st = st;
    if (threadIdx.x == 0) (void)xb_add(&bar[XB_XCNT(b.x)], 1u);
    return b;
}
__device__ __forceinline__ void xcd_barrier_complete(unsigned* bar, unsigned x, unsigned& nloc, unsigned& nx) {
    const unsigned G = gridDim.x * gridDim.y * gridDim.z;
    unsigned sum, cnt, mine, sp = 0u;
    for (;;) {
        sum = 0u; cnt = 0u; mine = 0u;
#pragma unroll
        for (unsigned j = 0; j < 16; ++j) { const unsigned c = xb_ld(&bar[XB_XCNT(j)]); sum += c; cnt += (c > 0u) ? 1u : 0u; mine = (j == x) ? c : mine; }
        if (sum == G) break;
        __builtin_amdgcn_s_sleep(1);
        if ((++sp & 255u) == 0u) { if (xb_ld(&bar[XB_TMO])) break; if (sp > XB_SPIN_CAP) { atomicAdd(&bar[XB_TMO], 1u); break; } }
    }
    nloc = mine > 0u ? mine : 1u; nx = cnt > 0u ? cnt : 1u;
}
__device__ __forceinline__ void xcd_barrier(const XcdBarrier& b) {
    asm volatile("s_waitcnt vmcnt(0)" ::: "memory");
    __syncthreads();
    if (threadIdx.x == 0) {
        unsigned* bar = b.bar;
        __builtin_amdgcn_s_waitcnt(0);
        unsigned nloc = b.st[0], nx = b.st[1];
        if (nloc == 0u) { xcd_barrier_complete(bar, b.x, nloc, nx); b.st[0] = nloc; b.st[1] = nx; }
        const unsigned old = xb_add(&bar[XB_XSUB(b.x)], 1u);
        const unsigned gen = old / nloc;
        if (old + 1u == (gen + 1u) * nloc) {
            __builtin_amdgcn_fence(__ATOMIC_RELEASE, "agent");
            asm volatile("s_waitcnt vmcnt(0)" ::: "memory");
            const unsigned og = xb_add(&bar[XB_TOP], 1u);
            const unsigned tg = og / nx;
            if (og + 1u == (tg + 1u) * nx) xb_add(&bar[XB_TOPGEN], 1u);
            else XB_SPIN(xb_ld(&bar[XB_TOPGEN]) == tg, bar);
            __builtin_amdgcn_fence(__ATOMIC_ACQUIRE, "agent");
            xb_add(&bar[XB_XGEN(b.x)], 1u);
            asm volatile("s_waitcnt vmcnt(0)" ::: "memory");
        } else {
            XB_SPIN(xb_ld(&bar[XB_XGEN(b.x)]) == gen, bar);
            __builtin_amdgcn_fence(__ATOMIC_ACQUIRE, "agent");
            asm volatile("s_waitcnt vmcnt(0)" ::: "memory");
        }
    }
    __syncthreads();
}

struct Frame {
    LAS unsigned char* lds;
    int tid, lane, wave, G, bx;
};
__device__ __forceinline__ Frame phase_frame(const Frame& F) { Frame R = F; int t = threadIdx.x; asm volatile("" : "+v"(t)); R.tid = t; R.lane = t & 63; R.wave = __builtin_amdgcn_readfirstlane(t >> 6); return R; }

struct TrDesc { const float* W; unsigned char* WT; const float* kgain; float nscale; int K, N, drow0, k0, n0, f8; };
__device__ __forceinline__ void tr_load(const TrDesc& d, float (&tv)[32], int lane) {
    const float* wp = d.W + (size_t)(d.k0 + (lane >> 5)) * d.N + d.n0 + (lane & 31);
#pragma unroll
    for (int i = 0; i < 32; ++i) tv[i] = wp[(size_t)(2 * i) * d.N];
}
__device__ __forceinline__ void tr_finish(const TrDesc& d, const float (&tv)[32], LAS float* scr, int lane) {
#pragma unroll
    for (int i = 0; i < 32; ++i) { float v = tv[i] * d.nscale; if (d.kgain) v *= d.kgain[d.k0 + 2 * i + (lane >> 5)]; scr[(2 * i + (lane >> 5)) * 33 + (lane & 31)] = v; }
    LDS_WAIT(); asm volatile("" ::: "memory");
    const int c = lane & 7;
#pragma unroll
    for (int j = 0; j < 4; ++j) { const int n = (lane >> 3) + 8 * j; const LAS float* s = scr + (8 * c) * 33 + n;
        if (d.f8) { u32x2 o; o.x = pk4_fp8(s[0 * 33], s[1 * 33], s[2 * 33], s[3 * 33]); o.y = pk4_fp8(s[4 * 33], s[5 * 33], s[6 * 33], s[7 * 33]);
            *(u32x2*)(d.WT + (size_t)(d.drow0 + n) * d.K + d.k0 + 8 * c) = o; }
        else { u32x4 o; o.x = pk2(s[0 * 33], s[1 * 33]); o.y = pk2(s[2 * 33], s[3 * 33]); o.z = pk2(s[4 * 33], s[5 * 33]); o.w = pk2(s[6 * 33], s[7 * 33]);
            *(u32x4*)(d.WT + ((size_t)(d.drow0 + n) * d.K + d.k0 + 8 * c) * 2) = o; } }
    LDS_WAIT(); asm volatile("" ::: "memory");
}
__device__ __forceinline__ int gu_row(int n0, int Fh) { return n0 < Fh ? ((n0 >> 7) * 256 + (n0 & 127)) : (((n0 - Fh) >> 7) * 256 + 128 + ((n0 - Fh) & 127)); }

struct Ptrs {
    const float *x, *mem, *anpre, *anpost, *fnpre, *fnpost, *w_in_a, *hlb, *hon, *w_in_b, *kvn, *w_kv, *memn, *w_mem_kv, *w_out, *w_gu, *w_dn, *w_router, *w_egu, *w_edn;
    float* out; unsigned char* ws;
};

__device__ __forceinline__ float row_rstd(const f32x4 (&a)[4]);
__device__ __forceinline__ void rms_row_to_bf16(const float* xrow, bf16_t* orow, const float* gain, int lane) {
    const f32x4* xr = (const f32x4*)xrow + lane;
    f32x4 v[4]; float s = 0.f;
#pragma unroll
    for (int j = 0; j < 4; ++j) { v[j] = xr[64 * j]; s += (v[j].x * v[j].x + v[j].y * v[j].y) + (v[j].z * v[j].z + v[j].w * v[j].w); }
    const float rstd = frsq(wave_sum(s) * (1.f / DM) + RMS_EPS);
    u32x2* o8 = (u32x2*)orow + lane;
#pragma unroll
    for (int j = 0; j < 4; ++j) { f32x4 gg = gain ? ((const f32x4*)gain)[lane + 64 * j] : (f32x4){1.f, 1.f, 1.f, 1.f};
        u32x2 w; w.x = pk2(v[j].x * rstd * gg.x, v[j].y * rstd * gg.y); w.y = pk2(v[j].z * rstd * gg.z, v[j].w * rstd * gg.w); o8[64 * j] = w; }
}

struct TrCounts {
    static constexpr int I_INA = (DM / 64) * (AW / 32), I_MKV = (DM / 64) * (512 / 32), I_OUT = (DM / 64) * (DM / 32), I_GU = (DM / 64) * (2 * DFF / 32), I_DN = (DFF / 64) * (DM / 32),
                         I_KV = (DM / 64) * (1536 / 32), I_INB = (DM / 64) * (DM / 32), I_EGU = (DM / 64) * (2 * DFE / 32), I_EDN = (DFE / 64) * (DM / 32);
    static constexpr int NEARLY = I_INA + 2 * I_MKV + 2 * I_OUT + I_GU + I_DN + I_KV + I_INB;
    static constexpr int NITEMS = NEARLY + NEXP * I_EGU + NEXP * I_EDN;
};
__device__ __forceinline__ TrDesc tr_decode(const Ptrs& P, int it) {
    using T = TrCounts; unsigned char* ws = P.ws; TrDesc d; d.kgain = nullptr; d.nscale = 1.f; d.f8 = 0;
    int r = it - (T::I_INA + 2 * T::I_MKV);
    if (r < 2 * T::I_OUT) { const int l = r / T::I_OUT; r -= l * T::I_OUT; const int nb = DM / 32; d.k0 = 64 * (r / nb); d.n0 = 32 * (r % nb);
        d.W = P.w_out + (size_t)l * DM * DM; d.K = DM; d.N = DM; d.WT = ws + (l ? WS_WOUT1 : WS_WOUT0); d.drow0 = d.n0; return d; } r -= 2 * T::I_OUT + T::I_GU;
    if (r < T::I_DN) { const int nb = DM / 32; d.k0 = 64 * (r / nb); d.n0 = 32 * (r % nb); d.W = P.w_dn; d.K = DFF; d.N = DM; d.WT = ws + WS_WDN; d.drow0 = d.n0; d.f8 = 1; d.nscale = FP8_SWDD; return d; } r -= T::I_DN + T::I_KV + T::I_INB;
    d.f8 = 1;
    if (r < NEXP * T::I_EGU) { const int e = r / T::I_EGU; r -= e * T::I_EGU; const int nb = 2 * DFE / 32; d.k0 = 64 * (r / nb); d.n0 = 32 * (r % nb);
        d.W = P.w_egu + (size_t)e * DM * 2 * DFE; d.K = DM; d.N = 2 * DFE; d.WT = ws + WS_WEGU + (size_t)e * 2 * DFE * DM; d.drow0 = gu_row(d.n0, DFE); d.nscale = FP8_SWGU; return d; } r -= NEXP * T::I_EGU;
    { const int e = r / T::I_EDN; r -= e * T::I_EDN; const int nb = DM / 32; d.k0 = 64 * (r / nb); d.n0 = 32 * (r % nb);
        d.W = P.w_edn + (size_t)e * DFE * DM; d.K = DFE; d.N = DM; d.WT = ws + WS_WEDN + (size_t)e * DM * DFE; d.drow0 = d.n0; d.nscale = FP8_SWDN; return d; }
}
__device__ __forceinline__ void convert_weights(const Frame& F, const Ptrs& P, int gw, int NGW) {
    LAS float* scr = (LAS float*)(F.lds + F.wave * 16384);
    const int it_lo = TrCounts::NEARLY, it_hi = TrCounts::NITEMS;
    for (int it = it_lo + gw; it < it_hi; it += 2 * NGW) {
        const bool two = it + NGW < it_hi;
        const TrDesc a = tr_decode(P, it), b = tr_decode(P, two ? it + NGW : it);
        float ta[32], tb[32];
        tr_load(a, ta, F.lane); if (two) tr_load(b, tb, F.lane);
        tr_finish(a, ta, scr, F.lane); if (two) tr_finish(b, tb, scr, F.lane);
    }
}
struct Q8Desc { const float* W; unsigned char* WT; const float* kgain; float nscale; int N, n0, drow0; float* wsc; };
constexpr int Q8_INA = AW / 32, Q8_MKV = 512 / 32, Q8_GU = 2 * DFF / 32, Q8_KV = 1536 / 32, Q8_INB = DM / 32, Q8_ITEMS = Q8_INA + 2 * Q8_MKV + Q8_GU + Q8_KV + Q8_INB;
__device__ __forceinline__ Q8Desc q8_decode(const Ptrs& P, int r) {
    unsigned char* ws = P.ws; float* const WSCp = (float*)(ws + WS_WSC); Q8Desc d; d.kgain = nullptr; d.nscale = 1.f;
    if (r < Q8_INA) { d.n0 = 32 * r; d.W = P.w_in_a; d.N = AW; d.WT = ws + WS_WINA; d.drow0 = d.n0; d.nscale = d.n0 >= 3072 ? C2 : 1.f; d.wsc = WSCp + WSC_INA; return d; } r -= Q8_INA;
    if (r < 2 * Q8_MKV) { const int l = r / Q8_MKV; r -= l * Q8_MKV; d.n0 = 32 * r; d.W = P.w_mem_kv + (size_t)l * DM * 512; d.N = 512; d.WT = ws + WS_WINA; d.drow0 = AW + l * 512 + d.n0; d.kgain = P.memn + l * DM; d.wsc = WSCp + WSC_INA; return d; } r -= 2 * Q8_MKV;
    if (r < Q8_GU) { d.n0 = 32 * r; d.W = P.w_gu; d.N = 2 * DFF; d.WT = ws + WS_WGU; d.drow0 = gu_row(d.n0, DFF); d.wsc = WSCp + WSC_GU; return d; } r -= Q8_GU;
    if (r < Q8_KV) { d.n0 = 32 * r; d.W = P.w_kv; d.N = 1536; d.WT = ws + WS_WKVB; d.drow0 = d.n0; d.kgain = P.kvn; d.wsc = WSCp + WSC_KVB; return d; } r -= Q8_KV;
    { d.n0 = 32 * r; d.W = P.w_in_b; d.N = DM; d.WT = ws + WS_WKVB; d.drow0 = 1536 + d.n0; d.kgain = P.anpre + DM; d.nscale = C2; d.wsc = WSCp + WSC_KVB; return d; }
}
__device__ __forceinline__ void q8_finish(const Q8Desc& q, const float (&tv)[32], int kbase, LAS float* scr, const LAS float* cfin, int lane) {
#pragma unroll
    for (int i = 0; i < 32; ++i) scr[(2 * i + (lane >> 5)) * 33 + (lane & 31)] = tv[i];
    LDS_WAIT(); asm volatile("" ::: "memory");
    const int c = lane & 7;
#pragma unroll
    for (int j = 0; j < 4; ++j) { const int n = (lane >> 3) + 8 * j; const LAS float* s = scr + (8 * c) * 33 + n; const float inv = 127.0f / cfin[n];
        u32x2 o; o.x = pk4_i8(s[0 * 33] * inv, s[1 * 33] * inv, s[2 * 33] * inv, s[3 * 33] * inv); o.y = pk4_i8(s[4 * 33] * inv, s[5 * 33] * inv, s[6 * 33] * inv, s[7 * 33] * inv);
        *(u32x2*)(q.WT + (size_t)(q.drow0 + n) * DM + kbase + 8 * c) = o; }
    LDS_WAIT(); asm volatile("" ::: "memory");
}
__device__ __forceinline__ void q8_item(const Frame& F, const Q8Desc& q, int parity) {
    const int lane = F.lane, kp = lane >> 5, nl = lane & 31, k0 = F.wave * 128;
    LAS float* scr = (LAS float*)(F.lds + F.wave * 16384);
    const float* wp = q.W + (size_t)(k0 + kp) * q.N + q.n0 + nl;
    float ga[32], gb[32];
    if (q.kgain) {
#pragma unroll
        for (int i = 0; i < 32; ++i) { ga[i] = q.kgain[k0 + 2 * i + kp]; gb[i] = q.kgain[k0 + 64 + 2 * i + kp]; }
    } else {
#pragma unroll
        for (int i = 0; i < 32; ++i) { ga[i] = 1.f; gb[i] = 1.f; }
    }
    float ta[32], tb[32];
#pragma unroll
    for (int i = 0; i < 32; ++i) ta[i] = wp[(size_t)(2 * i) * q.N];
#pragma unroll
    for (int i = 0; i < 32; ++i) tb[i] = wp[(size_t)(64 + 2 * i) * q.N];
    float m = 0.f;
#pragma unroll
    for (int i = 0; i < 32; ++i) { const float v = ta[i] * q.nscale * ga[i]; ta[i] = v; m = fmaxf(m, __builtin_fabsf(v)); }
#pragma unroll
    for (int i = 0; i < 32; ++i) { const float v = tb[i] * q.nscale * gb[i]; tb[i] = v; m = fmaxf(m, __builtin_fabsf(v)); }
    ((LAS float*)(F.lds + F.wave * 16384 + 12288 + parity * 256))[lane] = m;
    __syncthreads();
    float cm = 1e-30f;
#pragma unroll
    for (int w = 0; w < NWAVES; ++w) { const LAS float* cp = (const LAS float*)(F.lds + w * 16384 + 12288 + parity * 256); cm = fmaxf(cm, fmaxf(cp[nl], cp[nl + 32])); }
    LAS float* cfin = (LAS float*)(F.lds + F.wave * 16384 + 12288 + 512);
    if (lane < 32) cfin[lane] = cm;
    if (F.wave == 0 && lane < 32) q.wsc[q.drow0 + lane] = cm * (1.0f / 127.0f);
    q8_finish(q, ta, k0, scr, cfin, lane);
    q8_finish(q, tb, k0 + 64, scr, cfin, lane);
}
__device__ __forceinline__ void p0_rows4_load(const float* src, int m0, int lane, f32x4 (&v)[4][4]) {
#pragma unroll
    for (int r = 0; r < 4; ++r)
#pragma unroll
        for (int j = 0; j < 4; ++j) v[r][j] = ((const f32x4*)(src + (size_t)(m0 + r) * DM))[lane + 64 * j];
}
template <bool GAIN>
__device__ __forceinline__ void p0_rows4_finish(const f32x4 (&v)[4][4], const f32x4 (&gx)[4], unsigned char* dst, float* as, int m0, int lane) {
#pragma unroll
    for (int r = 0; r < 4; ++r) {
        const float rstd = row_rstd(v[r]);
        f32x4 uu[4];
#pragma unroll
        for (int j = 0; j < 4; ++j) { uu[j] = v[r][j] * rstd; if constexpr (GAIN) uu[j] = uu[j] * gx[j]; }
        quant_row_i8(uu, dst + (size_t)(m0 + r) * DM, as + m0 + r, lane);
    }
}
constexpr int P0_NB16 = 2 * TrCounts::I_OUT + TrCounts::I_DN, P0_G16 = P0_NB16 / 16, P0_XCH = MTOK / 32, P0_MCH = MROWS / 32, P0_WITEMS = Q8_ITEMS + P0_G16, P0_ITEMS = P0_WITEMS + P0_XCH + P0_MCH;
static_assert(P0_NB16 % 16 == 0, "bf16 wave items in groups of 16");
__device__ __forceinline__ void p0_prologue(const Frame& F, const Ptrs& P) {
    unsigned char* ws = P.ws;
    float* const ASA = (float*)(ws + WS_AS);
    int parity = 0, L = F.bx;
    for (; L < P0_WITEMS; L += F.G) {
        if (L < Q8_ITEMS) { const Q8Desc q = q8_decode(P, L); q8_item(F, q, parity); parity ^= 1; continue; }
        const int r = L - Q8_ITEMS;
        LAS float* scr = (LAS float*)(F.lds + F.wave * 16384);
        const int ia = r * 16 + F.wave, ib = ia + 8;
        const int base = TrCounts::I_INA + 2 * TrCounts::I_MKV;
        const TrDesc a = tr_decode(P, base + (ia < 2 * TrCounts::I_OUT ? ia : ia + TrCounts::I_GU)), b = tr_decode(P, base + (ib < 2 * TrCounts::I_OUT ? ib : ib + TrCounts::I_GU));
        float ta[32], tb[32];
        tr_load(a, ta, F.lane); tr_load(b, tb, F.lane);
        tr_finish(a, ta, scr, F.lane); tr_finish(b, tb, scr, F.lane);
    }
    f32x4 v[4][4], vn[4][4];
#define P0_LOAD(dst, LL) do { const int c_ = (LL) - P0_WITEMS; const bool isx_ = c_ < P0_XCH; p0_rows4_load(isx_ ? P.x : P.mem, 32 * (isx_ ? c_ : c_ - P0_XCH) + 4 * F.wave, F.lane, dst); } while (0)
#define P0_FIN(src, LL) do { const int c_ = (LL) - P0_WITEMS; const bool isx_ = c_ < P0_XCH; const int m0_ = 32 * (isx_ ? c_ : c_ - P0_XCH) + 4 * F.wave; \
        if (isx_) p0_rows4_finish<true>(src, gx, ws + WS_U, ASA, m0_, F.lane); else p0_rows4_finish<false>(src, gx, ws + WS_MEMN, ASA + MTOK, m0_, F.lane); } while (0)
    if (L < P0_ITEMS) {
        f32x4 gx[4];
#pragma unroll
        for (int j = 0; j < 4; ++j) gx[j] = ((const f32x4*)P.anpre)[F.lane + 64 * j];
        P0_LOAD(v, L);
        for (;;) {
            const int L1 = L + F.G; if (L1 < P0_ITEMS) P0_LOAD(vn, L1);
            P0_FIN(v, L);
            if (L1 >= P0_ITEMS) break;
            const int L2 = L1 + F.G; if (L2 < P0_ITEMS) P0_LOAD(v, L2);
            P0_FIN(vn, L1);
            if (L2 >= P0_ITEMS) break;
            L = L2;
        }
    }
#undef P0_LOAD
#undef P0_FIN
}

__device__ __forceinline__ void load_bf16_row(const bf16_t* arow, int lane, f32x4 (&a)[4]) {
    const u32x2* ar = (const u32x2*)arow + lane;
#pragma unroll
    for (int j = 0; j < 4; ++j) { const u32x2 w = ar[64 * j]; a[j] = (f32x4){bflo(w.x), bfhi(w.x), bflo(w.y), bfhi(w.y)}; }
}
__device__ __forceinline__ float row_rstd(const f32x4 (&a)[4]) {
    float s = 0.f;
#pragma unroll
    for (int j = 0; j < 4; ++j) s += (a[j].x * a[j].x + a[j].y * a[j].y) + (a[j].z * a[j].z + a[j].w * a[j].w);
    return frsq(wave_sum(s) * (1.f / DM) + RMS_EPS);
}
template <bool BASE16, bool Q8OUT>
__device__ __forceinline__ void norm_phase(const Frame& F, const bf16_t* A, const void* base, bf16_t* H, const float* g1, bf16_t* U, const float* g2, float* as_out) {
    f32x4 g1v[4], g2v[4];
#pragma unroll
    for (int j = 0; j < 4; ++j) { g1v[j] = ((const f32x4*)g1)[F.lane + 64 * j]; g2v[j] = g2 ? ((const f32x4*)g2)[F.lane + 64 * j] : (f32x4){1.f, 1.f, 1.f, 1.f}; }
    for (int i0 = 0; i0 < 16; i0 += 4) {
        const int m0 = F.bx * 128 + F.wave * 16 + i0;
        u32x2 ar[4][4]; f32x4 bs[4][4]; u32x2 bh[4][4];
#pragma unroll
        for (int r = 0; r < 4; ++r)
#pragma unroll
            for (int j = 0; j < 4; ++j) { ar[r][j] = ((const u32x2*)(A + (size_t)(m0 + r) * DM))[F.lane + 64 * j];
                if constexpr (BASE16) bh[r][j] = ((const u32x2*)((const bf16_t*)base + (size_t)(m0 + r) * DM))[F.lane + 64 * j];
                else bs[r][j] = ((const f32x4*)((const float*)base + (size_t)(m0 + r) * DM))[F.lane + 64 * j]; }
#pragma unroll
        for (int r = 0; r < 4; ++r) {
            const int m = m0 + r;
            f32x4 a[4];
#pragma unroll
            for (int j = 0; j < 4; ++j) a[j] = (f32x4){bflo(ar[r][j].x), bfhi(ar[r][j].x), bflo(ar[r][j].y), bfhi(ar[r][j].y)};
            const float rs = row_rstd(a);
            f32x4 h[4];
            u32x2* h8 = (u32x2*)(H + (size_t)m * DM) + F.lane;
#pragma unroll
            for (int j = 0; j < 4; ++j) { const f32x4 gg = g1v[j];
                f32x4 b; if constexpr (BASE16) b = (f32x4){bflo(bh[r][j].x), bfhi(bh[r][j].x), bflo(bh[r][j].y), bfhi(bh[r][j].y)}; else b = bs[r][j];
                h[j] = b + a[j] * rs * gg; u32x2 w; w.x = pk2(h[j].x, h[j].y); w.y = pk2(h[j].z, h[j].w); h8[64 * j] = w; }
            const float rh = row_rstd(h);
            if constexpr (Q8OUT) {
                f32x4 uu[4];
#pragma unroll
                for (int j = 0; j < 4; ++j) uu[j] = h[j] * rh * g2v[j];
                quant_row_i8(uu, (unsigned char*)U + (size_t)m * DM, as_out + m, F.lane);
            } else {
                u32x2* o8 = (u32x2*)(U + (size_t)m * DM) + F.lane;
#pragma unroll
                for (int j = 0; j < 4; ++j) { const f32x4 gg = g2v[j];
                    u32x2 w; w.x = pk2(h[j].x * rh * gg.x, h[j].y * rh * gg.y); w.y = pk2(h[j].z * rh * gg.z, h[j].w * rh * gg.w); o8[64 * j] = w; }
            }
        }
    }
}

constexpr float HG_US = 4.f;
constexpr int HG_RAWQ = 0, HG_RAWF = 18432, HG_RAWV = 36864;
constexpr int HG_OT = 0;
constexpr int HG_SC = 33792;
constexpr int HG_QD = 55296, HG_KI = 72704;
constexpr int HG_KST = 90112, HG_VT = 108544;
constexpr int HG_DEC = 126976;
typedef short s16x4 __attribute__((ext_vector_type(4)));
__device__ __forceinline__ s16x4 lds_tr16(const LAS unsigned char* p) { return __builtin_bit_cast(s16x4, __builtin_amdgcn_ds_read_tr16_b64_v4i16((LAS s16x4*)p)); }
constexpr int PA_GH = 0, PA_GL = 17408, PA_KH = 34816, PA_QH = 52224, PA_V = 69632;
__device__ __forceinline__ bf16x8 pa_trfrag(const LAS unsigned char* p) {
    const s16x4 lo = lds_tr16(p), hi = lds_tr16(p + 4 * 272);
    return (bf16x8){lo[0], lo[1], lo[2], lo[3], hi[0], hi[1], hi[2], hi[3]};
}
__device__ __forceinline__ void hgrnA_phase(const Frame& F, const Ptrs& P) {
    const int tid = F.tid, lane = F.lane, w = F.wave;
    LAS unsigned char* L = F.lds;
    const int sc0 = tid >> 4, sch = tid & 15;
    const int fr = lane & 15, g = lane >> 4;
    bf16_t* const GQD = (bf16_t*)(P.ws + WS_HGQD); bf16_t* const GOI = (bf16_t*)(P.ws + WS_HGOI); unsigned char* const GU = P.ws + WS_HGU; float* const GDEC = (float*)(P.ws + WS_HGDEC);
    const int NU = NB * 6 * 64;
    bf16x8 tri0, tri16, ones;
#pragma unroll
    for (int j = 0; j < 8; ++j) { tri0[j] = (8 * g + j <= fr) ? (short)0x3F80 : (short)0; tri16[j] = (8 * g + j <= fr + 16) ? (short)0x3F80 : (short)0; ones[j] = (short)0x3F80; }
    const int trl = (8 * g + ((lane & 15) >> 2)) * 272 + (lane & 3) * 8;
    u32x4 rq[2], rf[2], rv[2];
    {
        const int unit = F.bx; const int bh = unit >> 6, n = unit & 63, b = bh / 6, h = bh % 6;
        const bf16_t* PR = (const bf16_t*)(P.ws + WS_R1) + (size_t)(b * SEQ + n * 64) * AW;
#pragma unroll
        for (int i = 0; i < 2; ++i) { const bf16_t* rp = PR + (size_t)(sc0 + 32 * i) * AW + sch * 8;
            rq[i] = *(const u32x4*)(rp + h * 128); rf[i] = *(const u32x4*)(rp + 768 + h * 128); rv[i] = *(const u32x4*)(rp + 1536 + h * 128); }
    }
    for (int unit = F.bx; unit < NU; unit += F.G) {
        const int bh = unit >> 6, h = bh % 6;
        {
            float lb[8];
            { const f32x4 a00 = *(const f32x4*)(P.hlb + h * 128 + 8 * sch), a01 = *(const f32x4*)(P.hlb + h * 128 + 8 * sch + 4), a10 = *(const f32x4*)(P.hlb + HF + h * 128 + 8 * sch), a11 = *(const f32x4*)(P.hlb + HF + h * 128 + 8 * sch + 4);
#pragma unroll
              for (int e = 0; e < 4; ++e) { lb[e] = frcp(1.0f + fexp2(1.4426950408889634f * (a10[e] - a00[e]))); lb[4 + e] = frcp(1.0f + fexp2(1.4426950408889634f * (a11[e] - a01[e]))); } }
#pragma unroll
            for (int i = 0; i < 2; ++i) {
                const unsigned fw[4] = {rf[i].x, rf[i].y, rf[i].z, rf[i].w}, qw[4] = {rq[i].x, rq[i].y, rq[i].z, rq[i].w};
                unsigned gh[4], gl[4], kh[4], qh[4];
#pragma unroll
                for (int e2 = 0; e2 < 4; ++e2) {
                    float gg[2], kk[2], qq[2];
#pragma unroll
                    for (int o = 0; o < 2; ++o) {
                        const float fl = o ? bfhi(fw[e2]) : bflo(fw[e2]), ql = o ? bfhi(qw[e2]) : bflo(qw[e2]);
                        const float sg = sigmoidf_(fl); const float lbk = lb[2 * e2 + o];
                        gg[o] = flog2(lbk + (1.0f - lbk) * sg); kk[o] = (1.0f - lbk) * (1.0f - sg); qq[o] = ql * sigmoidf_(ql);
                    }
                    gh[e2] = pk2(gg[0], gg[1]);
                    gl[e2] = pk2(gg[0] - bflo(gh[e2]), gg[1] - bfhi(gh[e2]));
                    kh[e2] = pk2(kk[0], kk[1]); qh[e2] = pk2(qq[0], qq[1]);
                }
                const int off = (sc0 + 32 * i) * 272 + sch * 16;
                *(LAS u32x4*)(L + PA_GH + off) = (u32x4){gh[0], gh[1], gh[2], gh[3]}; *(LAS u32x4*)(L + PA_GL + off) = (u32x4){gl[0], gl[1], gl[2], gl[3]};
                *(LAS u32x4*)(L + PA_KH + off) = (u32x4){kh[0], kh[1], kh[2], kh[3]}; *(LAS u32x4*)(L + PA_QH + off) = (u32x4){qh[0], qh[1], qh[2], qh[3]};
                *(LAS u32x4*)(L + PA_V + off) = rv[i];
            }
        }
        LDS_BARRIER();
        if (unit + F.G < NU) {
            const int u2 = unit + F.G; const int bh2 = u2 >> 6, n2 = u2 & 63, b2 = bh2 / 6, h2 = bh2 % 6;
            const bf16_t* PR = (const bf16_t*)(P.ws + WS_R1) + (size_t)(b2 * SEQ + n2 * 64) * AW;
#pragma unroll
            for (int i = 0; i < 2; ++i) { const bf16_t* rp = PR + (size_t)(sc0 + 32 * i) * AW + sch * 8;
                rq[i] = *(const u32x4*)(rp + h2 * 128); rf[i] = *(const u32x4*)(rp + 768 + h2 * 128); rv[i] = *(const u32x4*)(rp + 1536 + h2 * 128); }
        }
        f32x4 bc[4];
        {
            bf16x8 gfh[2], gfl[2];
#pragma unroll
            for (int ks = 0; ks < 2; ++ks) { gfh[ks] = pa_trfrag(L + PA_GH + (32 * ks) * 272 + (16 * w) * 2 + trl); gfl[ks] = pa_trfrag(L + PA_GL + (32 * ks) * 272 + (16 * w) * 2 + trl); }
#pragma unroll
            for (int ct = 0; ct < 4; ++ct) bc[ct] = (f32x4){0.f, 0.f, 0.f, 0.f};
            bc[0] = __builtin_amdgcn_mfma_f32_16x16x32_bf16(gfh[0], tri0, bc[0], 0, 0, 0);  bc[0] = __builtin_amdgcn_mfma_f32_16x16x32_bf16(gfl[0], tri0, bc[0], 0, 0, 0);
            bc[1] = __builtin_amdgcn_mfma_f32_16x16x32_bf16(gfh[0], tri16, bc[1], 0, 0, 0); bc[1] = __builtin_amdgcn_mfma_f32_16x16x32_bf16(gfl[0], tri16, bc[1], 0, 0, 0);
            bc[2] = __builtin_amdgcn_mfma_f32_16x16x32_bf16(gfh[0], ones, bc[2], 0, 0, 0);  bc[2] = __builtin_amdgcn_mfma_f32_16x16x32_bf16(gfl[0], ones, bc[2], 0, 0, 0);
            bc[2] = __builtin_amdgcn_mfma_f32_16x16x32_bf16(gfh[1], tri0, bc[2], 0, 0, 0);  bc[2] = __builtin_amdgcn_mfma_f32_16x16x32_bf16(gfl[1], tri0, bc[2], 0, 0, 0);
            bc[3] = __builtin_amdgcn_mfma_f32_16x16x32_bf16(gfh[0], ones, bc[3], 0, 0, 0);  bc[3] = __builtin_amdgcn_mfma_f32_16x16x32_bf16(gfl[0], ones, bc[3], 0, 0, 0);
            bc[3] = __builtin_amdgcn_mfma_f32_16x16x32_bf16(gfh[1], tri16, bc[3], 0, 0, 0); bc[3] = __builtin_amdgcn_mfma_f32_16x16x32_bf16(gfl[1], tri16, bc[3], 0, 0, 0);
        }
        {
            f32x4 dec;
#pragma unroll
            for (int r = 0; r < 4; ++r) dec[r] = fexp2(__shfl(bc[3][r], (lane & 48) | 15));
            if (fr == 0) *(f32x4*)(GDEC + (size_t)unit * 128 + 16 * w + 4 * g) = dec;
#pragma unroll
            for (int ct = 0; ct < 4; ++ct) {
                const int off = (16 * ct + fr) * 272 + (16 * w + 4 * g) * 2;
                const u32x2 qh = *(const LAS u32x2*)(L + PA_QH + off), kh = *(const LAS u32x2*)(L + PA_KH + off);
                const float qv[4] = {bflo(qh.x), bfhi(qh.x), bflo(qh.y), bfhi(qh.y)}, kv[4] = {bflo(kh.x), bfhi(kh.x), bflo(kh.y), bfhi(kh.y)};
                float qd[4], ki[4], ks[4];
#pragma unroll
                for (int r = 0; r < 4; ++r) { const float e1 = fexp2(bc[ct][r]), e2 = fexp2(-bc[ct][r]); qd[r] = qv[r] * e1; ki[r] = kv[r] * e2; ks[r] = ki[r] * dec[r]; }
                *(LAS u32x2*)(L + PA_QH + off) = (u32x2){pk2(qd[0], qd[1]), pk2(qd[2], qd[3])};
                *(LAS u32x2*)(L + PA_KH + off) = (u32x2){pk2(ki[0], ki[1]), pk2(ki[2], ki[3])};
                *(LAS u32x2*)(L + PA_GH + off) = (u32x2){pk2(ks[0], ks[1]), pk2(ks[2], ks[3])};
            }
        }
        LDS_BARRIER();
#pragma unroll
        for (int i = 0; i < 2; ++i) { const int c = sc0 + 32 * i; *(u32x4*)(GQD + ((size_t)unit * 64 + c) * 128 + sch * 8) = *(const LAS u32x4*)(L + PA_QH + c * 272 + sch * 16); }
        {
            const int ci = w >> 1;
#pragma unroll
            for (int q = 0; q < 2; ++q) { const int si = 2 * (w & 1) + q;
                if (si <= ci) {
                    f32x4 d = (f32x4){0.f, 0.f, 0.f, 0.f};
#pragma unroll
                    for (int ks = 0; ks < 4; ++ks) {
                        const bf16x8 a = *(const LAS bf16x8*)(L + PA_KH + (16 * si + fr) * 272 + ks * 64 + g * 16);
                        const bf16x8 bb = *(const LAS bf16x8*)(L + PA_QH + (16 * ci + fr) * 272 + ks * 64 + g * 16);
                        d = __builtin_amdgcn_mfma_f32_16x16x32_bf16(a, bb, d, 0, 0, 0);
                    }
                    const int c = 16 * ci + fr, s0 = 16 * si + 4 * g;
#pragma unroll
                    for (int r = 0; r < 4; ++r) if (s0 + r > c) d[r] = 0.f;
                    *(LAS u32x2*)(L + PA_GL + c * 144 + s0 * 2) = (u32x2){pk2(d[0], d[1]), pk2(d[2], d[3])};
                } else {
                    const int c = 16 * ci + fr, s0 = 16 * si + 4 * g;
                    *(LAS u32x2*)(L + PA_GL + c * 144 + s0 * 2) = (u32x2){0u, 0u};
                }
            }
        }
        LDS_BARRIER();
        {
            const int j0 = 16 * w;
            bf16x8 vfrag[2];
#pragma unroll
            for (int ks = 0; ks < 2; ++ks) vfrag[ks] = pa_trfrag(L + PA_V + (32 * ks) * 272 + j0 * 2 + trl);
#pragma unroll
            for (int ct = 0; ct < 4; ++ct) {
                f32x4 o = (f32x4){0.f, 0.f, 0.f, 0.f};
#pragma unroll
                for (int ks = 0; ks < 2; ++ks) if (32 * ks <= 16 * ct + 15) {
                    const bf16x8 sc = *(const LAS bf16x8*)(L + PA_GL + (16 * ct + fr) * 144 + ks * 64 + g * 16);
                    o = __builtin_amdgcn_mfma_f32_16x16x32_bf16(vfrag[ks], sc, o, 0, 0, 0);
                }
                *(u32x2*)(GOI + ((size_t)unit * 64 + 16 * ct + fr) * 128 + j0 + 4 * g) = (u32x2){pk2(o[0], o[1]), pk2(o[2], o[3])};
            }
            unsigned uw[8];
#pragma unroll
            for (int kt = 0; kt < 8; ++kt) {
                f32x4 acc = (f32x4){0.f, 0.f, 0.f, 0.f};
#pragma unroll
                for (int cs = 0; cs < 2; ++cs) {
                    const bf16x8 a = pa_trfrag(L + PA_GH + (32 * cs) * 272 + (16 * kt) * 2 + trl);
                    acc = __builtin_amdgcn_mfma_f32_16x16x32_bf16(a, vfrag[cs], acc, 0, 0, 0);
                }
                uw[kt] = pk4_fp8s(acc[0] * HG_US, acc[1] * HG_US, acc[2] * HG_US, acc[3] * HG_US);
            }
            u32x4* up = (u32x4*)(GU + (((size_t)unit * 8 + w) * 64 + lane) * 32);
#pragma unroll
            for (int q = 0; q < 2; ++q) up[q] = (u32x4){uw[4 * q], uw[4 * q + 1], uw[4 * q + 2], uw[4 * q + 3]};
        }
        LDS_BARRIER();
    }
}

constexpr int HC_QD = 0;
constexpr int HC_DEC = 26112;
constexpr int HC_OT = 27648;
constexpr int HC_NG = 44544;
struct HcSet { u32x4 qp; float dp; u32x4 ur[2], oi, og; };
struct HcCtx { __amdgpu_buffer_rsrc_t rQD, rOI, rU, rDEC, rPR; bf16_t* MIX; unsigned vQD, vOI, vU, vDEC, vPR; int bh, b, h, r0, sc0, sch, c5, sub, fr, g, j0, tid, lane, w; };
__device__ __forceinline__ void abl16(u32x4& d, unsigned voff, __amdgpu_buffer_rsrc_t r, unsigned soff) { asm volatile("buffer_load_dwordx4 %0, %1, %2, %3 offen" : "=v"(d) : "v"(voff), "s"(r), "s"(soff) : "memory"); }
__device__ __forceinline__ void abl4(float& d, unsigned voff, __amdgpu_buffer_rsrc_t r, unsigned soff) { asm volatile("buffer_load_dword %0, %1, %2, %3 offen" : "=v"(d) : "v"(voff), "s"(r), "s"(soff) : "memory"); }
__device__ __forceinline__ void hc_load(const HcCtx& C, HcSet& d, int n) {
    const unsigned unit = (unsigned)(C.bh * 64 + n);
    abl16(d.qp, C.vQD, C.rQD, unit * 16384u);
    if (C.w < 2) abl4(d.dp, C.vDEC, C.rDEC, unit * 512u);
    abl16(d.ur[0], C.vU, C.rU, unit * 16384u); abl16(d.ur[1], C.vU + 16u, C.rU, unit * 16384u);
    abl16(d.oi, C.vOI, C.rOI, unit * 16384u);
    { const unsigned so = (unsigned)((C.b * SEQ + n * 64) * AW * 2); abl16(d.og, C.vPR, C.rPR, so); }
}
#define HC_PIN(d) "+v"((d).qp), "+v"((d).dp), "+v"((d).ur[0]), "+v"((d).ur[1]), "+v"((d).oi), "+v"((d).og)
__device__ __forceinline__ void hc_stage(const HcCtx& C, LAS unsigned char* L, const HcSet& d, int slot) {
    *(LAS u32x4*)(L + HC_QD + slot * 8704 + C.sc0 * 272 + C.sch * 16) = d.qp;
    if (C.w < 2) *(LAS float*)(L + HC_DEC + slot * 512 + C.tid * 4) = d.dp;
}
__device__ __forceinline__ void hc_step(const HcCtx& C, LAS unsigned char* L, f32x4 (&S)[8], int n, HcSet& cur, HcSet& nxt, HcSet& nx2, int slot, int slot_nxt) {
    if (n >= 64) return;
    if (n + 2 < 64) { hc_load(C, nx2, n + 2); asm volatile("s_waitcnt vmcnt(12)" : HC_PIN(cur)); }
    else asm volatile("s_waitcnt vmcnt(0)" : HC_PIN(cur));
    const int fr = C.fr, g = C.g, j0 = C.j0;
    {
        f32x4 o[2];
#pragma unroll
        for (int ct = 0; ct < 2; ++ct) o[ct] = (f32x4){0.f, 0.f, 0.f, 0.f};
#pragma unroll
        for (int ks = 0; ks < 4; ++ks) {
            u32x4 sa; sa.x = pk2(S[2 * ks][0], S[2 * ks][1]); sa.y = pk2(S[2 * ks][2], S[2 * ks][3]); sa.z = pk2(S[2 * ks + 1][0], S[2 * ks + 1][1]); sa.w = pk2(S[2 * ks + 1][2], S[2 * ks + 1][3]);
            const bf16x8 sfrag = __builtin_bit_cast(bf16x8, sa);
#pragma unroll
            for (int ct = 0; ct < 2; ++ct) {
                const u32x2 q0 = *(const LAS u32x2*)(L + HC_QD + slot * 8704 + (16 * ct + fr) * 272 + (32 * ks + 4 * g) * 2);
                const u32x2 q1 = *(const LAS u32x2*)(L + HC_QD + slot * 8704 + (16 * ct + fr) * 272 + (32 * ks + 16 + 4 * g) * 2);
                const bf16x8 qf = __builtin_bit_cast(bf16x8, (u32x4){q0.x, q0.y, q1.x, q1.y});
                o[ct] = __builtin_amdgcn_mfma_f32_16x16x32_bf16(sfrag, qf, o[ct], 0, 0, 0);
            }
        }
#pragma unroll
        for (int ct = 0; ct < 2; ++ct) *(LAS f32x4*)(L + HC_OT + (16 * ct + fr) * 528 + (j0 + 4 * g) * 4) = o[ct];
#pragma unroll
        for (int kt = 0; kt < 8; ++kt) {
            const f32x4 dc = *(const LAS f32x4*)(L + HC_DEC + slot * 512 + (16 * kt + 4 * g) * 4);
            const unsigned uu = (kt & 3) == 0 ? cur.ur[kt >> 2].x : (kt & 3) == 1 ? cur.ur[kt >> 2].y : (kt & 3) == 2 ? cur.ur[kt >> 2].z : cur.ur[kt >> 2].w;
            const f32x2 ulo = __builtin_amdgcn_cvt_pk_f32_fp8((int)uu, false), uhi = __builtin_amdgcn_cvt_pk_f32_fp8((int)uu, true);
            S[kt] = S[kt] * dc + (f32x4){ulo.x, ulo.y, uhi.x, uhi.y} * (1.0f / HG_US);
        }
    }
    LDS_BARRIER();
    {
        f32x4 ov[2]; float ss = 0.f;
        const unsigned oiw[4] = {cur.oi.x, cur.oi.y, cur.oi.z, cur.oi.w};
#pragma unroll
        for (int j = 0; j < 2; ++j) { ov[j] = *(const LAS f32x4*)(L + HC_OT + C.c5 * 528 + (8 * C.sub + 4 * j) * 4);
            ov[j] = ov[j] + (f32x4){bflo(oiw[2 * j]), bfhi(oiw[2 * j]), bflo(oiw[2 * j + 1]), bfhi(oiw[2 * j + 1])};
            ss += (ov[j].x * ov[j].x + ov[j].y * ov[j].y) + (ov[j].z * ov[j].z + ov[j].w * ov[j].w); }
        ss += swz_xor<1>(ss); ss += swz_xor<2>(ss); ss += swz_xor<4>(ss); ss += swz_xor<8>(ss);
        const float rs = frsq(ss * (1.f / 128.f) + RMS_EPS);
        const unsigned ogw[4] = {cur.og.x, cur.og.y, cur.og.z, cur.og.w};
        float r[8]; f32x4 ngv[2];
#pragma unroll
        for (int j = 0; j < 2; ++j) ngv[j] = *(const LAS f32x4*)(L + HC_NG + (8 * C.sub + 4 * j) * 4);
#pragma unroll
        for (int j = 0; j < 2; ++j)
#pragma unroll
            for (int e = 0; e < 4; ++e) { const unsigned wv = ogw[2 * j + (e >> 1)]; const float gg = (e & 1) ? bfhi(wv) : bflo(wv); r[4 * j + e] = ov[j][e] * rs * ngv[j][e] * gg * sigmoidf_(gg); }
        bf16_t* op = C.MIX + (size_t)(n * 64 + C.r0 + C.c5) * DM + C.h * 128 + 8 * C.sub;
        *(u32x4*)op = (u32x4){pk2(r[0], r[1]), pk2(r[2], r[3]), pk2(r[4], r[5]), pk2(r[6], r[7])};
    }
    if (n + 1 < 64) {
        if (n + 2 < 64) asm volatile("s_waitcnt vmcnt(7)" : HC_PIN(nxt)); else asm volatile("s_waitcnt vmcnt(0)" : HC_PIN(nxt));
        hc_stage(C, L, nxt, slot_nxt);
    }
    LDS_BARRIER();
}
__device__ __forceinline__ void hgrn_chain(const Frame& F, const Ptrs& P, int wgi) {
    HcCtx C;
    const int bh = wgi >> 1; const int b = bh / 6; C.bh = bh; C.b = b; C.h = bh % 6; C.r0 = 32 * (wgi & 1);
    C.tid = F.tid; C.lane = F.lane; C.w = F.wave;
    LAS unsigned char* L = F.lds;
    C.MIX = (bf16_t*)(P.ws + WS_MIX) + (size_t)b * SEQ * DM;
    C.rQD = __builtin_amdgcn_make_buffer_rsrc(P.ws + WS_HGQD, 0, 3072 * 16384, 0x00020000);
    C.rOI = __builtin_amdgcn_make_buffer_rsrc(P.ws + WS_HGOI, 0, 3072 * 16384, 0x00020000);
    C.rU = __builtin_amdgcn_make_buffer_rsrc(P.ws + WS_HGU, 0, 3072 * 16384, 0x00020000);
    C.rDEC = __builtin_amdgcn_make_buffer_rsrc(P.ws + WS_HGDEC, 0, 3072 * 512, 0x00020000);
    C.rPR = __builtin_amdgcn_make_buffer_rsrc(P.ws + WS_R1, 0, MTOK * AW * 2, 0x00020000);
    C.sc0 = C.tid >> 4; C.sch = C.tid & 15; C.c5 = C.tid >> 4; C.sub = C.tid & 15;
    C.fr = C.lane & 15; C.g = C.lane >> 4; C.j0 = 16 * C.w;
    C.vQD = (unsigned)(((C.r0 + C.sc0) * 128 + C.sch * 8) * 2); C.vOI = (unsigned)(((C.r0 + C.c5) * 128 + 8 * C.sub) * 2); C.vU = (unsigned)((C.w * 64 + C.lane) * 32); C.vDEC = (unsigned)(C.tid * 4);
    C.vPR = (unsigned)(((C.r0 + C.c5) * AW + 2304 + C.h * 128 + 8 * C.sub) * 2);
    if (C.tid < 128) *(LAS float*)(L + HC_NG + C.tid * 4) = P.hon[C.tid];
    f32x4 S[8];
#pragma unroll
    for (int kt = 0; kt < 8; ++kt) S[kt] = (f32x4){0.f, 0.f, 0.f, 0.f};
    HcSet d0, d1, d2;
    d0.dp = d1.dp = d2.dp = 0.f;
    d0.qp = d1.qp = d2.qp = (u32x4){0u, 0u, 0u, 0u};
    VM_WAIT();
    hc_load(C, d0, 0); hc_load(C, d1, 1);
    asm volatile("s_waitcnt vmcnt(5)" : HC_PIN(d0));
    hc_stage(C, L, d0, 0);
    LDS_BARRIER();
    for (int n = 0; n < 66; n += 6) {
        hc_step(C, L, S, n, d0, d1, d2, 0, 1);
        hc_step(C, L, S, n + 1, d1, d2, d0, 1, 2);
        hc_step(C, L, S, n + 2, d2, d0, d1, 2, 0);
        hc_step(C, L, S, n + 3, d0, d1, d2, 0, 1);
        hc_step(C, L, S, n + 4, d1, d2, d0, 1, 2);
        hc_step(C, L, S, n + 5, d2, d0, d1, 2, 0);
        asm volatile("s_waitcnt vmcnt(0)" : HC_PIN(d0), HC_PIN(d1), HC_PIN(d2));
    }
    VM_WAIT();
}

constexpr int MA_K = 0;
constexpr int MA_VT = 36864;
__device__ __forceinline__ void memattn_unit(const Frame& F, const bf16_t* Q, int qpitch, int qcol, const bf16_t* MKV, int kvcol, bf16_t* MIXo, int unit) {
    const int tb = unit >> 2, mh = unit & 3, b = tb >> 4;
    const int tid = F.tid, lane = F.lane, w = F.wave, r32 = lane & 31, hi = lane >> 5;
    LAS unsigned char* L = F.lds;
#pragma unroll
    for (int i = 0; i < 4; ++i) { const int p = tid + 512 * i, key = p >> 3, chn = p & 7;
        const bf16_t* src = MKV + (size_t)(b * MEML + key) * DM + kvcol + mh * 64 + chn * 8;
        const u32x4 kk = *(const u32x4*)src; const u32x4 vv = *(const u32x4*)(src + 256);
        *(LAS u32x4*)(L + MA_K + key * 144 + chn * 16) = kk;
        const unsigned vw[4] = {vv.x, vv.y, vv.z, vv.w};
#pragma unroll
        for (int e = 0; e < 4; ++e) { *(LAS unsigned short*)(L + MA_VT + (chn * 8 + 2 * e) * 520 + key * 2) = (unsigned short)(vw[e] & 0xffffu);
            *(LAS unsigned short*)(L + MA_VT + (chn * 8 + 2 * e + 1) * 520 + key * 2) = (unsigned short)(vw[e] >> 16); } }
    const int tok0 = tb * 256 + w * 32;
    bf16x8 qr[4];
#pragma unroll
    for (int s = 0; s < 4; ++s) qr[s] = *(const bf16x8*)(Q + (size_t)(tok0 + r32) * qpitch + qcol + mh * 64 + 16 * s + 8 * hi);
    LDS_BARRIER();
    f32x16 p[8];
#pragma unroll
    for (int kt = 0; kt < 8; ++kt) { p[kt] = f32x16{};
#pragma unroll
        for (int s = 0; s < 4; ++s) { const bf16x8 a = *(const LAS bf16x8*)(L + MA_K + (32 * kt + r32) * 144 + s * 32 + hi * 16);
            p[kt] = __builtin_amdgcn_mfma_f32_32x32x16_bf16(a, qr[s], p[kt], 0, 0, 0); } }
    float mx = -3.0e38f;
#pragma unroll
    for (int kt = 0; kt < 8; ++kt)
#pragma unroll
        for (int r = 0; r < 16; ++r) mx = fmaxf(mx, p[kt][r]);
    mx = fmaxf(mx, __shfl_xor(mx, 32));
    float sum = 0.f;
#pragma unroll
    for (int kt = 0; kt < 8; ++kt)
#pragma unroll
        for (int r = 0; r < 16; ++r) { p[kt][r] = fexp2(p[kt][r] - mx); sum += p[kt][r]; }
    sum += __shfl_xor(sum, 32);
    const float inv = frcp(sum);
    f32x16 o[2]; o[0] = f32x16{}; o[1] = f32x16{};
#pragma unroll
    for (int kt = 0; kt < 8; ++kt)
#pragma unroll
        for (int s2 = 0; s2 < 2; ++s2) {
            u32x4 pw; pw.x = pk2(p[kt][8 * s2 + 0] * inv, p[kt][8 * s2 + 1] * inv); pw.y = pk2(p[kt][8 * s2 + 2] * inv, p[kt][8 * s2 + 3] * inv);
            pw.z = pk2(p[kt][8 * s2 + 4] * inv, p[kt][8 * s2 + 5] * inv); pw.w = pk2(p[kt][8 * s2 + 6] * inv, p[kt][8 * s2 + 7] * inv);
            const bf16x8 pa = __builtin_bit_cast(bf16x8, pw);
#pragma unroll
            for (int dt = 0; dt < 2; ++dt) {
                const u32x2 v0 = *(const LAS u32x2*)(L + MA_VT + (32 * dt + r32) * 520 + (32 * kt + 16 * s2 + 4 * hi) * 2);
                const u32x2 v1 = *(const LAS u32x2*)(L + MA_VT + (32 * dt + r32) * 520 + (32 * kt + 16 * s2 + 8 + 4 * hi) * 2);
                const bf16x8 vb = __builtin_bit_cast(bf16x8, (u32x4){v0.x, v0.y, v1.x, v1.y});
                o[dt] = __builtin_amdgcn_mfma_f32_32x32x16_bf16(pa, vb, o[dt], 0, 0, 0);
            }
        }
#pragma unroll
    for (int dt = 0; dt < 2; ++dt)
#pragma unroll
        for (int r = 0; r < 16; ++r) MIXo[(size_t)(tok0 + crow(r, hi)) * DM + 768 + mh * 64 + 32 * dt + r32] = (bf16_t)f2bf(o[dt][r]);
    LDS_BARRIER();
}

constexpr int SB_SLOT = 19456;
constexpr int SB_VOFF = 9216;
constexpr int SB_NSLOT = 6;
constexpr int SB_FLAG = SB_NSLOT * SB_SLOT;
__device__ __forceinline__ int sb_unit_of(int L) { return (L >> 4) * 16 + (15 - (L & 15)); }
__device__ __forceinline__ void sb_prefetch_q(const Frame& F, const bf16_t* KVQ, int unit, bf16x8 (&q)[4]) {
    const int qb = unit & 15, hh = (unit >> 4) % 12, b = unit / 192;
    const int r32 = F.lane & 31, hi = F.lane >> 5;
    const bf16_t* base = KVQ + (size_t)b * SEQ * KVQW;
    const int tq = qb * 256 + F.wave * 32 + r32;
#pragma unroll
    for (int s = 0; s < 4; ++s) q[s] = *(const bf16x8*)(base + (size_t)tq * KVQW + 1536 + hh * 64 + 16 * s + 8 * hi);
}
__device__ __forceinline__ int sb_unit(const Frame& F, const bf16_t* KVQ, bf16_t* MIXo, int unit, const bf16x8 (&qpre)[4], int have_lo, int have_hi) {
    const int qb = unit & 15, hh = (unit >> 4) % 12, b = unit / 192;
    const int tid = F.tid, lane = F.lane, w = F.wave, r32 = lane & 31, hi = lane >> 5;
    LAS unsigned char* L = F.lds;
    const bf16_t* base = KVQ + (size_t)b * SEQ * KVQW;
    const int q0 = qb * 256 + w * 32;
    const int tq = q0 + r32;
    bf16x8 qr[4];
#pragma unroll
    for (int s = 0; s < 4; ++s) qr[s] = qpre[s];
    bf16x8 tri[2], ones;
#pragma unroll
    for (int s2 = 0; s2 < 2; ++s2)
#pragma unroll
        for (int j = 0; j < 8; ++j) { const int k = 16 * s2 + 8 * (j >> 2) + 4 * hi + (j & 3); tri[s2][j] = (k > r32) ? (short)0x3F80 : (short)0; }
#pragma unroll
    for (int j = 0; j < 8; ++j) ones[j] = (short)0x3F80;
    f32x16 o[2]; o[0] = f32x16{}; o[1] = f32x16{};
    float R = 0.f;
    const int skey = tid >> 3, schn = tid & 7;
    const bf16_t* srcb = base + (size_t)skey * KVQW + hh * 64 + schn * 8;
    const int kwr = skey * 144 + schn * 16, vwr = SB_VOFF + skey * 160 + schn * 16;
    const int vlane = SB_VOFF + (4 * hi + ((lane & 15) >> 2)) * 160 + ((lane >> 4) & 1) * 32 + (lane & 3) * 8;
    {
        u32x4 kk[4], vv[4];
#pragma unroll
        for (int i = 0; i < 4; ++i) { const int tt = 4 * qb + i; if (tt < have_lo || tt > have_hi) { const bf16_t* src = srcb + (size_t)(tt * 64) * KVQW; kk[i] = *(const u32x4*)src; vv[i] = *(const u32x4*)(src + 768); } }
#pragma unroll
        for (int i = 0; i < 4; ++i) { const int tt = 4 * qb + i; if (tt < have_lo || tt > have_hi) { const int sl = tt % SB_NSLOT; *(LAS u32x4*)(L + sl * SB_SLOT + kwr) = kk[i]; *(LAS u32x4*)(L + sl * SB_SLOT + vwr) = vv[i]; } }
    }
    LDS_BARRIER();
    const int jd = 4 * qb + (w >> 1);
    int slot = jd % SB_NSLOT;
    int pslot = (4 * qb + SB_NSLOT - 1) % SB_NSLOT;
    bool mydone = false;
    int lo_loaded = (have_lo <= have_hi && have_lo < 4 * qb) ? have_lo : 4 * qb;
    for (int st = 0; ; ++st) {
        const int tpre = 4 * qb - st - 1;
        u32x4 kreg, vreg;
        const bool need_pre = tpre >= 0 && (tpre < have_lo || tpre > have_hi);
        if (need_pre) { const bf16_t* src = srcb + (size_t)(tpre * 64) * KVQW; kreg = *(const u32x4*)src; vreg = *(const u32x4*)(src + 768); }
        const int t = jd - st;
        if (t >= 0 && !mydone) {
            const int k0 = 64 * t;
            const LAS unsigned char* Kb = L + slot * SB_SLOT;
            f32x16 p0 = f32x16{}, p1 = f32x16{};
#pragma unroll
            for (int s = 0; s < 4; ++s) {
                const bf16x8 a0 = *(const LAS bf16x8*)(Kb + r32 * 144 + s * 32 + hi * 16);
                const bf16x8 a1 = *(const LAS bf16x8*)(Kb + (32 + r32) * 144 + s * 32 + hi * 16);
                p0 = __builtin_amdgcn_mfma_f32_32x32x16_bf16(a0, qr[s], p0, 0, 0, 0);
                p1 = __builtin_amdgcn_mfma_f32_32x32x16_bf16(a1, qr[s], p1, 0, 0, 0);
            }
            float l0[16], l1[16];
            float csum = 0.f;
#pragma unroll
            for (int r = 0; r < 16; ++r) {
                const float z0 = fminf(p0[r], 80.f), z1 = fminf(p1[r], 80.f);
                const float sp0 = flog2(1.0f + fexp2(z0)), sp1 = flog2(1.0f + fexp2(z1));
                float a = -sp0, bq = -sp1, lb0 = z0 - sp0, lb1 = z1 - sp1;
                if (st == 0) { const int key0 = k0 + crow(r, hi); if (key0 >= tq) { a = 0.f; lb0 = -INFINITY; } if (key0 + 32 >= tq) { bq = 0.f; lb1 = -INFINITY; } }
                l0[r] = a; l1[r] = bq; p0[r] = lb0; p1[r] = lb1; csum += a + bq;
            }
            csum += __shfl_xor(csum, 32);
            bf16x8 x0[2], x1[2];
#pragma unroll
            for (int s2 = 0; s2 < 2; ++s2) {
                u32x4 t0, t1;
                t0.x = pk2(l0[8 * s2 + 0], l0[8 * s2 + 1]); t0.y = pk2(l0[8 * s2 + 2], l0[8 * s2 + 3]); t0.z = pk2(l0[8 * s2 + 4], l0[8 * s2 + 5]); t0.w = pk2(l0[8 * s2 + 6], l0[8 * s2 + 7]);
                t1.x = pk2(l1[8 * s2 + 0], l1[8 * s2 + 1]); t1.y = pk2(l1[8 * s2 + 2], l1[8 * s2 + 3]); t1.z = pk2(l1[8 * s2 + 4], l1[8 * s2 + 5]); t1.w = pk2(l1[8 * s2 + 6], l1[8 * s2 + 7]);
                x0[s2] = __builtin_bit_cast(bf16x8, t0); x1[s2] = __builtin_bit_cast(bf16x8, t1);
            }
            f32x16 y0, y1;
#pragma unroll
            for (int r = 0; r < 16; ++r) { y0[r] = R; y1[r] = R; }
            y0 = __builtin_amdgcn_mfma_f32_32x32x16_bf16(tri[0], x0[0], y0, 0, 0, 0);
            y0 = __builtin_amdgcn_mfma_f32_32x32x16_bf16(tri[1], x0[1], y0, 0, 0, 0);
            y0 = __builtin_amdgcn_mfma_f32_32x32x16_bf16(ones, x1[0], y0, 0, 0, 0);
            y0 = __builtin_amdgcn_mfma_f32_32x32x16_bf16(ones, x1[1], y0, 0, 0, 0);
            y1 = __builtin_amdgcn_mfma_f32_32x32x16_bf16(tri[0], x1[0], y1, 0, 0, 0);
            y1 = __builtin_amdgcn_mfma_f32_32x32x16_bf16(tri[1], x1[1], y1, 0, 0, 0);
#pragma unroll
            for (int r = 0; r < 16; ++r) { p0[r] = fexp2(p0[r] + y0[r]); p1[r] = fexp2(p1[r] + y1[r]); }
            R += csum;
            const LAS unsigned char* Vl = Kb + vlane;
#pragma unroll
            for (int half = 0; half < 2; ++half)
#pragma unroll
                for (int s2 = 0; s2 < 2; ++s2) {
                    u32x4 pw;
                    if (half == 0) { pw.x = pk2(p0[8 * s2 + 0], p0[8 * s2 + 1]); pw.y = pk2(p0[8 * s2 + 2], p0[8 * s2 + 3]); pw.z = pk2(p0[8 * s2 + 4], p0[8 * s2 + 5]); pw.w = pk2(p0[8 * s2 + 6], p0[8 * s2 + 7]); }
                    else { pw.x = pk2(p1[8 * s2 + 0], p1[8 * s2 + 1]); pw.y = pk2(p1[8 * s2 + 2], p1[8 * s2 + 3]); pw.z = pk2(p1[8 * s2 + 4], p1[8 * s2 + 5]); pw.w = pk2(p1[8 * s2 + 6], p1[8 * s2 + 7]); }
                    const bf16x8 pa = __builtin_bit_cast(bf16x8, pw);
#pragma unroll
                    for (int dt = 0; dt < 2; ++dt) {
                        const int kb = 32 * half + 16 * s2;
                        const s16x4 vlo = lds_tr16(Vl + kb * 160 + dt * 64), vhi = lds_tr16(Vl + (kb + 8) * 160 + dt * 64);
                        const bf16x8 vb = (bf16x8){vlo[0], vlo[1], vlo[2], vlo[3], vhi[0], vhi[1], vhi[2], vhi[3]};
                        o[dt] = __builtin_amdgcn_mfma_f32_32x32x16_bf16(pa, vb, o[dt], 0, 0, 0);
                    }
                }
        }
        if (t <= 0 || __all(R <= -150.f) != 0) mydone = true;
        if (lane == 0) *(LAS unsigned*)(L + SB_FLAG + ((st & 1) * 8 + w) * 4) = mydone ? 1u : 0u;
        if (need_pre) { *(LAS u32x4*)(L + pslot * SB_SLOT + kwr) = kreg; *(LAS u32x4*)(L + pslot * SB_SLOT + vwr) = vreg; }
        if (tpre >= 0 && tpre < lo_loaded) lo_loaded = tpre;
        LDS_BARRIER();
        { const u32x4 f0 = *(const LAS u32x4*)(L + SB_FLAG + (st & 1) * 32), f1 = *(const LAS u32x4*)(L + SB_FLAG + (st & 1) * 32 + 16);
          if ((f0.x & f0.y & f0.z & f0.w & f1.x & f1.y & f1.z & f1.w) != 0u) break; }
        slot = (slot == 0) ? SB_NSLOT - 1 : slot - 1;
        pslot = (pslot == 0) ? SB_NSLOT - 1 : pslot - 1;
    }
#pragma unroll
    for (int dt = 0; dt < 2; ++dt)
#pragma unroll
        for (int r = 0; r < 16; ++r) MIXo[(size_t)(b * SEQ + q0 + crow(r, hi)) * DM + hh * 64 + 32 * dt + r32] = (bf16_t)f2bf(o[dt][r]);
    LDS_BARRIER();
    return lo_loaded;
}
__device__ __forceinline__ void sb_phase(const Frame& F, const bf16_t* KVQ, bf16_t* MIXo) {
    bf16x8 qa[4], qb_[4];
    const int L0 = 6 * F.bx;
    sb_prefetch_q(F, KVQ, sb_unit_of(L0), qa);
    int have_lo = 1, have_hi = 0;
    for (int j = 0; j < 6; j += 2) {
        const int Lc = L0 + j;
        sb_prefetch_q(F, KVQ, sb_unit_of(Lc + 1), qb_);
        { const int u = sb_unit_of(Lc); const int lo = sb_unit(F, KVQ, MIXo, u, qa, have_lo, have_hi);
          if (((Lc + 1) >> 4) == (Lc >> 4)) { have_lo = lo; have_hi = lo + SB_NSLOT - 1; } else { have_lo = 1; have_hi = 0; } }
        if (j + 2 < 6) sb_prefetch_q(F, KVQ, sb_unit_of(Lc + 2), qa);
        { const int u = sb_unit_of(Lc + 1); const int lo = sb_unit(F, KVQ, MIXo, u, qb_, have_lo, have_hi);
          if (((Lc + 2) >> 4) == ((Lc + 1) >> 4)) { have_lo = lo; have_hi = lo + SB_NSLOT - 1; } else { have_lo = 1; have_hi = 0; } }
    }
}

struct Args { const float* in[20]; float* out; unsigned char* ws; };

__global__ void __launch_bounds__(NTHR, 2) yoco_fwd(Args args) {
    extern __shared__ __attribute__((aligned(16))) unsigned char lds_raw[];
    Frame F;
    F.lds = (LAS unsigned char*)lds_raw;
    F.tid = threadIdx.x; F.lane = F.tid & 63; F.wave = __builtin_amdgcn_readfirstlane(F.tid >> 6);
    F.G = gridDim.x; F.bx = blockIdx.x;
    Ptrs P;
    P.x = args.in[0]; P.mem = args.in[1]; P.anpre = args.in[2]; P.anpost = args.in[3]; P.fnpre = args.in[4]; P.fnpost = args.in[5];
    P.w_in_a = args.in[6]; P.hlb = args.in[7]; P.hon = args.in[8]; P.w_in_b = args.in[9]; P.kvn = args.in[10]; P.w_kv = args.in[11];
    P.memn = args.in[12]; P.w_mem_kv = args.in[13]; P.w_out = args.in[14]; P.w_gu = args.in[15]; P.w_dn = args.in[16]; P.w_router = args.in[17];
    P.w_egu = args.in[18]; P.w_edn = args.in[19]; P.out = args.out; P.ws = args.ws;
    unsigned char* ws = args.ws;
    unsigned* ctl = (unsigned*)(ws + WS_CTL);
    volatile LAS unsigned* MISC = (volatile LAS unsigned*)(F.lds + MISC_OFF);
    for (int u = F.tid; u < (LDS_BYTES - LDSCTL_OFF) / 4; u += NTHR) ((LAS unsigned*)(F.lds + LDSCTL_OFF))[u] = 0u;
    __syncthreads();
    XcdBarrier bar = xcd_barrier_post(ctl + CW_BAR, MISC + 8);
    {
        if (F.tid == 0) { const unsigned xcc = xb_xcc_id(); const unsigned rk = xb_add((unsigned*)ctl + CW_XRANK + xcc, 1u); MISC[12] = (xcc < 8u && rk < (unsigned)(F.G >> 3) && (F.G & 7) == 0) ? rk * 8u + xcc : 0xffffffffu; }
        __syncthreads();
        if (F.tid == 0 && MISC[12] == 0xffffffffu) __hip_atomic_store((unsigned*)ctl + CW_XRANK + 15, 1u, __ATOMIC_RELAXED, __HIP_MEMORY_SCOPE_AGENT);
    }
#define GRID_BAR() xcd_barrier(bar)

    bf16_t* const U = (bf16_t*)(ws + WS_U);
    bf16_t* const R1 = (bf16_t*)(ws + WS_R1);
    bf16_t* const MIX = (bf16_t*)(ws + WS_MIX);
    bf16_t* const MIXED = (bf16_t*)(ws + WS_MIXED);
    bf16_t* const MKV = (bf16_t*)(ws + WS_MKV);
    bf16_t* const H16 = (bf16_t*)(ws + WS_H16);

    { const Frame Fp = phase_frame(F); p0_prologue(Fp, P); }
    GRID_BAR();
    if (__hip_atomic_load((unsigned*)ctl + CW_XRANK + 15, __ATOMIC_RELAXED, __HIP_MEMORY_SCOPE_AGENT) == 0u) F.bx = (int)MISC[12];
    {
        pg8::Gemm g{U, (const bf16_t*)(ws + WS_WINA), MTOK, AW, DM / 2}; pg8::StaticOrder S; S.init(MTOK, AW, F.G, F.bx);
        S.ext_n = 32; S.ext_pm0 = MTOK / 256; S.ext_pn0 = AW / 256;
        pg8::EpiStoreQ E{R1, AW, (const float*)(ws + WS_AS), (const float*)(ws + WS_WSC) + WSC_INA, MKV, DM, MTOK / 256, AW / 256};
        pg8::gemm_phase<pg8::EpiStoreQ, pg8::StaticOrder, true, true, 2>(F.lds, g, S, E);
    }
    GRID_BAR();
    { const Frame Fp = phase_frame(F); hgrnA_phase(Fp, P); }
    { const Frame Fp = phase_frame(F); for (int u = F.bx; u < 512; u += F.G) memattn_unit(Fp, R1, AW, 3072, MKV, 0, MIX, u); }
    GRID_BAR();
    { const Frame Fp = phase_frame(F); if (F.bx < 96) hgrn_chain(Fp, P, ((((F.bx >> 4) << 3) | (F.bx & 7)) << 1) | ((F.bx >> 3) & 1));
      else convert_weights(Fp, P, (F.bx - 96) * NWAVES + Fp.wave, (F.G - 96) * NWAVES); }
    GRID_BAR();
    {
        pg8::Gemm g{MIX, (const bf16_t*)(ws + WS_WOUT0), MTOK, DM, DM}; pg8::StaticOrder S; S.init(MTOK, DM, F.G, F.bx);
        pg8::EpiStore E{MIXED, DM, 1.f, nullptr, 0, 0, 0};
        pg8::gemm_phase<pg8::EpiStore, pg8::StaticOrder, true, true>(F.lds, g, S, E);
    }
    GRID_BAR();
    { const Frame Fp = phase_frame(F); norm_phase<false, true>(Fp, MIXED, P.x, H16, P.anpost, U, P.fnpre, (float*)(ws + WS_AS + 256 * 1024)); }
#if STOP_AFTER >= 5
    GRID_BAR();
    {
        pg8::Gemm g{U, (const bf16_t*)(ws + WS_WGU), MTOK, 2 * DFF, DM / 2}; pg8::StaticOrder S; S.init(MTOK, 2 * DFF, F.G, F.bx);
        pg8::EpiSwiGLUQ8 E{(unsigned char*)R1, DFF, (const float*)(ws + WS_AS + 256 * 1024), (const float*)(ws + WS_WSC) + WSC_GU};
        pg8::gemm_phase<pg8::EpiSwiGLUQ8, pg8::StaticOrder, true, true, 2>(F.lds, g, S, E);
    }
    GRID_BAR();
    {
        pg8::Gemm g{R1, (const bf16_t*)(ws + WS_WDN), MTOK, DM, DFF / 2}; pg8::StaticOrder S; S.init(MTOK, DM, F.G, F.bx);
        pg8::EpiStore E{MIXED, DM, 1.0f / (FP8_SHD * FP8_SWDD), nullptr, 0, 0, 0};
        pg8::gemm_phase<pg8::EpiStore, pg8::StaticOrder, true, true, 1>(F.lds, g, S, E);
    }
    GRID_BAR();
    { const Frame Fp = phase_frame(F); norm_phase<true, true>(Fp, MIXED, H16, H16, P.fnpost, U, nullptr, (float*)(ws + WS_AS + 512 * 1024)); }
#endif
#if STOP_AFTER >= 8
    GRID_BAR();
    {
        pg8::Gemm g{U, (const bf16_t*)(ws + WS_WKVB), MTOK, KVQW, DM / 2}; pg8::StaticOrder S; S.init(MTOK, KVQW, F.G, F.bx);
        pg8::EpiStoreQ E{R1, KVQW, (const float*)(ws + WS_AS + 512 * 1024), (const float*)(ws + WS_WSC) + WSC_KVB, nullptr, 0, 0, 0};
        pg8::gemm_phase<pg8::EpiStoreQ, pg8::StaticOrder, true, true, 2>(F.lds, g, S, E);
    }
    GRID_BAR();
    {
        { const Frame Fp = phase_frame(F); sb_phase(Fp, R1, MIX); }
        { const Frame Fp = phase_frame(F); for (int u = F.bx; u < 512; u += F.G) memattn_unit(Fp, R1, KVQW, 2304, MKV, 512, MIX, u); }
    }
    GRID_BAR();
    {
        pg8::Gemm g{MIX, (const bf16_t*)(ws + WS_WOUT1), MTOK, DM, DM}; pg8::StaticOrder S; S.init(MTOK, DM, F.G, F.bx);
        pg8::EpiStore E{MIXED, DM, 1.f, nullptr, 0, 0, 0};
        pg8::gemm_phase<pg8::EpiStore, pg8::StaticOrder, true, true>(F.lds, g, S, E);
    }
    GRID_BAR();
    {
        const Frame Fq = phase_frame(F);
        LAS unsigned* lcnt = (LAS unsigned*)(F.lds + 32768);
        LAS float* WRt = (LAS float*)(F.lds);
        if (Fq.tid < 8) lcnt[Fq.tid] = 0u;
        for (int idx = Fq.tid; idx < DM * NEXP; idx += NTHR) WRt[(idx & 7) * DM + (idx >> 3)] = P.w_router[idx];
        __syncthreads();
        f32x4 g1v[4], g2v[4];
#pragma unroll
        for (int j = 0; j < 4; ++j) { g1v[j] = ((const f32x4*)(P.anpost + DM))[Fq.lane + 64 * j]; g2v[j] = ((const f32x4*)(P.fnpre + DM))[Fq.lane + 64 * j]; }
        for (int i0 = 0; i0 < 16; i0 += 4) {
          const int m0 = F.bx * 128 + Fq.wave * 16 + i0;
          u32x2 ar[4][4], bs[4][4];
#pragma unroll
          for (int r = 0; r < 4; ++r)
#pragma unroll
            for (int j = 0; j < 4; ++j) { ar[r][j] = ((const u32x2*)(MIXED + (size_t)(m0 + r) * DM))[Fq.lane + 64 * j]; bs[r][j] = ((const u32x2*)(H16 + (size_t)(m0 + r) * DM))[Fq.lane + 64 * j]; }
          f32x4 uu[4][4];
#pragma unroll
          for (int r = 0; r < 4; ++r) {
            const int m = m0 + r;
            f32x4 a[4];
#pragma unroll
            for (int j = 0; j < 4; ++j) a[j] = (f32x4){bflo(ar[r][j].x), bfhi(ar[r][j].x), bflo(ar[r][j].y), bfhi(ar[r][j].y)};
            const float rs = row_rstd(a);
            f32x4 h[4];
#pragma unroll
            for (int j = 0; j < 4; ++j) {
                h[j] = (f32x4){bflo(bs[r][j].x), bfhi(bs[r][j].x), bflo(bs[r][j].y), bfhi(bs[r][j].y)} + a[j] * rs * g1v[j];
                u32x2 hw; hw.x = pk2(h[j].x, h[j].y); hw.y = pk2(h[j].z, h[j].w); ((u32x2*)(H16 + (size_t)m * DM))[Fq.lane + 64 * j] = hw; }
            const float rh = row_rstd(h);
            unsigned* o4 = (unsigned*)((unsigned char*)U + (size_t)m * DM) + Fq.lane;
#pragma unroll
            for (int j = 0; j < 4; ++j) { uu[r][j] = h[j] * rh * g2v[j];
                o4[64 * j] = pk4_fp8s(uu[r][j].x * FP8_SX, uu[r][j].y * FP8_SX, uu[r][j].z * FP8_SX, uu[r][j].w * FP8_SX); }
          }
          float lg[4][8];
#pragma unroll
          for (int r = 0; r < 4; ++r)
#pragma unroll
            for (int e = 0; e < 8; ++e) lg[r][e] = 0.f;
#pragma unroll
          for (int j = 0; j < 4; ++j)
#pragma unroll
            for (int e = 0; e < 8; ++e) { const f32x4 w4 = *(const LAS f32x4*)(WRt + e * DM + 4 * Fq.lane + 256 * j);
#pragma unroll
                for (int r = 0; r < 4; ++r) lg[r][e] += uu[r][j].x * w4.x + uu[r][j].y * w4.y + uu[r][j].z * w4.z + uu[r][j].w * w4.w; }
#pragma unroll
          for (int r = 0; r < 4; ++r) {
            const int m = m0 + r;
#pragma unroll
            for (int e = 0; e < 8; ++e) lg[r][e] = wave_sum(lg[r][e]);
            int i0 = 0; float l0 = lg[r][0];
#pragma unroll
            for (int e = 1; e < 8; ++e) if (lg[r][e] > l0) { l0 = lg[r][e]; i0 = e; }
            int i1 = -1; float l1 = -3.0e38f;
#pragma unroll
            for (int e = 0; e < 8; ++e) if (e != i0 && lg[r][e] > l1) { l1 = lg[r][e]; i1 = e; }
            const float g0 = 1.0f / (1.0f + __expf(l1 - l0));
            if (Fq.lane == 0) {
                const unsigned r0 = __hip_atomic_fetch_add(lcnt + i0, 1u, __ATOMIC_RELAXED, __HIP_MEMORY_SCOPE_WORKGROUP);
                const unsigned r1 = __hip_atomic_fetch_add(lcnt + i1, 1u, __ATOMIC_RELAXED, __HIP_MEMORY_SCOPE_WORKGROUP);
                ((int4*)(ws + WS_META))[m] = make_int4(i0, i1, (int)r0, (int)r1);
                ((float2*)(ws + WS_GATE))[m] = make_float2(g0, 1.0f - g0);
            }
          }
        }
        __syncthreads();
        if (Fq.tid < 8) { const unsigned base = __hip_atomic_fetch_add(ctl + CW_GCNT + Fq.tid, lcnt[Fq.tid], __ATOMIC_RELAXED, __HIP_MEMORY_SCOPE_AGENT); ((unsigned*)(ws + WS_WGB))[F.bx * 8 + Fq.tid] = base; }
    }
#endif
#if STOP_AFTER >= 12
    GRID_BAR();
    int ts[NEXP + 1];
    {
        const Frame Fq = phase_frame(F);
        ts[0] = 0;
#pragma unroll
        for (int e = 0; e < NEXP; ++e) { const unsigned c = __hip_atomic_load(ctl + CW_GCNT + e, __ATOMIC_RELAXED, __HIP_MEMORY_SCOPE_AGENT); ts[e + 1] = ts[e] + (int)((c + 255u) >> 8); }
        bf16_t* XS = R1;
        for (int i0 = 0; i0 < 16; i0 += 4) {
            const int m0 = F.bx * 128 + Fq.wave * 16 + i0;
            int4 mt[4]; u32x4 v0[4];
#pragma unroll
            for (int r = 0; r < 4; ++r) { mt[r] = ((const int4*)(ws + WS_META))[m0 + r]; v0[r] = *((const u32x4*)((const unsigned char*)U + (size_t)(m0 + r) * DM) + Fq.lane); }
#pragma unroll
            for (int r = 0; r < 4; ++r) {
                int d0 = 0, d1 = 0;
#pragma unroll
                for (int e = 0; e < NEXP; ++e) { if (mt[r].x == e) d0 = ts[e] * 256; if (mt[r].y == e) d1 = ts[e] * 256; }
                d0 += (int)((const unsigned*)(ws + WS_WGB))[F.bx * 8 + mt[r].x] + mt[r].z;
                d1 += (int)((const unsigned*)(ws + WS_WGB))[F.bx * 8 + mt[r].y] + mt[r].w;
                *((u32x4*)((unsigned char*)XS + (size_t)d0 * DM) + Fq.lane) = v0[r]; *((u32x4*)((unsigned char*)XS + (size_t)d1 * DM) + Fq.lane) = v0[r];
                if (Fq.lane == 0) ((int2*)(ws + WS_DEST))[m0 + r] = make_int2(d0, d1);
            }
        }
    }
    GRID_BAR();
    {
        pg8::Gemm g{R1, (const bf16_t*)(ws + WS_WEGU), 0, 2 * DFE, DM / 2}; pg8::StaticOrder S; S.init(256, 2 * DFE, F.G, F.bx);
        S.nM = ts[NEXP]; S.nwg = S.nM * S.nN; S.moe = 1;
#pragma unroll
        for (int e = 0; e < NEXP; ++e) S.ts[e] = ts[e];
        pg8::EpiSwiGLU8 E{(unsigned char*)(ws + WS_EH), DFE, 1.0f / (FP8_SX * FP8_SWGU)};
        pg8::gemm_phase<pg8::EpiSwiGLU8, pg8::StaticOrder, true, true, 1>(F.lds, g, S, E);
    }
    GRID_BAR();
    {
        pg8::Gemm g{(const bf16_t*)(ws + WS_EH), (const bf16_t*)(ws + WS_WEDN), 0, DM, DFE / 2}; pg8::StaticOrder S; S.init(256, DM, F.G, F.bx);
        S.nM = ts[NEXP]; S.nwg = S.nM * S.nN; S.moe = 1;
#pragma unroll
        for (int e = 0; e < NEXP; ++e) S.ts[e] = ts[e];
        pg8::EpiStore E{R1 + (size_t)XS_ROWS * DM / 2, DM, 1.0f / (FP8_SH * FP8_SWDN), nullptr, 0, 0, 0};
        pg8::gemm_phase<pg8::EpiStore, pg8::StaticOrder, true, true, 1>(F.lds, g, S, E);
    }
    GRID_BAR();
    {
        const Frame Fq = phase_frame(F);
        f32x4 g1v[4];
#pragma unroll
        for (int j = 0; j < 4; ++j) g1v[j] = ((const f32x4*)(P.fnpost + DM))[Fq.lane + 64 * j];
        const bf16_t* YS = R1 + (size_t)XS_ROWS * DM / 2;
        for (int i0 = 0; i0 < 16; i0 += 4) {
            const int m0 = F.bx * 128 + Fq.wave * 16 + i0;
            int2 d[4]; float2 gt[4];
#pragma unroll
            for (int r = 0; r < 4; ++r) { d[r] = ((const int2*)(ws + WS_DEST))[m0 + r]; gt[r] = ((const float2*)(ws + WS_GATE))[m0 + r]; }
            u32x2 ya[4][4], yb[4][4], bs[4][4];
#pragma unroll
            for (int r = 0; r < 4; ++r)
#pragma unroll
                for (int j = 0; j < 4; ++j) { ya[r][j] = ((const u32x2*)(YS + (size_t)d[r].x * DM))[Fq.lane + 64 * j]; yb[r][j] = ((const u32x2*)(YS + (size_t)d[r].y * DM))[Fq.lane + 64 * j];
                    bs[r][j] = ((const u32x2*)(H16 + (size_t)(m0 + r) * DM))[Fq.lane + 64 * j]; }
#pragma unroll
            for (int r = 0; r < 4; ++r) {
                f32x4 a[4];
#pragma unroll
                for (int j = 0; j < 4; ++j) a[j] = (f32x4){bflo(ya[r][j].x), bfhi(ya[r][j].x), bflo(ya[r][j].y), bfhi(ya[r][j].y)} * gt[r].x + (f32x4){bflo(yb[r][j].x), bfhi(yb[r][j].x), bflo(yb[r][j].y), bfhi(yb[r][j].y)} * gt[r].y;
                const float rs = row_rstd(a);
#pragma unroll
                for (int j = 0; j < 4; ++j) { const f32x4 gg = g1v[j];
                    ((f32x4*)(P.out + (size_t)(m0 + r) * DM))[Fq.lane + 64 * j] = (f32x4){bflo(bs[r][j].x), bfhi(bs[r][j].x), bflo(bs[r][j].y), bfhi(bs[r][j].y)} + a[j] * rs * gg; }
            }
        }
    }
#endif
}

extern "C" void kernel_launch(void* const* d_in, const int* in_sizes, int n_in, void* d_out, int out_size, void* d_ws, size_t ws_size, hipStream_t stream) {
    static int grid = 0;
    if (grid == 0) {
        if (n_in != 20 || out_size != MTOK * DM || ws_size < WS_END) { fprintf(stderr, "kernel_launch: unexpected shapes (n_in %d out %d ws %zu)\n", n_in, out_size, ws_size); grid = -1; return; }
        int dev = 0, cus = 0, per_cu = 0;
        if (hipGetDevice(&dev) != hipSuccess || hipDeviceGetAttribute(&cus, hipDeviceAttributeMultiprocessorCount, dev) != hipSuccess) { grid = -1; return; }
        if (hipFuncSetAttribute((const void*)yoco_fwd, hipFuncAttributeMaxDynamicSharedMemorySize, LDS_BYTES) != hipSuccess) { fprintf(stderr, "kernel_launch: hipFuncSetAttribute failed\n"); grid = -1; return; }
        if (hipOccupancyMaxActiveBlocksPerMultiprocessor(&per_cu, (const void*)yoco_fwd, NTHR, LDS_BYTES) != hipSuccess || per_cu < 1) { fprintf(stderr, "kernel_launch: occupancy query says %d\n", per_cu); }
        (void)hipGetLastError();
        if (cus < 256) { fprintf(stderr, "kernel_launch: need 256 CUs, have %d\n", cus); grid = -1; return; }
        grid = 256;
    }
    if (grid < 0) return;
    if (hipMemsetAsync((char*)d_ws + WS_CTL, 0, CTL_ZERO_BYTES, stream) != hipSuccess) return;
    Args a{};
    for (int i = 0; i < 20; ++i) a.in[i] = (const float*)d_in[i];
    a.out = (float*)d_out; a.ws = (unsigned char*)d_ws;
    hipLaunchKernelGGL(yoco_fwd, dim3(grid), dim3(NTHR), LDS_BYTES, stream, a);
}
```

```cpp
#include <hip/hip_runtime.h>
#include <cstdio>
#include <cstdint>

#ifndef STOP_AFTER
#define STOP_AFTER 99
#endif

#define LAS __attribute__((address_space(3)))
#define GAS __attribute__((address_space(1)))
typedef unsigned short bf16_t;
typedef short bf16x8 __attribute__((ext_vector_type(8)));
typedef float f32x4 __attribute__((ext_vector_type(4)));
typedef float f32x16 __attribute__((ext_vector_type(16)));
typedef float f32x2 __attribute__((ext_vector_type(2)));
typedef unsigned u32x4 __attribute__((ext_vector_type(4)));
typedef unsigned u32x2 __attribute__((ext_vector_type(2)));
typedef __bf16 bf16x2_t __attribute__((ext_vector_type(2)));

constexpr int NB = 8, SEQ = 4096, DM = 1024, MTOK = NB * SEQ;
constexpr int MEML = 256, MROWS = NB * MEML;
constexpr int AW = 3328, HF = 768, DFF = 2816, NEXP = 8, DFE = 3584;
constexpr int KVQW = 2560;
constexpr int XS_ROWS = 2 * MTOK + NEXP * 256;
constexpr float RMS_EPS = 1e-6f;
constexpr float C2 = 0.125f * 1.4426950408889634f;
constexpr int NWAVES = 8, NTHR = 512;

constexpr size_t MiB = 1u << 20;
constexpr size_t WS_CTL = 0, CTL_ZERO_BYTES = 128 * 1024;
constexpr size_t WS_MEMN = 395 * MiB + 32 * MiB;
constexpr size_t WS_MEMN_OLD_UNUSED = 459 * MiB;
constexpr size_t WS_AS = 1 * MiB;
constexpr size_t WS_WSC = 2 * MiB;
constexpr int WSC_INA = 0, WSC_GU = 4352, WSC_KVB = 9984, WSC_N = 12544;
constexpr size_t WS_MKV = 5 * MiB;
constexpr size_t WS_META = 9 * MiB;
constexpr size_t WS_GATE = WS_META + 512 * 1024, WS_DEST = WS_GATE + 256 * 1024, WS_WGB = WS_DEST + 256 * 1024;
constexpr size_t WS_WOUT1 = 12 * MiB;
constexpr size_t WS_WKVB = 14 * MiB;
constexpr size_t WS_WEGU = 19 * MiB;
constexpr size_t WS_WEDN = 131 * MiB;
constexpr size_t WS_R1 = 187 * MiB;
constexpr size_t WS_EH = 395 * MiB;
constexpr size_t WS_U = 395 * MiB;
constexpr size_t WS_MIX = 459 * MiB;
constexpr size_t WS_MIXED = 523 * MiB;
constexpr size_t WS_WINA = 587 * MiB;
constexpr size_t WS_WMKV = 587 * MiB + (size_t)3328 * 1024;
constexpr size_t WS_WMKV_OLD_UNUSED = 587 * MiB + (size_t)3328 * 1024 * 2;
constexpr size_t WS_WOUT0 = 596 * MiB;
constexpr size_t WS_WGU = 598 * MiB;
constexpr size_t WS_WDN = 609 * MiB;
constexpr size_t WS_HGQD = 640 * MiB;
constexpr size_t WS_HGOI = 688 * MiB;
constexpr size_t WS_HGU = 736 * MiB;
constexpr size_t WS_HGDEC = 832 * MiB;
constexpr size_t WS_H16 = 640 * MiB;
constexpr size_t WS_END = 857 * MiB;
static_assert(WS_EH + (size_t)XS_ROWS * DFE * 2 <= WS_END, "EH fits");
static_assert(WS_R1 + (size_t)MTOK * AW * 2 <= WS_EH, "R1 fits");
constexpr int CW_BAR = 4096;
constexpr int CW_GCNT = 16384;
constexpr int CW_EARLY = 16448 + 64;
constexpr int CW_XRANK = 16448;
static_assert((CW_EARLY + 16) * 4 <= (int)CTL_ZERO_BYTES, "control words inside the zeroed region");

constexpr int RING_BYTES = 131072;
constexpr int LDSCTL_OFF = RING_BYTES, MISC_OFF = LDSCTL_OFF + 320;
constexpr int LDS_BYTES = 147456;

__device__ __forceinline__ unsigned f2bf(float f) { unsigned u = __builtin_bit_cast(unsigned, f); return (u + 0x7fffu + ((u >> 16) & 1u)) >> 16; }
__device__ __forceinline__ unsigned pk2(float lo, float hi) { f32x2 v = {lo, hi}; bf16x2_t b = __builtin_convertvector(v, bf16x2_t); return __builtin_bit_cast(unsigned, b); }
__device__ __forceinline__ float bflo(unsigned w) { return __builtin_bit_cast(float, w << 16); }
__device__ __forceinline__ float bfhi(unsigned w) { return __builtin_bit_cast(float, w & 0xffff0000u); }
__device__ __forceinline__ float bf1(unsigned short s) { return __builtin_bit_cast(float, (unsigned)s << 16); }
__device__ __forceinline__ float wave_sum(float v);
__device__ __forceinline__ float fexp2(float x) { return __builtin_amdgcn_exp2f(x); }
__device__ __forceinline__ float flog2(float x) { return __builtin_amdgcn_logf(x); }
__device__ __forceinline__ float frcp(float x) { return __builtin_amdgcn_rcpf(x); }
__device__ __forceinline__ float frsq(float x) { return __builtin_amdgcn_rsqf(x); }
template <int X> __device__ __forceinline__ float swz_xor(float v) { return __builtin_bit_cast(float, __builtin_amdgcn_ds_swizzle(__builtin_bit_cast(int, v), (X << 10) | 0x1F)); }
__device__ __forceinline__ float wave_sum(float v) {
    v += swz_xor<1>(v); v += swz_xor<2>(v); v += swz_xor<4>(v); v += swz_xor<8>(v); v += swz_xor<16>(v);
    const float lo = __builtin_bit_cast(float, __builtin_amdgcn_readlane(__builtin_bit_cast(int, v), 0)), hi = __builtin_bit_cast(float, __builtin_amdgcn_readlane(__builtin_bit_cast(int, v), 32));
    return lo + hi;
}
__device__ __forceinline__ float sigmoidf_(float x) { return frcp(1.0f + fexp2(-1.4426950408889634f * x)); }
typedef int i32x4 __attribute__((ext_vector_type(4)));
typedef int i32x8 __attribute__((ext_vector_type(8)));
__device__ __forceinline__ float sat8(float x) { return __builtin_amdgcn_fmed3f(x, -448.f, 448.f); }
__device__ __forceinline__ unsigned pk4_fp8s(float a, float b, float c, float d) { int w = 0; w = __builtin_amdgcn_cvt_pk_fp8_f32(sat8(a), sat8(b), w, false); w = __builtin_amdgcn_cvt_pk_fp8_f32(sat8(c), sat8(d), w, true); return (unsigned)w; }
__device__ __forceinline__ unsigned pk4_fp8(float a, float b, float c, float d) { int w = 0; w = __builtin_amdgcn_cvt_pk_fp8_f32(a, b, w, false); w = __builtin_amdgcn_cvt_pk_fp8_f32(c, d, w, true); return (unsigned)w; }
constexpr float FP8_SX = 8.f, FP8_SH = 8.f, FP8_SWGU = 32.f, FP8_SWDN = 64.f, FP8_SHD = 8.f, FP8_SWDD = 64.f;
__device__ __forceinline__ float wave_max(float v) {
    v = fmaxf(v, swz_xor<1>(v)); v = fmaxf(v, swz_xor<2>(v)); v = fmaxf(v, swz_xor<4>(v)); v = fmaxf(v, swz_xor<8>(v)); v = fmaxf(v, swz_xor<16>(v));
    const float lo = __builtin_bit_cast(float, __builtin_amdgcn_readlane(__builtin_bit_cast(int, v), 0)), hi = __builtin_bit_cast(float, __builtin_amdgcn_readlane(__builtin_bit_cast(int, v), 32));
    return fmaxf(lo, hi);
}
__device__ __forceinline__ unsigned pk4_i8(float a, float b, float c, float d) {
    const int ia = (int)__builtin_rintf(__builtin_amdgcn_fmed3f(a, -127.f, 127.f)), ib = (int)__builtin_rintf(__builtin_amdgcn_fmed3f(b, -127.f, 127.f)),
              ic = (int)__builtin_rintf(__builtin_amdgcn_fmed3f(c, -127.f, 127.f)), id = (int)__builtin_rintf(__builtin_amdgcn_fmed3f(d, -127.f, 127.f));
    return (unsigned)(ia & 0xff) | ((unsigned)(ib & 0xff) << 8) | ((unsigned)(ic & 0xff) << 16) | ((unsigned)id << 24);
}
__device__ __forceinline__ void quant_row_i8(const f32x4 (&uu)[4], unsigned char* qrow, float* as_slot, int lane) {
    float am = 0.f;
#pragma unroll
    for (int j = 0; j < 4; ++j) am = fmaxf(fmaxf(am, fmaxf(__builtin_fabsf(uu[j].x), __builtin_fabsf(uu[j].y))), fmaxf(__builtin_fabsf(uu[j].z), __builtin_fabsf(uu[j].w)));
    am = fmaxf(wave_max(am), 1e-20f);
    const float inv = 127.0f / am;
    unsigned* o4 = (unsigned*)qrow + lane;
#pragma unroll
    for (int j = 0; j < 4; ++j) o4[64 * j] = pk4_i8(uu[j].x * inv, uu[j].y * inv, uu[j].z * inv, uu[j].w * inv);
    if (lane == 0) *as_slot = am * (1.0f / 127.0f);
}
__device__ __forceinline__ int crow(int r, int hi) { return (r & 3) + 8 * (r >> 2) + 4 * hi; }
#define LDS_WAIT() asm volatile("s_waitcnt lgkmcnt(0)" ::: "memory")
#define VM_WAIT() asm volatile("s_waitcnt vmcnt(0)" ::: "memory")
#define LDS_BARRIER() do { asm volatile("s_waitcnt lgkmcnt(0)" ::: "memory"); __builtin_amdgcn_s_barrier(); asm volatile("" ::: "memory"); } while (0)

namespace pg8 {
#define PG8_LAS __attribute__((address_space(3)))
constexpr int BM = 256, BK = 64, HALF = 128, HTB = HALF * BK * 2, STAGE_BYTES = 8 * HTB, NXCD = 8, WGM = 4;
__host__ __device__ __forceinline__ int lds_byte(int r, int c) { const int st = (r >> 4) * 2 + (c >> 5), rr = r & 15, cc = c & 31, ob = rr * 64 + cc * 2; return st * 1024 + (ob ^ (((ob >> 9) & 1) << 5)); }
__host__ __device__ __forceinline__ void stage_rc(int b, int& R, int& C) { const int st = b / 1024, sb = b % 1024, swz = sb ^ (((sb >> 9) & 1) << 5); R = (st >> 1) * 16 + swz / 64; C = (st & 1) * 32 + (swz % 64) / 2; }
__host__ __device__ __forceinline__ int perm32(int rho) { const int n = rho >> 4, i = rho & 15; return 8 * (i >> 2) + 4 * n + (i & 3); }

struct Unit { int pm, pn, pb; };
struct Gemm { const bf16_t* A; const bf16_t* Bt; int M, N, K; };

struct StaticOrder {
    static constexpr bool SIGNALS = false;
    int nM, nN, nwg, G, c;
    int ts[NEXP];
    int moe;
    int ext_n, ext_pm0, ext_pn0;
    int sp_q, sp_R8;
    int pm_off;
    int one_on, one_has, one_pm, one_pn;
    __device__ void init(int M, int N, int G_, int c_) { nM = M / BM; nN = N / BM; nwg = nM * nN; G = G_; c = c_; moe = 0; ext_n = 0; ext_pm0 = 0; ext_pn0 = 0; sp_q = 0; sp_R8 = 0; pm_off = 0; one_on = 0; one_has = 0; one_pm = 0; one_pn = 0;
#pragma unroll
        for (int e = 0; e < NEXP; ++e) ts[e] = 0; }
    __device__ __forceinline__ bool next(int i, Unit& u) const {
        int pm, pn;
        if (one_on) { if (i > 0 || !one_has) return false; pm = one_pm; pn = one_pn; }
        else {
            long L = (long)i * G + c;
            if (sp_R8 > 0 && i >= sp_q) { if (c < sp_R8) return false; L = (long)sp_q * G + (long)(i - sp_q) * (G - sp_R8) + (c - sp_R8); }
            if (L >= nwg + ext_n) return false;
            if (L >= nwg) { const int j = (int)L - nwg; pm = ext_pm0 + (j >> 2); pn = ext_pn0 + (j & 3); }
            else {
                int wgid = (int)L; { const int q = nwg / NXCD, r = nwg % NXCD, xcd = wgid % NXCD, off = wgid / NXCD; wgid = (xcd < r ? xcd * (q + 1) : r * (q + 1) + (xcd - r) * q) + off; }
                const int nig = WGM * nN, gid = wgid / nig, fm = gid * WGM, gsz = (nM - fm) < WGM ? (nM - fm) : WGM;
                pm = fm + ((wgid % nig) % gsz) + pm_off; pn = (wgid % nig) / gsz;
            }
        }
        int pb = pn;
        if (moe) { int e = 0;
#pragma unroll
            for (int j = 1; j < NEXP; ++j) e += (pm >= ts[j]) ? 1 : 0;
            pb = e * nN + pn; }
        u.pm = pm; u.pn = pn; u.pb = pb;
        return true;
    }
    __device__ __forceinline__ void a_ready(const Unit&) const {}
    __device__ __forceinline__ void done(const Unit&) const {}
};
struct SignalOrder : StaticOrder {
    static constexpr bool SIGNALS = true;
    unsigned* cnt; int early_rt;
    __device__ __forceinline__ void signal(int n) const { __builtin_amdgcn_fence(__ATOMIC_RELEASE, "agent"); (void)__hip_atomic_fetch_add(cnt, (unsigned)n, __ATOMIC_RELAXED, __HIP_MEMORY_SCOPE_AGENT); }
};

struct EpiStore {
    static constexpr bool PERM = true, AFTER_DRAIN = false;
    bf16_t* O; int ldc; float sc;
    bf16_t* O2; int ldc2, pm2, pn2;
    __device__ __forceinline__ void operator()(const f32x4 (&acc)[2][2][4][2], const Unit& u, int wr, int wc, int fr, int fq) const {
        int row0 = u.pm * BM + wr * 64 + fr; int col0 = u.pn * BM + wc * 32 + 8 * fq; bf16_t* Ob = O; int ld = ldc;
        if (pm2 > 0 && u.pm >= pm2) { row0 -= pm2 * BM; col0 -= pn2 * BM; Ob = O2; ld = ldc2; }
#pragma unroll
        for (int ai = 0; ai < 2; ++ai)
#pragma unroll
            for (int m = 0; m < 4; ++m) { bf16_t* rowp = Ob + (size_t)(row0 + ai * HALF + m * 16) * ld + col0;
#pragma unroll
                for (int bj = 0; bj < 2; ++bj) { const f32x4 v0 = acc[ai][bj][m][0] * sc, v1 = acc[ai][bj][m][1] * sc;
                    u32x4 w; w.x = pk2(v0[0], v0[1]); w.y = pk2(v0[2], v0[3]); w.z = pk2(v1[0], v1[1]); w.w = pk2(v1[2], v1[3]);
                    *(u32x4*)(rowp + bj * HALF) = w; } }
    }
};
struct EpiSwiGLU {
    static constexpr bool PERM = true, AFTER_DRAIN = false;
    bf16_t* O; int ldc;
    __device__ __forceinline__ void operator()(const f32x4 (&acc)[2][2][4][2], const Unit& u, int wr, int wc, int fr, int fq) const {
        const int row0 = u.pm * BM + wr * 64 + fr; const int col0 = u.pn * HALF + wc * 32 + 8 * fq;
#pragma unroll
        for (int ai = 0; ai < 2; ++ai)
#pragma unroll
            for (int m = 0; m < 4; ++m) { bf16_t* rowp = O + (size_t)(row0 + ai * HALF + m * 16) * ldc + col0;
                float h[8];
#pragma unroll
                for (int n = 0; n < 2; ++n)
#pragma unroll
                    for (int i = 0; i < 4; ++i) { const float g = acc[ai][0][m][n][i], up = acc[ai][1][m][n][i]; h[4 * n + i] = (g * up) * frcp(1.0f + fexp2(-1.4426950408889634f * g)); }
                u32x4 w; w.x = pk2(h[0], h[1]); w.y = pk2(h[2], h[3]); w.z = pk2(h[4], h[5]); w.w = pk2(h[6], h[7]);
                *(u32x4*)rowp = w; }
    }
};

struct EpiStoreQ {
    static constexpr bool PERM = true, AFTER_DRAIN = false;
    bf16_t* O; int ldc; const float* as; const float* ws;
    bf16_t* O2; int ldc2, pm2, pn2;
    __device__ __forceinline__ void operator()(const f32x4 (&acc)[2][2][4][2], const Unit& u, int wr, int wc, int fr, int fq) const {
        const int arow0 = u.pm * BM + wr * 64 + fr, bcol0 = u.pb * BM + wc * 32 + 8 * fq;
        int row0 = arow0, col0 = u.pn * BM + wc * 32 + 8 * fq; bf16_t* Ob = O; int ld = ldc;
        if (pm2 > 0 && u.pm >= pm2) { row0 -= pm2 * BM; col0 -= pn2 * BM; Ob = O2; ld = ldc2; }
        f32x4 wsv[2][2];
#pragma unroll
        for (int bj = 0; bj < 2; ++bj) { wsv[bj][0] = *(const f32x4*)(ws + bcol0 + bj * HALF); wsv[bj][1] = *(const f32x4*)(ws + bcol0 + bj * HALF + 4); }
#pragma unroll
        for (int ai = 0; ai < 2; ++ai)
#pragma unroll
            for (int m = 0; m < 4; ++m) { const float a = as[arow0 + ai * HALF + m * 16]; bf16_t* rowp = Ob + (size_t)(row0 + ai * HALF + m * 16) * ld + col0;
#pragma unroll
                for (int bj = 0; bj < 2; ++bj) { const i32x4 i0 = __builtin_bit_cast(i32x4, acc[ai][bj][m][0]), i1 = __builtin_bit_cast(i32x4, acc[ai][bj][m][1]);
                    const f32x4 v0 = __builtin_convertvector(i0, f32x4) * wsv[bj][0] * a, v1 = __builtin_convertvector(i1, f32x4) * wsv[bj][1] * a;
                    u32x4 w; w.x = pk2(v0[0], v0[1]); w.y = pk2(v0[2], v0[3]); w.z = pk2(v1[0], v1[1]); w.w = pk2(v1[2], v1[3]);
                    *(u32x4*)(rowp + bj * HALF) = w; } }
    }
};
struct EpiSwiGLUQ {
    static constexpr bool PERM = true, AFTER_DRAIN = false;
    bf16_t* O; int ldc; const float* as; const float* ws;
    __device__ __forceinline__ void operator()(const f32x4 (&acc)[2][2][4][2], const Unit& u, int wr, int wc, int fr, int fq) const {
        const int row0 = u.pm * BM + wr * 64 + fr; const int col0 = u.pn * HALF + wc * 32 + 8 * fq, bcol0 = u.pb * BM + wc * 32 + 8 * fq;
        f32x4 wsv[2][2];
#pragma unroll
        for (int bj = 0; bj < 2; ++bj) { wsv[bj][0] = *(const f32x4*)(ws + bcol0 + bj * HALF); wsv[bj][1] = *(const f32x4*)(ws + bcol0 + bj * HALF + 4); }
#pragma unroll
        for (int ai = 0; ai < 2; ++ai)
#pragma unroll
            for (int m = 0; m < 4; ++m) { const float a = as[row0 + ai * HALF + m * 16]; bf16_t* rowp = O + (size_t)(row0 + ai * HALF + m * 16) * ldc + col0;
                float h[8];
#pragma unroll
                for (int n = 0; n < 2; ++n) { const f32x4 gv = __builtin_convertvector(__builtin_bit_cast(i32x4, acc[ai][0][m][n]), f32x4) * wsv[0][n] * a, uv = __builtin_convertvector(__builtin_bit_cast(i32x4, acc[ai][1][m][n]), f32x4) * wsv[1][n] * a;
#pragma unroll
                    for (int i = 0; i < 4; ++i) h[4 * n + i] = (gv[i] * uv[i]) * frcp(1.0f + fexp2(-1.4426950408889634f * gv[i])); }
                u32x4 w; w.x = pk2(h[0], h[1]); w.y = pk2(h[2], h[3]); w.z = pk2(h[4], h[5]); w.w = pk2(h[6], h[7]);
                *(u32x4*)rowp = w; }
    }
};
struct EpiSwiGLUQ8 {
    static constexpr bool PERM = true, AFTER_DRAIN = false;
    static constexpr int NST = 8;
    unsigned char* O; int ldc; const float* as; const float* ws;
    __device__ __forceinline__ void operator()(const f32x4 (&acc)[2][2][4][2], const Unit& u, int wr, int wc, int fr, int fq) const {
        const int row0 = u.pm * BM + wr * 64 + fr; const int col0 = u.pn * HALF + wc * 32 + 8 * fq, bcol0 = u.pb * BM + wc * 32 + 8 * fq;
        f32x4 wsv[2][2];
#pragma unroll
        for (int bj = 0; bj < 2; ++bj) { wsv[bj][0] = *(const f32x4*)(ws + bcol0 + bj * HALF); wsv[bj][1] = *(const f32x4*)(ws + bcol0 + bj * HALF + 4); }
#pragma unroll
        for (int ai = 0; ai < 2; ++ai)
#pragma unroll
            for (int m = 0; m < 4; ++m) { const float a = as[row0 + ai * HALF + m * 16]; unsigned char* rowp = O + (size_t)(row0 + ai * HALF + m * 16) * ldc + col0;
                float h[8];
#pragma unroll
                for (int n = 0; n < 2; ++n) { const f32x4 gv = __builtin_convertvector(__builtin_bit_cast(i32x4, acc[ai][0][m][n]), f32x4) * wsv[0][n] * a, uv = __builtin_convertvector(__builtin_bit_cast(i32x4, acc[ai][1][m][n]), f32x4) * wsv[1][n] * (a * FP8_SHD);
#pragma unroll
                    for (int i = 0; i < 4; ++i) h[4 * n + i] = (gv[i] * uv[i]) * frcp(1.0f + fexp2(-1.4426950408889634f * gv[i])); }
                u32x2 w; w.x = pk4_fp8s(h[0], h[1], h[2], h[3]); w.y = pk4_fp8s(h[4], h[5], h[6], h[7]);
                *(u32x2*)rowp = w; }
    }
};
struct EpiSwiGLU8 {
    static constexpr bool PERM = true, AFTER_DRAIN = false;
    unsigned char* O; int ldc; float ds;
    __device__ __forceinline__ void operator()(const f32x4 (&acc)[2][2][4][2], const Unit& u, int wr, int wc, int fr, int fq) const {
        const float c1 = -1.4426950408889634f * ds, c2 = ds * ds * FP8_SH;
        const int row0 = u.pm * BM + wr * 64 + fr; const int col0 = u.pn * HALF + wc * 32 + 8 * fq;
#pragma unroll
        for (int ai = 0; ai < 2; ++ai)
#pragma unroll
            for (int m = 0; m < 4; ++m) { unsigned char* rowp = O + (size_t)(row0 + ai * HALF + m * 16) * ldc + col0;
                float h[8];
#pragma unroll
                for (int n = 0; n < 2; ++n)
#pragma unroll
                    for (int i = 0; i < 4; ++i) { const float ga = acc[ai][0][m][n][i], ua = acc[ai][1][m][n][i];
                        h[4 * n + i] = (ga * ua) * (c2 * frcp(1.0f + fexp2(ga * c1))); }
                u32x2 w; w.x = pk4_fp8s(h[0], h[1], h[2], h[3]); w.y = pk4_fp8s(h[4], h[5], h[6], h[7]);
                *(u32x2*)rowp = w; }
    }
};

template <class Epi, class Sched, bool ALIGN_EPI = false, bool SP2 = false, int FP8 = 0>
__device__ __forceinline__ void gemm_phase(PG8_LAS unsigned char* lds, const Gemm g, const Sched& S, const Epi& E) {
    int tid_ = threadIdx.x; asm volatile("" : "+v"(tid_));
    const int tid = tid_, wid = __builtin_amdgcn_readfirstlane(tid >> 6), lane = tid & 63, wr = wid >> 2, wc = wid & 3, fr = lane & 15, fq = lane >> 4;
    const int K = g.K, nt = K / BK;
    unsigned voffA[2], voffB[2];
#pragma unroll
    for (int i = 0; i < 2; ++i) { int R, C; stage_rc(tid * 16 + i * 8192, R, C); const int Rb = Epi::PERM ? ((R & ~31) + perm32(R & 31)) : R;
        voffA[i] = (unsigned)(R * K + C) * 2u; voffB[i] = (unsigned)(Rb * K + C) * 2u; }
    const size_t kstep = (size_t)(BK * 2);
    const size_t hstep = (size_t)HALF * K * 2;
    const size_t tstep = 2 * hstep;
    const unsigned ldsw = (unsigned)wid * 1024u;
    const int aoff = lds_byte(wr * 64 + fr, fq * 8), boff = lds_byte(wc * 32 + fr, fq * 8);
#define PG8_SA(b, h) (((b) * 2 + (h)) * HTB)
#define PG8_SB(b, h) ((4 + (b) * 2 + (h)) * HTB)
#define PG8_STAGE(bufoff, gbase, voff) do { _Pragma("unroll") for (int _i = 0; _i < 2; ++_i) \
        __builtin_amdgcn_global_load_lds((const unsigned*)((const char*)(gbase) + (voff)[_i]), (PG8_LAS unsigned*)(lds + (bufoff) + ldsw + _i * 8192), 16, 0, 0); } while (0)
#define PG8_LD8(p) __builtin_shufflevector(*(const PG8_LAS i32x4*)(p), *(const PG8_LAS i32x4*)((p) + 1024), 0, 1, 2, 3, 4, 5, 6, 7)
#define PG8_LDA(dst, b, h) do { if constexpr (FP8 == 1) { _Pragma("unroll") for (int m = 0; m < 4; ++m) dst##8[m] = PG8_LD8(lds + PG8_SA(b, h) + aoff + m * 2048); } \
        else { _Pragma("unroll") for (int m = 0; m < 4; ++m) _Pragma("unroll") for (int k = 0; k < 2; ++k) dst[m][k] = *(const PG8_LAS bf16x8*)(lds + PG8_SA(b, h) + aoff + m * 2048 + k * 1024); } } while (0)
#define PG8_LDB(dst, b, h) do { if constexpr (FP8 == 1) { _Pragma("unroll") for (int n = 0; n < 2; ++n) dst##8[n] = PG8_LD8(lds + PG8_SB(b, h) + boff + n * 2048); } \
        else { _Pragma("unroll") for (int n = 0; n < 2; ++n) _Pragma("unroll") for (int k = 0; k < 2; ++k) dst[n][k] = *(const PG8_LAS bf16x8*)(lds + PG8_SB(b, h) + boff + n * 2048 + k * 1024); } } while (0)
#define PG8_CAT(x, y) __builtin_shufflevector(__builtin_bit_cast(i32x4, x), __builtin_bit_cast(i32x4, y), 0, 1, 2, 3, 4, 5, 6, 7)
#define PG8_MMA(ai, bj, At, Bt) do { __builtin_amdgcn_s_setprio(1); \
        if constexpr (FP8 == 1) { _Pragma("unroll") for (int m = 0; m < 4; ++m) _Pragma("unroll") for (int n = 0; n < 2; ++n) \
            asm volatile("v_mfma_scale_f32_16x16x128_f8f6f4 %0, %1, %2, %0, %3, %3 op_sel_hi:[0,0,0]" : "+v"(acc[ai][bj][m][n]) : "v"(Bt##8[n]), "v"(At##8[m]), "v"(sc1)); } \
        else if constexpr (FP8 == 2) { _Pragma("unroll") for (int m = 0; m < 4; ++m) _Pragma("unroll") for (int n = 0; n < 2; ++n) _Pragma("unroll") for (int k = 0; k < 2; ++k) \
            acc[ai][bj][m][n] = __builtin_bit_cast(f32x4, __builtin_amdgcn_mfma_i32_16x16x64_i8(__builtin_bit_cast(i32x4, Bt[n][k]), __builtin_bit_cast(i32x4, At[m][k]), __builtin_bit_cast(i32x4, acc[ai][bj][m][n]), 0, 0, 0)); } \
        else { _Pragma("unroll") for (int m = 0; m < 4; ++m) _Pragma("unroll") for (int n = 0; n < 2; ++n) _Pragma("unroll") for (int k = 0; k < 2; ++k) \
            acc[ai][bj][m][n] = __builtin_amdgcn_mfma_f32_16x16x32_bf16(Bt[n][k], At[m][k], acc[ai][bj][m][n], 0, 0, 0); } \
        __builtin_amdgcn_s_setprio(0); } while (0)
#define PG8_WAIT_V(n) asm volatile("s_waitcnt vmcnt(" #n ")" ::: "memory")
#define PG8_WAIT_L(n) asm volatile("s_waitcnt lgkmcnt(" #n ")" ::: "memory")
#define PG8_BAR __builtin_amdgcn_s_barrier()
#define PG8_SCHED __builtin_amdgcn_sched_barrier(0)
    Unit cur, nxt; int ui = 0; int early_cnt = 0;
    if (!S.next(0, cur)) return;
    f32x4 acc[2][2][4][2];
#pragma unroll
    for (int a = 0; a < 2; ++a)
#pragma unroll
        for (int b = 0; b < 2; ++b)
#pragma unroll
            for (int m = 0; m < 4; ++m)
#pragma unroll
                for (int n = 0; n < 2; ++n) acc[a][b][m][n] = (f32x4){0.f, 0.f, 0.f, 0.f};
    bf16x8 At[4][2], B0[2][2], B1[2][2];
    i32x8 At8[4], B08[2], B18[2];
    int sc1 = 0x7F7F7F7F; asm volatile("" : "+v"(sc1));
    const char* cA = (const char*)g.A + (size_t)cur.pm * tstep; const char* cB = (const char*)g.Bt + (size_t)cur.pb * tstep;
    S.a_ready(cur);
    if constexpr (SP2) {
        PG8_STAGE(PG8_SB(0, 0), cB, voffB); PG8_STAGE(PG8_SB(0, 1), cB + hstep, voffB); PG8_STAGE(PG8_SA(0, 0), cA, voffA); PG8_STAGE(PG8_SA(0, 1), cA + hstep, voffA);
        if (wr == 1) PG8_BAR;
        PG8_WAIT_V(2); PG8_BAR;
        PG8_STAGE(PG8_SB(1, 0), cB + kstep, voffB); PG8_STAGE(PG8_SA(1, 0), cA + kstep, voffA); PG8_STAGE(PG8_SB(1, 1), cB + hstep + kstep, voffB);
        PG8_WAIT_V(6); PG8_BAR;
    } else {
        PG8_STAGE(PG8_SB(0, 0), cB, voffB); PG8_STAGE(PG8_SA(0, 0), cA, voffA); PG8_STAGE(PG8_SB(0, 1), cB + hstep, voffB); PG8_STAGE(PG8_SA(0, 1), cA + hstep, voffA);
        if (wr == 1) PG8_BAR;
        PG8_WAIT_V(4); PG8_BAR;
        PG8_STAGE(PG8_SB(1, 0), cB + kstep, voffB); PG8_STAGE(PG8_SA(1, 0), cA + kstep, voffA); PG8_STAGE(PG8_SB(1, 1), cB + hstep + kstep, voffB);
        PG8_WAIT_V(6); PG8_BAR;
    }
    for (;;) {
        const bool has_next = S.next(ui + 1, nxt);
        const char* nA = has_next ? (const char*)g.A + (size_t)nxt.pm * tstep : cA; const char* nB = has_next ? (const char*)g.Bt + (size_t)nxt.pb * tstep : cB;
        for (int t = 0; t < nt; t += 2) {
            const bool last = (t == nt - 2);
            const char* a1 = cA + (size_t)(t + 1) * kstep;
            const char* a2 = last ? nA : cA + (size_t)(t + 2) * kstep; const char* b2 = last ? nB : cB + (size_t)(t + 2) * kstep;
            const char* a3 = a2 + kstep; const char* b3 = b2 + kstep;
            if (last && has_next) S.a_ready(nxt);
            if constexpr (SP2) {
            PG8_LDB(B0, 0, 0); PG8_LDB(B1, 0, 1); PG8_SCHED; PG8_LDA(At, 0, 0); PG8_STAGE(PG8_SA(1, 1), a1 + hstep, voffA);
            PG8_WAIT_V(8); PG8_WAIT_L(0); PG8_BAR; PG8_MMA(0, 0, At, B0); PG8_MMA(0, 1, At, B1); PG8_BAR; PG8_SCHED;
            PG8_LDA(At, 0, 1); PG8_STAGE(PG8_SB(0, 0), b2, voffB); PG8_STAGE(PG8_SB(0, 1), b2 + hstep, voffB); PG8_STAGE(PG8_SA(0, 0), a2, voffA);
            PG8_WAIT_V(8); PG8_WAIT_L(0); PG8_BAR; PG8_MMA(1, 0, At, B0); PG8_MMA(1, 1, At, B1); PG8_BAR; PG8_SCHED;
            PG8_LDB(B0, 1, 0); PG8_LDB(B1, 1, 1); PG8_SCHED; PG8_LDA(At, 1, 0); PG8_STAGE(PG8_SA(0, 1), a2 + hstep, voffA);
            PG8_WAIT_V(8); PG8_WAIT_L(0); PG8_BAR; PG8_MMA(0, 0, At, B0); PG8_MMA(0, 1, At, B1); PG8_BAR; PG8_SCHED;
            PG8_LDA(At, 1, 1); PG8_STAGE(PG8_SB(1, 0), b3, voffB); PG8_STAGE(PG8_SB(1, 1), b3 + hstep, voffB); PG8_STAGE(PG8_SA(1, 0), a3, voffA);
            PG8_WAIT_V(8); PG8_WAIT_L(0); PG8_BAR; PG8_MMA(1, 0, At, B0); PG8_MMA(1, 1, At, B1); PG8_BAR; PG8_SCHED;
            } else {
            PG8_LDB(B0, 0, 0); PG8_SCHED; PG8_LDA(At, 0, 0); PG8_STAGE(PG8_SA(1, 1), a1 + hstep, voffA);
            PG8_WAIT_L(8); PG8_BAR; PG8_WAIT_L(0); PG8_MMA(0, 0, At, B0); PG8_BAR; PG8_SCHED;
            PG8_LDB(B1, 0, 1); PG8_STAGE(PG8_SB(0, 0), b2, voffB);
            PG8_BAR; PG8_WAIT_L(0); PG8_MMA(0, 1, At, B1); PG8_BAR;
            PG8_LDA(At, 0, 1); PG8_STAGE(PG8_SA(0, 0), a2, voffA);
            PG8_BAR; PG8_WAIT_L(0); PG8_MMA(1, 0, At, B0); PG8_BAR; PG8_SCHED;
            PG8_STAGE(PG8_SB(0, 1), b2 + hstep, voffB);
            PG8_WAIT_V(6); PG8_BAR; PG8_MMA(1, 1, At, B1); PG8_BAR;
            PG8_LDB(B0, 1, 0); PG8_SCHED; PG8_LDA(At, 1, 0); PG8_STAGE(PG8_SA(0, 1), a2 + hstep, voffA);
            PG8_WAIT_L(8); PG8_BAR; PG8_WAIT_L(0); PG8_MMA(0, 0, At, B0); PG8_BAR; PG8_SCHED;
            PG8_LDB(B1, 1, 1); PG8_STAGE(PG8_SB(1, 0), b3, voffB);
            PG8_BAR; PG8_WAIT_L(0); PG8_MMA(0, 1, At, B1); PG8_BAR;
            PG8_LDA(At, 1, 1); PG8_STAGE(PG8_SA(1, 0), a3, voffA);
            PG8_BAR; PG8_WAIT_L(0); PG8_MMA(1, 0, At, B0); PG8_BAR; PG8_SCHED;
            PG8_STAGE(PG8_SB(1, 1), b3 + hstep, voffB);
            PG8_WAIT_V(6); PG8_BAR; PG8_MMA(1, 1, At, B1); PG8_BAR;
            }
        }
        if constexpr (ALIGN_EPI) { if (wr == 0) PG8_BAR; }
        if constexpr (FP8 == 1) asm volatile("s_nop 15\n\ts_nop 15\n\ts_nop 15\n\ts_nop 15\n\ts_nop 15" ::: "memory");
        if constexpr (!Epi::AFTER_DRAIN) { E(acc, cur, wr, wc, fr, fq); S.done(cur); }
        if constexpr (Sched::SIGNALS) {
            early_cnt += (cur.pm < S.early_rt) ? 1 : 0;
            if (ui == 8) { PG8_WAIT_V(0); PG8_BAR; if (tid == 0 && early_cnt > 0) S.signal(early_cnt); early_cnt = 0; }
        }
        if (!has_next) break;
#pragma unroll
        for (int a = 0; a < 2; ++a)
#pragma unroll
            for (int b = 0; b < 2; ++b)
#pragma unroll
                for (int m = 0; m < 4; ++m)
#pragma unroll
                    for (int n = 0; n < 2; ++n) acc[a][b][m][n] = (f32x4){0.f, 0.f, 0.f, 0.f};
        cur = nxt; cA = nA; cB = nB; ++ui;
        if constexpr (ALIGN_EPI) { if (wr == 1) PG8_BAR; }
    }
    PG8_WAIT_V(0);
    if constexpr (!ALIGN_EPI) { if (wr == 0) PG8_BAR; }
    PG8_BAR;
    if constexpr (Sched::SIGNALS) { if (tid == 0 && early_cnt > 0) S.signal(early_cnt); }
#undef PG8_SA
#undef PG8_SB
#undef PG8_STAGE
#undef PG8_LDA
#undef PG8_LD8
#undef PG8_LDB
#undef PG8_MMA
#undef PG8_CAT
#undef PG8_WAIT_V
#undef PG8_WAIT_L
#undef PG8_BAR
#undef PG8_SCHED
}
}

#define XB_TMO      128
#define XB_XCNT(j)  (256  + 64 * (j))
#define XB_XSUB(j)  (1280 + 64 * (j))
#define XB_XGEN(j)  (2304 + 64 * (j))
#define XB_TOP      3328
#define XB_TOPGEN   3392
#define XCD_BAR_WORDS 3456
#define XB_SPIN_CAP (1u << 22)
__device__ __forceinline__ unsigned xb_ld(unsigned* p)              { return __hip_atomic_load(p, __ATOMIC_RELAXED, __HIP_MEMORY_SCOPE_AGENT); }
__device__ __forceinline__ unsigned xb_add(unsigned* p, unsigned v) { return __hip_atomic_fetch_add(p, v, __ATOMIC_RELAXED, __HIP_MEMORY_SCOPE_AGENT); }
__device__ __forceinline__ unsigned xb_xcc_id() { return (unsigned)__builtin_amdgcn_s_getreg((3 << 11) | 20) & 0xFu; }
#define XB_SPIN(cond, bar) do { unsigned _sp = 0; while (cond) { __builtin_amdgcn_s_sleep(1); \
    if ((++_sp & 255u) == 0u) { if (xb_ld(&(bar)[XB_TMO])) break; if (_sp > XB_SPIN_CAP) { atomicAdd(&(bar)[XB_TMO], 1u); break; } } } } while (0)
struct XcdBarrier { unsigned* bar; unsigned x; volatile LAS unsigned* st; };
__device__ __forceinline__ XcdBarrier xcd_barrier_post(unsigned* bar, volatile LAS unsigned* st) {
    XcdBarrier b; b.bar = bar; b.x = xb_xcc_id(); b.st = st;
    if (threadIdx.x == 0) (void)xb_add(&bar[XB_XCNT(b.x)], 1u);
    return b;
}
__device__ __forceinline__ void xcd_barrier_complete(unsigned* bar, unsigned x, unsigned& nloc, unsigned& nx) {
    const unsigned G = gridDim.x * gridDim.y * gridDim.z;
    unsigned sum, cnt, mine, sp = 0u;
    for (;;) {
        sum = 0u; cnt = 0u; mine = 0u;
#pragma unroll
        for (unsigned j = 0; j < 16; ++j) { const unsigned c = xb_ld(&bar[XB_XCNT(j)]); sum += c; cnt += (c > 0u) ? 1u : 0u; mine = (j == x) ? c : mine; }
        if (sum == G) break;
        __builtin_amdgcn_s_sleep(1);
        if ((++sp & 255u) == 0u) { if (xb_ld(&bar[XB_TMO])) break; if (sp > XB_SPIN_CAP) { atomicAdd(&bar[XB_TMO], 1u); break; } }
    }
    nloc = mine > 0u ? mine : 1u; nx = cnt > 0u ? cnt : 1u;
}
__device__ __forceinline__ void xcd_barrier(const XcdBarrier& b) {
    asm volatile("s_waitcnt vmcnt(0)" ::: "memory");
    __syncthreads();
    if (threadIdx.x == 0) {
        unsigned* bar = b.bar;
        __builtin_amdgcn_s_waitcnt(0);
        unsigned nloc = b.st[0], nx = b.st[1];
        if (nloc == 0u) { xcd_barrier_complete(bar, b.x, nloc, nx); b.st[0] = nloc; b.st[1] = nx; }
        const unsigned old = xb_add(&bar[XB_XSUB(b.x)], 1u);
        const unsigned gen = old / nloc;
        if (old + 1u == (gen + 1u) * nloc) {
            __builtin_amdgcn_fence(__ATOMIC_RELEASE, "agent");
            asm volatile("s_waitcnt vmcnt(0)" ::: "memory");
            const unsigned og = xb_add(&bar[XB_TOP], 1u);
            const unsigned tg = og / nx;
            if (og + 1u == (tg + 1u) * nx) xb_add(&bar[XB_TOPGEN], 1u);
            else XB_SPIN(xb_ld(&bar[XB_TOPGEN]) == tg, bar);
            __builtin_amdgcn_fence(__ATOMIC_ACQUIRE, "agent");
            xb_add(&bar[XB_XGEN(b.x)], 1u);
            asm volatile("s_waitcnt vmcnt(0)" ::: "memory");
        } else {
            XB_SPIN(xb_ld(&bar[XB_XGEN(b.x)]) == gen, bar);
            __builtin_amdgcn_fence(__ATOMIC_ACQUIRE, "agent");
            asm volatile("s_waitcnt vmcnt(0)" ::: "memory");
        }
    }
    __syncthreads();
}

struct Frame {
    LAS unsigned char* lds;
    int tid, lane, wave, G, bx;
};
__device__ __forceinline__ Frame phase_frame(const Frame& F) { Frame R = F; int t = threadIdx.x; asm volatile("" : "+v"(t)); R.tid = t; R.lane = t & 63; R.wave = __builtin_amdgcn_readfirstlane(t >> 6); return R; }

struct TrDesc { const float* W; unsigned char* WT; const float* kgain; float nscale; int K, N, drow0, k0, n0, f8; };
__device__ __forceinline__ void tr_load(const TrDesc& d, float (&tv)[32], int lane) {
    const float* wp = d.W + (size_t)(d.k0 + (lane >> 5)) * d.N + d.n0 + (lane & 31);
#pragma unroll
    for (int i = 0; i < 32; ++i) tv[i] = wp[(size_t)(2 * i) * d.N];
}
__device__ __forceinline__ void tr_finish(const TrDesc& d, const float (&tv)[32], LAS float* scr, int lane) {
#pragma unroll
    for (int i = 0; i < 32; ++i) { float v = tv[i] * d.nscale; if (d.kgain) v *= d.kgain[d.k0 + 2 * i + (lane >> 5)]; scr[(2 * i + (lane >> 5)) * 33 + (lane & 31)] = v; }
    LDS_WAIT(); asm volatile("" ::: "memory");
    const int c = lane & 7;
#pragma unroll
    for (int j = 0; j < 4; ++j) { const int n = (lane >> 3) + 8 * j; const LAS float* s = scr + (8 * c) * 33 + n;
        if (d.f8) { u32x2 o; o.x = pk4_fp8(s[0 * 33], s[1 * 33], s[2 * 33], s[3 * 33]); o.y = pk4_fp8(s[4 * 33], s[5 * 33], s[6 * 33], s[7 * 33]);
            *(u32x2*)(d.WT + (size_t)(d.drow0 + n) * d.K + d.k0 + 8 * c) = o; }
        else { u32x4 o; o.x = pk2(s[0 * 33], s[1 * 33]); o.y = pk2(s[2 * 33], s[3 * 33]); o.z = pk2(s[4 * 33], s[5 * 33]); o.w = pk2(s[6 * 33], s[7 * 33]);
            *(u32x4*)(d.WT + ((size_t)(d.drow0 + n) * d.K + d.k0 + 8 * c) * 2) = o; } }
    LDS_WAIT(); asm volatile("" ::: "memory");
}
__device__ __forceinline__ int gu_row(int n0, int Fh) { return n0 < Fh ? ((n0 >> 7) * 256 + (n0 & 127)) : (((n0 - Fh) >> 7) * 256 + 128 + ((n0 - Fh) & 127)); }

struct Ptrs {
    const float *x, *mem, *anpre, *anpost, *fnpre, *fnpost, *w_in_a, *hlb, *hon, *w_in_b, *kvn, *w_kv, *memn, *w_mem_kv, *w_out, *w_gu, *w_dn, *w_router, *w_egu, *w_edn;
    float* out; unsigned char* ws;
};

__device__ __forceinline__ float row_rstd(const f32x4 (&a)[4]);
__device__ __forceinline__ void rms_row_to_bf16(const float* xrow, bf16_t* orow, const float* gain, int lane) {
    const f32x4* xr = (const f32x4*)xrow + lane;
    f32x4 v[4]; float s = 0.f;
#pragma unroll
    for (int j = 0; j < 4; ++j) { v[j] = xr[64 * j]; s += (v[j].x * v[j].x + v[j].y * v[j].y) + (v[j].z * v[j].z + v[j].w * v[j].w); }
    const float rstd = frsq(wave_sum(s) * (1.f / DM) + RMS_EPS);
    u32x2* o8 = (u32x2*)orow + lane;
#pragma unroll
    for (int j = 0; j < 4; ++j) { f32x4 gg = gain ? ((const f32x4*)gain)[lane + 64 * j] : (f32x4){1.f, 1.f, 1.f, 1.f};
        u32x2 w; w.x = pk2(v[j].x * rstd * gg.x, v[j].y * rstd * gg.y); w.y = pk2(v[j].z * rstd * gg.z, v[j].w * rstd * gg.w); o8[64 * j] = w; }
}

struct TrCounts {
    static constexpr int I_INA = (DM / 64) * (AW / 32), I_MKV = (DM / 64) * (512 / 32), I_OUT = (DM / 64) * (DM / 32), I_GU = (DM / 64) * (2 * DFF / 32), I_DN = (DFF / 64) * (DM / 32),
                         I_KV = (DM / 64) * (1536 / 32), I_INB = (DM / 64) * (DM / 32), I_EGU = (DM / 64) * (2 * DFE / 32), I_EDN = (DFE / 64) * (DM / 32);
    static constexpr int NEARLY = I_INA + 2 * I_MKV + 2 * I_OUT + I_GU + I_DN + I_KV + I_INB;
    static constexpr int NITEMS = NEARLY + NEXP * I_EGU + NEXP * I_EDN;
};
__device__ __forceinline__ TrDesc tr_decode(const Ptrs& P, int it) {
    using T = TrCounts; unsigned char* ws = P.ws; TrDesc d; d.kgain = nullptr; d.nscale = 1.f; d.f8 = 0;
    int r = it - (T::I_INA + 2 * T::I_MKV);
    if (r < 2 * T::I_OUT) { const int l = r / T::I_OUT; r -= l * T::I_OUT; const int nb = DM / 32; d.k0 = 64 * (r / nb); d.n0 = 32 * (r % nb);
        d.W = P.w_out + (size_t)l * DM * DM; d.K = DM; d.N = DM; d.WT = ws + (l ? WS_WOUT1 : WS_WOUT0); d.drow0 = d.n0; return d; } r -= 2 * T::I_OUT + T::I_GU;
    if (r < T::I_DN) { const int nb = DM / 32; d.k0 = 64 * (r / nb); d.n0 = 32 * (r % nb); d.W = P.w_dn; d.K = DFF; d.N = DM; d.WT = ws + WS_WDN; d.drow0 = d.n0; d.f8 = 1; d.nscale = FP8_SWDD; return d; } r -= T::I_DN + T::I_KV + T::I_INB;
    d.f8 = 1;
    if (r < NEXP * T::I_EGU) { const int e = r / T::I_EGU; r -= e * T::I_EGU; const int nb = 2 * DFE / 32; d.k0 = 64 * (r / nb); d.n0 = 32 * (r % nb);
        d.W = P.w_egu + (size_t)e * DM * 2 * DFE; d.K = DM; d.N = 2 * DFE; d.WT = ws + WS_WEGU + (size_t)e * 2 * DFE * DM; d.drow0 = gu_row(d.n0, DFE); d.nscale = FP8_SWGU; return d; } r -= NEXP * T::I_EGU;
    { const int e = r / T::I_EDN; r -= e * T::I_EDN; const int nb = DM / 32; d.k0 = 64 * (r / nb); d.n0 = 32 * (r % nb);
        d.W = P.w_edn + (size_t)e * DFE * DM; d.K = DFE; d.N = DM; d.WT = ws + WS_WEDN + (size_t)e * DM * DFE; d.drow0 = d.n0; d.nscale = FP8_SWDN; return d; }
}
__device__ __forceinline__ void convert_weights(const Frame& F, const Ptrs& P, int gw, int NGW) {
    LAS float* scr = (LAS float*)(F.lds + F.wave * 16384);
    const int it_lo = TrCounts::NEARLY, it_hi = TrCounts::NITEMS;
    for (int it = it_lo + gw; it < it_hi; it += 2 * NGW) {
        const bool two = it + NGW < it_hi;
        const TrDesc a = tr_decode(P, it), b = tr_decode(P, two ? it + NGW : it);
        float ta[32], tb[32];
        tr_load(a, ta, F.lane); if (two) tr_load(b, tb, F.lane);
        tr_finish(a, ta, scr, F.lane); if (two) tr_finish(b, tb, scr, F.lane);
    }
}
struct Q8Desc { const float* W; unsigned char* WT; const float* kgain; float nscale; int N, n0, drow0; float* wsc; };
constexpr int Q8_INA = AW / 32, Q8_MKV = 512 / 32, Q8_GU = 2 * DFF / 32, Q8_KV = 1536 / 32, Q8_INB = DM / 32, Q8_ITEMS = Q8_INA + 2 * Q8_MKV + Q8_GU + Q8_KV + Q8_INB;
__device__ __forceinline__ Q8Desc q8_decode(const Ptrs& P, int r) {
    unsigned char* ws = P.ws; float* const WSCp = (float*)(ws + WS_WSC); Q8Desc d; d.kgain = nullptr; d.nscale = 1.f;
    if (r < Q8_INA) { d.n0 = 32 * r; d.W = P.w_in_a; d.N = AW; d.WT = ws + WS_WINA; d.drow0 = d.n0; d.nscale = d.n0 >= 3072 ? C2 : 1.f; d.wsc = WSCp + WSC_INA; return d; } r -= Q8_INA;
    if (r < 2 * Q8_MKV) { const int l = r / Q8_MKV; r -= l * Q8_MKV; d.n0 = 32 * r; d.W = P.w_mem_kv + (size_t)l * DM * 512; d.N = 512; d.WT = ws + WS_WINA; d.drow0 = AW + l * 512 + d.n0; d.kgain = P.memn + l * DM; d.wsc = WSCp + WSC_INA; return d; } r -= 2 * Q8_MKV;
    if (r < Q8_GU) { d.n0 = 32 * r; d.W = P.w_gu; d.N = 2 * DFF; d.WT = ws + WS_WGU; d.drow0 = gu_row(d.n0, DFF); d.wsc = WSCp + WSC_GU; return d; } r -= Q8_GU;
    if (r < Q8_KV) { d.n0 = 32 * r; d.W = P.w_kv; d.N = 1536; d.WT = ws + WS_WKVB; d.drow0 = d.n0; d.kgain = P.kvn; d.wsc = WSCp + WSC_KVB; return d; } r -= Q8_KV;
    { d.n0 = 32 * r; d.W = P.w_in_b; d.N = DM; d.WT = ws + WS_WKVB; d.drow0 = 1536 + d.n0; d.kgain = P.anpre + DM; d.nscale = C2; d.wsc = WSCp + WSC_KVB; return d; }
}
__device__ __forceinline__ void q8_finish(const Q8Desc& q, const float (&tv)[32], int kbase, LAS float* scr, const LAS float* cfin, int lane) {
#pragma unroll
    for (int i = 0; i < 32; ++i) scr[(2 * i + (lane >> 5)) * 33 + (lane & 31)] = tv[i];
    LDS_WAIT(); asm volatile("" ::: "memory");
    const int c = lane & 7;
#pragma unroll
    for (int j = 0; j < 4; ++j) { const int n = (lane >> 3) + 8 * j; const LAS float* s = scr + (8 * c) * 33 + n; const float inv = 127.0f / cfin[n];
        u32x2 o; o.x = pk4_i8(s[0 * 33] * inv, s[1 * 33] * inv, s[2 * 33] * inv, s[3 * 33] * inv); o.y = pk4_i8(s[4 * 33] * inv, s[5 * 33] * inv, s[6 * 33] * inv, s[7 * 33] * inv);
        *(u32x2*)(q.WT + (size_t)(q.drow0 + n) * DM + kbase + 8 * c) = o; }
    LDS_WAIT(); asm volatile("" ::: "memory");
}
__device__ __forceinline__ void q8_item(const Frame& F, const Q8Desc& q, int parity) {
    const int lane = F.lane, kp = lane >> 5, nl = lane & 31, k0 = F.wave * 128;
    LAS float* scr = (LAS float*)(F.lds + F.wave * 16384);
    const float* wp = q.W + (size_t)(k0 + kp) * q.N + q.n0 + nl;
    float ga[32], gb[32];
    if (q.kgain) {
#pragma unroll
        for (int i = 0; i < 32; ++i) { ga[i] = q.kgain[k0 + 2 * i + kp]; gb[i] = q.kgain[k0 + 64 + 2 * i + kp]; }
    } else {
#pragma unroll
        for (int i = 0; i < 32; ++i) { ga[i] = 1.f; gb[i] = 1.f; }
    }
    float ta[32], tb[32];
#pragma unroll
    for (int i = 0; i < 32; ++i) ta[i] = wp[(size_t)(2 * i) * q.N];
#pragma unroll
    for (int i = 0; i < 32; ++i) tb[i] = wp[(size_t)(64 + 2 * i) * q.N];
    float m = 0.f;
#pragma unroll
    for (int i = 0; i < 32; ++i) { const float v = ta[i] * q.nscale * ga[i]; ta[i] = v; m = fmaxf(m, __builtin_fabsf(v)); }
#pragma unroll
    for (int i = 0; i < 32; ++i) { const float v = tb[i] * q.nscale * gb[i]; tb[i] = v; m = fmaxf(m, __builtin_fabsf(v)); }
    ((LAS float*)(F.lds + F.wave * 16384 + 12288 + parity * 256))[lane] = m;
    __syncthreads();
    float cm = 1e-30f;
#pragma unroll
    for (int w = 0; w < NWAVES; ++w) { const LAS float* cp = (const LAS float*)(F.lds + w * 16384 + 12288 + parity * 256); cm = fmaxf(cm, fmaxf(cp[nl], cp[nl + 32])); }
    LAS float* cfin = (LAS float*)(F.lds + F.wave * 16384 + 12288 + 512);
    if (lane < 32) cfin[lane] = cm;
    if (F.wave == 0 && lane < 32) q.wsc[q.drow0 + lane] = cm * (1.0f / 127.0f);
    q8_finish(q, ta, k0, scr, cfin, lane);
    q8_finish(q, tb, k0 + 64, scr, cfin, lane);
}
__device__ __forceinline__ void p0_rows4_load(const float* src, int m0, int lane, f32x4 (&v)[4][4]) {
#pragma unroll
    for (int r = 0; r < 4; ++r)
#pragma unroll
        for (int j = 0; j < 4; ++j) v[r][j] = ((const f32x4*)(src + (size_t)(m0 + r) * DM))[lane + 64 * j];
}
template <bool GAIN>
__device__ __forceinline__ void p0_rows4_finish(const f32x4 (&v)[4][4], const f32x4 (&gx)[4], unsigned char* dst, float* as, int m0, int lane) {
#pragma unroll
    for (int r = 0; r < 4; ++r) {
        const float rstd = row_rstd(v[r]);
        f32x4 uu[4];
#pragma unroll
        for (int j = 0; j < 4; ++j) { uu[j] = v[r][j] * rstd; if constexpr (GAIN) uu[j] = uu[j] * gx[j]; }
        quant_row_i8(uu, dst + (size_t)(m0 + r) * DM, as + m0 + r, lane);
    }
}
constexpr int P0_NB16 = 2 * TrCounts::I_OUT + TrCounts::I_DN, P0_G16 = P0_NB16 / 16, P0_XCH = MTOK / 32, P0_MCH = MROWS / 32, P0_WITEMS = Q8_ITEMS + P0_G16, P0_ITEMS = P0_WITEMS + P0_XCH + P0_MCH;
static_assert(P0_NB16 % 16 == 0, "bf16 wave items in groups of 16");
__device__ __forceinline__ void p0_prologue(const Frame& F, const Ptrs& P) {
    unsigned char* ws = P.ws;
    float* const ASA = (float*)(ws + WS_AS);
    int parity = 0, L = F.bx;
    for (; L < P0_WITEMS; L += F.G) {
        if (L < Q8_ITEMS) { const Q8Desc q = q8_decode(P, L); q8_item(F, q, parity); parity ^= 1; continue; }
        const int r = L - Q8_ITEMS;
        LAS float* scr = (LAS float*)(F.lds + F.wave * 16384);
        const int ia = r * 16 + F.wave, ib = ia + 8;
        const int base = TrCounts::I_INA + 2 * TrCounts::I_MKV;
        const TrDesc a = tr_decode(P, base + (ia < 2 * TrCounts::I_OUT ? ia : ia + TrCounts::I_GU)), b = tr_decode(P, base + (ib < 2 * TrCounts::I_OUT ? ib : ib + TrCounts::I_GU));
        float ta[32], tb[32];
        tr_load(a, ta, F.lane); tr_load(b, tb, F.lane);
        tr_finish(a, ta, scr, F.lane); tr_finish(b, tb, scr, F.lane);
    }
    f32x4 v[4][4], vn[4][4];
#define P0_LOAD(dst, LL) do { const int c_ = (LL) - P0_WITEMS; const bool isx_ = c_ < P0_XCH; p0_rows4_load(isx_ ? P.x : P.mem, 32 * (isx_ ? c_ : c_ - P0_XCH) + 4 * F.wave, F.lane, dst); } while (0)
#define P0_FIN(src, LL) do { const int c_ = (LL) - P0_WITEMS; const bool isx_ = c_ < P0_XCH; const int m0_ = 32 * (isx_ ? c_ : c_ - P0_XCH) + 4 * F.wave; \
        if (isx_) p0_rows4_finish<true>(src, gx, ws + WS_U, ASA, m0_, F.lane); else p0_rows4_finish<false>(src, gx, ws + WS_MEMN, ASA + MTOK, m0_, F.lane); } while (0)
    if (L < P0_ITEMS) {
        f32x4 gx[4];
#pragma unroll
        for (int j = 0; j < 4; ++j) gx[j] = ((const f32x4*)P.anpre)[F.lane + 64 * j];
        P0_LOAD(v, L);
        for (;;) {
            const int L1 = L + F.G; if (L1 < P0_ITEMS) P0_LOAD(vn, L1);
            P0_FIN(v, L);
            if (L1 >= P0_ITEMS) break;
            const int L2 = L1 + F.G; if (L2 < P0_ITEMS) P0_LOAD(v, L2);
            P0_FIN(vn, L1);
            if (L2 >= P0_ITEMS) break;
            L = L2;
        }
    }
#undef P0_LOAD
#undef P0_FIN
}

__device__ __forceinline__ void load_bf16_row(const bf16_t* arow, int lane, f32x4 (&a)[4]) {
    const u32x2* ar = (const u32x2*)arow + lane;
#pragma unroll
    for (int j = 0; j < 4; ++j) { const u32x2 w = ar[64 * j]; a[j] = (f32x4){bflo(w.x), bfhi(w.x), bflo(w.y), bfhi(w.y)}; }
}
__device__ __forceinline__ float row_rstd(const f32x4 (&a)[4]) {
    float s = 0.f;
#pragma unroll
    for (int j = 0; j < 4; ++j) s += (a[j].x * a[j].x + a[j].y * a[j].y) + (a[j].z * a[j].z + a[j].w * a[j].w);
    return frsq(wave_sum(s) * (1.f / DM) + RMS_EPS);
}
template <bool BASE16, bool Q8OUT>
__device__ __forceinline__ void norm_phase(const Frame& F, const bf16_t* A, const void* base, bf16_t* H, const float* g1, bf16_t* U, const float* g2, float* as_out) {
    f32x4 g1v[4], g2v[4];
#pragma unroll
    for (int j = 0; j < 4; ++j) { g1v[j] = ((const f32x4*)g1)[F.lane + 64 * j]; g2v[j] = g2 ? ((const f32x4*)g2)[F.lane + 64 * j] : (f32x4){1.f, 1.f, 1.f, 1.f}; }
    for (int i0 = 0; i0 < 16; i0 += 4) {
        const int m0 = F.bx * 128 + F.wave * 16 + i0;
        u32x2 ar[4][4]; f32x4 bs[4][4]; u32x2 bh[4][4];
#pragma unroll
        for (int r = 0; r < 4; ++r)
#pragma unroll
            for (int j = 0; j < 4; ++j) { ar[r][j] = ((const u32x2*)(A + (size_t)(m0 + r) * DM))[F.lane + 64 * j];
                if constexpr (BASE16) bh[r][j] = ((const u32x2*)((const bf16_t*)base + (size_t)(m0 + r) * DM))[F.lane + 64 * j];
                else bs[r][j] = ((const f32x4*)((const float*)base + (size_t)(m0 + r) * DM))[F.lane + 64 * j]; }
#pragma unroll
        for (int r = 0; r < 4; ++r) {
            const int m = m0 + r;
            f32x4 a[4];
#pragma unroll
            for (int j = 0; j < 4; ++j) a[j] = (f32x4){bflo(ar[r][j].x), bfhi(ar[r][j].x), bflo(ar[r][j].y), bfhi(ar[r][j].y)};
            const float rs = row_rstd(a);
            f32x4 h[4];
            u32x2* h8 = (u32x2*)(H + (size_t)m * DM) + F.lane;
#pragma unroll
            for (int j = 0; j < 4; ++j) { const f32x4 gg = g1v[j];
                f32x4 b; if constexpr (BASE16) b = (f32x4){bflo(bh[r][j].x), bfhi(bh[r][j].x), bflo(bh[r][j].y), bfhi(bh[r][j].y)}; else b = bs[r][j];
                h[j] = b + a[j] * rs * gg; u32x2 w; w.x = pk2(h[j].x, h[j].y); w.y = pk2(h[j].z, h[j].w); h8[64 * j] = w; }
            const float rh = row_rstd(h);
            if constexpr (Q8OUT) {
                f32x4 uu[4];
#pragma unroll
                for (int j = 0; j < 4; ++j) uu[j] = h[j] * rh * g2v[j];
                quant_row_i8(uu, (unsigned char*)U + (size_t)m * DM, as_out + m, F.lane);
            } else {
                u32x2* o8 = (u32x2*)(U + (size_t)m * DM) + F.lane;
#pragma unroll
                for (int j = 0; j < 4; ++j) { const f32x4 gg = g2v[j];
                    u32x2 w; w.x = pk2(h[j].x * rh * gg.x, h[j].y * rh * gg.y); w.y = pk2(h[j].z * rh * gg.z, h[j].w * rh * gg.w); o8[64 * j] = w; }
            }
        }
    }
}

constexpr float HG_US = 4.f;
constexpr int HG_RAWQ = 0, HG_RAWF = 18432, HG_RAWV = 36864;
constexpr int HG_OT = 0;
constexpr int HG_SC = 33792;
constexpr int HG_QD = 55296, HG_KI = 72704;
constexpr int HG_KST = 90112, HG_VT = 108544;
constexpr int HG_DEC = 126976;
typedef short s16x4 __attribute__((ext_vector_type(4)));
__device__ __forceinline__ s16x4 lds_tr16(const LAS unsigned char* p) { return __builtin_bit_cast(s16x4, __builtin_amdgcn_ds_read_tr16_b64_v4i16((LAS s16x4*)p)); }
constexpr int PA_GH = 0, PA_GL = 17408, PA_KH = 34816, PA_QH = 52224, PA_V = 69632;
__device__ __forceinline__ bf16x8 pa_trfrag(const LAS unsigned char* p) {
    const s16x4 lo = lds_tr16(p), hi = lds_tr16(p + 4 * 272);
    return (bf16x8){lo[0], lo[1], lo[2], lo[3], hi[0], hi[1], hi[2], hi[3]};
}
__device__ __forceinline__ void hgrnA_phase(const Frame& F, const Ptrs& P) {
    const int tid = F.tid, lane = F.lane, w = F.wave;
    LAS unsigned char* L = F.lds;
    const int sc0 = tid >> 4, sch = tid & 15;
    const int fr = lane & 15, g = lane >> 4;
    bf16_t* const GQD = (bf16_t*)(P.ws + WS_HGQD); bf16_t* const GOI = (bf16_t*)(P.ws + WS_HGOI); unsigned char* const GU = P.ws + WS_HGU; float* const GDEC = (float*)(P.ws + WS_HGDEC);
    const int NU = NB * 6 * 64;
    bf16x8 tri0, tri16, ones;
#pragma unroll
    for (int j = 0; j < 8; ++j) { tri0[j] = (8 * g + j <= fr) ? (short)0x3F80 : (short)0; tri16[j] = (8 * g + j <= fr + 16) ? (short)0x3F80 : (short)0; ones[j] = (short)0x3F80; }
    const int trl = (8 * g + ((lane & 15) >> 2)) * 272 + (lane & 3) * 8;
    u32x4 rq[2], rf[2], rv[2];
    {
        const int unit = F.bx; const int bh = unit >> 6, n = unit & 63, b = bh / 6, h = bh % 6;
        const bf16_t* PR = (const bf16_t*)(P.ws + WS_R1) + (size_t)(b * SEQ + n * 64) * AW;
#pragma unroll
        for (int i = 0; i < 2; ++i) { const bf16_t* rp = PR + (size_t)(sc0 + 32 * i) * AW + sch * 8;
            rq[i] = *(const u32x4*)(rp + h * 128); rf[i] = *(const u32x4*)(rp + 768 + h * 128); rv[i] = *(const u32x4*)(rp + 1536 + h * 128); }
    }
    for (int unit = F.bx; unit < NU; unit += F.G) {
        const int bh = unit >> 6, h = bh % 6;
        {
            float lb[8];
            { const f32x4 a00 = *(const f32x4*)(P.hlb + h * 128 + 8 * sch), a01 = *(const f32x4*)(P.hlb + h * 128 + 8 * sch + 4), a10 = *(const f32x4*)(P.hlb + HF + h * 128 + 8 * sch), a11 = *(const f32x4*)(P.hlb + HF + h * 128 + 8 * sch + 4);
#pragma unroll
              for (int e = 0; e < 4; ++e) { lb[e] = frcp(1.0f + fexp2(1.4426950408889634f * (a10[e] - a00[e]))); lb[4 + e] = frcp(1.0f + fexp2(1.4426950408889634f * (a11[e] - a01[e]))); } }
#pragma unroll
            for (int i = 0; i < 2; ++i) {
                const unsigned fw[4] = {rf[i].x, rf[i].y, rf[i].z, rf[i].w}, qw[4] = {rq[i].x, rq[i].y, rq[i].z, rq[i].w};
                unsigned gh[4], gl[4], kh[4], qh[4];
#pragma unroll
                for (int e2 = 0; e2 < 4; ++e2) {
                    float gg[2], kk[2], qq[2];
#pragma unroll
                    for (int o = 0; o < 2; ++o) {
                        const float fl = o ? bfhi(fw[e2]) : bflo(fw[e2]), ql = o ? bfhi(qw[e2]) : bflo(qw[e2]);
                        const float sg = sigmoidf_(fl); const float lbk = lb[2 * e2 + o];
                        gg[o] = flog2(lbk + (1.0f - lbk) * sg); kk[o] = (1.0f - lbk) * (1.0f - sg); qq[o] = ql * sigmoidf_(ql);
                    }
                    gh[e2] = pk2(gg[0], gg[1]);
                    gl[e2] = pk2(gg[0] - bflo(gh[e2]), gg[1] - bfhi(gh[e2]));
                    kh[e2] = pk2(kk[0], kk[1]); qh[e2] = pk2(qq[0], qq[1]);
                }
                const int off = (sc0 + 32 * i) * 272 + sch * 16;
                *(LAS u32x4*)(L + PA_GH + off) = (u32x4){gh[0], gh[1], gh[2], gh[3]}; *(LAS u32x4*)(L + PA_GL + off) = (u32x4){gl[0], gl[1], gl[2], gl[3]};
                *(LAS u32x4*)(L + PA_KH + off) = (u32x4){kh[0], kh[1], kh[2], kh[3]}; *(LAS u32x4*)(L + PA_QH + off) = (u32x4){qh[0], qh[1], qh[2], qh[3]};
                *(LAS u32x4*)(L + PA_V + off) = rv[i];
            }
        }
        LDS_BARRIER();
        if (unit + F.G < NU) {
            const int u2 = unit + F.G; const int bh2 = u2 >> 6, n2 = u2 & 63, b2 = bh2 / 6, h2 = bh2 % 6;
            const bf16_t* PR = (const bf16_t*)(P.ws + WS_R1) + (size_t)(b2 * SEQ + n2 * 64) * AW;
#pragma unroll
            for (int i = 0; i < 2; ++i) { const bf16_t* rp = PR + (size_t)(sc0 + 32 * i) * AW + sch * 8;
                rq[i] = *(const u32x4*)(rp + h2 * 128); rf[i] = *(const u32x4*)(rp + 768 + h2 * 128); rv[i] = *(const u32x4*)(rp + 1536 + h2 * 128); }
        }
        f32x4 bc[4];
        {
            bf16x8 gfh[2], gfl[2];
#pragma unroll
            for (int ks = 0; ks < 2; ++ks) { gfh[ks] = pa_trfrag(L + PA_GH + (32 * ks) * 272 + (16 * w) * 2 + trl); gfl[ks] = pa_trfrag(L + PA_GL + (32 * ks) * 272 + (16 * w) * 2 + trl); }
#pragma unroll
            for (int ct = 0; ct < 4; ++ct) bc[ct] = (f32x4){0.f, 0.f, 0.f, 0.f};
            bc[0] = __builtin_amdgcn_mfma_f32_16x16x32_bf16(gfh[0], tri0, bc[0], 0, 0, 0);  bc[0] = __builtin_amdgcn_mfma_f32_16x16x32_bf16(gfl[0], tri0, bc[0], 0, 0, 0);
            bc[1] = __builtin_amdgcn_mfma_f32_16x16x32_bf16(gfh[0], tri16, bc[1], 0, 0, 0); bc[1] = __builtin_amdgcn_mfma_f32_16x16x32_bf16(gfl[0], tri16, bc[1], 0, 0, 0);
            bc[2] = __builtin_amdgcn_mfma_f32_16x16x32_bf16(gfh[0], ones, bc[2], 0, 0, 0);  bc[2] = __builtin_amdgcn_mfma_f32_16x16x32_bf16(gfl[0], ones, bc[2], 0, 0, 0);
            bc[2] = __builtin_amdgcn_mfma_f32_16x16x32_bf16(gfh[1], tri0, bc[2], 0, 0, 0);  bc[2] = __builtin_amdgcn_mfma_f32_16x16x32_bf16(gfl[1], tri0, bc[2], 0, 0, 0);
            bc[3] = __builtin_amdgcn_mfma_f32_16x16x32_bf16(gfh[0], ones, bc[3], 0, 0, 0);  bc[3] = __builtin_amdgcn_mfma_f32_16x16x32_bf16(gfl[0], ones, bc[3], 0, 0, 0);
            bc[3] = __builtin_amdgcn_mfma_f32_16x16x32_bf16(gfh[1], tri16, bc[3], 0, 0, 0); bc[3] = __builtin_amdgcn_mfma_f32_16x16x32_bf16(gfl[1], tri16, bc[3], 0, 0, 0);
        }
        {
            f32x4 dec;
#pragma unroll
            for (int r = 0; r < 4; ++r) dec[r] = fexp2(__shfl(bc[3][r], (lane & 48) | 15));
            if (fr == 0) *(f32x4*)(GDEC + (size_t)unit * 128 + 16 * w + 4 * g) = dec;
#pragma unroll
            for (int ct = 0; ct < 4; ++ct) {
                const int off = (16 * ct + fr) * 272 + (16 * w + 4 * g) * 2;
                const u32x2 qh = *(const LAS u32x2*)(L + PA_QH + off), kh = *(const LAS u32x2*)(L + PA_KH + off);
                const float qv[4] = {bflo(qh.x), bfhi(qh.x), bflo(qh.y), bfhi(qh.y)}, kv[4] = {bflo(kh.x), bfhi(kh.x), bflo(kh.y), bfhi(kh.y)};
                float qd[4], ki[4], ks[4];
#pragma unroll
                for (int r = 0; r < 4; ++r) { const float e1 = fexp2(bc[ct][r]), e2 = fexp2(-bc[ct][r]); qd[r] = qv[r] * e1; ki[r] = kv[r] * e2; ks[r] = ki[r] * dec[r]; }
                *(LAS u32x2*)(L + PA_QH + off) = (u32x2){pk2(qd[0], qd[1]), pk2(qd[2], qd[3])};
                *(LAS u32x2*)(L + PA_KH + off) = (u32x2){pk2(ki[0], ki[1]), pk2(ki[2], ki[3])};
                *(LAS u32x2*)(L + PA_GH + off) = (u32x2){pk2(ks[0], ks[1]), pk2(ks[2], ks[3])};
            }
        }
        LDS_BARRIER();
#pragma unroll
        for (int i = 0; i < 2; ++i) { const int c = sc0 + 32 * i; *(u32x4*)(GQD + ((size_t)unit * 64 + c) * 128 + sch * 8) = *(const LAS u32x4*)(L + PA_QH + c * 272 + sch * 16); }
        {
            const int ci = w >> 1;
#pragma unroll
            for (int q = 0; q < 2; ++q) { const int si = 2 * (w & 1) + q;
                if (si <= ci) {
                    f32x4 d = (f32x4){0.f, 0.f, 0.f, 0.f};
#pragma unroll
                    for (int ks = 0; ks < 4; ++ks) {
                        const bf16x8 a = *(const LAS bf16x8*)(L + PA_KH + (16 * si + fr) * 272 + ks * 64 + g * 16);
                        const bf16x8 bb = *(const LAS bf16x8*)(L + PA_QH + (16 * ci + fr) * 272 + ks * 64 + g * 16);
                        d = __builtin_amdgcn_mfma_f32_16x16x32_bf16(a, bb, d, 0, 0, 0);
                    }
                    const int c = 16 * ci + fr, s0 = 16 * si + 4 * g;
#pragma unroll
                    for (int r = 0; r < 4; ++r) if (s0 + r > c) d[r] = 0.f;
                    *(LAS u32x2*)(L + PA_GL + c * 144 + s0 * 2) = (u32x2){pk2(d[0], d[1]), pk2(d[2], d[3])};
                } else {
                    const int c = 16 * ci + fr, s0 = 16 * si + 4 * g;
                    *(LAS u32x2*)(L + PA_GL + c * 144 + s0 * 2) = (u32x2){0u, 0u};
                }
            }
        }
        LDS_BARRIER();
        {
            const int j0 = 16 * w;
            bf16x8 vfrag[2];
#pragma unroll
            for (int ks = 0; ks < 2; ++ks) vfrag[ks] = pa_trfrag(L + PA_V + (32 * ks) * 272 + j0 * 2 + trl);
#pragma unroll
            for (int ct = 0; ct < 4; ++ct) {
                f32x4 o = (f32x4){0.f, 0.f, 0.f, 0.f};
#pragma unroll
                for (int ks = 0; ks < 2; ++ks) if (32 * ks <= 16 * ct + 15) {
                    const bf16x8 sc = *(const LAS bf16x8*)(L + PA_GL + (16 * ct + fr) * 144 + ks * 64 + g * 16);
                    o = __builtin_amdgcn_mfma_f32_16x16x32_bf16(vfrag[ks], sc, o, 0, 0, 0);
                }
                *(u32x2*)(GOI + ((size_t)unit * 64 + 16 * ct + fr) * 128 + j0 + 4 * g) = (u32x2){pk2(o[0], o[1]), pk2(o[2], o[3])};
            }
            unsigned uw[8];
#pragma unroll
            for (int kt = 0; kt < 8; ++kt) {
                f32x4 acc = (f32x4){0.f, 0.f, 0.f, 0.f};
#pragma unroll
                for (int cs = 0; cs < 2; ++cs) {
                    const bf16x8 a = pa_trfrag(L + PA_GH + (32 * cs) * 272 + (16 * kt) * 2 + trl);
                    acc = __builtin_amdgcn_mfma_f32_16x16x32_bf16(a, vfrag[cs], acc, 0, 0, 0);
                }
                uw[kt] = pk4_fp8s(acc[0] * HG_US, acc[1] * HG_US, acc[2] * HG_US, acc[3] * HG_US);
            }
            u32x4* up = (u32x4*)(GU + (((size_t)unit * 8 + w) * 64 + lane) * 32);
#pragma unroll
            for (int q = 0; q < 2; ++q) up[q] = (u32x4){uw[4 * q], uw[4 * q + 1], uw[4 * q + 2], uw[4 * q + 3]};
        }
        LDS_BARRIER();
    }
}

constexpr int HC_QD = 0;
constexpr int HC_DEC = 26112;
constexpr int HC_OT = 27648;
constexpr int HC_NG = 44544;
struct HcSet { u32x4 qp; float dp; u32x4 ur[2], oi, og; };
struct HcCtx { __amdgpu_buffer_rsrc_t rQD, rOI, rU, rDEC, rPR; bf16_t* MIX; unsigned vQD, vOI, vU, vDEC, vPR; int bh, b, h, r0, sc0, sch, c5, sub, fr, g, j0, tid, lane, w; };
__device__ __forceinline__ void abl16(u32x4& d, unsigned voff, __amdgpu_buffer_rsrc_t r, unsigned soff) { asm volatile("buffer_load_dwordx4 %0, %1, %2, %3 offen" : "=v"(d) : "v"(voff), "s"(r), "s"(soff) : "memory"); }
__device__ __forceinline__ void abl4(float& d, unsigned voff, __amdgpu_buffer_rsrc_t r, unsigned soff) { asm volatile("buffer_load_dword %0, %1, %2, %3 offen" : "=v"(d) : "v"(voff), "s"(r), "s"(soff) : "memory"); }
__device__ __forceinline__ void hc_load(const HcCtx& C, HcSet& d, int n) {
    const unsigned unit = (unsigned)(C.bh * 64 + n);
    abl16(d.qp, C.vQD, C.rQD, unit * 16384u);
    if (C.w < 2) abl4(d.dp, C.vDEC, C.rDEC, unit * 512u);
    abl16(d.ur[0], C.vU, C.rU, unit * 16384u); abl16(d.ur[1], C.vU + 16u, C.rU, unit * 16384u);
    abl16(d.oi, C.vOI, C.rOI, unit * 16384u);
    { const unsigned so = (unsigned)((C.b * SEQ + n * 64) * AW * 2); abl16(d.og, C.vPR, C.rPR, so); }
}
#define HC_PIN(d) "+v"((d).qp), "+v"((d).dp), "+v"((d).ur[0]), "+v"((d).ur[1]), "+v"((d).oi), "+v"((d).og)
__device__ __forceinline__ void hc_stage(const HcCtx& C, LAS unsigned char* L, const HcSet& d, int slot) {
    *(LAS u32x4*)(L + HC_QD + slot * 8704 + C.sc0 * 272 + C.sch * 16) = d.qp;
    if (C.w < 2) *(LAS float*)(L + HC_DEC + slot * 512 + C.tid * 4) = d.dp;
}
__device__ __forceinline__ void hc_step(const HcCtx& C, LAS unsigned char* L, f32x4 (&S)[8], int n, HcSet& cur, HcSet& nxt, HcSet& nx2, int slot, int slot_nxt) {
    if (n >= 64) return;
    if (n + 2 < 64) { hc_load(C, nx2, n + 2); asm volatile("s_waitcnt vmcnt(12)" : HC_PIN(cur)); }
    else asm volatile("s_waitcnt vmcnt(0)" : HC_PIN(cur));
    const int fr = C.fr, g = C.g, j0 = C.j0;
    {
        f32x4 o[2];
#pragma unroll
        for (int ct = 0; ct < 2; ++ct) o[ct] = (f32x4){0.f, 0.f, 0.f, 0.f};
#pragma unroll
        for (int ks = 0; ks < 4; ++ks) {
            u32x4 sa; sa.x = pk2(S[2 * ks][0], S[2 * ks][1]); sa.y = pk2(S[2 * ks][2], S[2 * ks][3]); sa.z = pk2(S[2 * ks + 1][0], S[2 * ks + 1][1]); sa.w = pk2(S[2 * ks + 1][2], S[2 * ks + 1][3]);
            const bf16x8 sfrag = __builtin_bit_cast(bf16x8, sa);
#pragma unroll
            for (int ct = 0; ct < 2; ++ct) {
                const u32x2 q0 = *(const LAS u32x2*)(L + HC_QD + slot * 8704 + (16 * ct + fr) * 272 + (32 * ks + 4 * g) * 2);
                const u32x2 q1 = *(const LAS u32x2*)(L + HC_QD + slot * 8704 + (16 * ct + fr) * 272 + (32 * ks + 16 + 4 * g) * 2);
                const bf16x8 qf = __builtin_bit_cast(bf16x8, (u32x4){q0.x, q0.y, q1.x, q1.y});
                o[ct] = __builtin_amdgcn_mfma_f32_16x16x32_bf16(sfrag, qf, o[ct], 0, 0, 0);
            }
        }
#pragma unroll
        for (int ct = 0; ct < 2; ++ct) *(LAS f32x4*)(L + HC_OT + (16 * ct + fr) * 528 + (j0 + 4 * g) * 4) = o[ct];
#pragma unroll
        for (int kt = 0; kt < 8; ++kt) {
            const f32x4 dc = *(const LAS f32x4*)(L + HC_DEC + slot * 512 + (16 * kt + 4 * g) * 4);
            const unsigned uu = (kt & 3) == 0 ? cur.ur[kt >> 2].x : (kt & 3) == 1 ? cur.ur[kt >> 2].y : (kt & 3) == 2 ? cur.ur[kt >> 2].z : cur.ur[kt >> 2].w;
            const f32x2 ulo = __builtin_amdgcn_cvt_pk_f32_fp8((int)uu, false), uhi = __builtin_amdgcn_cvt_pk_f32_fp8((int)uu, true);
            S[kt] = S[kt] * dc + (f32x4){ulo.x, ulo.y, uhi.x, uhi.y} * (1.0f / HG_US);
        }
    }
    LDS_BARRIER();
    {
        f32x4 ov[2]; float ss = 0.f;
        const unsigned oiw[4] = {cur.oi.x, cur.oi.y, cur.oi.z, cur.oi.w};
#pragma unroll
        for (int j = 0; j < 2; ++j) { ov[j] = *(const LAS f32x4*)(L + HC_OT + C.c5 * 528 + (8 * C.sub + 4 * j) * 4);
            ov[j] = ov[j] + (f32x4){bflo(oiw[2 * j]), bfhi(oiw[2 * j]), bflo(oiw[2 * j + 1]), bfhi(oiw[2 * j + 1])};
            ss += (ov[j].x * ov[j].x + ov[j].y * ov[j].y) + (ov[j].z * ov[j].z + ov[j].w * ov[j].w); }
        ss += swz_xor<1>(ss); ss += swz_xor<2>(ss); ss += swz_xor<4>(ss); ss += swz_xor<8>(ss);
        const float rs = frsq(ss * (1.f / 128.f) + RMS_EPS);
        const unsigned ogw[4] = {cur.og.x, cur.og.y, cur.og.z, cur.og.w};
        float r[8]; f32x4 ngv[2];
#pragma unroll
        for (int j = 0; j < 2; ++j) ngv[j] = *(const LAS f32x4*)(L + HC_NG + (8 * C.sub + 4 * j) * 4);
#pragma unroll
        for (int j = 0; j < 2; ++j)
#pragma unroll
            for (int e = 0; e < 4; ++e) { const unsigned wv = ogw[2 * j + (e >> 1)]; const float gg = (e & 1) ? bfhi(wv) : bflo(wv); r[4 * j + e] = ov[j][e] * rs * ngv[j][e] * gg * sigmoidf_(gg); }
        bf16_t* op = C.MIX + (size_t)(n * 64 + C.r0 + C.c5) * DM + C.h * 128 + 8 * C.sub;
        *(u32x4*)op = (u32x4){pk2(r[0], r[1]), pk2(r[2], r[3]), pk2(r[4], r[5]), pk2(r[6], r[7])};
    }
    if (n + 1 < 64) {
        if (n + 2 < 64) asm volatile("s_waitcnt vmcnt(7)" : HC_PIN(nxt)); else asm volatile("s_waitcnt vmcnt(0)" : HC_PIN(nxt));
        hc_stage(C, L, nxt, slot_nxt);
    }
    LDS_BARRIER();
}
__device__ __forceinline__ void hgrn_chain(const Frame& F, const Ptrs& P, int wgi) {
    HcCtx C;
    const int bh = wgi >> 1; const int b = bh / 6; C.bh = bh; C.b = b; C.h = bh % 6; C.r0 = 32 * (wgi & 1);
    C.tid = F.tid; C.lane = F.lane; C.w = F.wave;
    LAS unsigned char* L = F.lds;
    C.MIX = (bf16_t*)(P.ws + WS_MIX) + (size_t)b * SEQ * DM;
    C.rQD = __builtin_amdgcn_make_buffer_rsrc(P.ws + WS_HGQD, 0, 3072 * 16384, 0x00020000);
    C.rOI = __builtin_amdgcn_make_buffer_rsrc(P.ws + WS_HGOI, 0, 3072 * 16384, 0x00020000);
    C.rU = __builtin_amdgcn_make_buffer_rsrc(P.ws + WS_HGU, 0, 3072 * 16384, 0x00020000);
    C.rDEC = __builtin_amdgcn_make_buffer_rsrc(P.ws + WS_HGDEC, 0, 3072 * 512, 0x00020000);
    C.rPR = __builtin_amdgcn_make_buffer_rsrc(P.ws + WS_R1, 0, MTOK * AW * 2, 0x00020000);
    C.sc0 = C.tid >> 4; C.sch = C.tid & 15; C.c5 = C.tid >> 4; C.sub = C.tid & 15;
    C.fr = C.lane & 15; C.g = C.lane >> 4; C.j0 = 16 * C.w;
    C.vQD = (unsigned)(((C.r0 + C.sc0) * 128 + C.sch * 8) * 2); C.vOI = (unsigned)(((C.r0 + C.c5) * 128 + 8 * C.sub) * 2); C.vU = (unsigned)((C.w * 64 + C.lane) * 32); C.vDEC = (unsigned)(C.tid * 4);
    C.vPR = (unsigned)(((C.r0 + C.c5) * AW + 2304 + C.h * 128 + 8 * C.sub) * 2);
    if (C.tid < 128) *(LAS float*)(L + HC_NG + C.tid * 4) = P.hon[C.tid];
    f32x4 S[8];
#pragma unroll
    for (int kt = 0; kt < 8; ++kt) S[kt] = (f32x4){0.f, 0.f, 0.f, 0.f};
    HcSet d0, d1, d2;
    d0.dp = d1.dp = d2.dp = 0.f;
    d0.qp = d1.qp = d2.qp = (u32x4){0u, 0u, 0u, 0u};
    VM_WAIT();
    hc_load(C, d0, 0); hc_load(C, d1, 1);
    asm volatile("s_waitcnt vmcnt(5)" : HC_PIN(d0));
    hc_stage(C, L, d0, 0);
    LDS_BARRIER();
    for (int n = 0; n < 66; n += 6) {
        hc_step(C, L, S, n, d0, d1, d2, 0, 1);
        hc_step(C, L, S, n + 1, d1, d2, d0, 1, 2);
        hc_step(C, L, S, n + 2, d2, d0, d1, 2, 0);
        hc_step(C, L, S, n + 3, d0, d1, d2, 0, 1);
        hc_step(C, L, S, n + 4, d1, d2, d0, 1, 2);
        hc_step(C, L, S, n + 5, d2, d0, d1, 2, 0);
        asm volatile("s_waitcnt vmcnt(0)" : HC_PIN(d0), HC_PIN(d1), HC_PIN(d2));
    }
    VM_WAIT();
}

constexpr int MA_K = 0;
constexpr int MA_VT = 36864;
__device__ __forceinline__ void memattn_unit(const Frame& F, const bf16_t* Q, int qpitch, int qcol, const bf16_t* MKV, int kvcol, bf16_t* MIXo, int unit) {
    const int tb = unit >> 2, mh = unit & 3, b = tb >> 4;
    const int tid = F.tid, lane = F.lane, w = F.wave, r32 = lane & 31, hi = lane >> 5;
    LAS unsigned char* L = F.lds;
#pragma unroll
    for (int i = 0; i < 4; ++i) { const int p = tid + 512 * i, key = p >> 3, chn = p & 7;
        const bf16_t* src = MKV + (size_t)(b * MEML + key) * DM + kvcol + mh * 64 + chn * 8;
        const u32x4 kk = *(const u32x4*)src; const u32x4 vv = *(const u32x4*)(src + 256);
        *(LAS u32x4*)(L + MA_K + key * 144 + chn * 16) = kk;
        const unsigned vw[4] = {vv.x, vv.y, vv.z, vv.w};
#pragma unroll
        for (int e = 0; e < 4; ++e) { *(LAS unsigned short*)(L + MA_VT + (chn * 8 + 2 * e) * 520 + key * 2) = (unsigned short)(vw[e] & 0xffffu);
            *(LAS unsigned short*)(L + MA_VT + (chn * 8 + 2 * e + 1) * 520 + key * 2) = (unsigned short)(vw[e] >> 16); } }
    const int tok0 = tb * 256 + w * 32;
    bf16x8 qr[4];
#pragma unroll
    for (int s = 0; s < 4; ++s) qr[s] = *(const bf16x8*)(Q + (size_t)(tok0 + r32) * qpitch + qcol + mh * 64 + 16 * s + 8 * hi);
    LDS_BARRIER();
    f32x16 p[8];
#pragma unroll
    for (int kt = 0; kt < 8; ++kt) { p[kt] = f32x16{};
#pragma unroll
        for (int s = 0; s < 4; ++s) { const bf16x8 a = *(const LAS bf16x8*)(L + MA_K + (32 * kt + r32) * 144 + s * 32 + hi * 16);
            p[kt] = __builtin_amdgcn_mfma_f32_32x32x16_bf16(a, qr[s], p[kt], 0, 0, 0); } }
    float mx = -3.0e38f;
#pragma unroll
    for (int kt = 0; kt < 8; ++kt)
#pragma unroll
        for (int r = 0; r < 16; ++r) mx = fmaxf(mx, p[kt][r]);
    mx = fmaxf(mx, __shfl_xor(mx, 32));
    float sum = 0.f;
#pragma unroll
    for (int kt = 0; kt < 8; ++kt)
#pragma unroll
        for (int r = 0; r < 16; ++r) { p[kt][r] = fexp2(p[kt][r] - mx); sum += p[kt][r]; }
    sum += __shfl_xor(sum, 32);
    const float inv = frcp(sum);
    f32x16 o[2]; o[0] = f32x16{}; o[1] = f32x16{};
#pragma unroll
    for (int kt = 0; kt < 8; ++kt)
#pragma unroll
        for (int s2 = 0; s2 < 2; ++s2) {
            u32x4 pw; pw.x = pk2(p[kt][8 * s2 + 0] * inv, p[kt][8 * s2 + 1] * inv); pw.y = pk2(p[kt][8 * s2 + 2] * inv, p[kt][8 * s2 + 3] * inv);
            pw.z = pk2(p[kt][8 * s2 + 4] * inv, p[kt][8 * s2 + 5] * inv); pw.w = pk2(p[kt][8 * s2 + 6] * inv, p[kt][8 * s2 + 7] * inv);
            const bf16x8 pa = __builtin_bit_cast(bf16x8, pw);
#pragma unroll
            for (int dt = 0; dt < 2; ++dt) {
                const u32x2 v0 = *(const LAS u32x2*)(L + MA_VT + (32 * dt + r32) * 520 + (32 * kt + 16 * s2 + 4 * hi) * 2);
                const u32x2 v1 = *(const LAS u32x2*)(L + MA_VT + (32 * dt + r32) * 520 + (32 * kt + 16 * s2 + 8 + 4 * hi) * 2);
                const bf16x8 vb = __builtin_bit_cast(bf16x8, (u32x4){v0.x, v0.y, v1.x, v1.y});
                o[dt] = __builtin_amdgcn_mfma_f32_32x32x16_bf16(pa, vb, o[dt], 0, 0, 0);
            }
        }
#pragma unroll
    for (int dt = 0; dt < 2; ++dt)
#pragma unroll
        for (int r = 0; r < 16; ++r) MIXo[(size_t)(tok0 + crow(r, hi)) * DM + 768 + mh * 64 + 32 * dt + r32] = (bf16_t)f2bf(o[dt][r]);
    LDS_BARRIER();
}

constexpr int SB_SLOT = 19456;
constexpr int SB_VOFF = 9216;
constexpr int SB_NSLOT = 6;
constexpr int SB_FLAG = SB_NSLOT * SB_SLOT;
__device__ __forceinline__ int sb_unit_of(int L) { return (L >> 4) * 16 + (15 - (L & 15)); }
__device__ __forceinline__ void sb_prefetch_q(const Frame& F, const bf16_t* KVQ, int unit, bf16x8 (&q)[4]) {
    const int qb = unit & 15, hh = (unit >> 4) % 12, b = unit / 192;
    const int r32 = F.lane & 31, hi = F.lane >> 5;
    const bf16_t* base = KVQ + (size_t)b * SEQ * KVQW;
    const int tq = qb * 256 + F.wave * 32 + r32;
#pragma unroll
    for (int s = 0; s < 4; ++s) q[s] = *(const bf16x8*)(base + (size_t)tq * KVQW + 1536 + hh * 64 + 16 * s + 8 * hi);
}
__device__ __forceinline__ int sb_unit(const Frame& F, const bf16_t* KVQ, bf16_t* MIXo, int unit, const bf16x8 (&qpre)[4], int have_lo, int have_hi) {
    const int qb = unit & 15, hh = (unit >> 4) % 12, b = unit / 192;
    const int tid = F.tid, lane = F.lane, w = F.wave, r32 = lane & 31, hi = lane >> 5;
    LAS unsigned char* L = F.lds;
    const bf16_t* base = KVQ + (size_t)b * SEQ * KVQW;
    const int q0 = qb * 256 + w * 32;
    const int tq = q0 + r32;
    bf16x8 qr[4];
#pragma unroll
    for (int s = 0; s < 4; ++s) qr[s] = qpre[s];
    bf16x8 tri[2], ones;
#pragma unroll
    for (int s2 = 0; s2 < 2; ++s2)
#pragma unroll
        for (int j = 0; j < 8; ++j) { const int k = 16 * s2 + 8 * (j >> 2) + 4 * hi + (j & 3); tri[s2][j] = (k > r32) ? (short)0x3F80 : (short)0; }
#pragma unroll
    for (int j = 0; j < 8; ++j) ones[j] = (short)0x3F80;
    f32x16 o[2]; o[0] = f32x16{}; o[1] = f32x16{};
    float R = 0.f;
    const int skey = tid >> 3, schn = tid & 7;
    const bf16_t* srcb = base + (size_t)skey * KVQW + hh * 64 + schn * 8;
    const int kwr = skey * 144 + schn * 16, vwr = SB_VOFF + skey * 160 + schn * 16;
    const int vlane = SB_VOFF + (4 * hi + ((lane & 15) >> 2)) * 160 + ((lane >> 4) & 1) * 32 + (lane & 3) * 8;
    {
        u32x4 kk[4], vv[4];
#pragma unroll
        for (int i = 0; i < 4; ++i) { const int tt = 4 * qb + i; if (tt < have_lo || tt > have_hi) { const bf16_t* src = srcb + (size_t)(tt * 64) * KVQW; kk[i] = *(const u32x4*)src; vv[i] = *(const u32x4*)(src + 768); } }
#pragma unroll
        for (int i = 0; i < 4; ++i) { const int tt = 4 * qb + i; if (tt < have_lo || tt > have_hi) { const int sl = tt % SB_NSLOT; *(LAS u32x4*)(L + sl * SB_SLOT + kwr) = kk[i]; *(LAS u32x4*)(L + sl * SB_SLOT + vwr) = vv[i]; } }
    }
    LDS_BARRIER();
    const int jd = 4 * qb + (w >> 1);
    int slot = jd % SB_NSLOT;
    int pslot = (4 * qb + SB_NSLOT - 1) % SB_NSLOT;
    bool mydone = false;
    int lo_loaded = (have_lo <= have_hi && have_lo < 4 * qb) ? have_lo : 4 * qb;
    for (int st = 0; ; ++st) {
        const int tpre = 4 * qb - st - 1;
        u32x4 kreg, vreg;
        const bool need_pre = tpre >= 0 && (tpre < have_lo || tpre > have_hi);
        if (need_pre) { const bf16_t* src = srcb + (size_t)(tpre * 64) * KVQW; kreg = *(const u32x4*)src; vreg = *(const u32x4*)(src + 768); }
        const int t = jd - st;
        if (t >= 0 && !mydone) {
            const int k0 = 64 * t;
            const LAS unsigned char* Kb = L + slot * SB_SLOT;
            f32x16 p0 = f32x16{}, p1 = f32x16{};
#pragma unroll
            for (int s = 0; s < 4; ++s) {
                const bf16x8 a0 = *(const LAS bf16x8*)(Kb + r32 * 144 + s * 32 + hi * 16);
                const bf16x8 a1 = *(const LAS bf16x8*)(Kb + (32 + r32) * 144 + s * 32 + hi * 16);
                p0 = __builtin_amdgcn_mfma_f32_32x32x16_bf16(a0, qr[s], p0, 0, 0, 0);
                p1 = __builtin_amdgcn_mfma_f32_32x32x16_bf16(a1, qr[s], p1, 0, 0, 0);
            }
            float l0[16], l1[16];
            float csum = 0.f;
#pragma unroll
            for (int r = 0; r < 16; ++r) {
                const float z0 = fminf(p0[r], 80.f), z1 = fminf(p1[r], 80.f);
                const float sp0 = flog2(1.0f + fexp2(z0)), sp1 = flog2(1.0f + fexp2(z1));
                float a = -sp0, bq = -sp1, lb0 = z0 - sp0, lb1 = z1 - sp1;
                if (st == 0) { const int key0 = k0 + crow(r, hi); if (key0 >= tq) { a = 0.f; lb0 = -INFINITY; } if (key0 + 32 >= tq) { bq = 0.f; lb1 = -INFINITY; } }
                l0[r] = a; l1[r] = bq; p0[r] = lb0; p1[r] = lb1; csum += a + bq;
            }
            csum += __shfl_xor(csum, 32);
            bf16x8 x0[2], x1[2];
#pragma unroll
            for (int s2 = 0; s2 < 2; ++s2) {
                u32x4 t0, t1;
                t0.x = pk2(l0[8 * s2 + 0], l0[8 * s2 + 1]); t0.y = pk2(l0[8 * s2 + 2], l0[8 * s2 + 3]); t0.z = pk2(l0[8 * s2 + 4], l0[8 * s2 + 5]); t0.w = pk2(l0[8 * s2 + 6], l0[8 * s2 + 7]);
                t1.x = pk2(l1[8 * s2 + 0], l1[8 * s2 + 1]); t1.y = pk2(l1[8 * s2 + 2], l1[8 * s2 + 3]); t1.z = pk2(l1[8 * s2 + 4], l1[8 * s2 + 5]); t1.w = pk2(l1[8 * s2 + 6], l1[8 * s2 + 7]);
                x0[s2] = __builtin_bit_cast(bf16x8, t0); x1[s2] = __builtin_bit_cast(bf16x8, t1);
            }
            f32x16 y0, y1;
#pragma unroll
            for (int r = 0; r < 16; ++r) { y0[r] = R; y1[r] = R; }
            y0 = __builtin_amdgcn_mfma_f32_32x32x16_bf16(tri[0], x0[0], y0, 0, 0, 0);
            y0 = __builtin_amdgcn_mfma_f32_32x32x16_bf16(tri[1], x0[1], y0, 0, 0, 0);
            y0 = __builtin_amdgcn_mfma_f32_32x32x16_bf16(ones, x1[0], y0, 0, 0, 0);
            y0 = __builtin_amdgcn_mfma_f32_32x32x16_bf16(ones, x1[1], y0, 0, 0, 0);
            y1 = __builtin_amdgcn_mfma_f32_32x32x16_bf16(tri[0], x1[0], y1, 0, 0, 0);
            y1 = __builtin_amdgcn_mfma_f32_32x32x16_bf16(tri[1], x1[1], y1, 0, 0, 0);
#pragma unroll
            for (int r = 0; r < 16; ++r) { p0[r] = fexp2(p0[r] + y0[r]); p1[r] = fexp2(p1[r] + y1[r]); }
            R += csum;
            const LAS unsigned char* Vl = Kb + vlane;
#pragma unroll
            for (int half = 0; half < 2; ++half)
#pragma unroll
                for (int s2 = 0; s2 < 2; ++s2) {
                    u32x4 pw;
                    if (half == 0) { pw.x = pk2(p0[8 * s2 + 0], p0[8 * s2 + 1]); pw.y = pk2(p0[8 * s2 + 2], p0[8 * s2 + 3]); pw.z = pk2(p0[8 * s2 + 4], p0[8 * s2 + 5]); pw.w = pk2(p0[8 * s2 + 6], p0[8 * s2 + 7]); }
                    else { pw.x = pk2(p1[8 * s2 + 0], p1[8 * s2 + 1]); pw.y = pk2(p1[8 * s2 + 2], p1[8 * s2 + 3]); pw.z = pk2(p1[8 * s2 + 4], p1[8 * s2 + 5]); pw.w = pk2(p1[8 * s2 + 6], p1[8 * s2 + 7]); }
                    const bf16x8 pa = __builtin_bit_cast(bf16x8, pw);
#pragma unroll
                    for (int dt = 0; dt < 2; ++dt) {
                        const int kb = 32 * half + 16 * s2;
                        const s16x4 vlo = lds_tr16(Vl + kb * 160 + dt * 64), vhi = lds_tr16(Vl + (kb + 8) * 160 + dt * 64);
                        const bf16x8 vb = (bf16x8){vlo[0], vlo[1], vlo[2], vlo[3], vhi[0], vhi[1], vhi[2], vhi[3]};
                        o[dt] = __builtin_amdgcn_mfma_f32_32x32x16_bf16(pa, vb, o[dt], 0, 0, 0);
                    }
                }
        }
        if (t <= 0 || __all(R <= -150.f) != 0) mydone = true;
        if (lane == 0) *(LAS unsigned*)(L + SB_FLAG + ((st & 1) * 8 + w) * 4) = mydone ? 1u : 0u;
        if (need_pre) { *(LAS u32x4*)(L + pslot * SB_SLOT + kwr) = kreg; *(LAS u32x4*)(L + pslot * SB_SLOT + vwr) = vreg; }
        if (tpre >= 0 && tpre < lo_loaded) lo_loaded = tpre;
        LDS_BARRIER();
        { const u32x4 f0 = *(const LAS u32x4*)(L + SB_FLAG + (st & 1) * 32), f1 = *(const LAS u32x4*)(L + SB_FLAG + (st & 1) * 32 + 16);
          if ((f0.x & f0.y & f0.z & f0.w & f1.x & f1.y & f1.z & f1.w) != 0u) break; }
        slot = (slot == 0) ? SB_NSLOT - 1 : slot - 1;
        pslot = (pslot == 0) ? SB_NSLOT - 1 : pslot - 1;
    }
#pragma unroll
    for (int dt = 0; dt < 2; ++dt)
#pragma unroll
        for (int r = 0; r < 16; ++r) MIXo[(size_t)(b * SEQ + q0 + crow(r, hi)) * DM + hh * 64 + 32 * dt + r32] = (bf16_t)f2bf(o[dt][r]);
    LDS_BARRIER();
    return lo_loaded;
}
__device__ __forceinline__ void sb_phase(const Frame& F, const bf16_t* KVQ, bf16_t* MIXo) {
    bf16x8 qa[4], qb_[4];
    const int L0 = 6 * F.bx;
    sb_prefetch_q(F, KVQ, sb_unit_of(L0), qa);
    int have_lo = 1, have_hi = 0;
    for (int j = 0; j < 6; j += 2) {
        const int Lc = L0 + j;
        sb_prefetch_q(F, KVQ, sb_unit_of(Lc + 1), qb_);
        { const int u = sb_unit_of(Lc); const int lo = sb_unit(F, KVQ, MIXo, u, qa, have_lo, have_hi);
          if (((Lc + 1) >> 4) == (Lc >> 4)) { have_lo = lo; have_hi = lo + SB_NSLOT - 1; } else { have_lo = 1; have_hi = 0; } }
        if (j + 2 < 6) sb_prefetch_q(F, KVQ, sb_unit_of(Lc + 2), qa);
        { const int u = sb_unit_of(Lc + 1); const int lo = sb_unit(F, KVQ, MIXo, u, qb_, have_lo, have_hi);
          if (((Lc + 2) >> 4) == ((Lc + 1) >> 4)) { have_lo = lo; have_hi = lo + SB_NSLOT - 1; } else { have_lo = 1; have_hi = 0; } }
    }
}

struct Args { const float* in[20]; float* out; unsigned char* ws; };

__global__ void __launch_bounds__(NTHR, 2) yoco_fwd(Args args) {
    extern __shared__ __attribute__((aligned(16))) unsigned char lds_raw[];
    Frame F;
    F.lds = (LAS unsigned char*)lds_raw;
    F.tid = threadIdx.x; F.lane = F.tid & 63; F.wave = __builtin_amdgcn_readfirstlane(F.tid >> 6);
    F.G = gridDim.x; F.bx = blockIdx.x;
    Ptrs P;
    P.x = args.in[0]; P.mem = args.in[1]; P.anpre = args.in[2]; P.anpost = args.in[3]; P.fnpre = args.in[4]; P.fnpost = args.in[5];
    P.w_in_a = args.in[6]; P.hlb = args.in[7]; P.hon = args.in[8]; P.w_in_b = args.in[9]; P.kvn = args.in[10]; P.w_kv = args.in[11];
    P.memn = args.in[12]; P.w_mem_kv = args.in[13]; P.w_out = args.in[14]; P.w_gu = args.in[15]; P.w_dn = args.in[16]; P.w_router = args.in[17];
    P.w_egu = args.in[18]; P.w_edn = args.in[19]; P.out = args.out; P.ws = args.ws;
    unsigned char* ws = args.ws;
    unsigned* ctl = (unsigned*)(ws + WS_CTL);
    volatile LAS unsigned* MISC = (volatile LAS unsigned*)(F.lds + MISC_OFF);
    for (int u = F.tid; u < (LDS_BYTES - LDSCTL_OFF) / 4; u += NTHR) ((LAS unsigned*)(F.lds + LDSCTL_OFF))[u] = 0u;
    __syncthreads();
    XcdBarrier bar = xcd_barrier_post(ctl + CW_BAR, MISC + 8);
    {
        if (F.tid == 0) { const unsigned xcc = xb_xcc_id(); const unsigned rk = xb_add((unsigned*)ctl + CW_XRANK + xcc, 1u); MISC[12] = (xcc < 8u && rk < (unsigned)(F.G >> 3) && (F.G & 7) == 0) ? rk * 8u + xcc : 0xffffffffu; }
        __syncthreads();
        if (F.tid == 0 && MISC[12] == 0xffffffffu) __hip_atomic_store((unsigned*)ctl + CW_XRANK + 15, 1u, __ATOMIC_RELAXED, __HIP_MEMORY_SCOPE_AGENT);
    }
#define GRID_BAR() xcd_barrier(bar)

    bf16_t* const U = (bf16_t*)(ws + WS_U);
    bf16_t* const R1 = (bf16_t*)(ws + WS_R1);
    bf16_t* const MIX = (bf16_t*)(ws + WS_MIX);
    bf16_t* const MIXED = (bf16_t*)(ws + WS_MIXED);
    bf16_t* const MKV = (bf16_t*)(ws + WS_MKV);
    bf16_t* const H16 = (bf16_t*)(ws + WS_H16);

    { const Frame Fp = phase_frame(F); p0_prologue(Fp, P); }
    GRID_BAR();
    if (__hip_atomic_load((unsigned*)ctl + CW_XRANK + 15, __ATOMIC_RELAXED, __HIP_MEMORY_SCOPE_AGENT) == 0u) F.bx = (int)MISC[12];
    {
        pg8::Gemm g{U, (const bf16_t*)(ws + WS_WINA), MTOK, AW, DM / 2}; pg8::StaticOrder S; S.init(MTOK, AW, F.G, F.bx);
        S.ext_n = 32; S.ext_pm0 = MTOK / 256; S.ext_pn0 = AW / 256;
        pg8::EpiStoreQ E{R1, AW, (const float*)(ws + WS_AS), (const float*)(ws + WS_WSC) + WSC_INA, MKV, DM, MTOK / 256, AW / 256};
        pg8::gemm_phase<pg8::EpiStoreQ, pg8::StaticOrder, true, true, 2>(F.lds, g, S, E);
    }
    GRID_BAR();
    { const Frame Fp = phase_frame(F); hgrnA_phase(Fp, P); }
    { const Frame Fp = phase_frame(F); for (int u = F.bx; u < 512; u += F.G) memattn_unit(Fp, R1, AW, 3072, MKV, 0, MIX, u); }
    GRID_BAR();
    { const Frame Fp = phase_frame(F); if (F.bx < 96) hgrn_chain(Fp, P, ((((F.bx >> 4) << 3) | (F.bx & 7)) << 1) | ((F.bx >> 3) & 1));
      else convert_weights(Fp, P, (F.bx - 96) * NWAVES + Fp.wave, (F.G - 96) * NWAVES); }
    GRID_BAR();
    {
        pg8::Gemm g{MIX, (const bf16_t*)(ws + WS_WOUT0), MTOK, DM, DM}; pg8::StaticOrder S; S.init(MTOK, DM, F.G, F.bx);
        pg8::EpiStore E{MIXED, DM, 1.f, nullptr, 0, 0, 0};
        pg8::gemm_phase<pg8::EpiStore, pg8::StaticOrder, true, true>(F.lds, g, S, E);
    }
    GRID_BAR();
    { const Frame Fp = phase_frame(F); norm_phase<false, true>(Fp, MIXED, P.x, H16, P.anpost, U, P.fnpre, (float*)(ws + WS_AS + 256 * 1024)); }
#if STOP_AFTER >= 5
    GRID_BAR();
    {
        pg8::Gemm g{U, (const bf16_t*)(ws + WS_WGU), MTOK, 2 * DFF, DM / 2}; pg8::StaticOrder S; S.init(MTOK, 2 * DFF, F.G, F.bx);
        pg8::EpiSwiGLUQ8 E{(unsigned char*)R1, DFF, (const float*)(ws + WS_AS + 256 * 1024), (const float*)(ws + WS_WSC) + WSC_GU};
        pg8::gemm_phase<pg8::EpiSwiGLUQ8, pg8::StaticOrder, true, true, 2>(F.lds, g, S, E);
    }
    GRID_BAR();
    {
        pg8::Gemm g{R1, (const bf16_t*)(ws + WS_WDN), MTOK, DM, DFF / 2}; pg8::StaticOrder S; S.init(MTOK, DM, F.G, F.bx);
        pg8::EpiStore E{MIXED, DM, 1.0f / (FP8_SHD * FP8_SWDD), nullptr, 0, 0, 0};
        pg8::gemm_phase<pg8::EpiStore, pg8::StaticOrder, true, true, 1>(F.lds, g, S, E);
    }
    GRID_BAR();
    { const Frame Fp = phase_frame(F); norm_phase<true, true>(Fp, MIXED, H16, H16, P.fnpost, U, nullptr, (float*)(ws + WS_AS + 512 * 1024)); }
#endif
#if STOP_AFTER >= 8
    GRID_BAR();
    {
        pg8::Gemm g{U, (const bf16_t*)(ws + WS_WKVB), MTOK, KVQW, DM / 2}; pg8::StaticOrder S; S.init(MTOK, KVQW, F.G, F.bx);
        pg8::EpiStoreQ E{R1, KVQW, (const float*)(ws + WS_AS + 512 * 1024), (const float*)(ws + WS_WSC) + WSC_KVB, nullptr, 0, 0, 0};
        pg8::gemm_phase<pg8::EpiStoreQ, pg8::StaticOrder, true, true, 2>(F.lds, g, S, E);
    }
    GRID_BAR();
    {
        { const Frame Fp = phase_frame(F); sb_phase(Fp, R1, MIX); }
        { const Frame Fp = phase_frame(F); for (int u = F.bx; u < 512; u += F.G) memattn_unit(Fp, R1, KVQW, 2304, MKV, 512, MIX, u); }
    }
    GRID_BAR();
    {
        pg8::Gemm g{MIX, (const bf16_t*)(ws + WS_WOUT1), MTOK, DM, DM}; pg8::StaticOrder S; S.init(MTOK, DM, F.G, F.bx);
        pg8::EpiStore E{MIXED, DM, 1.f, nullptr, 0, 0, 0};
        pg8::gemm_phase<pg8::EpiStore, pg8::StaticOrder, true, true>(F.lds, g, S, E);
    }
    GRID_BAR();
    {
        const Frame Fq = phase_frame(F);
        LAS unsigned* lcnt = (LAS unsigned*)(F.lds + 32768);
        LAS float* WRt = (LAS float*)(F.lds);
        if (Fq.tid < 8) lcnt[Fq.tid] = 0u;
        for (int idx = Fq.tid; idx < DM * NEXP; idx += NTHR) WRt[(idx & 7) * DM + (idx >> 3)] = P.w_router[idx];
        __syncthreads();
        f32x4 g1v[4], g2v[4];
#pragma unroll
        for (int j = 0; j < 4; ++j) { g1v[j] = ((const f32x4*)(P.anpost + DM))[Fq.lane + 64 * j]; g2v[j] = ((const f32x4*)(P.fnpre + DM))[Fq.lane + 64 * j]; }
        for (int i0 = 0; i0 < 16; i0 += 4) {
          const int m0 = F.bx * 128 + Fq.wave * 16 + i0;
          u32x2 ar[4][4], bs[4][4];
#pragma unroll
          for (int r = 0; r < 4; ++r)
#pragma unroll
            for (int j = 0; j < 4; ++j) { ar[r][j] = ((const u32x2*)(MIXED + (size_t)(m0 + r) * DM))[Fq.lane + 64 * j]; bs[r][j] = ((const u32x2*)(H16 + (size_t)(m0 + r) * DM))[Fq.lane + 64 * j]; }
          f32x4 uu[4][4];
#pragma unroll
          for (int r = 0; r < 4; ++r) {
            const int m = m0 + r;
            f32x4 a[4];
#pragma unroll
            for (int j = 0; j < 4; ++j) a[j] = (f32x4){bflo(ar[r][j].x), bfhi(ar[r][j].x), bflo(ar[r][j].y), bfhi(ar[r][j].y)};
            const float rs = row_rstd(a);
            f32x4 h[4];
#pragma unroll
            for (int j = 0; j < 4; ++j) {
                h[j] = (f32x4){bflo(bs[r][j].x), bfhi(bs[r][j].x), bflo(bs[r][j].y), bfhi(bs[r][j].y)} + a[j] * rs * g1v[j];
                u32x2 hw; hw.x = pk2(h[j].x, h[j].y); hw.y = pk2(h[j].z, h[j].w); ((u32x2*)(H16 + (size_t)m * DM))[Fq.lane + 64 * j] = hw; }
            const float rh = row_rstd(h);
            unsigned* o4 = (unsigned*)((unsigned char*)U + (size_t)m * DM) + Fq.lane;
#pragma unroll
            for (int j = 0; j < 4; ++j) { uu[r][j] = h[j] * rh * g2v[j];
                o4[64 * j] = pk4_fp8s(uu[r][j].x * FP8_SX, uu[r][j].y * FP8_SX, uu[r][j].z * FP8_SX, uu[r][j].w * FP8_SX); }
          }
          float lg[4][8];
#pragma unroll
          for (int r = 0; r < 4; ++r)
#pragma unroll
            for (int e = 0; e < 8; ++e) lg[r][e] = 0.f;
#pragma unroll
          for (int j = 0; j < 4; ++j)
#pragma unroll
            for (int e = 0; e < 8; ++e) { const f32x4 w4 = *(const LAS f32x4*)(WRt + e * DM + 4 * Fq.lane + 256 * j);
#pragma unroll
                for (int r = 0; r < 4; ++r) lg[r][e] += uu[r][j].x * w4.x + uu[r][j].y * w4.y + uu[r][j].z * w4.z + uu[r][j].w * w4.w; }
#pragma unroll
          for (int r = 0; r < 4; ++r) {
            const int m = m0 + r;
#pragma unroll
            for (int e = 0; e < 8; ++e) lg[r][e] = wave_sum(lg[r][e]);
            int i0 = 0; float l0 = lg[r][0];
#pragma unroll
            for (int e = 1; e < 8; ++e) if (lg[r][e] > l0) { l0 = lg[r][e]; i0 = e; }
            int i1 = -1; float l1 = -3.0e38f;
#pragma unroll
            for (int e = 0; e < 8; ++e) if (e != i0 && lg[r][e] > l1) { l1 = lg[r][e]; i1 = e; }
            const float g0 = 1.0f / (1.0f + __expf(l1 - l0));
            if (Fq.lane == 0) {
                const unsigned r0 = __hip_atomic_fetch_add(lcnt + i0, 1u, __ATOMIC_RELAXED, __HIP_MEMORY_SCOPE_WORKGROUP);
                const unsigned r1 = __hip_atomic_fetch_add(lcnt + i1, 1u, __ATOMIC_RELAXED, __HIP_MEMORY_SCOPE_WORKGROUP);
                ((int4*)(ws + WS_META))[m] = make_int4(i0, i1, (int)r0, (int)r1);
                ((float2*)(ws + WS_GATE))[m] = make_float2(g0, 1.0f - g0);
            }
          }
        }
        __syncthreads();
        if (Fq.tid < 8) { const unsigned base = __hip_atomic_fetch_add(ctl + CW_GCNT + Fq.tid, lcnt[Fq.tid], __ATOMIC_RELAXED, __HIP_MEMORY_SCOPE_AGENT); ((unsigned*)(ws + WS_WGB))[F.bx * 8 + Fq.tid] = base; }
    }
#endif
#if STOP_AFTER >= 12
    GRID_BAR();
    int ts[NEXP + 1];
    {
        const Frame Fq = phase_frame(F);
        ts[0] = 0;
#pragma unroll
        for (int e = 0; e < NEXP; ++e) { const unsigned c = __hip_atomic_load(ctl + CW_GCNT + e, __ATOMIC_RELAXED, __HIP_MEMORY_SCOPE_AGENT); ts[e + 1] = ts[e] + (int)((c + 255u) >> 8); }
        bf16_t* XS = R1;
        for (int i0 = 0; i0 < 16; i0 += 4) {
            const int m0 = F.bx * 128 + Fq.wave * 16 + i0;
            int4 mt[4]; u32x4 v0[4];
#pragma unroll
            for (int r = 0; r < 4; ++r) { mt[r] = ((const int4*)(ws + WS_META))[m0 + r]; v0[r] = *((const u32x4*)((const unsigned char*)U + (size_t)(m0 + r) * DM) + Fq.lane); }
#pragma unroll
            for (int r = 0; r < 4; ++r) {
                int d0 = 0, d1 = 0;
#pragma unroll
                for (int e = 0; e < NEXP; ++e) { if (mt[r].x == e) d0 = ts[e] * 256; if (mt[r].y == e) d1 = ts[e] * 256; }
                d0 += (int)((const unsigned*)(ws + WS_WGB))[F.bx * 8 + mt[r].x] + mt[r].z;
                d1 += (int)((const unsigned*)(ws + WS_WGB))[F.bx * 8 + mt[r].y] + mt[r].w;
                *((u32x4*)((unsigned char*)XS + (size_t)d0 * DM) + Fq.lane) = v0[r]; *((u32x4*)((unsigned char*)XS + (size_t)d1 * DM) + Fq.lane) = v0[r];
                if (Fq.lane == 0) ((int2*)(ws + WS_DEST))[m0 + r] = make_int2(d0, d1);
            }
        }
    }
    GRID_BAR();
    const int nMt = ts[NEXP], RT = nMt > 256 ? nMt - 256 : 0, R_early = 4 * RT, R8 = (R_early + 7) & ~7;
    unsigned* const ecnt = ctl + CW_EARLY;
    {
        pg8::Gemm g{R1, (const bf16_t*)(ws + WS_WEGU), 0, 2 * DFE, DM / 2}; pg8::SignalOrder S; S.init(256, 2 * DFE, F.G, F.bx);
        S.nM = nMt; S.nwg = S.nM * S.nN; S.moe = 1; S.sp_q = 25; S.sp_R8 = ((F.G & 7) == 0 && R8 < F.G) ? R8 : 0; S.cnt = ecnt; S.early_rt = RT;
#pragma unroll
        for (int e = 0; e < NEXP; ++e) S.ts[e] = ts[e];
        pg8::EpiSwiGLU8 E{(unsigned char*)(ws + WS_EH), DFE, 1.0f / (FP8_SX * FP8_SWGU)};
        pg8::gemm_phase<pg8::EpiSwiGLU8, pg8::SignalOrder, true, true, 1>(F.lds, g, S, E);
    }
#pragma unroll 1
    for (int pass = 0; pass < 2; ++pass) {
        pg8::Gemm g{(const bf16_t*)(ws + WS_EH), (const bf16_t*)(ws + WS_WEDN), 0, DM, DFE / 2}; pg8::StaticOrder S; S.init(256, DM, F.G, F.bx);
        S.moe = 1;
#pragma unroll
        for (int e = 0; e < NEXP; ++e) S.ts[e] = ts[e];
        if (pass == 0) {
            S.one_on = 1; S.one_has = (F.bx < R_early) ? 1 : 0; S.one_pm = F.bx >> 2; S.one_pn = F.bx & 3;
            if (S.one_has) {
                if (F.tid == 0) { unsigned sp = 0; while (__hip_atomic_load(ecnt, __ATOMIC_RELAXED, __HIP_MEMORY_SCOPE_AGENT) < (unsigned)(28 * RT) && ++sp < (1u << 22)) __builtin_amdgcn_s_sleep(2);
                    __builtin_amdgcn_fence(__ATOMIC_ACQUIRE, "agent"); }
                __syncthreads();
            }
        } else { S.nM = nMt - RT; S.nwg = S.nM * S.nN; S.pm_off = RT; }
        pg8::EpiStore E{R1 + (size_t)XS_ROWS * DM / 2, DM, 1.0f / (FP8_SH * FP8_SWDN), nullptr, 0, 0, 0};
        pg8::gemm_phase<pg8::EpiStore, pg8::StaticOrder, true, true, 1>(F.lds, g, S, E);
        GRID_BAR();
    }
    {
        const Frame Fq = phase_frame(F);
        f32x4 g1v[4];
#pragma unroll
        for (int j = 0; j < 4; ++j) g1v[j] = ((const f32x4*)(P.fnpost + DM))[Fq.lane + 64 * j];
        const bf16_t* YS = R1 + (size_t)XS_ROWS * DM / 2;
        for (int i0 = 0; i0 < 16; i0 += 4) {
            const int m0 = F.bx * 128 + Fq.wave * 16 + i0;
            int2 d[4]; float2 gt[4];
#pragma unroll
            for (int r = 0; r < 4; ++r) { d[r] = ((const int2*)(ws + WS_DEST))[m0 + r]; gt[r] = ((const float2*)(ws + WS_GATE))[m0 + r]; }
            u32x2 ya[4][4], yb[4][4], bs[4][4];
#pragma unroll
            for (int r = 0; r < 4; ++r)
#pragma unroll
                for (int j = 0; j < 4; ++j) { ya[r][j] = ((const u32x2*)(YS + (size_t)d[r].x * DM))[Fq.lane + 64 * j]; yb[r][j] = ((const u32x2*)(YS + (size_t)d[r].y * DM))[Fq.lane + 64 * j];
                    bs[r][j] = ((const u32x2*)(H16 + (size_t)(m0 + r) * DM))[Fq.lane + 64 * j]; }
#pragma unroll
            for (int r = 0; r < 4; ++r) {
                f32x4 a[4];
#pragma unroll
                for (int j = 0; j < 4; ++j) a[j] = (f32x4){bflo(ya[r][j].x), bfhi(ya[r][j].x), bflo(ya[r][j].y), bfhi(ya[r][j].y)} * gt[r].x + (f32x4){bflo(yb[r][j].x), bfhi(yb[r][j].x), bflo(yb[r][j].y), bfhi(yb[r][j].y)} * gt[r].y;
                const float rs = row_rstd(a);
#pragma unroll
                for (int j = 0; j < 4; ++j) { const f32x4 gg = g1v[j];
                    ((f32x4*)(P.out + (size_t)(m0 + r) * DM))[Fq.lane + 64 * j] = (f32x4){bflo(bs[r][j].x), bfhi(bs[r][j].x), bflo(bs[r][j].y), bfhi(bs[r][j].y)} + a[j] * rs * gg; }
            }
        }
    }
#endif
}

extern "C" void kernel_launch(void* const* d_in, const int* in_sizes, int n_in, void* d_out, int out_size, void* d_ws, size_t ws_size, hipStream_t stream) {
    static int grid = 0;
    if (grid == 0) {
        if (n_in != 20 || out_size != MTOK * DM || ws_size < WS_END) { fprintf(stderr, "kernel_launch: unexpected shapes (n_in %d out %d ws %zu)\n", n_in, out_size, ws_size); grid = -1; return; }
        int dev = 0, cus = 0, per_cu = 0;
        if (hipGetDevice(&dev) != hipSuccess || hipDeviceGetAttribute(&cus, hipDeviceAttributeMultiprocessorCount, dev) != hipSuccess) { grid = -1; return; }
        if (hipFuncSetAttribute((const void*)yoco_fwd, hipFuncAttributeMaxDynamicSharedMemorySize, LDS_BYTES) != hipSuccess) { fprintf(stderr, "kernel_launch: hipFuncSetAttribute failed\n"); grid = -1; return; }
        if (hipOccupancyMaxActiveBlocksPerMultiprocessor(&per_cu, (const void*)yoco_fwd, NTHR, LDS_BYTES) != hipSuccess || per_cu < 1) { fprintf(stderr, "kernel_launch: occupancy query says %d\n", per_cu); }
        (void)hipGetLastError();
        if (cus < 256) { fprintf(stderr, "kernel_launch: need 256 CUs, have %d\n", cus); grid = -1; return; }
        grid = 256;
    }
    if (grid < 0) return;
    if (hipMemsetAsync((char*)d_ws + WS_CTL, 0, CTL_ZERO_BYTES, stream) != hipSuccess) return;
    Args a{};
    for (int i = 0; i < 20; ++i) a.in[i] = (const float*)d_in[i];
    a.out = (float*)d_out; a.ws = (unsigned char*)d_ws;
    hipLaunchKernelGGL(yoco_fwd, dim3(grid), dim3(NTHR), LDS_BYTES, stream, a);
}
```

```cpp
#include <hip/hip_runtime.h>
#include <cstdio>
#include <cstdint>

#ifndef STOP_AFTER
#define STOP_AFTER 99
#endif

#define LAS __attribute__((address_space(3)))
#define GAS __attribute__((address_space(1)))
typedef unsigned short bf16_t;
typedef short bf16x8 __attribute__((ext_vector_type(8)));
typedef float f32x4 __attribute__((ext_vector_type(4)));
typedef float f32x16 __attribute__((ext_vector_type(16)));
typedef float f32x2 __attribute__((ext_vector_type(2)));
typedef unsigned u32x4 __attribute__((ext_vector_type(4)));
typedef unsigned u32x2 __attribute__((ext_vector_type(2)));
typedef __bf16 bf16x2_t __attribute__((ext_vector_type(2)));

constexpr int NB = 8, SEQ = 4096, DM = 1024, MTOK = NB * SEQ;
constexpr int MEML = 256, MROWS = NB * MEML;
constexpr int AW = 3328, HF = 768, DFF = 2816, NEXP = 8, DFE = 3584;
constexpr int KVQW = 2560;
constexpr int XS_ROWS = 2 * MTOK + NEXP * 256;
constexpr float RMS_EPS = 1e-6f;
constexpr float C2 = 0.125f * 1.4426950408889634f;
constexpr int NWAVES = 8, NTHR = 512;

constexpr size_t MiB = 1u << 20;
constexpr size_t WS_CTL = 0, CTL_ZERO_BYTES = 128 * 1024;
constexpr size_t WS_MEMN = 395 * MiB + 32 * MiB;
constexpr size_t WS_MEMN_OLD_UNUSED = 459 * MiB;
constexpr size_t WS_AS = 1 * MiB;
constexpr size_t WS_WSC = 2 * MiB;
constexpr int WSC_INA = 0, WSC_GU = 4352, WSC_KVB = 9984, WSC_N = 12544;
constexpr size_t WS_MKV = 5 * MiB;
constexpr size_t WS_META = 9 * MiB;
constexpr size_t WS_GATE = WS_META + 512 * 1024, WS_DEST = WS_GATE + 256 * 1024, WS_WGB = WS_DEST + 256 * 1024;
constexpr size_t WS_WOUT1 = 12 * MiB;
constexpr size_t WS_WKVB = 14 * MiB;
constexpr size_t WS_WEGU = 19 * MiB;
constexpr size_t WS_WEDN = 131 * MiB;
constexpr size_t WS_R1 = 187 * MiB;
constexpr size_t WS_EH = 395 * MiB;
constexpr size_t WS_U = 395 * MiB;
constexpr size_t WS_MIX = 459 * MiB;
constexpr size_t WS_MIXED = 523 * MiB;
constexpr size_t WS_WINA = 587 * MiB;
constexpr size_t WS_WMKV = 587 * MiB + (size_t)3328 * 1024;
constexpr size_t WS_WMKV_OLD_UNUSED = 587 * MiB + (size_t)3328 * 1024 * 2;
constexpr size_t WS_WOUT0 = 596 * MiB;
constexpr size_t WS_WGU = 598 * MiB;
constexpr size_t WS_WDN = 609 * MiB;
constexpr size_t WS_HGQD = 640 * MiB;
constexpr size_t WS_HGOI = 688 * MiB;
constexpr size_t WS_HGU = 736 * MiB;
constexpr size_t WS_HGDEC = 832 * MiB;
constexpr size_t WS_H16 = 640 * MiB;
constexpr size_t WS_END = 857 * MiB;
static_assert(WS_EH + (size_t)XS_ROWS * DFE * 2 <= WS_END, "EH fits");
static_assert(WS_R1 + (size_t)MTOK * AW * 2 <= WS_EH, "R1 fits");
constexpr int CW_BAR = 4096;
constexpr int CW_GCNT = 16384;
constexpr int CW_EARLY = 16448 + 64;
constexpr int CW_XRANK = 16448;
static_assert((CW_EARLY + 16) * 4 <= (int)CTL_ZERO_BYTES, "control words inside the zeroed region");

constexpr int RING_BYTES = 131072;
constexpr int LDSCTL_OFF = RING_BYTES, MISC_OFF = LDSCTL_OFF + 320;
constexpr int LDS_BYTES = 147456;

__device__ __forceinline__ unsigned f2bf(float f) { unsigned u = __builtin_bit_cast(unsigned, f); return (u + 0x7fffu + ((u >> 16) & 1u)) >> 16; }
__device__ __forceinline__ unsigned pk2(float lo, float hi) { f32x2 v = {lo, hi}; bf16x2_t b = __builtin_convertvector(v, bf16x2_t); return __builtin_bit_cast(unsigned, b); }
__device__ __forceinline__ float bflo(unsigned w) { return __builtin_bit_cast(float, w << 16); }
__device__ __forceinline__ float bfhi(unsigned w) { return __builtin_bit_cast(float, w & 0xffff0000u); }
__device__ __forceinline__ float bf1(unsigned short s) { return __builtin_bit_cast(float, (unsigned)s << 16); }
__device__ __forceinline__ float wave_sum(float v);
__device__ __forceinline__ float fexp2(float x) { return __builtin_amdgcn_exp2f(x); }
__device__ __forceinline__ float flog2(float x) { return __builtin_amdgcn_logf(x); }
__device__ __forceinline__ float frcp(float x) { return __builtin_amdgcn_rcpf(x); }
__device__ __forceinline__ float frsq(float x) { return __builtin_amdgcn_rsqf(x); }
template <int X> __device__ __forceinline__ float swz_xor(float v) { return __builtin_bit_cast(float, __builtin_amdgcn_ds_swizzle(__builtin_bit_cast(int, v), (X << 10) | 0x1F)); }
__device__ __forceinline__ float wave_sum(float v) {
    v += swz_xor<1>(v); v += swz_xor<2>(v); v += swz_xor<4>(v); v += swz_xor<8>(v); v += swz_xor<16>(v);
    const float lo = __builtin_bit_cast(float, __builtin_amdgcn_readlane(__builtin_bit_cast(int, v), 0)), hi = __builtin_bit_cast(float, __builtin_amdgcn_readlane(__builtin_bit_cast(int, v), 32));
    return lo + hi;
}
__device__ __forceinline__ float sigmoidf_(float x) { return frcp(1.0f + fexp2(-1.4426950408889634f * x)); }
typedef int i32x4 __attribute__((ext_vector_type(4)));
typedef int i32x8 __attribute__((ext_vector_type(8)));
__device__ __forceinline__ float sat8(float x) { return __builtin_amdgcn_fmed3f(x, -448.f, 448.f); }
__device__ __forceinline__ unsigned pk4_fp8s(float a, float b, float c, float d) { int w = 0; w = __builtin_amdgcn_cvt_pk_fp8_f32(sat8(a), sat8(b), w, false); w = __builtin_amdgcn_cvt_pk_fp8_f32(sat8(c), sat8(d), w, true); return (unsigned)w; }
__device__ __forceinline__ unsigned char fp8_1(float x) { return (unsigned char)(__builtin_amdgcn_cvt_pk_fp8_f32(sat8(x), 0.f, 0, false) & 0xff); }
__device__ __forceinline__ unsigned pk4_fp8(float a, float b, float c, float d) { int w = 0; w = __builtin_amdgcn_cvt_pk_fp8_f32(a, b, w, false); w = __builtin_amdgcn_cvt_pk_fp8_f32(c, d, w, true); return (unsigned)w; }
constexpr float FP8_SX = 8.f, FP8_SH = 8.f, FP8_SWGU = 32.f, FP8_SWDN = 64.f, FP8_SHD = 8.f, FP8_SWDD = 64.f, FP8_SM = 16.f, FP8_SWO = 64.f;
__device__ __forceinline__ float wave_max(float v) {
    v = fmaxf(v, swz_xor<1>(v)); v = fmaxf(v, swz_xor<2>(v)); v = fmaxf(v, swz_xor<4>(v)); v = fmaxf(v, swz_xor<8>(v)); v = fmaxf(v, swz_xor<16>(v));
    const float lo = __builtin_bit_cast(float, __builtin_amdgcn_readlane(__builtin_bit_cast(int, v), 0)), hi = __builtin_bit_cast(float, __builtin_amdgcn_readlane(__builtin_bit_cast(int, v), 32));
    return fmaxf(lo, hi);
}
__device__ __forceinline__ unsigned pk4_i8(float a, float b, float c, float d) {
    const int ia = (int)__builtin_rintf(__builtin_amdgcn_fmed3f(a, -127.f, 127.f)), ib = (int)__builtin_rintf(__builtin_amdgcn_fmed3f(b, -127.f, 127.f)),
              ic = (int)__builtin_rintf(__builtin_amdgcn_fmed3f(c, -127.f, 127.f)), id = (int)__builtin_rintf(__builtin_amdgcn_fmed3f(d, -127.f, 127.f));
    return (unsigned)(ia & 0xff) | ((unsigned)(ib & 0xff) << 8) | ((unsigned)(ic & 0xff) << 16) | ((unsigned)id << 24);
}
__device__ __forceinline__ void quant_row_i8(const f32x4 (&uu)[4], unsigned char* qrow, float* as_slot, int lane) {
    float am = 0.f;
#pragma unroll
    for (int j = 0; j < 4; ++j) am = fmaxf(fmaxf(am, fmaxf(__builtin_fabsf(uu[j].x), __builtin_fabsf(uu[j].y))), fmaxf(__builtin_fabsf(uu[j].z), __builtin_fabsf(uu[j].w)));
    am = fmaxf(wave_max(am), 1e-20f);
    const float inv = 127.0f / am;
    unsigned* o4 = (unsigned*)qrow + lane;
#pragma unroll
    for (int j = 0; j < 4; ++j) o4[64 * j] = pk4_i8(uu[j].x * inv, uu[j].y * inv, uu[j].z * inv, uu[j].w * inv);
    if (lane == 0) *as_slot = am * (1.0f / 127.0f);
}
__device__ __forceinline__ int crow(int r, int hi) { return (r & 3) + 8 * (r >> 2) + 4 * hi; }
#define LDS_WAIT() asm volatile("s_waitcnt lgkmcnt(0)" ::: "memory")
#define VM_WAIT() asm volatile("s_waitcnt vmcnt(0)" ::: "memory")
#define LDS_BARRIER() do { asm volatile("s_waitcnt lgkmcnt(0)" ::: "memory"); __builtin_amdgcn_s_barrier(); asm volatile("" ::: "memory"); } while (0)

namespace pg8 {
#define PG8_LAS __attribute__((address_space(3)))
constexpr int BM = 256, BK = 64, HALF = 128, HTB = HALF * BK * 2, STAGE_BYTES = 8 * HTB, NXCD = 8, WGM = 4;
__host__ __device__ __forceinline__ int lds_byte(int r, int c) { const int st = (r >> 4) * 2 + (c >> 5), rr = r & 15, cc = c & 31, ob = rr * 64 + cc * 2; return st * 1024 + (ob ^ (((ob >> 9) & 1) << 5)); }
__host__ __device__ __forceinline__ void stage_rc(int b, int& R, int& C) { const int st = b / 1024, sb = b % 1024, swz = sb ^ (((sb >> 9) & 1) << 5); R = (st >> 1) * 16 + swz / 64; C = (st & 1) * 32 + (swz % 64) / 2; }
__host__ __device__ __forceinline__ int perm32(int rho) { const int n = rho >> 4, i = rho & 15; return 8 * (i >> 2) + 4 * n + (i & 3); }

struct Unit { int pm, pn, pb; };
struct Gemm { const bf16_t* A; const bf16_t* Bt; int M, N, K; };

struct StaticOrder {
    static constexpr bool SIGNALS = false;
    int nM, nN, nwg, G, c;
    int ts[NEXP];
    int moe;
    int ext_n, ext_pm0, ext_pn0;
    int sp_q, sp_R8;
    int pm_off;
    int one_on, one_has, one_pm, one_pn;
    __device__ void init(int M, int N, int G_, int c_) { nM = M / BM; nN = N / BM; nwg = nM * nN; G = G_; c = c_; moe = 0; ext_n = 0; ext_pm0 = 0; ext_pn0 = 0; sp_q = 0; sp_R8 = 0; pm_off = 0; one_on = 0; one_has = 0; one_pm = 0; one_pn = 0;
#pragma unroll
        for (int e = 0; e < NEXP; ++e) ts[e] = 0; }
    __device__ __forceinline__ bool next(int i, Unit& u) const {
        int pm, pn;
        if (one_on) { if (i > 0 || !one_has) return false; pm = one_pm; pn = one_pn; }
        else {
            long L = (long)i * G + c;
            if (sp_R8 > 0 && i >= sp_q) { if (c < sp_R8) return false; L = (long)sp_q * G + (long)(i - sp_q) * (G - sp_R8) + (c - sp_R8); }
            if (L >= nwg + ext_n) return false;
            if (L >= nwg) { const int j = (int)L - nwg; pm = ext_pm0 + (j >> 2); pn = ext_pn0 + (j & 3); }
            else {
                int wgid = (int)L; { const int q = nwg / NXCD, r = nwg % NXCD, xcd = wgid % NXCD, off = wgid / NXCD; wgid = (xcd < r ? xcd * (q + 1) : r * (q + 1) + (xcd - r) * q) + off; }
                const int nig = WGM * nN, gid = wgid / nig, fm = gid * WGM, gsz = (nM - fm) < WGM ? (nM - fm) : WGM;
                pm = fm + ((wgid % nig) % gsz) + pm_off; pn = (wgid % nig) / gsz;
            }
        }
        int pb = pn;
        if (moe) { int e = 0;
#pragma unroll
            for (int j = 1; j < NEXP; ++j) e += (pm >= ts[j]) ? 1 : 0;
            pb = e * nN + pn; }
        u.pm = pm; u.pn = pn; u.pb = pb;
        return true;
    }
    __device__ __forceinline__ void a_ready(const Unit&) const {}
    __device__ __forceinline__ void done(const Unit&) const {}
};
struct SignalOrder : StaticOrder {
    static constexpr bool SIGNALS = true;
    unsigned* cnt; int early_rt;
    __device__ __forceinline__ void signal(int n) const { __builtin_amdgcn_fence(__ATOMIC_RELEASE, "agent"); (void)__hip_atomic_fetch_add(cnt, (unsigned)n, __ATOMIC_RELAXED, __HIP_MEMORY_SCOPE_AGENT); }
};

struct EpiStore {
    static constexpr bool PERM = true, AFTER_DRAIN = false;
    bf16_t* O; int ldc; float sc;
    bf16_t* O2; int ldc2, pm2, pn2;
    __device__ __forceinline__ void operator()(const f32x4 (&acc)[2][2][4][2], const Unit& u, int wr, int wc, int fr, int fq) const {
        int row0 = u.pm * BM + wr * 64 + fr; int col0 = u.pn * BM + wc * 32 + 8 * fq; bf16_t* Ob = O; int ld = ldc;
        if (pm2 > 0 && u.pm >= pm2) { row0 -= pm2 * BM; col0 -= pn2 * BM; Ob = O2; ld = ldc2; }
#pragma unroll
        for (int ai = 0; ai < 2; ++ai)
#pragma unroll
            for (int m = 0; m < 4; ++m) { bf16_t* rowp = Ob + (size_t)(row0 + ai * HALF + m * 16) * ld + col0;
#pragma unroll
                for (int bj = 0; bj < 2; ++bj) { const f32x4 v0 = acc[ai][bj][m][0] * sc, v1 = acc[ai][bj][m][1] * sc;
                    u32x4 w; w.x = pk2(v0[0], v0[1]); w.y = pk2(v0[2], v0[3]); w.z = pk2(v1[0], v1[1]); w.w = pk2(v1[2], v1[3]);
                    *(u32x4*)(rowp + bj * HALF) = w; } }
    }
};
struct EpiSwiGLU {
    static constexpr bool PERM = true, AFTER_DRAIN = false;
    bf16_t* O; int ldc;
    __device__ __forceinline__ void operator()(const f32x4 (&acc)[2][2][4][2], const Unit& u, int wr, int wc, int fr, int fq) const {
        const int row0 = u.pm * BM + wr * 64 + fr; const int col0 = u.pn * HALF + wc * 32 + 8 * fq;
#pragma unroll
        for (int ai = 0; ai < 2; ++ai)
#pragma unroll
            for (int m = 0; m < 4; ++m) { bf16_t* rowp = O + (size_t)(row0 + ai * HALF + m * 16) * ldc + col0;
                float h[8];
#pragma unroll
                for (int n = 0; n < 2; ++n)
#pragma unroll
                    for (int i = 0; i < 4; ++i) { const float g = acc[ai][0][m][n][i], up = acc[ai][1][m][n][i]; h[4 * n + i] = (g * up) * frcp(1.0f + fexp2(-1.4426950408889634f * g)); }
                u32x4 w; w.x = pk2(h[0], h[1]); w.y = pk2(h[2], h[3]); w.z = pk2(h[4], h[5]); w.w = pk2(h[6], h[7]);
                *(u32x4*)rowp = w; }
    }
};

struct EpiStoreQ {
    static constexpr bool PERM = true, AFTER_DRAIN = false;
    bf16_t* O; int ldc; const float* as; const float* ws;
    bf16_t* O2; int ldc2, pm2, pn2;
    __device__ __forceinline__ void operator()(const f32x4 (&acc)[2][2][4][2], const Unit& u, int wr, int wc, int fr, int fq) const {
        const int arow0 = u.pm * BM + wr * 64 + fr, bcol0 = u.pb * BM + wc * 32 + 8 * fq;
        int row0 = arow0, col0 = u.pn * BM + wc * 32 + 8 * fq; bf16_t* Ob = O; int ld = ldc;
        if (pm2 > 0 && u.pm >= pm2) { row0 -= pm2 * BM; col0 -= pn2 * BM; Ob = O2; ld = ldc2; }
        f32x4 wsv[2][2];
#pragma unroll
        for (int bj = 0; bj < 2; ++bj) { wsv[bj][0] = *(const f32x4*)(ws + bcol0 + bj * HALF); wsv[bj][1] = *(const f32x4*)(ws + bcol0 + bj * HALF + 4); }
#pragma unroll
        for (int ai = 0; ai < 2; ++ai)
#pragma unroll
            for (int m = 0; m < 4; ++m) { const float a = as[arow0 + ai * HALF + m * 16]; bf16_t* rowp = Ob + (size_t)(row0 + ai * HALF + m * 16) * ld + col0;
#pragma unroll
                for (int bj = 0; bj < 2; ++bj) { const i32x4 i0 = __builtin_bit_cast(i32x4, acc[ai][bj][m][0]), i1 = __builtin_bit_cast(i32x4, acc[ai][bj][m][1]);
                    const f32x4 v0 = __builtin_convertvector(i0, f32x4) * wsv[bj][0] * a, v1 = __builtin_convertvector(i1, f32x4) * wsv[bj][1] * a;
                    u32x4 w; w.x = pk2(v0[0], v0[1]); w.y = pk2(v0[2], v0[3]); w.z = pk2(v1[0], v1[1]); w.w = pk2(v1[2], v1[3]);
                    *(u32x4*)(rowp + bj * HALF) = w; } }
    }
};
struct EpiSwiGLUQ {
    static constexpr bool PERM = true, AFTER_DRAIN = false;
    bf16_t* O; int ldc; const float* as; const float* ws;
    __device__ __forceinline__ void operator()(const f32x4 (&acc)[2][2][4][2], const Unit& u, int wr, int wc, int fr, int fq) const {
        const int row0 = u.pm * BM + wr * 64 + fr; const int col0 = u.pn * HALF + wc * 32 + 8 * fq, bcol0 = u.pb * BM + wc * 32 + 8 * fq;
        f32x4 wsv[2][2];
#pragma unroll
        for (int bj = 0; bj < 2; ++bj) { wsv[bj][0] = *(const f32x4*)(ws + bcol0 + bj * HALF); wsv[bj][1] = *(const f32x4*)(ws + bcol0 + bj * HALF + 4); }
#pragma unroll
        for (int ai = 0; ai < 2; ++ai)
#pragma unroll
            for (int m = 0; m < 4; ++m) { const float a = as[row0 + ai * HALF + m * 16]; bf16_t* rowp = O + (size_t)(row0 + ai * HALF + m * 16) * ldc + col0;
                float h[8];
#pragma unroll
                for (int n = 0; n < 2; ++n) { const f32x4 gv = __builtin_convertvector(__builtin_bit_cast(i32x4, acc[ai][0][m][n]), f32x4) * wsv[0][n] * a, uv = __builtin_convertvector(__builtin_bit_cast(i32x4, acc[ai][1][m][n]), f32x4) * wsv[1][n] * a;
#pragma unroll
                    for (int i = 0; i < 4; ++i) h[4 * n + i] = (gv[i] * uv[i]) * frcp(1.0f + fexp2(-1.4426950408889634f * gv[i])); }
                u32x4 w; w.x = pk2(h[0], h[1]); w.y = pk2(h[2], h[3]); w.z = pk2(h[4], h[5]); w.w = pk2(h[6], h[7]);
                *(u32x4*)rowp = w; }
    }
};
struct EpiSwiGLUQ8 {
    static constexpr bool PERM = true, AFTER_DRAIN = false;
    static constexpr int NST = 8;
    unsigned char* O; int ldc; const float* as; const float* ws;
    __device__ __forceinline__ void operator()(const f32x4 (&acc)[2][2][4][2], const Unit& u, int wr, int wc, int fr, int fq) const {
        const int row0 = u.pm * BM + wr * 64 + fr; const int col0 = u.pn * HALF + wc * 32 + 8 * fq, bcol0 = u.pb * BM + wc * 32 + 8 * fq;
        f32x4 wsv[2][2];
#pragma unroll
        for (int bj = 0; bj < 2; ++bj) { wsv[bj][0] = *(const f32x4*)(ws + bcol0 + bj * HALF); wsv[bj][1] = *(const f32x4*)(ws + bcol0 + bj * HALF + 4); }
#pragma unroll
        for (int ai = 0; ai < 2; ++ai)
#pragma unroll
            for (int m = 0; m < 4; ++m) { const float a = as[row0 + ai * HALF + m * 16]; unsigned char* rowp = O + (size_t)(row0 + ai * HALF + m * 16) * ldc + col0;
                float h[8];
#pragma unroll
                for (int n = 0; n < 2; ++n) { const f32x4 gv = __builtin_convertvector(__builtin_bit_cast(i32x4, acc[ai][0][m][n]), f32x4) * wsv[0][n] * a, uv = __builtin_convertvector(__builtin_bit_cast(i32x4, acc[ai][1][m][n]), f32x4) * wsv[1][n] * (a * FP8_SHD);
#pragma unroll
                    for (int i = 0; i < 4; ++i) h[4 * n + i] = (gv[i] * uv[i]) * frcp(1.0f + fexp2(-1.4426950408889634f * gv[i])); }
                u32x2 w; w.x = pk4_fp8s(h[0], h[1], h[2], h[3]); w.y = pk4_fp8s(h[4], h[5], h[6], h[7]);
                *(u32x2*)rowp = w; }
    }
};
struct EpiSwiGLU8 {
    static constexpr bool PERM = true, AFTER_DRAIN = false;
    unsigned char* O; int ldc; float ds;
    __device__ __forceinline__ void operator()(const f32x4 (&acc)[2][2][4][2], const Unit& u, int wr, int wc, int fr, int fq) const {
        const float c1 = -1.4426950408889634f * ds, c2 = ds * ds * FP8_SH;
        const int row0 = u.pm * BM + wr * 64 + fr; const int col0 = u.pn * HALF + wc * 32 + 8 * fq;
#pragma unroll
        for (int ai = 0; ai < 2; ++ai)
#pragma unroll
            for (int m = 0; m < 4; ++m) { unsigned char* rowp = O + (size_t)(row0 + ai * HALF + m * 16) * ldc + col0;
                float h[8];
#pragma unroll
                for (int n = 0; n < 2; ++n)
#pragma unroll
                    for (int i = 0; i < 4; ++i) { const float ga = acc[ai][0][m][n][i], ua = acc[ai][1][m][n][i];
                        h[4 * n + i] = (ga * ua) * (c2 * frcp(1.0f + fexp2(ga * c1))); }
                u32x2 w; w.x = pk4_fp8s(h[0], h[1], h[2], h[3]); w.y = pk4_fp8s(h[4], h[5], h[6], h[7]);
                *(u32x2*)rowp = w; }
    }
};

template <class Epi, class Sched, bool ALIGN_EPI = false, bool SP2 = false, int FP8 = 0>
__device__ __forceinline__ void gemm_phase(PG8_LAS unsigned char* lds, const Gemm g, const Sched& S, const Epi& E) {
    int tid_ = threadIdx.x; asm volatile("" : "+v"(tid_));
    const int tid = tid_, wid = __builtin_amdgcn_readfirstlane(tid >> 6), lane = tid & 63, wr = wid >> 2, wc = wid & 3, fr = lane & 15, fq = lane >> 4;
    const int K = g.K, nt = K / BK;
    unsigned voffA[2], voffB[2];
#pragma unroll
    for (int i = 0; i < 2; ++i) { int R, C; stage_rc(tid * 16 + i * 8192, R, C); const int Rb = Epi::PERM ? ((R & ~31) + perm32(R & 31)) : R;
        voffA[i] = (unsigned)(R * K + C) * 2u; voffB[i] = (unsigned)(Rb * K + C) * 2u; }
    const size_t kstep = (size_t)(BK * 2);
    const size_t hstep = (size_t)HALF * K * 2;
    const size_t tstep = 2 * hstep;
    const unsigned ldsw = (unsigned)wid * 1024u;
    const int aoff = lds_byte(wr * 64 + fr, fq * 8), boff = lds_byte(wc * 32 + fr, fq * 8);
#define PG8_SA(b, h) (((b) * 2 + (h)) * HTB)
#define PG8_SB(b, h) ((4 + (b) * 2 + (h)) * HTB)
#define PG8_STAGE(bufoff, gbase, voff) do { _Pragma("unroll") for (int _i = 0; _i < 2; ++_i) \
        __builtin_amdgcn_global_load_lds((const unsigned*)((const char*)(gbase) + (voff)[_i]), (PG8_LAS unsigned*)(lds + (bufoff) + ldsw + _i * 8192), 16, 0, 0); } while (0)
#define PG8_LD8(p) __builtin_shufflevector(*(const PG8_LAS i32x4*)(p), *(const PG8_LAS i32x4*)((p) + 1024), 0, 1, 2, 3, 4, 5, 6, 7)
#define PG8_LDA(dst, b, h) do { if constexpr (FP8 == 1) { _Pragma("unroll") for (int m = 0; m < 4; ++m) dst##8[m] = PG8_LD8(lds + PG8_SA(b, h) + aoff + m * 2048); } \
        else { _Pragma("unroll") for (int m = 0; m < 4; ++m) _Pragma("unroll") for (int k = 0; k < 2; ++k) dst[m][k] = *(const PG8_LAS bf16x8*)(lds + PG8_SA(b, h) + aoff + m * 2048 + k * 1024); } } while (0)
#define PG8_LDB(dst, b, h) do { if constexpr (FP8 == 1) { _Pragma("unroll") for (int n = 0; n < 2; ++n) dst##8[n] = PG8_LD8(lds + PG8_SB(b, h) + boff + n * 2048); } \
        else { _Pragma("unroll") for (int n = 0; n < 2; ++n) _Pragma("unroll") for (int k = 0; k < 2; ++k) dst[n][k] = *(const PG8_LAS bf16x8*)(lds + PG8_SB(b, h) + boff + n * 2048 + k * 1024); } } while (0)
#define PG8_CAT(x, y) __builtin_shufflevector(__builtin_bit_cast(i32x4, x), __builtin_bit_cast(i32x4, y), 0, 1, 2, 3, 4, 5, 6, 7)
#define PG8_MMA(ai, bj, At, Bt) do { __builtin_amdgcn_s_setprio(1); \
        if constexpr (FP8 == 1) { _Pragma("unroll") for (int m = 0; m < 4; ++m) _Pragma("unroll") for (int n = 0; n < 2; ++n) \
            asm volatile("v_mfma_scale_f32_16x16x128_f8f6f4 %0, %1, %2, %0, %3, %3 op_sel_hi:[0,0,0]" : "+v"(acc[ai][bj][m][n]) : "v"(Bt##8[n]), "v"(At##8[m]), "v"(sc1)); } \
        else if constexpr (FP8 == 2) { _Pragma("unroll") for (int m = 0; m < 4; ++m) _Pragma("unroll") for (int n = 0; n < 2; ++n) _Pragma("unroll") for (int k = 0; k < 2; ++k) \
            acc[ai][bj][m][n] = __builtin_bit_cast(f32x4, __builtin_amdgcn_mfma_i32_16x16x64_i8(__builtin_bit_cast(i32x4, Bt[n][k]), __builtin_bit_cast(i32x4, At[m][k]), __builtin_bit_cast(i32x4, acc[ai][bj][m][n]), 0, 0, 0)); } \
        else { _Pragma("unroll") for (int m = 0; m < 4; ++m) _Pragma("unroll") for (int n = 0; n < 2; ++n) _Pragma("unroll") for (int k = 0; k < 2; ++k) \
            acc[ai][bj][m][n] = __builtin_amdgcn_mfma_f32_16x16x32_bf16(Bt[n][k], At[m][k], acc[ai][bj][m][n], 0, 0, 0); } \
        __builtin_amdgcn_s_setprio(0); } while (0)
#define PG8_WAIT_V(n) asm volatile("s_waitcnt vmcnt(" #n ")" ::: "memory")
#define PG8_WAIT_L(n) asm volatile("s_waitcnt lgkmcnt(" #n ")" ::: "memory")
#define PG8_BAR __builtin_amdgcn_s_barrier()
#define PG8_SCHED __builtin_amdgcn_sched_barrier(0)
    Unit cur, nxt; int ui = 0; int early_cnt = 0;
    if (!S.next(0, cur)) return;
    f32x4 acc[2][2][4][2];
#pragma unroll
    for (int a = 0; a < 2; ++a)
#pragma unroll
        for (int b = 0; b < 2; ++b)
#pragma unroll
            for (int m = 0; m < 4; ++m)
#pragma unroll
                for (int n = 0; n < 2; ++n) acc[a][b][m][n] = (f32x4){0.f, 0.f, 0.f, 0.f};
    bf16x8 At[4][2], B0[2][2], B1[2][2];
    i32x8 At8[4], B08[2], B18[2];
    int sc1 = 0x7F7F7F7F; asm volatile("" : "+v"(sc1));
    const char* cA = (const char*)g.A + (size_t)cur.pm * tstep; const char* cB = (const char*)g.Bt + (size_t)cur.pb * tstep;
    S.a_ready(cur);
    if constexpr (SP2) {
        PG8_STAGE(PG8_SB(0, 0), cB, voffB); PG8_STAGE(PG8_SB(0, 1), cB + hstep, voffB); PG8_STAGE(PG8_SA(0, 0), cA, voffA); PG8_STAGE(PG8_SA(0, 1), cA + hstep, voffA);
        if (wr == 1) PG8_BAR;
        PG8_WAIT_V(2); PG8_BAR;
        PG8_STAGE(PG8_SB(1, 0), cB + kstep, voffB); PG8_STAGE(PG8_SA(1, 0), cA + kstep, voffA); PG8_STAGE(PG8_SB(1, 1), cB + hstep + kstep, voffB);
        PG8_WAIT_V(6); PG8_BAR;
    } else {
        PG8_STAGE(PG8_SB(0, 0), cB, voffB); PG8_STAGE(PG8_SA(0, 0), cA, voffA); PG8_STAGE(PG8_SB(0, 1), cB + hstep, voffB); PG8_STAGE(PG8_SA(0, 1), cA + hstep, voffA);
        if (wr == 1) PG8_BAR;
        PG8_WAIT_V(4); PG8_BAR;
        PG8_STAGE(PG8_SB(1, 0), cB + kstep, voffB); PG8_STAGE(PG8_SA(1, 0), cA + kstep, voffA); PG8_STAGE(PG8_SB(1, 1), cB + hstep + kstep, voffB);
        PG8_WAIT_V(6); PG8_BAR;
    }
    for (;;) {
        const bool has_next = S.next(ui + 1, nxt);
        const char* nA = has_next ? (const char*)g.A + (size_t)nxt.pm * tstep : cA; const char* nB = has_next ? (const char*)g.Bt + (size_t)nxt.pb * tstep : cB;
        for (int t = 0; t < nt; t += 2) {
            const bool last = (t == nt - 2);
            const char* a1 = cA + (size_t)(t + 1) * kstep;
            const char* a2 = last ? nA : cA + (size_t)(t + 2) * kstep; const char* b2 = last ? nB : cB + (size_t)(t + 2) * kstep;
            const char* a3 = a2 + kstep; const char* b3 = b2 + kstep;
            if (last && has_next) S.a_ready(nxt);
            if constexpr (SP2) {
            PG8_LDB(B0, 0, 0); PG8_LDB(B1, 0, 1); PG8_SCHED; PG8_LDA(At, 0, 0); PG8_STAGE(PG8_SA(1, 1), a1 + hstep, voffA);
            PG8_WAIT_V(8); PG8_WAIT_L(0); PG8_BAR; PG8_MMA(0, 0, At, B0); PG8_MMA(0, 1, At, B1); PG8_BAR; PG8_SCHED;
            PG8_LDA(At, 0, 1); PG8_STAGE(PG8_SB(0, 0), b2, voffB); PG8_STAGE(PG8_SB(0, 1), b2 + hstep, voffB); PG8_STAGE(PG8_SA(0, 0), a2, voffA);
            PG8_WAIT_V(8); PG8_WAIT_L(0); PG8_BAR; PG8_MMA(1, 0, At, B0); PG8_MMA(1, 1, At, B1); PG8_BAR; PG8_SCHED;
            PG8_LDB(B0, 1, 0); PG8_LDB(B1, 1, 1); PG8_SCHED; PG8_LDA(At, 1, 0); PG8_STAGE(PG8_SA(0, 1), a2 + hstep, voffA);
            PG8_WAIT_V(8); PG8_WAIT_L(0); PG8_BAR; PG8_MMA(0, 0, At, B0); PG8_MMA(0, 1, At, B1); PG8_BAR; PG8_SCHED;
            PG8_LDA(At, 1, 1); PG8_STAGE(PG8_SB(1, 0), b3, voffB); PG8_STAGE(PG8_SB(1, 1), b3 + hstep, voffB); PG8_STAGE(PG8_SA(1, 0), a3, voffA);
            PG8_WAIT_V(8); PG8_WAIT_L(0); PG8_BAR; PG8_MMA(1, 0, At, B0); PG8_MMA(1, 1, At, B1); PG8_BAR; PG8_SCHED;
            } else {
            PG8_LDB(B0, 0, 0); PG8_SCHED; PG8_LDA(At, 0, 0); PG8_STAGE(PG8_SA(1, 1), a1 + hstep, voffA);
            PG8_WAIT_L(8); PG8_BAR; PG8_WAIT_L(0); PG8_MMA(0, 0, At, B0); PG8_BAR; PG8_SCHED;
            PG8_LDB(B1, 0, 1); PG8_STAGE(PG8_SB(0, 0), b2, voffB);
            PG8_BAR; PG8_WAIT_L(0); PG8_MMA(0, 1, At, B1); PG8_BAR;
            PG8_LDA(At, 0, 1); PG8_STAGE(PG8_SA(0, 0), a2, voffA);
            PG8_BAR; PG8_WAIT_L(0); PG8_MMA(1, 0, At, B0); PG8_BAR; PG8_SCHED;
            PG8_STAGE(PG8_SB(0, 1), b2 + hstep, voffB);
            PG8_WAIT_V(6); PG8_BAR; PG8_MMA(1, 1, At, B1); PG8_BAR;
            PG8_LDB(B0, 1, 0); PG8_SCHED; PG8_LDA(At, 1, 0); PG8_STAGE(PG8_SA(0, 1), a2 + hstep, voffA);
            PG8_WAIT_L(8); PG8_BAR; PG8_WAIT_L(0); PG8_MMA(0, 0, At, B0); PG8_BAR; PG8_SCHED;
            PG8_LDB(B1, 1, 1); PG8_STAGE(PG8_SB(1, 0), b3, voffB);
            PG8_BAR; PG8_WAIT_L(0); PG8_MMA(0, 1, At, B1); PG8_BAR;
            PG8_LDA(At, 1, 1); PG8_STAGE(PG8_SA(1, 0), a3, voffA);
            PG8_BAR; PG8_WAIT_L(0); PG8_MMA(1, 0, At, B0); PG8_BAR; PG8_SCHED;
            PG8_STAGE(PG8_SB(1, 1), b3 + hstep, voffB);
            PG8_WAIT_V(6); PG8_BAR; PG8_MMA(1, 1, At, B1); PG8_BAR;
            }
        }
        if constexpr (ALIGN_EPI) { if (wr == 0) PG8_BAR; }
        if constexpr (FP8 == 1) asm volatile("s_nop 15\n\ts_nop 15\n\ts_nop 15\n\ts_nop 15\n\ts_nop 15" ::: "memory");
        if constexpr (!Epi::AFTER_DRAIN) { E(acc, cur, wr, wc, fr, fq); S.done(cur); }
        if constexpr (Sched::SIGNALS) {
            early_cnt += (cur.pm < S.early_rt) ? 1 : 0;
            if (ui == 8) { PG8_WAIT_V(0); PG8_BAR; if (tid == 0 && early_cnt > 0) S.signal(early_cnt); early_cnt = 0; }
        }
        if (!has_next) break;
#pragma unroll
        for (int a = 0; a < 2; ++a)
#pragma unroll
            for (int b = 0; b < 2; ++b)
#pragma unroll
                for (int m = 0; m < 4; ++m)
#pragma unroll
                    for (int n = 0; n < 2; ++n) acc[a][b][m][n] = (f32x4){0.f, 0.f, 0.f, 0.f};
        cur = nxt; cA = nA; cB = nB; ++ui;
        if constexpr (ALIGN_EPI) { if (wr == 1) PG8_BAR; }
    }
    PG8_WAIT_V(0);
    if constexpr (!ALIGN_EPI) { if (wr == 0) PG8_BAR; }
    PG8_BAR;
    if constexpr (Sched::SIGNALS) { if (tid == 0 && early_cnt > 0) S.signal(early_cnt); }
#undef PG8_SA
#undef PG8_SB
#undef PG8_STAGE
#undef PG8_LDA
#undef PG8_LD8
#undef PG8_LDB
#undef PG8_MMA
#undef PG8_CAT
#undef PG8_WAIT_V
#undef PG8_WAIT_L
#undef PG8_BAR
#undef PG8_SCHED
}
}

#define XB_TMO      128
#define XB_XCNT(j)  (256  + 64 * (j))
#define XB_XSUB(j)  (1280 + 64 * (j))
#define XB_XGEN(j)  (2304 + 64 * (j))
#define XB_TOP      3328
#define XB_TOPGEN   3392
#define XCD_BAR_WORDS 3456
#define XB_SPIN_CAP (1u << 22)
__device__ __forceinline__ unsigned xb_ld(unsigned* p)              { return __hip_atomic_load(p, __ATOMIC_RELAXED, __HIP_MEMORY_SCOPE_AGENT); }
__device__ __forceinline__ unsigned xb_add(unsigned* p, unsigned v) { return __hip_atomic_fetch_add(p, v, __ATOMIC_RELAXED, __HIP_MEMORY_SCOPE_AGENT); }
__device__ __forceinline__ unsigned xb_xcc_id() { return (unsigned)__builtin_amdgcn_s_getreg((3 << 11) | 20) & 0xFu; }
#define XB_SPIN(cond, bar) do { unsigned _sp = 0; while (cond) { __builtin_amdgcn_s_sleep(1); \
    if ((++_sp & 255u) == 0u) { if (xb_ld(&(bar)[XB_TMO])) break; if (_sp > XB_SPIN_CAP) { atomicAdd(&(bar)[XB_TMO], 1u); break; } } } } while (0)
struct XcdBarrier { unsigned* bar; unsigned x; volatile LAS unsigned* st; };
__device__ __forceinline__ XcdBarrier xcd_barrier_post(unsigned* bar, volatile LAS unsigned* st) {
    XcdBarrier b; b.bar = bar; b.x = xb_xcc_id(); b.st = st;
    if (threadIdx.x == 0) (void)xb_add(&bar[XB_XCNT(b.x)], 1u);
    return b;
}
__device__ __forceinline__ void xcd_barrier_complete(unsigned* bar, unsigned x, unsigned& nloc, unsigned& nx) {
    const unsigned G = gridDim.x * gridDim.y * gridDim.z;
    unsigned sum, cnt, mine, sp = 0u;
    for (;;) {
        sum = 0u; cnt = 0u; mine = 0u;
#pragma unroll
        for (unsigned j = 0; j < 16; ++j) { const unsigned c = xb_ld(&bar[XB_XCNT(j)]); sum += c; cnt += (c > 0u) ? 1u : 0u; mine = (j == x) ? c : mine; }
        if (sum == G) break;
        __builtin_amdgcn_s_sleep(1);
        if ((++sp & 255u) == 0u) { if (xb_ld(&bar[XB_TMO])) break; if (sp > XB_SPIN_CAP) { atomicAdd(&bar[XB_TMO], 1u); break; } }
    }
    nloc = mine > 0u ? mine : 1u; nx = cnt > 0u ? cnt : 1u;
}
__device__ __forceinline__ void xcd_barrier(const XcdBarrier& b) {
    asm volatile("s_waitcnt vmcnt(0)" ::: "memory");
    __syncthreads();
    if (threadIdx.x == 0) {
        unsigned* bar = b.bar;
        __builtin_amdgcn_s_waitcnt(0);
        unsigned nloc = b.st[0], nx = b.st[1];
        if (nloc == 0u) { xcd_barrier_complete(bar, b.x, nloc, nx); b.st[0] = nloc; b.st[1] = nx; }
        const unsigned old = xb_add(&bar[XB_XSUB(b.x)], 1u);
        const unsigned gen = old / nloc;
        if (old + 1u == (gen + 1u) * nloc) {
            __builtin_amdgcn_fence(__ATOMIC_RELEASE, "agent");
            asm volatile("s_waitcnt vmcnt(0)" ::: "memory");
            const unsigned og = xb_add(&bar[XB_TOP], 1u);
            const unsigned tg = og / nx;
            if (og + 1u == (tg + 1u) * nx) xb_add(&bar[XB_TOPGEN], 1u);
            else XB_SPIN(xb_ld(&bar[XB_TOPGEN]) == tg, bar);
            __builtin_amdgcn_fence(__ATOMIC_ACQUIRE, "agent");
            xb_add(&bar[XB_XGEN(b.x)], 1u);
            asm volatile("s_waitcnt vmcnt(0)" ::: "memory");
        } else {
            XB_SPIN(xb_ld(&bar[XB_XGEN(b.x)]) == gen, bar);
            __builtin_amdgcn_fence(__ATOMIC_ACQUIRE, "agent");
            asm volatile("s_waitcnt vmcnt(0)" ::: "memory");
        }
    }
    __syncthreads();
}

struct Frame {
    LAS unsigned char* lds;
    int tid, lane, wave, G, bx;
};
__device__ __forceinline__ Frame phase_frame(const Frame& F) { Frame R = F; int t = threadIdx.x; asm volatile("" : "+v"(t)); R.tid = t; R.lane = t & 63; R.wave = __builtin_amdgcn_readfirstlane(t >> 6); return R; }

struct TrDesc { const float* W; unsigned char* WT; const float* kgain; float nscale; int K, N, drow0, k0, n0, f8; };
__device__ __forceinline__ void tr_load(const TrDesc& d, float (&tv)[32], int lane) {
    const float* wp = d.W + (size_t)(d.k0 + (lane >> 5)) * d.N + d.n0 + (lane & 31);
#pragma unroll
    for (int i = 0; i < 32; ++i) tv[i] = wp[(size_t)(2 * i) * d.N];
}
__device__ __forceinline__ void tr_finish(const TrDesc& d, const float (&tv)[32], LAS float* scr, int lane) {
#pragma unroll
    for (int i = 0; i < 32; ++i) { float v = tv[i] * d.nscale; if (d.kgain) v *= d.kgain[d.k0 + 2 * i + (lane >> 5)]; scr[(2 * i + (lane >> 5)) * 33 + (lane & 31)] = v; }
    LDS_WAIT(); asm volatile("" ::: "memory");
    const int c = lane & 7;
#pragma unroll
    for (int j = 0; j < 4; ++j) { const int n = (lane >> 3) + 8 * j; const LAS float* s = scr + (8 * c) * 33 + n;
        if (d.f8) { u32x2 o; o.x = pk4_fp8(s[0 * 33], s[1 * 33], s[2 * 33], s[3 * 33]); o.y = pk4_fp8(s[4 * 33], s[5 * 33], s[6 * 33], s[7 * 33]);
            *(u32x2*)(d.WT + (size_t)(d.drow0 + n) * d.K + d.k0 + 8 * c) = o; }
        else { u32x4 o; o.x = pk2(s[0 * 33], s[1 * 33]); o.y = pk2(s[2 * 33], s[3 * 33]); o.z = pk2(s[4 * 33], s[5 * 33]); o.w = pk2(s[6 * 33], s[7 * 33]);
            *(u32x4*)(d.WT + ((size_t)(d.drow0 + n) * d.K + d.k0 + 8 * c) * 2) = o; } }
    LDS_WAIT(); asm volatile("" ::: "memory");
}
__device__ __forceinline__ int gu_row(int n0, int Fh) { return n0 < Fh ? ((n0 >> 7) * 256 + (n0 & 127)) : (((n0 - Fh) >> 7) * 256 + 128 + ((n0 - Fh) & 127)); }

struct Ptrs {
    const float *x, *mem, *anpre, *anpost, *fnpre, *fnpost, *w_in_a, *hlb, *hon, *w_in_b, *kvn, *w_kv, *memn, *w_mem_kv, *w_out, *w_gu, *w_dn, *w_router, *w_egu, *w_edn;
    float* out; unsigned char* ws;
};

__device__ __forceinline__ float row_rstd(const f32x4 (&a)[4]);
__device__ __forceinline__ void rms_row_to_bf16(const float* xrow, bf16_t* orow, const float* gain, int lane) {
    const f32x4* xr = (const f32x4*)xrow + lane;
    f32x4 v[4]; float s = 0.f;
#pragma unroll
    for (int j = 0; j < 4; ++j) { v[j] = xr[64 * j]; s += (v[j].x * v[j].x + v[j].y * v[j].y) + (v[j].z * v[j].z + v[j].w * v[j].w); }
    const float rstd = frsq(wave_sum(s) * (1.f / DM) + RMS_EPS);
    u32x2* o8 = (u32x2*)orow + lane;
#pragma unroll
    for (int j = 0; j < 4; ++j) { f32x4 gg = gain ? ((const f32x4*)gain)[lane + 64 * j] : (f32x4){1.f, 1.f, 1.f, 1.f};
        u32x2 w; w.x = pk2(v[j].x * rstd * gg.x, v[j].y * rstd * gg.y); w.y = pk2(v[j].z * rstd * gg.z, v[j].w * rstd * gg.w); o8[64 * j] = w; }
}

struct TrCounts {
    static constexpr int I_INA = (DM / 64) * (AW / 32), I_MKV = (DM / 64) * (512 / 32), I_OUT = (DM / 64) * (DM / 32), I_GU = (DM / 64) * (2 * DFF / 32), I_DN = (DFF / 64) * (DM / 32),
                         I_KV = (DM / 64) * (1536 / 32), I_INB = (DM / 64) * (DM / 32), I_EGU = (DM / 64) * (2 * DFE / 32), I_EDN = (DFE / 64) * (DM / 32);
    static constexpr int NEARLY = I_INA + 2 * I_MKV + 2 * I_OUT + I_GU + I_DN + I_KV + I_INB;
    static constexpr int NITEMS = NEARLY + NEXP * I_EGU + NEXP * I_EDN;
};
__device__ __forceinline__ TrDesc tr_decode(const Ptrs& P, int it) {
    using T = TrCounts; unsigned char* ws = P.ws; TrDesc d; d.kgain = nullptr; d.nscale = 1.f; d.f8 = 0;
    int r = it - (T::I_INA + 2 * T::I_MKV);
    if (r < 2 * T::I_OUT) { const int l = r / T::I_OUT; r -= l * T::I_OUT; const int nb = DM / 32; d.k0 = 64 * (r / nb); d.n0 = 32 * (r % nb);
        d.W = P.w_out + (size_t)l * DM * DM; d.K = DM; d.N = DM; d.WT = ws + (l ? WS_WOUT1 : WS_WOUT0); d.drow0 = d.n0; if (l) { d.f8 = 1; d.nscale = FP8_SWO; } return d; } r -= 2 * T::I_OUT + T::I_GU;
    if (r < T::I_DN) { const int nb = DM / 32; d.k0 = 64 * (r / nb); d.n0 = 32 * (r % nb); d.W = P.w_dn; d.K = DFF; d.N = DM; d.WT = ws + WS_WDN; d.drow0 = d.n0; d.f8 = 1; d.nscale = FP8_SWDD; return d; } r -= T::I_DN + T::I_KV + T::I_INB;
    d.f8 = 1;
    if (r < NEXP * T::I_EGU) { const int e = r / T::I_EGU; r -= e * T::I_EGU; const int nb = 2 * DFE / 32; d.k0 = 64 * (r / nb); d.n0 = 32 * (r % nb);
        d.W = P.w_egu + (size_t)e * DM * 2 * DFE; d.K = DM; d.N = 2 * DFE; d.WT = ws + WS_WEGU + (size_t)e * 2 * DFE * DM; d.drow0 = gu_row(d.n0, DFE); d.nscale = FP8_SWGU; return d; } r -= NEXP * T::I_EGU;
    { const int e = r / T::I_EDN; r -= e * T::I_EDN; const int nb = DM / 32; d.k0 = 64 * (r / nb); d.n0 = 32 * (r % nb);
        d.W = P.w_edn + (size_t)e * DFE * DM; d.K = DFE; d.N = DM; d.WT = ws + WS_WEDN + (size_t)e * DM * DFE; d.drow0 = d.n0; d.nscale = FP8_SWDN; return d; }
}
__device__ __forceinline__ void convert_weights(const Frame& F, const Ptrs& P, int gw, int NGW) {
    LAS float* scr = (LAS float*)(F.lds + F.wave * 16384);
    const int it_lo = TrCounts::NEARLY, it_hi = TrCounts::NITEMS;
    for (int it = it_lo + gw; it < it_hi; it += 2 * NGW) {
        const bool two = it + NGW < it_hi;
        const TrDesc a = tr_decode(P, it), b = tr_decode(P, two ? it + NGW : it);
        float ta[32], tb[32];
        tr_load(a, ta, F.lane); if (two) tr_load(b, tb, F.lane);
        tr_finish(a, ta, scr, F.lane); if (two) tr_finish(b, tb, scr, F.lane);
    }
}
struct Q8Desc { const float* W; unsigned char* WT; const float* kgain; float nscale; int N, n0, drow0; float* wsc; };
constexpr int Q8_INA = AW / 32, Q8_MKV = 512 / 32, Q8_GU = 2 * DFF / 32, Q8_KV = 1536 / 32, Q8_INB = DM / 32, Q8_ITEMS = Q8_INA + 2 * Q8_MKV + Q8_GU + Q8_KV + Q8_INB;
__device__ __forceinline__ Q8Desc q8_decode(const Ptrs& P, int r) {
    unsigned char* ws = P.ws; float* const WSCp = (float*)(ws + WS_WSC); Q8Desc d; d.kgain = nullptr; d.nscale = 1.f;
    if (r < Q8_INA) { d.n0 = 32 * r; d.W = P.w_in_a; d.N = AW; d.WT = ws + WS_WINA; d.drow0 = d.n0; d.nscale = d.n0 >= 3072 ? C2 : 1.f; d.wsc = WSCp + WSC_INA; return d; } r -= Q8_INA;
    if (r < 2 * Q8_MKV) { const int l = r / Q8_MKV; r -= l * Q8_MKV; d.n0 = 32 * r; d.W = P.w_mem_kv + (size_t)l * DM * 512; d.N = 512; d.WT = ws + WS_WINA; d.drow0 = AW + l * 512 + d.n0; d.kgain = P.memn + l * DM; d.wsc = WSCp + WSC_INA; return d; } r -= 2 * Q8_MKV;
    if (r < Q8_GU) { d.n0 = 32 * r; d.W = P.w_gu; d.N = 2 * DFF; d.WT = ws + WS_WGU; d.drow0 = gu_row(d.n0, DFF); d.wsc = WSCp + WSC_GU; return d; } r -= Q8_GU;
    if (r < Q8_KV) { d.n0 = 32 * r; d.W = P.w_kv; d.N = 1536; d.WT = ws + WS_WKVB; d.drow0 = d.n0; d.kgain = P.kvn; d.wsc = WSCp + WSC_KVB; return d; } r -= Q8_KV;
    { d.n0 = 32 * r; d.W = P.w_in_b; d.N = DM; d.WT = ws + WS_WKVB; d.drow0 = 1536 + d.n0; d.kgain = P.anpre + DM; d.nscale = C2; d.wsc = WSCp + WSC_KVB; return d; }
}
__device__ __forceinline__ void q8_finish(const Q8Desc& q, const float (&tv)[32], int kbase, LAS float* scr, const LAS float* cfin, int lane) {
#pragma unroll
    for (int i = 0; i < 32; ++i) scr[(2 * i + (lane >> 5)) * 33 + (lane & 31)] = tv[i];
    LDS_WAIT(); asm volatile("" ::: "memory");
    const int c = lane & 7;
#pragma unroll
    for (int j = 0; j < 4; ++j) { const int n = (lane >> 3) + 8 * j; const LAS float* s = scr + (8 * c) * 33 + n; const float inv = 127.0f / cfin[n];
        u32x2 o; o.x = pk4_i8(s[0 * 33] * inv, s[1 * 33] * inv, s[2 * 33] * inv, s[3 * 33] * inv); o.y = pk4_i8(s[4 * 33] * inv, s[5 * 33] * inv, s[6 * 33] * inv, s[7 * 33] * inv);
        *(u32x2*)(q.WT + (size_t)(q.drow0 + n) * DM + kbase + 8 * c) = o; }
    LDS_WAIT(); asm volatile("" ::: "memory");
}
__device__ __forceinline__ void q8_item(const Frame& F, const Q8Desc& q, int parity) {
    const int lane = F.lane, kp = lane >> 5, nl = lane & 31, k0 = F.wave * 128;
    LAS float* scr = (LAS float*)(F.lds + F.wave * 16384);
    const float* wp = q.W + (size_t)(k0 + kp) * q.N + q.n0 + nl;
    float ga[32], gb[32];
    if (q.kgain) {
#pragma unroll
        for (int i = 0; i < 32; ++i) { ga[i] = q.kgain[k0 + 2 * i + kp]; gb[i] = q.kgain[k0 + 64 + 2 * i + kp]; }
    } else {
#pragma unroll
        for (int i = 0; i < 32; ++i) { ga[i] = 1.f; gb[i] = 1.f; }
    }
    float ta[32], tb[32];
#pragma unroll
    for (int i = 0; i < 32; ++i) ta[i] = wp[(size_t)(2 * i) * q.N];
#pragma unroll
    for (int i = 0; i < 32; ++i) tb[i] = wp[(size_t)(64 + 2 * i) * q.N];
    float m = 0.f;
#pragma unroll
    for (int i = 0; i < 32; ++i) { const float v = ta[i] * q.nscale * ga[i]; ta[i] = v; m = fmaxf(m, __builtin_fabsf(v)); }
#pragma unroll
    for (int i = 0; i < 32; ++i) { const float v = tb[i] * q.nscale * gb[i]; tb[i] = v; m = fmaxf(m, __builtin_fabsf(v)); }
    ((LAS float*)(F.lds + F.wave * 16384 + 12288 + parity * 256))[lane] = m;
    __syncthreads();
    float cm = 1e-30f;
#pragma unroll
    for (int w = 0; w < NWAVES; ++w) { const LAS float* cp = (const LAS float*)(F.lds + w * 16384 + 12288 + parity * 256); cm = fmaxf(cm, fmaxf(cp[nl], cp[nl + 32])); }
    LAS float* cfin = (LAS float*)(F.lds + F.wave * 16384 + 12288 + 512);
    if (lane < 32) cfin[lane] = cm;
    if (F.wave == 0 && lane < 32) q.wsc[q.drow0 + lane] = cm * (1.0f / 127.0f);
    q8_finish(q, ta, k0, scr, cfin, lane);
    q8_finish(q, tb, k0 + 64, scr, cfin, lane);
}
__device__ __forceinline__ void p0_rows4_load(const float* src, int m0, int lane, f32x4 (&v)[4][4]) {
#pragma unroll
    for (int r = 0; r < 4; ++r)
#pragma unroll
        for (int j = 0; j < 4; ++j) v[r][j] = ((const f32x4*)(src + (size_t)(m0 + r) * DM))[lane + 64 * j];
}
template <bool GAIN>
__device__ __forceinline__ void p0_rows4_finish(const f32x4 (&v)[4][4], const f32x4 (&gx)[4], unsigned char* dst, float* as, int m0, int lane) {
#pragma unroll
    for (int r = 0; r < 4; ++r) {
        const float rstd = row_rstd(v[r]);
        f32x4 uu[4];
#pragma unroll
        for (int j = 0; j < 4; ++j) { uu[j] = v[r][j] * rstd; if constexpr (GAIN) uu[j] = uu[j] * gx[j]; }
        quant_row_i8(uu, dst + (size_t)(m0 + r) * DM, as + m0 + r, lane);
    }
}
constexpr int P0_NB16 = 2 * TrCounts::I_OUT + TrCounts::I_DN, P0_G16 = P0_NB16 / 16, P0_XCH = MTOK / 32, P0_MCH = MROWS / 32, P0_WITEMS = Q8_ITEMS + P0_G16, P0_ITEMS = P0_WITEMS + P0_XCH + P0_MCH;
static_assert(P0_NB16 % 16 == 0, "bf16 wave items in groups of 16");
__device__ __forceinline__ void p0_prologue(const Frame& F, const Ptrs& P) {
    unsigned char* ws = P.ws;
    float* const ASA = (float*)(ws + WS_AS);
    int parity = 0, L = F.bx;
    for (; L < P0_WITEMS; L += F.G) {
        if (L < Q8_ITEMS) { const Q8Desc q = q8_decode(P, L); q8_item(F, q, parity); parity ^= 1; continue; }
        const int r = L - Q8_ITEMS;
        LAS float* scr = (LAS float*)(F.lds + F.wave * 16384);
        const int ia = r * 16 + F.wave, ib = ia + 8;
        const int base = TrCounts::I_INA + 2 * TrCounts::I_MKV;
        const TrDesc a = tr_decode(P, base + (ia < 2 * TrCounts::I_OUT ? ia : ia + TrCounts::I_GU)), b = tr_decode(P, base + (ib < 2 * TrCounts::I_OUT ? ib : ib + TrCounts::I_GU));
        float ta[32], tb[32];
        tr_load(a, ta, F.lane); tr_load(b, tb, F.lane);
        tr_finish(a, ta, scr, F.lane); tr_finish(b, tb, scr, F.lane);
    }
    f32x4 v[4][4], vn[4][4];
#define P0_LOAD(dst, LL) do { const int c_ = (LL) - P0_WITEMS; const bool isx_ = c_ < P0_XCH; p0_rows4_load(isx_ ? P.x : P.mem, 32 * (isx_ ? c_ : c_ - P0_XCH) + 4 * F.wave, F.lane, dst); } while (0)
#define P0_FIN(src, LL) do { const int c_ = (LL) - P0_WITEMS; const bool isx_ = c_ < P0_XCH; const int m0_ = 32 * (isx_ ? c_ : c_ - P0_XCH) + 4 * F.wave; \
        if (isx_) p0_rows4_finish<true>(src, gx, ws + WS_U, ASA, m0_, F.lane); else p0_rows4_finish<false>(src, gx, ws + WS_MEMN, ASA + MTOK, m0_, F.lane); } while (0)
    if (L < P0_ITEMS) {
        f32x4 gx[4];
#pragma unroll
        for (int j = 0; j < 4; ++j) gx[j] = ((const f32x4*)P.anpre)[F.lane + 64 * j];
        P0_LOAD(v, L);
        for (;;) {
            const int L1 = L + F.G; if (L1 < P0_ITEMS) P0_LOAD(vn, L1);
            P0_FIN(v, L);
            if (L1 >= P0_ITEMS) break;
            const int L2 = L1 + F.G; if (L2 < P0_ITEMS) P0_LOAD(v, L2);
            P0_FIN(vn, L1);
            if (L2 >= P0_ITEMS) break;
            L = L2;
        }
    }
#undef P0_LOAD
#undef P0_FIN
}

__device__ __forceinline__ void load_bf16_row(const bf16_t* arow, int lane, f32x4 (&a)[4]) {
    const u32x2* ar = (const u32x2*)arow + lane;
#pragma unroll
    for (int j = 0; j < 4; ++j) { const u32x2 w = ar[64 * j]; a[j] = (f32x4){bflo(w.x), bfhi(w.x), bflo(w.y), bfhi(w.y)}; }
}
__device__ __forceinline__ float row_rstd(const f32x4 (&a)[4]) {
    float s = 0.f;
#pragma unroll
    for (int j = 0; j < 4; ++j) s += (a[j].x * a[j].x + a[j].y * a[j].y) + (a[j].z * a[j].z + a[j].w * a[j].w);
    return frsq(wave_sum(s) * (1.f / DM) + RMS_EPS);
}
template <bool BASE16, bool Q8OUT>
__device__ __forceinline__ void norm_phase(const Frame& F, const bf16_t* A, const void* base, bf16_t* H, const float* g1, bf16_t* U, const float* g2, float* as_out) {
    f32x4 g1v[4], g2v[4];
#pragma unroll
    for (int j = 0; j < 4; ++j) { g1v[j] = ((const f32x4*)g1)[F.lane + 64 * j]; g2v[j] = g2 ? ((const f32x4*)g2)[F.lane + 64 * j] : (f32x4){1.f, 1.f, 1.f, 1.f}; }
    for (int i0 = 0; i0 < 16; i0 += 4) {
        const int m0 = F.bx * 128 + F.wave * 16 + i0;
        u32x2 ar[4][4]; f32x4 bs[4][4]; u32x2 bh[4][4];
#pragma unroll
        for (int r = 0; r < 4; ++r)
#pragma unroll
            for (int j = 0; j < 4; ++j) { ar[r][j] = ((const u32x2*)(A + (size_t)(m0 + r) * DM))[F.lane + 64 * j];
                if constexpr (BASE16) bh[r][j] = ((const u32x2*)((const bf16_t*)base + (size_t)(m0 + r) * DM))[F.lane + 64 * j];
                else bs[r][j] = ((const f32x4*)((const float*)base + (size_t)(m0 + r) * DM))[F.lane + 64 * j]; }
#pragma unroll
        for (int r = 0; r < 4; ++r) {
            const int m = m0 + r;
            f32x4 a[4];
#pragma unroll
            for (int j = 0; j < 4; ++j) a[j] = (f32x4){bflo(ar[r][j].x), bfhi(ar[r][j].x), bflo(ar[r][j].y), bfhi(ar[r][j].y)};
            const float rs = row_rstd(a);
            f32x4 h[4];
            u32x2* h8 = (u32x2*)(H + (size_t)m * DM) + F.lane;
#pragma unroll
            for (int j = 0; j < 4; ++j) { const f32x4 gg = g1v[j];
                f32x4 b; if constexpr (BASE16) b = (f32x4){bflo(bh[r][j].x), bfhi(bh[r][j].x), bflo(bh[r][j].y), bfhi(bh[r][j].y)}; else b = bs[r][j];
                h[j] = b + a[j] * rs * gg; u32x2 w; w.x = pk2(h[j].x, h[j].y); w.y = pk2(h[j].z, h[j].w); h8[64 * j] = w; }
            const float rh = row_rstd(h);
            if constexpr (Q8OUT) {
                f32x4 uu[4];
#pragma unroll
                for (int j = 0; j < 4; ++j) uu[j] = h[j] * rh * g2v[j];
                quant_row_i8(uu, (unsigned char*)U + (size_t)m * DM, as_out + m, F.lane);
            } else {
                u32x2* o8 = (u32x2*)(U + (size_t)m * DM) + F.lane;
#pragma unroll
                for (int j = 0; j < 4; ++j) { const f32x4 gg = g2v[j];
                    u32x2 w; w.x = pk2(h[j].x * rh * gg.x, h[j].y * rh * gg.y); w.y = pk2(h[j].z * rh * gg.z, h[j].w * rh * gg.w); o8[64 * j] = w; }
            }
        }
    }
}

constexpr float HG_US = 4.f;
constexpr int HG_RAWQ = 0, HG_RAWF = 18432, HG_RAWV = 36864;
constexpr int HG_OT = 0;
constexpr int HG_SC = 33792;
constexpr int HG_QD = 55296, HG_KI = 72704;
constexpr int HG_KST = 90112, HG_VT = 108544;
constexpr int HG_DEC = 126976;
typedef short s16x4 __attribute__((ext_vector_type(4)));
__device__ __forceinline__ s16x4 lds_tr16(const LAS unsigned char* p) { return __builtin_bit_cast(s16x4, __builtin_amdgcn_ds_read_tr16_b64_v4i16((LAS s16x4*)p)); }
constexpr int PA_GH = 0, PA_GL = 17408, PA_KH = 34816, PA_QH = 52224, PA_V = 69632;
__device__ __forceinline__ bf16x8 pa_trfrag(const LAS unsigned char* p) {
    const s16x4 lo = lds_tr16(p), hi = lds_tr16(p + 4 * 272);
    return (bf16x8){lo[0], lo[1], lo[2], lo[3], hi[0], hi[1], hi[2], hi[3]};
}
__device__ __forceinline__ void hgrnA_phase(const Frame& F, const Ptrs& P) {
    const int tid = F.tid, lane = F.lane, w = F.wave;
    LAS unsigned char* L = F.lds;
    const int sc0 = tid >> 4, sch = tid & 15;
    const int fr = lane & 15, g = lane >> 4;
    bf16_t* const GQD = (bf16_t*)(P.ws + WS_HGQD); bf16_t* const GOI = (bf16_t*)(P.ws + WS_HGOI); unsigned char* const GU = P.ws + WS_HGU; float* const GDEC = (float*)(P.ws + WS_HGDEC);
    const int NU = NB * 6 * 64;
    bf16x8 tri0, tri16, ones;
#pragma unroll
    for (int j = 0; j < 8; ++j) { tri0[j] = (8 * g + j <= fr) ? (short)0x3F80 : (short)0; tri16[j] = (8 * g + j <= fr + 16) ? (short)0x3F80 : (short)0; ones[j] = (short)0x3F80; }
    const int trl = (8 * g + ((lane & 15) >> 2)) * 272 + (lane & 3) * 8;
    u32x4 rq[2], rf[2], rv[2];
    {
        const int unit = F.bx; const int bh = unit >> 6, n = unit & 63, b = bh / 6, h = bh % 6;
        const bf16_t* PR = (const bf16_t*)(P.ws + WS_R1) + (size_t)(b * SEQ + n * 64) * AW;
#pragma unroll
        for (int i = 0; i < 2; ++i) { const bf16_t* rp = PR + (size_t)(sc0 + 32 * i) * AW + sch * 8;
            rq[i] = *(const u32x4*)(rp + h * 128); rf[i] = *(const u32x4*)(rp + 768 + h * 128); rv[i] = *(const u32x4*)(rp + 1536 + h * 128); }
    }
    for (int unit = F.bx; unit < NU; unit += F.G) {
        const int bh = unit >> 6, h = bh % 6;
        {
            float lb[8];
            { const f32x4 a00 = *(const f32x4*)(P.hlb + h * 128 + 8 * sch), a01 = *(const f32x4*)(P.hlb + h * 128 + 8 * sch + 4), a10 = *(const f32x4*)(P.hlb + HF + h * 128 + 8 * sch), a11 = *(const f32x4*)(P.hlb + HF + h * 128 + 8 * sch + 4);
#pragma unroll
              for (int e = 0; e < 4; ++e) { lb[e] = frcp(1.0f + fexp2(1.4426950408889634f * (a10[e] - a00[e]))); lb[4 + e] = frcp(1.0f + fexp2(1.4426950408889634f * (a11[e] - a01[e]))); } }
#pragma unroll
            for (int i = 0; i < 2; ++i) {
                const unsigned fw[4] = {rf[i].x, rf[i].y, rf[i].z, rf[i].w}, qw[4] = {rq[i].x, rq[i].y, rq[i].z, rq[i].w};
                unsigned gh[4], gl[4], kh[4], qh[4];
#pragma unroll
                for (int e2 = 0; e2 < 4; ++e2) {
                    float gg[2], kk[2], qq[2];
#pragma unroll
                    for (int o = 0; o < 2; ++o) {
                        const float fl = o ? bfhi(fw[e2]) : bflo(fw[e2]), ql = o ? bfhi(qw[e2]) : bflo(qw[e2]);
                        const float sg = sigmoidf_(fl); const float lbk = lb[2 * e2 + o];
                        gg[o] = flog2(lbk + (1.0f - lbk) * sg); kk[o] = (1.0f - lbk) * (1.0f - sg); qq[o] = ql * sigmoidf_(ql);
                    }
                    gh[e2] = pk2(gg[0], gg[1]);
                    gl[e2] = pk2(gg[0] - bflo(gh[e2]), gg[1] - bfhi(gh[e2]));
                    kh[e2] = pk2(kk[0], kk[1]); qh[e2] = pk2(qq[0], qq[1]);
                }
                const int off = (sc0 + 32 * i) * 272 + sch * 16;
                *(LAS u32x4*)(L + PA_GH + off) = (u32x4){gh[0], gh[1], gh[2], gh[3]}; *(LAS u32x4*)(L + PA_GL + off) = (u32x4){gl[0], gl[1], gl[2], gl[3]};
                *(LAS u32x4*)(L + PA_KH + off) = (u32x4){kh[0], kh[1], kh[2], kh[3]}; *(LAS u32x4*)(L + PA_QH + off) = (u32x4){qh[0], qh[1], qh[2], qh[3]};
                *(LAS u32x4*)(L + PA_V + off) = rv[i];
            }
        }
        LDS_BARRIER();
        if (unit + F.G < NU) {
            const int u2 = unit + F.G; const int bh2 = u2 >> 6, n2 = u2 & 63, b2 = bh2 / 6, h2 = bh2 % 6;
            const bf16_t* PR = (const bf16_t*)(P.ws + WS_R1) + (size_t)(b2 * SEQ + n2 * 64) * AW;
#pragma unroll
            for (int i = 0; i < 2; ++i) { const bf16_t* rp = PR + (size_t)(sc0 + 32 * i) * AW + sch * 8;
                rq[i] = *(const u32x4*)(rp + h2 * 128); rf[i] = *(const u32x4*)(rp + 768 + h2 * 128); rv[i] = *(const u32x4*)(rp + 1536 + h2 * 128); }
        }
        f32x4 bc[4];
        {
            bf16x8 gfh[2], gfl[2];
#pragma unroll
            for (int ks = 0; ks < 2; ++ks) { gfh[ks] = pa_trfrag(L + PA_GH + (32 * ks) * 272 + (16 * w) * 2 + trl); gfl[ks] = pa_trfrag(L + PA_GL + (32 * ks) * 272 + (16 * w) * 2 + trl); }
#pragma unroll
            for (int ct = 0; ct < 4; ++ct) bc[ct] = (f32x4){0.f, 0.f, 0.f, 0.f};
            bc[0] = __builtin_amdgcn_mfma_f32_16x16x32_bf16(gfh[0], tri0, bc[0], 0, 0, 0);  bc[0] = __builtin_amdgcn_mfma_f32_16x16x32_bf16(gfl[0], tri0, bc[0], 0, 0, 0);
            bc[1] = __builtin_amdgcn_mfma_f32_16x16x32_bf16(gfh[0], tri16, bc[1], 0, 0, 0); bc[1] = __builtin_amdgcn_mfma_f32_16x16x32_bf16(gfl[0], tri16, bc[1], 0, 0, 0);
            bc[2] = __builtin_amdgcn_mfma_f32_16x16x32_bf16(gfh[0], ones, bc[2], 0, 0, 0);  bc[2] = __builtin_amdgcn_mfma_f32_16x16x32_bf16(gfl[0], ones, bc[2], 0, 0, 0);
            bc[2] = __builtin_amdgcn_mfma_f32_16x16x32_bf16(gfh[1], tri0, bc[2], 0, 0, 0);  bc[2] = __builtin_amdgcn_mfma_f32_16x16x32_bf16(gfl[1], tri0, bc[2], 0, 0, 0);
            bc[3] = __builtin_amdgcn_mfma_f32_16x16x32_bf16(gfh[0], ones, bc[3], 0, 0, 0);  bc[3] = __builtin_amdgcn_mfma_f32_16x16x32_bf16(gfl[0], ones, bc[3], 0, 0, 0);
            bc[3] = __builtin_amdgcn_mfma_f32_16x16x32_bf16(gfh[1], tri16, bc[3], 0, 0, 0); bc[3] = __builtin_amdgcn_mfma_f32_16x16x32_bf16(gfl[1], tri16, bc[3], 0, 0, 0);
        }
        {
            f32x4 dec;
#pragma unroll
            for (int r = 0; r < 4; ++r) dec[r] = fexp2(__shfl(bc[3][r], (lane & 48) | 15));
            if (fr == 0) *(f32x4*)(GDEC + (size_t)unit * 128 + 16 * w + 4 * g) = dec;
#pragma unroll
            for (int ct = 0; ct < 4; ++ct) {
                const int off = (16 * ct + fr) * 272 + (16 * w + 4 * g) * 2;
                const u32x2 qh = *(const LAS u32x2*)(L + PA_QH + off), kh = *(const LAS u32x2*)(L + PA_KH + off);
                const float qv[4] = {bflo(qh.x), bfhi(qh.x), bflo(qh.y), bfhi(qh.y)}, kv[4] = {bflo(kh.x), bfhi(kh.x), bflo(kh.y), bfhi(kh.y)};
                float qd[4], ki[4], ks[4];
#pragma unroll
                for (int r = 0; r < 4; ++r) { const float e1 = fexp2(bc[ct][r]), e2 = fexp2(-bc[ct][r]); qd[r] = qv[r] * e1; ki[r] = kv[r] * e2; ks[r] = ki[r] * dec[r]; }
                *(LAS u32x2*)(L + PA_QH + off) = (u32x2){pk2(qd[0], qd[1]), pk2(qd[2], qd[3])};
                *(LAS u32x2*)(L + PA_KH + off) = (u32x2){pk2(ki[0], ki[1]), pk2(ki[2], ki[3])};
                *(LAS u32x2*)(L + PA_GH + off) = (u32x2){pk2(ks[0], ks[1]), pk2(ks[2], ks[3])};
            }
        }
        LDS_BARRIER();
#pragma unroll
        for (int i = 0; i < 2; ++i) { const int c = sc0 + 32 * i; *(u32x4*)(GQD + ((size_t)unit * 64 + c) * 128 + sch * 8) = *(const LAS u32x4*)(L + PA_QH + c * 272 + sch * 16); }
        {
            const int ci = w >> 1;
#pragma unroll
            for (int q = 0; q < 2; ++q) { const int si = 2 * (w & 1) + q;
                if (si <= ci) {
                    f32x4 d = (f32x4){0.f, 0.f, 0.f, 0.f};
#pragma unroll
                    for (int ks = 0; ks < 4; ++ks) {
                        const bf16x8 a = *(const LAS bf16x8*)(L + PA_KH + (16 * si + fr) * 272 + ks * 64 + g * 16);
                        const bf16x8 bb = *(const LAS bf16x8*)(L + PA_QH + (16 * ci + fr) * 272 + ks * 64 + g * 16);
                        d = __builtin_amdgcn_mfma_f32_16x16x32_bf16(a, bb, d, 0, 0, 0);
                    }
                    const int c = 16 * ci + fr, s0 = 16 * si + 4 * g;
#pragma unroll
                    for (int r = 0; r < 4; ++r) if (s0 + r > c) d[r] = 0.f;
                    *(LAS u32x2*)(L + PA_GL + c * 144 + s0 * 2) = (u32x2){pk2(d[0], d[1]), pk2(d[2], d[3])};
                } else {
                    const int c = 16 * ci + fr, s0 = 16 * si + 4 * g;
                    *(LAS u32x2*)(L + PA_GL + c * 144 + s0 * 2) = (u32x2){0u, 0u};
                }
            }
        }
        LDS_BARRIER();
        {
            const int j0 = 16 * w;
            bf16x8 vfrag[2];
#pragma unroll
            for (int ks = 0; ks < 2; ++ks) vfrag[ks] = pa_trfrag(L + PA_V + (32 * ks) * 272 + j0 * 2 + trl);
#pragma unroll
            for (int ct = 0; ct < 4; ++ct) {
                f32x4 o = (f32x4){0.f, 0.f, 0.f, 0.f};
#pragma unroll
                for (int ks = 0; ks < 2; ++ks) if (32 * ks <= 16 * ct + 15) {
                    const bf16x8 sc = *(const LAS bf16x8*)(L + PA_GL + (16 * ct + fr) * 144 + ks * 64 + g * 16);
                    o = __builtin_amdgcn_mfma_f32_16x16x32_bf16(vfrag[ks], sc, o, 0, 0, 0);
                }
                *(u32x2*)(GOI + ((size_t)unit * 64 + 16 * ct + fr) * 128 + j0 + 4 * g) = (u32x2){pk2(o[0], o[1]), pk2(o[2], o[3])};
            }
            unsigned uw[8];
#pragma unroll
            for (int kt = 0; kt < 8; ++kt) {
                f32x4 acc = (f32x4){0.f, 0.f, 0.f, 0.f};
#pragma unroll
                for (int cs = 0; cs < 2; ++cs) {
                    const bf16x8 a = pa_trfrag(L + PA_GH + (32 * cs) * 272 + (16 * kt) * 2 + trl);
                    acc = __builtin_amdgcn_mfma_f32_16x16x32_bf16(a, vfrag[cs], acc, 0, 0, 0);
                }
                uw[kt] = pk4_fp8s(acc[0] * HG_US, acc[1] * HG_US, acc[2] * HG_US, acc[3] * HG_US);
            }
            u32x4* up = (u32x4*)(GU + (((size_t)unit * 8 + w) * 64 + lane) * 32);
#pragma unroll
            for (int q = 0; q < 2; ++q) up[q] = (u32x4){uw[4 * q], uw[4 * q + 1], uw[4 * q + 2], uw[4 * q + 3]};
        }
        LDS_BARRIER();
    }
}

constexpr int HC_QD = 0;
constexpr int HC_DEC = 26112;
constexpr int HC_OT = 27648;
constexpr int HC_NG = 44544;
struct HcSet { u32x4 qp; float dp; u32x4 ur[2], oi, og; };
struct HcCtx { __amdgpu_buffer_rsrc_t rQD, rOI, rU, rDEC, rPR; bf16_t* MIX; unsigned vQD, vOI, vU, vDEC, vPR; int bh, b, h, r0, sc0, sch, c5, sub, fr, g, j0, tid, lane, w; };
__device__ __forceinline__ void abl16(u32x4& d, unsigned voff, __amdgpu_buffer_rsrc_t r, unsigned soff) { asm volatile("buffer_load_dwordx4 %0, %1, %2, %3 offen" : "=v"(d) : "v"(voff), "s"(r), "s"(soff) : "memory"); }
__device__ __forceinline__ void abl4(float& d, unsigned voff, __amdgpu_buffer_rsrc_t r, unsigned soff) { asm volatile("buffer_load_dword %0, %1, %2, %3 offen" : "=v"(d) : "v"(voff), "s"(r), "s"(soff) : "memory"); }
__device__ __forceinline__ void hc_load(const HcCtx& C, HcSet& d, int n) {
    const unsigned unit = (unsigned)(C.bh * 64 + n);
    abl16(d.qp, C.vQD, C.rQD, unit * 16384u);
    if (C.w < 2) abl4(d.dp, C.vDEC, C.rDEC, unit * 512u);
    abl16(d.ur[0], C.vU, C.rU, unit * 16384u); abl16(d.ur[1], C.vU + 16u, C.rU, unit * 16384u);
    abl16(d.oi, C.vOI, C.rOI, unit * 16384u);
    { const unsigned so = (unsigned)((C.b * SEQ + n * 64) * AW * 2); abl16(d.og, C.vPR, C.rPR, so); }
}
#define HC_PIN(d) "+v"((d).qp), "+v"((d).dp), "+v"((d).ur[0]), "+v"((d).ur[1]), "+v"((d).oi), "+v"((d).og)
__device__ __forceinline__ void hc_stage(const HcCtx& C, LAS unsigned char* L, const HcSet& d, int slot) {
    *(LAS u32x4*)(L + HC_QD + slot * 8704 + C.sc0 * 272 + C.sch * 16) = d.qp;
    if (C.w < 2) *(LAS float*)(L + HC_DEC + slot * 512 + C.tid * 4) = d.dp;
}
__device__ __forceinline__ void hc_step(const HcCtx& C, LAS unsigned char* L, f32x4 (&S)[8], int n, HcSet& cur, HcSet& nxt, HcSet& nx2, int slot, int slot_nxt) {
    if (n >= 64) return;
    if (n + 2 < 64) { hc_load(C, nx2, n + 2); asm volatile("s_waitcnt vmcnt(12)" : HC_PIN(cur)); }
    else asm volatile("s_waitcnt vmcnt(0)" : HC_PIN(cur));
    const int fr = C.fr, g = C.g, j0 = C.j0;
    {
        f32x4 o[2];
#pragma unroll
        for (int ct = 0; ct < 2; ++ct) o[ct] = (f32x4){0.f, 0.f, 0.f, 0.f};
#pragma unroll
        for (int ks = 0; ks < 4; ++ks) {
            u32x4 sa; sa.x = pk2(S[2 * ks][0], S[2 * ks][1]); sa.y = pk2(S[2 * ks][2], S[2 * ks][3]); sa.z = pk2(S[2 * ks + 1][0], S[2 * ks + 1][1]); sa.w = pk2(S[2 * ks + 1][2], S[2 * ks + 1][3]);
            const bf16x8 sfrag = __builtin_bit_cast(bf16x8, sa);
#pragma unroll
            for (int ct = 0; ct < 2; ++ct) {
                const u32x2 q0 = *(const LAS u32x2*)(L + HC_QD + slot * 8704 + (16 * ct + fr) * 272 + (32 * ks + 4 * g) * 2);
                const u32x2 q1 = *(const LAS u32x2*)(L + HC_QD + slot * 8704 + (16 * ct + fr) * 272 + (32 * ks + 16 + 4 * g) * 2);
                const bf16x8 qf = __builtin_bit_cast(bf16x8, (u32x4){q0.x, q0.y, q1.x, q1.y});
                o[ct] = __builtin_amdgcn_mfma_f32_16x16x32_bf16(sfrag, qf, o[ct], 0, 0, 0);
            }
        }
#pragma unroll
        for (int ct = 0; ct < 2; ++ct) *(LAS f32x4*)(L + HC_OT + (16 * ct + fr) * 528 + (j0 + 4 * g) * 4) = o[ct];
#pragma unroll
        for (int kt = 0; kt < 8; ++kt) {
            const f32x4 dc = *(const LAS f32x4*)(L + HC_DEC + slot * 512 + (16 * kt + 4 * g) * 4);
            const unsigned uu = (kt & 3) == 0 ? cur.ur[kt >> 2].x : (kt & 3) == 1 ? cur.ur[kt >> 2].y : (kt & 3) == 2 ? cur.ur[kt >> 2].z : cur.ur[kt >> 2].w;
            const f32x2 ulo = __builtin_amdgcn_cvt_pk_f32_fp8((int)uu, false), uhi = __builtin_amdgcn_cvt_pk_f32_fp8((int)uu, true);
            S[kt] = S[kt] * dc + (f32x4){ulo.x, ulo.y, uhi.x, uhi.y} * (1.0f / HG_US);
        }
    }
    LDS_BARRIER();
    {
        f32x4 ov[2]; float ss = 0.f;
        const unsigned oiw[4] = {cur.oi.x, cur.oi.y, cur.oi.z, cur.oi.w};
#pragma unroll
        for (int j = 0; j < 2; ++j) { ov[j] = *(const LAS f32x4*)(L + HC_OT + C.c5 * 528 + (8 * C.sub + 4 * j) * 4);
            ov[j] = ov[j] + (f32x4){bflo(oiw[2 * j]), bfhi(oiw[2 * j]), bflo(oiw[2 * j + 1]), bfhi(oiw[2 * j + 1])};
            ss += (ov[j].x * ov[j].x + ov[j].y * ov[j].y) + (ov[j].z * ov[j].z + ov[j].w * ov[j].w); }
        ss += swz_xor<1>(ss); ss += swz_xor<2>(ss); ss += swz_xor<4>(ss); ss += swz_xor<8>(ss);
        const float rs = frsq(ss * (1.f / 128.f) + RMS_EPS);
        const unsigned ogw[4] = {cur.og.x, cur.og.y, cur.og.z, cur.og.w};
        float r[8]; f32x4 ngv[2];
#pragma unroll
        for (int j = 0; j < 2; ++j) ngv[j] = *(const LAS f32x4*)(L + HC_NG + (8 * C.sub + 4 * j) * 4);
#pragma unroll
        for (int j = 0; j < 2; ++j)
#pragma unroll
            for (int e = 0; e < 4; ++e) { const unsigned wv = ogw[2 * j + (e >> 1)]; const float gg = (e & 1) ? bfhi(wv) : bflo(wv); r[4 * j + e] = ov[j][e] * rs * ngv[j][e] * gg * sigmoidf_(gg); }
        bf16_t* op = C.MIX + (size_t)(n * 64 + C.r0 + C.c5) * DM + C.h * 128 + 8 * C.sub;
        *(u32x4*)op = (u32x4){pk2(r[0], r[1]), pk2(r[2], r[3]), pk2(r[4], r[5]), pk2(r[6], r[7])};
    }
    if (n + 1 < 64) {
        if (n + 2 < 64) asm volatile("s_waitcnt vmcnt(7)" : HC_PIN(nxt)); else asm volatile("s_waitcnt vmcnt(0)" : HC_PIN(nxt));
        hc_stage(C, L, nxt, slot_nxt);
    }
    LDS_BARRIER();
}
__device__ __forceinline__ void hgrn_chain(const Frame& F, const Ptrs& P, int wgi) {
    HcCtx C;
    const int bh = wgi >> 1; const int b = bh / 6; C.bh = bh; C.b = b; C.h = bh % 6; C.r0 = 32 * (wgi & 1);
    C.tid = F.tid; C.lane = F.lane; C.w = F.wave;
    LAS unsigned char* L = F.lds;
    C.MIX = (bf16_t*)(P.ws + WS_MIX) + (size_t)b * SEQ * DM;
    C.rQD = __builtin_amdgcn_make_buffer_rsrc(P.ws + WS_HGQD, 0, 3072 * 16384, 0x00020000);
    C.rOI = __builtin_amdgcn_make_buffer_rsrc(P.ws + WS_HGOI, 0, 3072 * 16384, 0x00020000);
    C.rU = __builtin_amdgcn_make_buffer_rsrc(P.ws + WS_HGU, 0, 3072 * 16384, 0x00020000);
    C.rDEC = __builtin_amdgcn_make_buffer_rsrc(P.ws + WS_HGDEC, 0, 3072 * 512, 0x00020000);
    C.rPR = __builtin_amdgcn_make_buffer_rsrc(P.ws + WS_R1, 0, MTOK * AW * 2, 0x00020000);
    C.sc0 = C.tid >> 4; C.sch = C.tid & 15; C.c5 = C.tid >> 4; C.sub = C.tid & 15;
    C.fr = C.lane & 15; C.g = C.lane >> 4; C.j0 = 16 * C.w;
    C.vQD = (unsigned)(((C.r0 + C.sc0) * 128 + C.sch * 8) * 2); C.vOI = (unsigned)(((C.r0 + C.c5) * 128 + 8 * C.sub) * 2); C.vU = (unsigned)((C.w * 64 + C.lane) * 32); C.vDEC = (unsigned)(C.tid * 4);
    C.vPR = (unsigned)(((C.r0 + C.c5) * AW + 2304 + C.h * 128 + 8 * C.sub) * 2);
    if (C.tid < 128) *(LAS float*)(L + HC_NG + C.tid * 4) = P.hon[C.tid];
    f32x4 S[8];
#pragma unroll
    for (int kt = 0; kt < 8; ++kt) S[kt] = (f32x4){0.f, 0.f, 0.f, 0.f};
    HcSet d0, d1, d2;
    d0.dp = d1.dp = d2.dp = 0.f;
    d0.qp = d1.qp = d2.qp = (u32x4){0u, 0u, 0u, 0u};
    VM_WAIT();
    hc_load(C, d0, 0); hc_load(C, d1, 1);
    asm volatile("s_waitcnt vmcnt(5)" : HC_PIN(d0));
    hc_stage(C, L, d0, 0);
    LDS_BARRIER();
    for (int n = 0; n < 66; n += 6) {
        hc_step(C, L, S, n, d0, d1, d2, 0, 1);
        hc_step(C, L, S, n + 1, d1, d2, d0, 1, 2);
        hc_step(C, L, S, n + 2, d2, d0, d1, 2, 0);
        hc_step(C, L, S, n + 3, d0, d1, d2, 0, 1);
        hc_step(C, L, S, n + 4, d1, d2, d0, 1, 2);
        hc_step(C, L, S, n + 5, d2, d0, d1, 2, 0);
        asm volatile("s_waitcnt vmcnt(0)" : HC_PIN(d0), HC_PIN(d1), HC_PIN(d2));
    }
    VM_WAIT();
}

constexpr int MA_K = 0;
constexpr int MA_VT = 36864;
constexpr int MA_OB = 70144;
template <bool OUT8>
__device__ __forceinline__ void memattn_unit(const Frame& F, const bf16_t* Q, int qpitch, int qcol, const bf16_t* MKV, int kvcol, bf16_t* MIXo, int unit) {
    const int tb = unit >> 2, mh = unit & 3, b = tb >> 4;
    const int tid = F.tid, lane = F.lane, w = F.wave, r32 = lane & 31, hi = lane >> 5;
    LAS unsigned char* L = F.lds;
#pragma unroll
    for (int i = 0; i < 4; ++i) { const int p = tid + 512 * i, key = p >> 3, chn = p & 7;
        const bf16_t* src = MKV + (size_t)(b * MEML + key) * DM + kvcol + mh * 64 + chn * 8;
        const u32x4 kk = *(const u32x4*)src; const u32x4 vv = *(const u32x4*)(src + 256);
        *(LAS u32x4*)(L + MA_K + key * 144 + chn * 16) = kk;
        const unsigned vw[4] = {vv.x, vv.y, vv.z, vv.w};
#pragma unroll
        for (int e = 0; e < 4; ++e) { *(LAS unsigned short*)(L + MA_VT + (chn * 8 + 2 * e) * 520 + key * 2) = (unsigned short)(vw[e] & 0xffffu);
            *(LAS unsigned short*)(L + MA_VT + (chn * 8 + 2 * e + 1) * 520 + key * 2) = (unsigned short)(vw[e] >> 16); } }
    const int tok0 = tb * 256 + w * 32;
    bf16x8 qr[4];
#pragma unroll
    for (int s = 0; s < 4; ++s) qr[s] = *(const bf16x8*)(Q + (size_t)(tok0 + r32) * qpitch + qcol + mh * 64 + 16 * s + 8 * hi);
    LDS_BARRIER();
    f32x16 p[8];
#pragma unroll
    for (int kt = 0; kt < 8; ++kt) { p[kt] = f32x16{};
#pragma unroll
        for (int s = 0; s < 4; ++s) { const bf16x8 a = *(const LAS bf16x8*)(L + MA_K + (32 * kt + r32) * 144 + s * 32 + hi * 16);
            p[kt] = __builtin_amdgcn_mfma_f32_32x32x16_bf16(a, qr[s], p[kt], 0, 0, 0); } }
    float mx = -3.0e38f;
#pragma unroll
    for (int kt = 0; kt < 8; ++kt)
#pragma unroll
        for (int r = 0; r < 16; ++r) mx = fmaxf(mx, p[kt][r]);
    mx = fmaxf(mx, __shfl_xor(mx, 32));
    float sum = 0.f;
#pragma unroll
    for (int kt = 0; kt < 8; ++kt)
#pragma unroll
        for (int r = 0; r < 16; ++r) { p[kt][r] = fexp2(p[kt][r] - mx); sum += p[kt][r]; }
    sum += __shfl_xor(sum, 32);
    const float inv = frcp(sum);
    f32x16 o[2]; o[0] = f32x16{}; o[1] = f32x16{};
#pragma unroll
    for (int kt = 0; kt < 8; ++kt)
#pragma unroll
        for (int s2 = 0; s2 < 2; ++s2) {
            u32x4 pw; pw.x = pk2(p[kt][8 * s2 + 0] * inv, p[kt][8 * s2 + 1] * inv); pw.y = pk2(p[kt][8 * s2 + 2] * inv, p[kt][8 * s2 + 3] * inv);
            pw.z = pk2(p[kt][8 * s2 + 4] * inv, p[kt][8 * s2 + 5] * inv); pw.w = pk2(p[kt][8 * s2 + 6] * inv, p[kt][8 * s2 + 7] * inv);
            const bf16x8 pa = __builtin_bit_cast(bf16x8, pw);
#pragma unroll
            for (int dt = 0; dt < 2; ++dt) {
                const u32x2 v0 = *(const LAS u32x2*)(L + MA_VT + (32 * dt + r32) * 520 + (32 * kt + 16 * s2 + 4 * hi) * 2);
                const u32x2 v1 = *(const LAS u32x2*)(L + MA_VT + (32 * dt + r32) * 520 + (32 * kt + 16 * s2 + 8 + 4 * hi) * 2);
                const bf16x8 vb = __builtin_bit_cast(bf16x8, (u32x4){v0.x, v0.y, v1.x, v1.y});
                o[dt] = __builtin_amdgcn_mfma_f32_32x32x16_bf16(pa, vb, o[dt], 0, 0, 0);
            }
        }
#pragma unroll
    for (int dt = 0; dt < 2; ++dt)
#pragma unroll
        for (int r = 0; r < 16; ++r) {
            if constexpr (!OUT8) MIXo[(size_t)(tok0 + crow(r, hi)) * DM + 768 + mh * 64 + 32 * dt + r32] = (bf16_t)f2bf(o[dt][r]); }
    if constexpr (OUT8) {
        LAS unsigned char* ob = L + MA_OB + w * 1024;
#pragma unroll
        for (int dt = 0; dt < 2; ++dt) {
#pragma unroll
            for (int r = 0; r < 16; ++r) ob[crow(r, hi) * 32 + r32] = fp8_1(o[dt][r] * FP8_SM);
            LDS_WAIT(); asm volatile("" ::: "memory");
            const u32x4 ov = *(const LAS u32x4*)(ob + (lane >> 1) * 32 + (lane & 1) * 16);
            *(u32x4*)((unsigned char*)MIXo + (size_t)(tok0 + (lane >> 1)) * DM + 768 + mh * 64 + 32 * dt + 16 * (lane & 1)) = ov;
            LDS_WAIT(); asm volatile("" ::: "memory");
        }
    }
    LDS_BARRIER();
}

constexpr int SB_SLOT = 19456;
constexpr int SB_VOFF = 9216;
constexpr int SB_NSLOT = 6;
constexpr int SB_FLAG = SB_NSLOT * SB_SLOT;
__device__ __forceinline__ int sb_unit_of(int L) { return (L >> 4) * 16 + (15 - (L & 15)); }
__device__ __forceinline__ void sb_prefetch_q(const Frame& F, const bf16_t* KVQ, int unit, bf16x8 (&q)[4]) {
    const int qb = unit & 15, hh = (unit >> 4) % 12, b = unit / 192;
    const int r32 = F.lane & 31, hi = F.lane >> 5;
    const bf16_t* base = KVQ + (size_t)b * SEQ * KVQW;
    const int tq = qb * 256 + F.wave * 32 + r32;
#pragma unroll
    for (int s = 0; s < 4; ++s) q[s] = *(const bf16x8*)(base + (size_t)tq * KVQW + 1536 + hh * 64 + 16 * s + 8 * hi);
}
__device__ __forceinline__ int sb_unit(const Frame& F, const bf16_t* KVQ, bf16_t* MIXo, int unit, const bf16x8 (&qpre)[4], int have_lo, int have_hi) {
    const int qb = unit & 15, hh = (unit >> 4) % 12, b = unit / 192;
    const int tid = F.tid, lane = F.lane, w = F.wave, r32 = lane & 31, hi = lane >> 5;
    LAS unsigned char* L = F.lds;
    const bf16_t* base = KVQ + (size_t)b * SEQ * KVQW;
    const int q0 = qb * 256 + w * 32;
    const int tq = q0 + r32;
    bf16x8 qr[4];
#pragma unroll
    for (int s = 0; s < 4; ++s) qr[s] = qpre[s];
    bf16x8 tri[2], ones;
#pragma unroll
    for (int s2 = 0; s2 < 2; ++s2)
#pragma unroll
        for (int j = 0; j < 8; ++j) { const int k = 16 * s2 + 8 * (j >> 2) + 4 * hi + (j & 3); tri[s2][j] = (k > r32) ? (short)0x3F80 : (short)0; }
#pragma unroll
    for (int j = 0; j < 8; ++j) ones[j] = (short)0x3F80;
    f32x16 o[2]; o[0] = f32x16{}; o[1] = f32x16{};
    float R = 0.f;
    const int skey = tid >> 3, schn = tid & 7;
    const bf16_t* srcb = base + (size_t)skey * KVQW + hh * 64 + schn * 8;
    const int kwr = skey * 144 + schn * 16, vwr = SB_VOFF + skey * 160 + schn * 16;
    const int vlane = SB_VOFF + (4 * hi + ((lane & 15) >> 2)) * 160 + ((lane >> 4) & 1) * 32 + (lane & 3) * 8;
    {
        u32x4 kk[4], vv[4];
#pragma unroll
        for (int i = 0; i < 4; ++i) { const int tt = 4 * qb + i; if (tt < have_lo || tt > have_hi) { const bf16_t* src = srcb + (size_t)(tt * 64) * KVQW; kk[i] = *(const u32x4*)src; vv[i] = *(const u32x4*)(src + 768); } }
#pragma unroll
        for (int i = 0; i < 4; ++i) { const int tt = 4 * qb + i; if (tt < have_lo || tt > have_hi) { const int sl = tt % SB_NSLOT; *(LAS u32x4*)(L + sl * SB_SLOT + kwr) = kk[i]; *(LAS u32x4*)(L + sl * SB_SLOT + vwr) = vv[i]; } }
    }
    LDS_BARRIER();
    const int jd = 4 * qb + (w >> 1);
    int slot = jd % SB_NSLOT;
    int pslot = (4 * qb + SB_NSLOT - 1) % SB_NSLOT;
    bool mydone = false;
    int lo_loaded = (have_lo <= have_hi && have_lo < 4 * qb) ? have_lo : 4 * qb;
    for (int st = 0; ; ++st) {
        const int tpre = 4 * qb - st - 1;
        u32x4 kreg, vreg;
        const bool need_pre = tpre >= 0 && (tpre < have_lo || tpre > have_hi);
        if (need_pre) { const bf16_t* src = srcb + (size_t)(tpre * 64) * KVQW; kreg = *(const u32x4*)src; vreg = *(const u32x4*)(src + 768); }
        const int t = jd - st;
        if (t >= 0 && !mydone) {
            const int k0 = 64 * t;
            const LAS unsigned char* Kb = L + slot * SB_SLOT;
            f32x16 p0 = f32x16{}, p1 = f32x16{};
#pragma unroll
            for (int s = 0; s < 4; ++s) {
                const bf16x8 a0 = *(const LAS bf16x8*)(Kb + r32 * 144 + s * 32 + hi * 16);
                const bf16x8 a1 = *(const LAS bf16x8*)(Kb + (32 + r32) * 144 + s * 32 + hi * 16);
                p0 = __builtin_amdgcn_mfma_f32_32x32x16_bf16(a0, qr[s], p0, 0, 0, 0);
                p1 = __builtin_amdgcn_mfma_f32_32x32x16_bf16(a1, qr[s], p1, 0, 0, 0);
            }
            float l0[16], l1[16];
            float csum = 0.f;
#pragma unroll
            for (int r = 0; r < 16; ++r) {
                const float z0 = fminf(p0[r], 80.f), z1 = fminf(p1[r], 80.f);
                const float sp0 = flog2(1.0f + fexp2(z0)), sp1 = flog2(1.0f + fexp2(z1));
                float a = -sp0, bq = -sp1, lb0 = z0 - sp0, lb1 = z1 - sp1;
                if (st == 0) { const int key0 = k0 + crow(r, hi); if (key0 >= tq) { a = 0.f; lb0 = -INFINITY; } if (key0 + 32 >= tq) { bq = 0.f; lb1 = -INFINITY; } }
                l0[r] = a; l1[r] = bq; p0[r] = lb0; p1[r] = lb1; csum += a + bq;
            }
            csum += __shfl_xor(csum, 32);
            bf16x8 x0[2], x1[2];
#pragma unroll
            for (int s2 = 0; s2 < 2; ++s2) {
                u32x4 t0, t1;
                t0.x = pk2(l0[8 * s2 + 0], l0[8 * s2 + 1]); t0.y = pk2(l0[8 * s2 + 2], l0[8 * s2 + 3]); t0.z = pk2(l0[8 * s2 + 4], l0[8 * s2 + 5]); t0.w = pk2(l0[8 * s2 + 6], l0[8 * s2 + 7]);
                t1.x = pk2(l1[8 * s2 + 0], l1[8 * s2 + 1]); t1.y = pk2(l1[8 * s2 + 2], l1[8 * s2 + 3]); t1.z = pk2(l1[8 * s2 + 4], l1[8 * s2 + 5]); t1.w = pk2(l1[8 * s2 + 6], l1[8 * s2 + 7]);
                x0[s2] = __builtin_bit_cast(bf16x8, t0); x1[s2] = __builtin_bit_cast(bf16x8, t1);
            }
            f32x16 y0, y1;
#pragma unroll
            for (int r = 0; r < 16; ++r) { y0[r] = R; y1[r] = R; }
            y0 = __builtin_amdgcn_mfma_f32_32x32x16_bf16(tri[0], x0[0], y0, 0, 0, 0);
            y0 = __builtin_amdgcn_mfma_f32_32x32x16_bf16(tri[1], x0[1], y0, 0, 0, 0);
            y0 = __builtin_amdgcn_mfma_f32_32x32x16_bf16(ones, x1[0], y0, 0, 0, 0);
            y0 = __builtin_amdgcn_mfma_f32_32x32x16_bf16(ones, x1[1], y0, 0, 0, 0);
            y1 = __builtin_amdgcn_mfma_f32_32x32x16_bf16(tri[0], x1[0], y1, 0, 0, 0);
            y1 = __builtin_amdgcn_mfma_f32_32x32x16_bf16(tri[1], x1[1], y1, 0, 0, 0);
#pragma unroll
            for (int r = 0; r < 16; ++r) { p0[r] = fexp2(p0[r] + y0[r]); p1[r] = fexp2(p1[r] + y1[r]); }
            R += csum;
            const LAS unsigned char* Vl = Kb + vlane;
#pragma unroll
            for (int half = 0; half < 2; ++half)
#pragma unroll
                for (int s2 = 0; s2 < 2; ++s2) {
                    u32x4 pw;
                    if (half == 0) { pw.x = pk2(p0[8 * s2 + 0], p0[8 * s2 + 1]); pw.y = pk2(p0[8 * s2 + 2], p0[8 * s2 + 3]); pw.z = pk2(p0[8 * s2 + 4], p0[8 * s2 + 5]); pw.w = pk2(p0[8 * s2 + 6], p0[8 * s2 + 7]); }
                    else { pw.x = pk2(p1[8 * s2 + 0], p1[8 * s2 + 1]); pw.y = pk2(p1[8 * s2 + 2], p1[8 * s2 + 3]); pw.z = pk2(p1[8 * s2 + 4], p1[8 * s2 + 5]); pw.w = pk2(p1[8 * s2 + 6], p1[8 * s2 + 7]); }
                    const bf16x8 pa = __builtin_bit_cast(bf16x8, pw);
#pragma unroll
                    for (int dt = 0; dt < 2; ++dt) {
                        const int kb = 32 * half + 16 * s2;
                        const s16x4 vlo = lds_tr16(Vl + kb * 160 + dt * 64), vhi = lds_tr16(Vl + (kb + 8) * 160 + dt * 64);
                        const bf16x8 vb = (bf16x8){vlo[0], vlo[1], vlo[2], vlo[3], vhi[0], vhi[1], vhi[2], vhi[3]};
                        o[dt] = __builtin_amdgcn_mfma_f32_32x32x16_bf16(pa, vb, o[dt], 0, 0, 0);
                    }
                }
        }
        if (t <= 0 || __all(R <= -150.f) != 0) mydone = true;
        if (lane == 0) *(LAS unsigned*)(L + SB_FLAG + ((st & 1) * 8 + w) * 4) = mydone ? 1u : 0u;
        if (need_pre) { *(LAS u32x4*)(L + pslot * SB_SLOT + kwr) = kreg; *(LAS u32x4*)(L + pslot * SB_SLOT + vwr) = vreg; }
        if (tpre >= 0 && tpre < lo_loaded) lo_loaded = tpre;
        LDS_BARRIER();
        { const u32x4 f0 = *(const LAS u32x4*)(L + SB_FLAG + (st & 1) * 32), f1 = *(const LAS u32x4*)(L + SB_FLAG + (st & 1) * 32 + 16);
          if ((f0.x & f0.y & f0.z & f0.w & f1.x & f1.y & f1.z & f1.w) != 0u) break; }
        slot = (slot == 0) ? SB_NSLOT - 1 : slot - 1;
        pslot = (pslot == 0) ? SB_NSLOT - 1 : pslot - 1;
    }
    LAS unsigned char* ob = L + SB_FLAG + 64 + w * 1024;
#pragma unroll
    for (int dt = 0; dt < 2; ++dt) {
#pragma unroll
        for (int r = 0; r < 16; ++r) ob[crow(r, hi) * 32 + r32] = fp8_1(o[dt][r] * FP8_SM);
        LDS_WAIT(); asm volatile("" ::: "memory");
        const u32x4 ov = *(const LAS u32x4*)(ob + (lane >> 1) * 32 + (lane & 1) * 16);
        *(u32x4*)((unsigned char*)MIXo + (size_t)(b * SEQ + q0 + (lane >> 1)) * DM + hh * 64 + 32 * dt + 16 * (lane & 1)) = ov;
        LDS_WAIT(); asm volatile("" ::: "memory");
    }
    LDS_BARRIER();
    return lo_loaded;
}
__device__ __forceinline__ void sb_phase(const Frame& F, const bf16_t* KVQ, bf16_t* MIXo) {
    bf16x8 qa[4], qb_[4];
    const int L0 = 6 * F.bx;
    sb_prefetch_q(F, KVQ, sb_unit_of(L0), qa);
    int have_lo = 1, have_hi = 0;
    for (int j = 0; j < 6; j += 2) {
        const int Lc = L0 + j;
        sb_prefetch_q(F, KVQ, sb_unit_of(Lc + 1), qb_);
        { const int u = sb_unit_of(Lc); const int lo = sb_unit(F, KVQ, MIXo, u, qa, have_lo, have_hi);
          if (((Lc + 1) >> 4) == (Lc >> 4)) { have_lo = lo; have_hi = lo + SB_NSLOT - 1; } else { have_lo = 1; have_hi = 0; } }
        if (j + 2 < 6) sb_prefetch_q(F, KVQ, sb_unit_of(Lc + 2), qa);
        { const int u = sb_unit_of(Lc + 1); const int lo = sb_unit(F, KVQ, MIXo, u, qb_, have_lo, have_hi);
          if (((Lc + 2) >> 4) == ((Lc + 1) >> 4)) { have_lo = lo; have_hi = lo + SB_NSLOT - 1; } else { have_lo = 1; have_hi = 0; } }
    }
}

struct Args { const float* in[20]; float* out; unsigned char* ws; };

__global__ void __launch_bounds__(NTHR, 2) yoco_fwd(Args args) {
    extern __shared__ __attribute__((aligned(16))) unsigned char lds_raw[];
    Frame F;
    F.lds = (LAS unsigned char*)lds_raw;
    F.tid = threadIdx.x; F.lane = F.tid & 63; F.wave = __builtin_amdgcn_readfirstlane(F.tid >> 6);
    F.G = gridDim.x; F.bx = blockIdx.x;
    Ptrs P;
    P.x = args.in[0]; P.mem = args.in[1]; P.anpre = args.in[2]; P.anpost = args.in[3]; P.fnpre = args.in[4]; P.fnpost = args.in[5];
    P.w_in_a = args.in[6]; P.hlb = args.in[7]; P.hon = args.in[8]; P.w_in_b = args.in[9]; P.kvn = args.in[10]; P.w_kv = args.in[11];
    P.memn = args.in[12]; P.w_mem_kv = args.in[13]; P.w_out = args.in[14]; P.w_gu = args.in[15]; P.w_dn = args.in[16]; P.w_router = args.in[17];
    P.w_egu = args.in[18]; P.w_edn = args.in[19]; P.out = args.out; P.ws = args.ws;
    unsigned char* ws = args.ws;
    unsigned* ctl = (unsigned*)(ws + WS_CTL);
    volatile LAS unsigned* MISC = (volatile LAS unsigned*)(F.lds + MISC_OFF);
    for (int u = F.tid; u < (LDS_BYTES - LDSCTL_OFF) / 4; u += NTHR) ((LAS unsigned*)(F.lds + LDSCTL_OFF))[u] = 0u;
    __syncthreads();
    XcdBarrier bar = xcd_barrier_post(ctl + CW_BAR, MISC + 8);
    {
        if (F.tid == 0) { const unsigned xcc = xb_xcc_id(); const unsigned rk = xb_add((unsigned*)ctl + CW_XRANK + xcc, 1u); MISC[12] = (xcc < 8u && rk < (unsigned)(F.G >> 3) && (F.G & 7) == 0) ? rk * 8u + xcc : 0xffffffffu; }
        __syncthreads();
        if (F.tid == 0 && MISC[12] == 0xffffffffu) __hip_atomic_store((unsigned*)ctl + CW_XRANK + 15, 1u, __ATOMIC_RELAXED, __HIP_MEMORY_SCOPE_AGENT);
    }
#define GRID_BAR() xcd_barrier(bar)

    bf16_t* const U = (bf16_t*)(ws + WS_U);
    bf16_t* const R1 = (bf16_t*)(ws + WS_R1);
    bf16_t* const MIX = (bf16_t*)(ws + WS_MIX);
    bf16_t* const MIXED = (bf16_t*)(ws + WS_MIXED);
    bf16_t* const MKV = (bf16_t*)(ws + WS_MKV);
    bf16_t* const H16 = (bf16_t*)(ws + WS_H16);

    { const Frame Fp = phase_frame(F); p0_prologue(Fp, P); }
    GRID_BAR();
    if (__hip_atomic_load((unsigned*)ctl + CW_XRANK + 15, __ATOMIC_RELAXED, __HIP_MEMORY_SCOPE_AGENT) == 0u) F.bx = (int)MISC[12];
    {
        pg8::Gemm g{U, (const bf16_t*)(ws + WS_WINA), MTOK, AW, DM / 2}; pg8::StaticOrder S; S.init(MTOK, AW, F.G, F.bx);
        S.ext_n = 32; S.ext_pm0 = MTOK / 256; S.ext_pn0 = AW / 256;
        pg8::EpiStoreQ E{R1, AW, (const float*)(ws + WS_AS), (const float*)(ws + WS_WSC) + WSC_INA, MKV, DM, MTOK / 256, AW / 256};
        pg8::gemm_phase<pg8::EpiStoreQ, pg8::StaticOrder, true, true, 2>(F.lds, g, S, E);
    }
    GRID_BAR();
    { const Frame Fp = phase_frame(F); hgrnA_phase(Fp, P); }
    { const Frame Fp = phase_frame(F); for (int u = F.bx; u < 512; u += F.G) memattn_unit<false>(Fp, R1, AW, 3072, MKV, 0, MIX, u); }
    GRID_BAR();
    { const Frame Fp = phase_frame(F); if (F.bx < 96) hgrn_chain(Fp, P, ((((F.bx >> 4) << 3) | (F.bx & 7)) << 1) | ((F.bx >> 3) & 1));
      else convert_weights(Fp, P, (F.bx - 96) * NWAVES + Fp.wave, (F.G - 96) * NWAVES); }
    GRID_BAR();
    {
        pg8::Gemm g{MIX, (const bf16_t*)(ws + WS_WOUT0), MTOK, DM, DM}; pg8::StaticOrder S; S.init(MTOK, DM, F.G, F.bx);
        pg8::EpiStore E{MIXED, DM, 1.f, nullptr, 0, 0, 0};
        pg8::gemm_phase<pg8::EpiStore, pg8::StaticOrder, true, true>(F.lds, g, S, E);
    }
    GRID_BAR();
    { const Frame Fp = phase_frame(F); norm_phase<false, true>(Fp, MIXED, P.x, H16, P.anpost, U, P.fnpre, (float*)(ws + WS_AS + 256 * 1024)); }
#if STOP_AFTER >= 5
    GRID_BAR();
    {
        pg8::Gemm g{U, (const bf16_t*)(ws + WS_WGU), MTOK, 2 * DFF, DM / 2}; pg8::StaticOrder S; S.init(MTOK, 2 * DFF, F.G, F.bx);
        pg8::EpiSwiGLUQ8 E{(unsigned char*)R1, DFF, (const float*)(ws + WS_AS + 256 * 1024), (const float*)(ws + WS_WSC) + WSC_GU};
        pg8::gemm_phase<pg8::EpiSwiGLUQ8, pg8::StaticOrder, true, true, 2>(F.lds, g, S, E);
    }
    GRID_BAR();
    {
        pg8::Gemm g{R1, (const bf16_t*)(ws + WS_WDN), MTOK, DM, DFF / 2}; pg8::StaticOrder S; S.init(MTOK, DM, F.G, F.bx);
        pg8::EpiStore E{MIXED, DM, 1.0f / (FP8_SHD * FP8_SWDD), nullptr, 0, 0, 0};
        pg8::gemm_phase<pg8::EpiStore, pg8::StaticOrder, true, true, 1>(F.lds, g, S, E);
    }
    GRID_BAR();
    { const Frame Fp = phase_frame(F); norm_phase<true, true>(Fp, MIXED, H16, H16, P.fnpost, U, nullptr, (float*)(ws + WS_AS + 512 * 1024)); }
#endif
#if STOP_AFTER >= 8
    GRID_BAR();
    {
        pg8::Gemm g{U, (const bf16_t*)(ws + WS_WKVB), MTOK, KVQW, DM / 2}; pg8::StaticOrder S; S.init(MTOK, KVQW, F.G, F.bx);
        pg8::EpiStoreQ E{R1, KVQW, (const float*)(ws + WS_AS + 512 * 1024), (const float*)(ws + WS_WSC) + WSC_KVB, nullptr, 0, 0, 0};
        pg8::gemm_phase<pg8::EpiStoreQ, pg8::StaticOrder, true, true, 2>(F.lds, g, S, E);
    }
    GRID_BAR();
    {
        { const Frame Fp = phase_frame(F); sb_phase(Fp, R1, MIX); }
        { const Frame Fp = phase_frame(F); for (int u = F.bx; u < 512; u += F.G) memattn_unit<true>(Fp, R1, KVQW, 2304, MKV, 512, MIX, u); }
    }
    GRID_BAR();
    {
        pg8::Gemm g{MIX, (const bf16_t*)(ws + WS_WOUT1), MTOK, DM, DM / 2}; pg8::StaticOrder S; S.init(MTOK, DM, F.G, F.bx);
        pg8::EpiStore E{MIXED, DM, 1.0f / (FP8_SM * FP8_SWO), nullptr, 0, 0, 0};
        pg8::gemm_phase<pg8::EpiStore, pg8::StaticOrder, true, true, 1>(F.lds, g, S, E);
    }
    GRID_BAR();
    {
        const Frame Fq = phase_frame(F);
        LAS unsigned* lcnt = (LAS unsigned*)(F.lds + 32768);
        LAS float* WRt = (LAS float*)(F.lds);
        if (Fq.tid < 8) lcnt[Fq.tid] = 0u;
        for (int idx = Fq.tid; idx < DM * NEXP; idx += NTHR) WRt[(idx & 7) * DM + (idx >> 3)] = P.w_router[idx];
        __syncthreads();
        f32x4 g1v[4], g2v[4];
#pragma unroll
        for (int j = 0; j < 4; ++j) { g1v[j] = ((const f32x4*)(P.anpost + DM))[Fq.lane + 64 * j]; g2v[j] = ((const f32x4*)(P.fnpre + DM))[Fq.lane + 64 * j]; }
        for (int i0 = 0; i0 < 16; i0 += 4) {
          const int m0 = F.bx * 128 + Fq.wave * 16 + i0;
          u32x2 ar[4][4], bs[4][4];
#pragma unroll
          for (int r = 0; r < 4; ++r)
#pragma unroll
            for (int j = 0; j < 4; ++j) { ar[r][j] = ((const u32x2*)(MIXED + (size_t)(m0 + r) * DM))[Fq.lane + 64 * j]; bs[r][j] = ((const u32x2*)(H16 + (size_t)(m0 + r) * DM))[Fq.lane + 64 * j]; }
          f32x4 uu[4][4];
#pragma unroll
          for (int r = 0; r < 4; ++r) {
            const int m = m0 + r;
            f32x4 a[4];
#pragma unroll
            for (int j = 0; j < 4; ++j) a[j] = (f32x4){bflo(ar[r][j].x), bfhi(ar[r][j].x), bflo(ar[r][j].y), bfhi(ar[r][j].y)};
            const float rs = row_rstd(a);
            f32x4 h[4];
#pragma unroll
            for (int j = 0; j < 4; ++j) {
                h[j] = (f32x4){bflo(bs[r][j].x), bfhi(bs[r][j].x), bflo(bs[r][j].y), bfhi(bs[r][j].y)} + a[j] * rs * g1v[j];
                u32x2 hw; hw.x = pk2(h[j].x, h[j].y); hw.y = pk2(h[j].z, h[j].w); ((u32x2*)(H16 + (size_t)m * DM))[Fq.lane + 64 * j] = hw; }
            const float rh = row_rstd(h);
            unsigned* o4 = (unsigned*)((unsigned char*)U + (size_t)m * DM) + Fq.lane;
#pragma unroll
            for (int j = 0; j < 4; ++j) { uu[r][j] = h[j] * rh * g2v[j];
                o4[64 * j] = pk4_fp8s(uu[r][j].x * FP8_SX, uu[r][j].y * FP8_SX, uu[r][j].z * FP8_SX, uu[r][j].w * FP8_SX); }
          }
          float lg[4][8];
#pragma unroll
          for (int r = 0; r < 4; ++r)
#pragma unroll
            for (int e = 0; e < 8; ++e) lg[r][e] = 0.f;
#pragma unroll
          for (int j = 0; j < 4; ++j)
#pragma unroll
            for (int e = 0; e < 8; ++e) { const f32x4 w4 = *(const LAS f32x4*)(WRt + e * DM + 4 * Fq.lane + 256 * j);
#pragma unroll
                for (int r = 0; r < 4; ++r) lg[r][e] += uu[r][j].x * w4.x + uu[r][j].y * w4.y + uu[r][j].z * w4.z + uu[r][j].w * w4.w; }
#pragma unroll
          for (int r = 0; r < 4; ++r) {
            const int m = m0 + r;
#pragma unroll
            for (int e = 0; e < 8; ++e) lg[r][e] = wave_sum(lg[r][e]);
            int i0 = 0; float l0 = lg[r][0];
#pragma unroll
            for (int e = 1; e < 8; ++e) if (lg[r][e] > l0) { l0 = lg[r][e]; i0 = e; }
            int i1 = -1; float l1 = -3.0e38f;
#pragma unroll
            for (int e = 0; e < 8; ++e) if (e != i0 && lg[r][e] > l1) { l1 = lg[r][e]; i1 = e; }
            const float g0 = 1.0f / (1.0f + __expf(l1 - l0));
            if (Fq.lane == 0) {
                const unsigned r0 = __hip_atomic_fetch_add(lcnt + i0, 1u, __ATOMIC_RELAXED, __HIP_MEMORY_SCOPE_WORKGROUP);
                const unsigned r1 = __hip_atomic_fetch_add(lcnt + i1, 1u, __ATOMIC_RELAXED, __HIP_MEMORY_SCOPE_WORKGROUP);
                ((int4*)(ws + WS_META))[m] = make_int4(i0, i1, (int)r0, (int)r1);
                ((float2*)(ws + WS_GATE))[m] = make_float2(g0, 1.0f - g0);
            }
          }
        }
        __syncthreads();
        if (Fq.tid < 8) { const unsigned base = __hip_atomic_fetch_add(ctl + CW_GCNT + Fq.tid, lcnt[Fq.tid], __ATOMIC_RELAXED, __HIP_MEMORY_SCOPE_AGENT); ((unsigned*)(ws + WS_WGB))[F.bx * 8 + Fq.tid] = base; }
    }
#endif
#if STOP_AFTER >= 12
    GRID_BAR();
    int ts[NEXP + 1];
    {
        const Frame Fq = phase_frame(F);
        ts[0] = 0;
#pragma unroll
        for (int e = 0; e < NEXP; ++e) { const unsigned c = __hip_atomic_load(ctl + CW_GCNT + e, __ATOMIC_RELAXED, __HIP_MEMORY_SCOPE_AGENT); ts[e + 1] = ts[e] + (int)((c + 255u) >> 8); }
        bf16_t* XS = R1;
        for (int i0 = 0; i0 < 16; i0 += 4) {
            const int m0 = F.bx * 128 + Fq.wave * 16 + i0;
            int4 mt[4]; u32x4 v0[4];
#pragma unroll
            for (int r = 0; r < 4; ++r) { mt[r] = ((const int4*)(ws + WS_META))[m0 + r]; v0[r] = *((const u32x4*)((const unsigned char*)U + (size_t)(m0 + r) * DM) + Fq.lane); }
#pragma unroll
            for (int r = 0; r < 4; ++r) {
                int d0 = 0, d1 = 0;
#pragma unroll
                for (int e = 0; e < NEXP; ++e) { if (mt[r].x == e) d0 = ts[e] * 256; if (mt[r].y == e) d1 = ts[e] * 256; }
                d0 += (int)((const unsigned*)(ws + WS_WGB))[F.bx * 8 + mt[r].x] + mt[r].z;
                d1 += (int)((const unsigned*)(ws + WS_WGB))[F.bx * 8 + mt[r].y] + mt[r].w;
                *((u32x4*)((unsigned char*)XS + (size_t)d0 * DM) + Fq.lane) = v0[r]; *((u32x4*)((unsigned char*)XS + (size_t)d1 * DM) + Fq.lane) = v0[r];
                if (Fq.lane == 0) ((int2*)(ws + WS_DEST))[m0 + r] = make_int2(d0, d1);
            }
        }
    }
    GRID_BAR();
    const int nMt = ts[NEXP], RT = nMt > 256 ? nMt - 256 : 0, R_early = 4 * RT, R8 = (R_early + 7) & ~7;
    unsigned* const ecnt = ctl + CW_EARLY;
    {
        pg8::Gemm g{R1, (const bf16_t*)(ws + WS_WEGU), 0, 2 * DFE, DM / 2}; pg8::SignalOrder S; S.init(256, 2 * DFE, F.G, F.bx);
        S.nM = nMt; S.nwg = S.nM * S.nN; S.moe = 1; S.sp_q = 25; S.sp_R8 = ((F.G & 7) == 0 && R8 < F.G) ? R8 : 0; S.cnt = ecnt; S.early_rt = RT;
#pragma unroll
        for (int e = 0; e < NEXP; ++e) S.ts[e] = ts[e];
        pg8::EpiSwiGLU8 E{(unsigned char*)(ws + WS_EH), DFE, 1.0f / (FP8_SX * FP8_SWGU)};
        pg8::gemm_phase<pg8::EpiSwiGLU8, pg8::SignalOrder, true, true, 1>(F.lds, g, S, E);
    }
#pragma unroll 1
    for (int pass = 0; pass < 2; ++pass) {
        pg8::Gemm g{(const bf16_t*)(ws + WS_EH), (const bf16_t*)(ws + WS_WEDN), 0, DM, DFE / 2}; pg8::StaticOrder S; S.init(256, DM, F.G, F.bx);
        S.moe = 1;
#pragma unroll
        for (int e = 0; e < NEXP; ++e) S.ts[e] = ts[e];
        if (pass == 0) {
            S.one_on = 1; S.one_has = (F.bx < R_early) ? 1 : 0; S.one_pm = F.bx >> 2; S.one_pn = F.bx & 3;
            if (S.one_has) {
                if (F.tid == 0) { unsigned sp = 0; while (__hip_atomic_load(ecnt, __ATOMIC_RELAXED, __HIP_MEMORY_SCOPE_AGENT) < (unsigned)(28 * RT) && ++sp < (1u << 22)) __builtin_amdgcn_s_sleep(2);
                    __builtin_amdgcn_fence(__ATOMIC_ACQUIRE, "agent"); }
                __syncthreads();
            }
        } else { S.nM = nMt - RT; S.nwg = S.nM * S.nN; S.pm_off = RT; }
        pg8::EpiStore E{R1 + (size_t)XS_ROWS * DM / 2, DM, 1.0f / (FP8_SH * FP8_SWDN), nullptr, 0, 0, 0};
        pg8::gemm_phase<pg8::EpiStore, pg8::StaticOrder, true, true, 1>(F.lds, g, S, E);
        GRID_BAR();
    }
    {
        const Frame Fq = phase_frame(F);
        f32x4 g1v[4];
#pragma unroll
        for (int j = 0; j < 4; ++j) g1v[j] = ((const f32x4*)(P.fnpost + DM))[Fq.lane + 64 * j];
        const bf16_t* YS = R1 + (size_t)XS_ROWS * DM / 2;
        for (int i0 = 0; i0 < 16; i0 += 4) {
            const int m0 = F.bx * 128 + Fq.wave * 16 + i0;
            int2 d[4]; float2 gt[4];
#pragma unroll
            for (int r = 0; r < 4; ++r) { d[r] = ((const int2*)(ws + WS_DEST))[m0 + r]; gt[r] = ((const float2*)(ws + WS_GATE))[m0 + r]; }
            u32x2 ya[4][4], yb[4][4], bs[4][4];
#pragma unroll
            for (int r = 0; r < 4; ++r)
#pragma unroll
                for (int j = 0; j < 4; ++j) { ya[r][j] = ((const u32x2*)(YS + (size_t)d[r].x * DM))[Fq.lane + 64 * j]; yb[r][j] = ((const u32x2*)(YS + (size_t)d[r].y * DM))[Fq.lane + 64 * j];
                    bs[r][j] = ((const u32x2*)(H16 + (size_t)(m0 + r) * DM))[Fq.lane + 64 * j]; }
#pragma unroll
            for (int r = 0; r < 4; ++r) {
                f32x4 a[4];
#pragma unroll
                for (int j = 0; j < 4; ++j) a[j] = (f32x4){bflo(ya[r][j].x), bfhi(ya[r][j].x), bflo(ya[r][j].y), bfhi(ya[r][j].y)} * gt[r].x + (f32x4){bflo(yb[r][j].x), bfhi(yb[r][j].x), bflo(yb[r][j].y), bfhi(yb[r][j].y)} * gt[r].y;
                const float rs = row_rstd(a);
#pragma unroll
                for (int j = 0; j < 4; ++j) { const f32x4 gg = g1v[j];
                    ((f32x4*)(P.out + (size_t)(m0 + r) * DM))[Fq.lane + 64 * j] = (f32x4){bflo(bs[r][j].x), bfhi(bs[r][j].x), bflo(bs[r][j].y), bfhi(bs[r][j].y)} + a[j] * rs * gg; }
            }
        }
    }
#endif
}

extern "C" void kernel_launch(void* const* d_in, const int* in_sizes, int n_in, void* d_out, int out_size, void* d_ws, size_t ws_size, hipStream_t stream) {
    static int grid = 0;
    if (grid == 0) {
        if (n_in != 20 || out_size != MTOK * DM || ws_size < WS_END) { fprintf(stderr, "kernel_launch: unexpected shapes (n_in %d out %d ws %zu)\n", n_in, out_size, ws_size); grid = -1; return; }
        int dev = 0, cus = 0, per_cu = 0;
        if (hipGetDevice(&dev) != hipSuccess || hipDeviceGetAttribute(&cus, hipDeviceAttributeMultiprocessorCount, dev) != hipSuccess) { grid = -1; return; }
        if (hipFuncSetAttribute((const void*)yoco_fwd, hipFuncAttributeMaxDynamicSharedMemorySize, LDS_BYTES) != hipSuccess) { fprintf(stderr, "kernel_launch: hipFuncSetAttribute failed\n"); grid = -1; return; }
        if (hipOccupancyMaxActiveBlocksPerMultiprocessor(&per_cu, (const void*)yoco_fwd, NTHR, LDS_BYTES) != hipSuccess || per_cu < 1) { fprintf(stderr, "kernel_launch: occupancy query says %d\n", per_cu); }
        (void)hipGetLastError();
        if (cus < 256) { fprintf(stderr, "kernel_launch: need 256 CUs, have %d\n", cus); grid = -1; return; }
        grid = 256;
    }
    if (grid < 0) return;
    if (hipMemsetAsync((char*)d_ws + WS_CTL, 0, CTL_ZERO_BYTES, stream) != hipSuccess) return;
    Args a{};
    for (int i = 0; i < 20; ++i) a.in[i] = (const float*)d_in[i];
    a.out = (float*)d_out; a.ws = (unsigned char*)d_ws;
    hipLaunchKernelGGL(yoco_fwd, dim3(grid), dim3(NTHR), LDS_BYTES, stream, a);
}
```

```cpp
#include <hip/hip_runtime.h>
#include <cstdio>
#include <cstdint>

#ifndef STOP_AFTER
#define STOP_AFTER 99
#endif

#define LAS __attribute__((address_space(3)))
#define GAS __attribute__((address_space(1)))
typedef unsigned short bf16_t;
typedef short bf16x8 __attribute__((ext_vector_type(8)));
typedef float f32x4 __attribute__((ext_vector_type(4)));
typedef float f32x16 __attribute__((ext_vector_type(16)));
typedef float f32x2 __attribute__((ext_vector_type(2)));
typedef unsigned u32x4 __attribute__((ext_vector_type(4)));
typedef unsigned u32x2 __attribute__((ext_vector_type(2)));
typedef __bf16 bf16x2_t __attribute__((ext_vector_type(2)));

constexpr int NB = 8, SEQ = 4096, DM = 1024, MTOK = NB * SEQ;
constexpr int MEML = 256, MROWS = NB * MEML;
constexpr int AW = 3328, HF = 768, DFF = 2816, NEXP = 8, DFE = 3584;
constexpr int KVQW = 2560;
constexpr int XS_ROWS = 2 * MTOK + NEXP * 256;
constexpr float RMS_EPS = 1e-6f;
constexpr float C2 = 0.125f * 1.4426950408889634f;
constexpr int NWAVES = 8, NTHR = 512;

constexpr size_t MiB = 1u << 20;
constexpr size_t WS_CTL = 0, CTL_ZERO_BYTES = 128 * 1024;
constexpr size_t WS_MEMN = 395 * MiB + 32 * MiB;
constexpr size_t WS_MEMN_OLD_UNUSED = 459 * MiB;
constexpr size_t WS_AS = 1 * MiB;
constexpr size_t WS_WSC = 2 * MiB;
constexpr int WSC_INA = 0, WSC_GU = 4352, WSC_KVB = 9984, WSC_N = 12544;
constexpr size_t WS_MKV = 5 * MiB;
constexpr size_t WS_META = 9 * MiB;
constexpr size_t WS_GATE = WS_META + 512 * 1024, WS_DEST = WS_GATE + 256 * 1024, WS_WGB = WS_DEST + 256 * 1024;
constexpr size_t WS_WOUT1 = 12 * MiB;
constexpr size_t WS_WKVB = 14 * MiB;
constexpr size_t WS_WEGU = 19 * MiB;
constexpr size_t WS_WEDN = 131 * MiB;
constexpr size_t WS_R1 = 187 * MiB;
constexpr size_t WS_EH = 395 * MiB;
constexpr size_t WS_U = 395 * MiB;
constexpr size_t WS_MIX = 459 * MiB;
constexpr size_t WS_MIXED = 523 * MiB;
constexpr size_t WS_WINA = 587 * MiB;
constexpr size_t WS_WMKV = 587 * MiB + (size_t)3328 * 1024;
constexpr size_t WS_WMKV_OLD_UNUSED = 587 * MiB + (size_t)3328 * 1024 * 2;
constexpr size_t WS_WOUT0 = 596 * MiB;
constexpr size_t WS_WGU = 598 * MiB;
constexpr size_t WS_WDN = 609 * MiB;
constexpr size_t WS_HGQD = 640 * MiB;
constexpr size_t WS_HGOI = 688 * MiB;
constexpr size_t WS_HGU = 736 * MiB;
constexpr size_t WS_HGDEC = 832 * MiB;
constexpr size_t WS_H16 = 640 * MiB;
constexpr size_t WS_END = 857 * MiB;
static_assert(WS_EH + (size_t)XS_ROWS * DFE * 2 <= WS_END, "EH fits");
static_assert(WS_R1 + (size_t)MTOK * AW * 2 <= WS_EH, "R1 fits");
constexpr int CW_BAR = 4096;
constexpr int CW_GCNT = 16384;
constexpr int CW_P0T = 16448 + 128;
constexpr int CW_EARLY = 16448 + 64;
constexpr int CW_XRANK = 16448;
static_assert((CW_P0T + 16) * 4 <= (int)CTL_ZERO_BYTES, "control words inside the zeroed region");

constexpr int RING_BYTES = 131072;
constexpr int LDSCTL_OFF = RING_BYTES, MISC_OFF = LDSCTL_OFF + 320;
constexpr int LDS_BYTES = 147456;

__device__ __forceinline__ unsigned f2bf(float f) { unsigned u = __builtin_bit_cast(unsigned, f); return (u + 0x7fffu + ((u >> 16) & 1u)) >> 16; }
__device__ __forceinline__ unsigned pk2(float lo, float hi) { f32x2 v = {lo, hi}; bf16x2_t b = __builtin_convertvector(v, bf16x2_t); return __builtin_bit_cast(unsigned, b); }
__device__ __forceinline__ float bflo(unsigned w) { return __builtin_bit_cast(float, w << 16); }
__device__ __forceinline__ float bfhi(unsigned w) { return __builtin_bit_cast(float, w & 0xffff0000u); }
__device__ __forceinline__ float bf1(unsigned short s) { return __builtin_bit_cast(float, (unsigned)s << 16); }
__device__ __forceinline__ float wave_sum(float v);
__device__ __forceinline__ float fexp2(float x) { return __builtin_amdgcn_exp2f(x); }
__device__ __forceinline__ float flog2(float x) { return __builtin_amdgcn_logf(x); }
__device__ __forceinline__ float frcp(float x) { return __builtin_amdgcn_rcpf(x); }
__device__ __forceinline__ float frsq(float x) { return __builtin_amdgcn_rsqf(x); }
template <int X> __device__ __forceinline__ float swz_xor(float v) { return __builtin_bit_cast(float, __builtin_amdgcn_ds_swizzle(__builtin_bit_cast(int, v), (X << 10) | 0x1F)); }
__device__ __forceinline__ float wave_sum(float v) {
    v += swz_xor<1>(v); v += swz_xor<2>(v); v += swz_xor<4>(v); v += swz_xor<8>(v); v += swz_xor<16>(v);
    const float lo = __builtin_bit_cast(float, __builtin_amdgcn_readlane(__builtin_bit_cast(int, v), 0)), hi = __builtin_bit_cast(float, __builtin_amdgcn_readlane(__builtin_bit_cast(int, v), 32));
    return lo + hi;
}
__device__ __forceinline__ float sigmoidf_(float x) { return frcp(1.0f + fexp2(-1.4426950408889634f * x)); }
typedef int i32x4 __attribute__((ext_vector_type(4)));
typedef int i32x8 __attribute__((ext_vector_type(8)));
__device__ __forceinline__ float sat8(float x) { return __builtin_amdgcn_fmed3f(x, -448.f, 448.f); }
__device__ __forceinline__ unsigned pk4_fp8s(float a, float b, float c, float d) { int w = 0; w = __builtin_amdgcn_cvt_pk_fp8_f32(sat8(a), sat8(b), w, false); w = __builtin_amdgcn_cvt_pk_fp8_f32(sat8(c), sat8(d), w, true); return (unsigned)w; }
__device__ __forceinline__ unsigned char fp8_1(float x) { return (unsigned char)(__builtin_amdgcn_cvt_pk_fp8_f32(sat8(x), 0.f, 0, false) & 0xff); }
__device__ __forceinline__ unsigned pk4_fp8(float a, float b, float c, float d) { int w = 0; w = __builtin_amdgcn_cvt_pk_fp8_f32(a, b, w, false); w = __builtin_amdgcn_cvt_pk_fp8_f32(c, d, w, true); return (unsigned)w; }
constexpr float FP8_SX = 8.f, FP8_SH = 8.f, FP8_SWGU = 32.f, FP8_SWDN = 64.f, FP8_SHD = 8.f, FP8_SWDD = 64.f, FP8_SM = 16.f, FP8_SWO = 64.f;
__device__ __forceinline__ float wave_max(float v) {
    v = fmaxf(v, swz_xor<1>(v)); v = fmaxf(v, swz_xor<2>(v)); v = fmaxf(v, swz_xor<4>(v)); v = fmaxf(v, swz_xor<8>(v)); v = fmaxf(v, swz_xor<16>(v));
    const float lo = __builtin_bit_cast(float, __builtin_amdgcn_readlane(__builtin_bit_cast(int, v), 0)), hi = __builtin_bit_cast(float, __builtin_amdgcn_readlane(__builtin_bit_cast(int, v), 32));
    return fmaxf(lo, hi);
}
__device__ __forceinline__ unsigned pk4_i8(float a, float b, float c, float d) {
    const int ia = (int)__builtin_rintf(__builtin_amdgcn_fmed3f(a, -127.f, 127.f)), ib = (int)__builtin_rintf(__builtin_amdgcn_fmed3f(b, -127.f, 127.f)),
              ic = (int)__builtin_rintf(__builtin_amdgcn_fmed3f(c, -127.f, 127.f)), id = (int)__builtin_rintf(__builtin_amdgcn_fmed3f(d, -127.f, 127.f));
    return (unsigned)(ia & 0xff) | ((unsigned)(ib & 0xff) << 8) | ((unsigned)(ic & 0xff) << 16) | ((unsigned)id << 24);
}
__device__ __forceinline__ void quant_row_i8(const f32x4 (&uu)[4], unsigned char* qrow, float* as_slot, int lane) {
    float am = 0.f;
#pragma unroll
    for (int j = 0; j < 4; ++j) am = fmaxf(fmaxf(am, fmaxf(__builtin_fabsf(uu[j].x), __builtin_fabsf(uu[j].y))), fmaxf(__builtin_fabsf(uu[j].z), __builtin_fabsf(uu[j].w)));
    am = fmaxf(wave_max(am), 1e-20f);
    const float inv = 127.0f / am;
    unsigned* o4 = (unsigned*)qrow + lane;
#pragma unroll
    for (int j = 0; j < 4; ++j) o4[64 * j] = pk4_i8(uu[j].x * inv, uu[j].y * inv, uu[j].z * inv, uu[j].w * inv);
    if (lane == 0) *as_slot = am * (1.0f / 127.0f);
}
__device__ __forceinline__ int crow(int r, int hi) { return (r & 3) + 8 * (r >> 2) + 4 * hi; }
#define LDS_WAIT() asm volatile("s_waitcnt lgkmcnt(0)" ::: "memory")
#define VM_WAIT() asm volatile("s_waitcnt vmcnt(0)" ::: "memory")
#define LDS_BARRIER() do { asm volatile("s_waitcnt lgkmcnt(0)" ::: "memory"); __builtin_amdgcn_s_barrier(); asm volatile("" ::: "memory"); } while (0)

namespace pg8 {
#define PG8_LAS __attribute__((address_space(3)))
constexpr int BM = 256, BK = 64, HALF = 128, HTB = HALF * BK * 2, STAGE_BYTES = 8 * HTB, NXCD = 8, WGM = 4;
__host__ __device__ __forceinline__ int lds_byte(int r, int c) { const int st = (r >> 4) * 2 + (c >> 5), rr = r & 15, cc = c & 31, ob = rr * 64 + cc * 2; return st * 1024 + (ob ^ (((ob >> 9) & 1) << 5)); }
__host__ __device__ __forceinline__ void stage_rc(int b, int& R, int& C) { const int st = b / 1024, sb = b % 1024, swz = sb ^ (((sb >> 9) & 1) << 5); R = (st >> 1) * 16 + swz / 64; C = (st & 1) * 32 + (swz % 64) / 2; }
__host__ __device__ __forceinline__ int perm32(int rho) { const int n = rho >> 4, i = rho & 15; return 8 * (i >> 2) + 4 * n + (i & 3); }

struct Unit { int pm, pn, pb; };
struct Gemm { const bf16_t* A; const bf16_t* Bt; int M, N, K; };

struct StaticOrder {
    static constexpr bool SIGNALS = false;
    int nM, nN, nwg, G, c;
    int ts[NEXP];
    int moe;
    int ext_n, ext_pm0, ext_pn0;
    int sp_q, sp_R8;
    int pm_off;
    int one_on, one_has, one_pm, one_pn;
    __device__ void init(int M, int N, int G_, int c_) { nM = M / BM; nN = N / BM; nwg = nM * nN; G = G_; c = c_; moe = 0; ext_n = 0; ext_pm0 = 0; ext_pn0 = 0; sp_q = 0; sp_R8 = 0; pm_off = 0; one_on = 0; one_has = 0; one_pm = 0; one_pn = 0;
#pragma unroll
        for (int e = 0; e < NEXP; ++e) ts[e] = 0; }
    __device__ __forceinline__ bool next(int i, Unit& u) const {
        int pm, pn;
        if (one_on) { if (i > 0 || !one_has) return false; pm = one_pm; pn = one_pn; }
        else {
            long L = (long)i * G + c;
            if (sp_R8 > 0 && i >= sp_q) { if (c < sp_R8) return false; L = (long)sp_q * G + (long)(i - sp_q) * (G - sp_R8) + (c - sp_R8); }
            if (L >= nwg + ext_n) return false;
            if (L >= nwg) { const int j = (int)L - nwg; pm = ext_pm0 + (j >> 2); pn = ext_pn0 + (j & 3); }
            else {
                int wgid = (int)L; { const int q = nwg / NXCD, r = nwg % NXCD, xcd = wgid % NXCD, off = wgid / NXCD; wgid = (xcd < r ? xcd * (q + 1) : r * (q + 1) + (xcd - r) * q) + off; }
                const int nig = WGM * nN, gid = wgid / nig, fm = gid * WGM, gsz = (nM - fm) < WGM ? (nM - fm) : WGM;
                pm = fm + ((wgid % nig) % gsz) + pm_off; pn = (wgid % nig) / gsz;
            }
        }
        int pb = pn;
        if (moe) { int e = 0;
#pragma unroll
            for (int j = 1; j < NEXP; ++j) e += (pm >= ts[j]) ? 1 : 0;
            pb = e * nN + pn; }
        u.pm = pm; u.pn = pn; u.pb = pb;
        return true;
    }
    __device__ __forceinline__ void a_ready(const Unit&) const {}
    __device__ __forceinline__ void done(const Unit&) const {}
};
struct SignalOrder : StaticOrder {
    static constexpr bool SIGNALS = true;
    unsigned* cnt; int early_rt;
    __device__ __forceinline__ void signal(int n) const { __builtin_amdgcn_fence(__ATOMIC_RELEASE, "agent"); (void)__hip_atomic_fetch_add(cnt, (unsigned)n, __ATOMIC_RELAXED, __HIP_MEMORY_SCOPE_AGENT); }
};

struct EpiStore {
    static constexpr bool PERM = true, AFTER_DRAIN = false;
    bf16_t* O; int ldc; float sc;
    bf16_t* O2; int ldc2, pm2, pn2;
    __device__ __forceinline__ void operator()(const f32x4 (&acc)[2][2][4][2], const Unit& u, int wr, int wc, int fr, int fq) const {
        int row0 = u.pm * BM + wr * 64 + fr; int col0 = u.pn * BM + wc * 32 + 8 * fq; bf16_t* Ob = O; int ld = ldc;
        if (pm2 > 0 && u.pm >= pm2) { row0 -= pm2 * BM; col0 -= pn2 * BM; Ob = O2; ld = ldc2; }
#pragma unroll
        for (int ai = 0; ai < 2; ++ai)
#pragma unroll
            for (int m = 0; m < 4; ++m) { bf16_t* rowp = Ob + (size_t)(row0 + ai * HALF + m * 16) * ld + col0;
#pragma unroll
                for (int bj = 0; bj < 2; ++bj) { const f32x4 v0 = acc[ai][bj][m][0] * sc, v1 = acc[ai][bj][m][1] * sc;
                    u32x4 w; w.x = pk2(v0[0], v0[1]); w.y = pk2(v0[2], v0[3]); w.z = pk2(v1[0], v1[1]); w.w = pk2(v1[2], v1[3]);
                    *(u32x4*)(rowp + bj * HALF) = w; } }
    }
};
struct EpiSwiGLU {
    static constexpr bool PERM = true, AFTER_DRAIN = false;
    bf16_t* O; int ldc;
    __device__ __forceinline__ void operator()(const f32x4 (&acc)[2][2][4][2], const Unit& u, int wr, int wc, int fr, int fq) const {
        const int row0 = u.pm * BM + wr * 64 + fr; const int col0 = u.pn * HALF + wc * 32 + 8 * fq;
#pragma unroll
        for (int ai = 0; ai < 2; ++ai)
#pragma unroll
            for (int m = 0; m < 4; ++m) { bf16_t* rowp = O + (size_t)(row0 + ai * HALF + m * 16) * ldc + col0;
                float h[8];
#pragma unroll
                for (int n = 0; n < 2; ++n)
#pragma unroll
                    for (int i = 0; i < 4; ++i) { const float g = acc[ai][0][m][n][i], up = acc[ai][1][m][n][i]; h[4 * n + i] = (g * up) * frcp(1.0f + fexp2(-1.4426950408889634f * g)); }
                u32x4 w; w.x = pk2(h[0], h[1]); w.y = pk2(h[2], h[3]); w.z = pk2(h[4], h[5]); w.w = pk2(h[6], h[7]);
                *(u32x4*)rowp = w; }
    }
};

struct EpiStoreQ {
    static constexpr bool PERM = true, AFTER_DRAIN = false;
    bf16_t* O; int ldc; const float* as; const float* ws;
    bf16_t* O2; int ldc2, pm2, pn2;
    __device__ __forceinline__ void operator()(const f32x4 (&acc)[2][2][4][2], const Unit& u, int wr, int wc, int fr, int fq) const {
        const int arow0 = u.pm * BM + wr * 64 + fr, bcol0 = u.pb * BM + wc * 32 + 8 * fq;
        int row0 = arow0, col0 = u.pn * BM + wc * 32 + 8 * fq; bf16_t* Ob = O; int ld = ldc;
        if (pm2 > 0 && u.pm >= pm2) { row0 -= pm2 * BM; col0 -= pn2 * BM; Ob = O2; ld = ldc2; }
        f32x4 wsv[2][2];
#pragma unroll
        for (int bj = 0; bj < 2; ++bj) { wsv[bj][0] = *(const f32x4*)(ws + bcol0 + bj * HALF); wsv[bj][1] = *(const f32x4*)(ws + bcol0 + bj * HALF + 4); }
#pragma unroll
        for (int ai = 0; ai < 2; ++ai)
#pragma unroll
            for (int m = 0; m < 4; ++m) { const float a = as[arow0 + ai * HALF + m * 16]; bf16_t* rowp = Ob + (size_t)(row0 + ai * HALF + m * 16) * ld + col0;
#pragma unroll
                for (int bj = 0; bj < 2; ++bj) { const i32x4 i0 = __builtin_bit_cast(i32x4, acc[ai][bj][m][0]), i1 = __builtin_bit_cast(i32x4, acc[ai][bj][m][1]);
                    const f32x4 v0 = __builtin_convertvector(i0, f32x4) * wsv[bj][0] * a, v1 = __builtin_convertvector(i1, f32x4) * wsv[bj][1] * a;
                    u32x4 w; w.x = pk2(v0[0], v0[1]); w.y = pk2(v0[2], v0[3]); w.z = pk2(v1[0], v1[1]); w.w = pk2(v1[2], v1[3]);
                    *(u32x4*)(rowp + bj * HALF) = w; } }
    }
};
struct EpiSwiGLUQ {
    static constexpr bool PERM = true, AFTER_DRAIN = false;
    bf16_t* O; int ldc; const float* as; const float* ws;
    __device__ __forceinline__ void operator()(const f32x4 (&acc)[2][2][4][2], const Unit& u, int wr, int wc, int fr, int fq) const {
        const int row0 = u.pm * BM + wr * 64 + fr; const int col0 = u.pn * HALF + wc * 32 + 8 * fq, bcol0 = u.pb * BM + wc * 32 + 8 * fq;
        f32x4 wsv[2][2];
#pragma unroll
        for (int bj = 0; bj < 2; ++bj) { wsv[bj][0] = *(const f32x4*)(ws + bcol0 + bj * HALF); wsv[bj][1] = *(const f32x4*)(ws + bcol0 + bj * HALF + 4); }
#pragma unroll
        for (int ai = 0; ai < 2; ++ai)
#pragma unroll
            for (int m = 0; m < 4; ++m) { const float a = as[row0 + ai * HALF + m * 16]; bf16_t* rowp = O + (size_t)(row0 + ai * HALF + m * 16) * ldc + col0;
                float h[8];
#pragma unroll
                for (int n = 0; n < 2; ++n) { const f32x4 gv = __builtin_convertvector(__builtin_bit_cast(i32x4, acc[ai][0][m][n]), f32x4) * wsv[0][n] * a, uv = __builtin_convertvector(__builtin_bit_cast(i32x4, acc[ai][1][m][n]), f32x4) * wsv[1][n] * a;
#pragma unroll
                    for (int i = 0; i < 4; ++i) h[4 * n + i] = (gv[i] * uv[i]) * frcp(1.0f + fexp2(-1.4426950408889634f * gv[i])); }
                u32x4 w; w.x = pk2(h[0], h[1]); w.y = pk2(h[2], h[3]); w.z = pk2(h[4], h[5]); w.w = pk2(h[6], h[7]);
                *(u32x4*)rowp = w; }
    }
};
struct EpiSwiGLUQ8 {
    static constexpr bool PERM = true, AFTER_DRAIN = false;
    static constexpr int NST = 8;
    unsigned char* O; int ldc; const float* as; const float* ws;
    __device__ __forceinline__ void operator()(const f32x4 (&acc)[2][2][4][2], const Unit& u, int wr, int wc, int fr, int fq) const {
        const int row0 = u.pm * BM + wr * 64 + fr; const int col0 = u.pn * HALF + wc * 32 + 8 * fq, bcol0 = u.pb * BM + wc * 32 + 8 * fq;
        f32x4 wsv[2][2];
#pragma unroll
        for (int bj = 0; bj < 2; ++bj) { wsv[bj][0] = *(const f32x4*)(ws + bcol0 + bj * HALF); wsv[bj][1] = *(const f32x4*)(ws + bcol0 + bj * HALF + 4); }
#pragma unroll
        for (int ai = 0; ai < 2; ++ai)
#pragma unroll
            for (int m = 0; m < 4; ++m) { const float a = as[row0 + ai * HALF + m * 16]; unsigned char* rowp = O + (size_t)(row0 + ai * HALF + m * 16) * ldc + col0;
                float h[8];
#pragma unroll
                for (int n = 0; n < 2; ++n) { const f32x4 gv = __builtin_convertvector(__builtin_bit_cast(i32x4, acc[ai][0][m][n]), f32x4) * wsv[0][n] * a, uv = __builtin_convertvector(__builtin_bit_cast(i32x4, acc[ai][1][m][n]), f32x4) * wsv[1][n] * (a * FP8_SHD);
#pragma unroll
                    for (int i = 0; i < 4; ++i) h[4 * n + i] = (gv[i] * uv[i]) * frcp(1.0f + fexp2(-1.4426950408889634f * gv[i])); }
                u32x2 w; w.x = pk4_fp8s(h[0], h[1], h[2], h[3]); w.y = pk4_fp8s(h[4], h[5], h[6], h[7]);
                *(u32x2*)rowp = w; }
    }
};
struct EpiSwiGLU8 {
    static constexpr bool PERM = true, AFTER_DRAIN = false;
    unsigned char* O; int ldc; float ds;
    __device__ __forceinline__ void operator()(const f32x4 (&acc)[2][2][4][2], const Unit& u, int wr, int wc, int fr, int fq) const {
        const float c1 = -1.4426950408889634f * ds, c2 = ds * ds * FP8_SH;
        const int row0 = u.pm * BM + wr * 64 + fr; const int col0 = u.pn * HALF + wc * 32 + 8 * fq;
#pragma unroll
        for (int ai = 0; ai < 2; ++ai)
#pragma unroll
            for (int m = 0; m < 4; ++m) { unsigned char* rowp = O + (size_t)(row0 + ai * HALF + m * 16) * ldc + col0;
                float h[8];
#pragma unroll
                for (int n = 0; n < 2; ++n)
#pragma unroll
                    for (int i = 0; i < 4; ++i) { const float ga = acc[ai][0][m][n][i], ua = acc[ai][1][m][n][i];
                        h[4 * n + i] = (ga * ua) * (c2 * frcp(1.0f + fexp2(ga * c1))); }
                u32x2 w; w.x = pk4_fp8s(h[0], h[1], h[2], h[3]); w.y = pk4_fp8s(h[4], h[5], h[6], h[7]);
                *(u32x2*)rowp = w; }
    }
};

template <class Epi, class Sched, bool ALIGN_EPI = false, bool SP2 = false, int FP8 = 0>
__device__ __forceinline__ void gemm_phase(PG8_LAS unsigned char* lds, const Gemm g, const Sched& S, const Epi& E) {
    int tid_ = threadIdx.x; asm volatile("" : "+v"(tid_));
    const int tid = tid_, wid = __builtin_amdgcn_readfirstlane(tid >> 6), lane = tid & 63, wr = wid >> 2, wc = wid & 3, fr = lane & 15, fq = lane >> 4;
    const int K = g.K, nt = K / BK;
    unsigned voffA[2], voffB[2];
#pragma unroll
    for (int i = 0; i < 2; ++i) { int R, C; stage_rc(tid * 16 + i * 8192, R, C); const int Rb = Epi::PERM ? ((R & ~31) + perm32(R & 31)) : R;
        voffA[i] = (unsigned)(R * K + C) * 2u; voffB[i] = (unsigned)(Rb * K + C) * 2u; }
    const size_t kstep = (size_t)(BK * 2);
    const size_t hstep = (size_t)HALF * K * 2;
    const size_t tstep = 2 * hstep;
    const unsigned ldsw = (unsigned)wid * 1024u;
    const int aoff = lds_byte(wr * 64 + fr, fq * 8), boff = lds_byte(wc * 32 + fr, fq * 8);
#define PG8_SA(b, h) (((b) * 2 + (h)) * HTB)
#define PG8_SB(b, h) ((4 + (b) * 2 + (h)) * HTB)
#define PG8_STAGE(bufoff, gbase, voff) do { _Pragma("unroll") for (int _i = 0; _i < 2; ++_i) \
        __builtin_amdgcn_global_load_lds((const unsigned*)((const char*)(gbase) + (voff)[_i]), (PG8_LAS unsigned*)(lds + (bufoff) + ldsw + _i * 8192), 16, 0, 0); } while (0)
#define PG8_LD8(p) __builtin_shufflevector(*(const PG8_LAS i32x4*)(p), *(const PG8_LAS i32x4*)((p) + 1024), 0, 1, 2, 3, 4, 5, 6, 7)
#define PG8_LDA(dst, b, h) do { if constexpr (FP8 == 1) { _Pragma("unroll") for (int m = 0; m < 4; ++m) dst##8[m] = PG8_LD8(lds + PG8_SA(b, h) + aoff + m * 2048); } \
        else { _Pragma("unroll") for (int m = 0; m < 4; ++m) _Pragma("unroll") for (int k = 0; k < 2; ++k) dst[m][k] = *(const PG8_LAS bf16x8*)(lds + PG8_SA(b, h) + aoff + m * 2048 + k * 1024); } } while (0)
#define PG8_LDB(dst, b, h) do { if constexpr (FP8 == 1) { _Pragma("unroll") for (int n = 0; n < 2; ++n) dst##8[n] = PG8_LD8(lds + PG8_SB(b, h) + boff + n * 2048); } \
        else { _Pragma("unroll") for (int n = 0; n < 2; ++n) _Pragma("unroll") for (int k = 0; k < 2; ++k) dst[n][k] = *(const PG8_LAS bf16x8*)(lds + PG8_SB(b, h) + boff + n * 2048 + k * 1024); } } while (0)
#define PG8_CAT(x, y) __builtin_shufflevector(__builtin_bit_cast(i32x4, x), __builtin_bit_cast(i32x4, y), 0, 1, 2, 3, 4, 5, 6, 7)
#define PG8_MMA(ai, bj, At, Bt) do { __builtin_amdgcn_s_setprio(1); \
        if constexpr (FP8 == 1) { _Pragma("unroll") for (int m = 0; m < 4; ++m) _Pragma("unroll") for (int n = 0; n < 2; ++n) \
            asm volatile("v_mfma_scale_f32_16x16x128_f8f6f4 %0, %1, %2, %0, %3, %3 op_sel_hi:[0,0,0]" : "+v"(acc[ai][bj][m][n]) : "v"(Bt##8[n]), "v"(At##8[m]), "v"(sc1)); } \
        else if constexpr (FP8 == 2) { _Pragma("unroll") for (int m = 0; m < 4; ++m) _Pragma("unroll") for (int n = 0; n < 2; ++n) _Pragma("unroll") for (int k = 0; k < 2; ++k) \
            acc[ai][bj][m][n] = __builtin_bit_cast(f32x4, __builtin_amdgcn_mfma_i32_16x16x64_i8(__builtin_bit_cast(i32x4, Bt[n][k]), __builtin_bit_cast(i32x4, At[m][k]), __builtin_bit_cast(i32x4, acc[ai][bj][m][n]), 0, 0, 0)); } \
        else { _Pragma("unroll") for (int m = 0; m < 4; ++m) _Pragma("unroll") for (int n = 0; n < 2; ++n) _Pragma("unroll") for (int k = 0; k < 2; ++k) \
            acc[ai][bj][m][n] = __builtin_amdgcn_mfma_f32_16x16x32_bf16(Bt[n][k], At[m][k], acc[ai][bj][m][n], 0, 0, 0); } \
        __builtin_amdgcn_s_setprio(0); } while (0)
#define PG8_WAIT_V(n) asm volatile("s_waitcnt vmcnt(" #n ")" ::: "memory")
#define PG8_WAIT_L(n) asm volatile("s_waitcnt lgkmcnt(" #n ")" ::: "memory")
#define PG8_BAR __builtin_amdgcn_s_barrier()
#define PG8_SCHED __builtin_amdgcn_sched_barrier(0)
    Unit cur, nxt; int ui = 0; int early_cnt = 0;
    if (!S.next(0, cur)) return;
    f32x4 acc[2][2][4][2];
#pragma unroll
    for (int a = 0; a < 2; ++a)
#pragma unroll
        for (int b = 0; b < 2; ++b)
#pragma unroll
            for (int m = 0; m < 4; ++m)
#pragma unroll
                for (int n = 0; n < 2; ++n) acc[a][b][m][n] = (f32x4){0.f, 0.f, 0.f, 0.f};
    bf16x8 At[4][2], B0[2][2], B1[2][2];
    i32x8 At8[4], B08[2], B18[2];
    int sc1 = 0x7F7F7F7F; asm volatile("" : "+v"(sc1));
    const char* cA = (const char*)g.A + (size_t)cur.pm * tstep; const char* cB = (const char*)g.Bt + (size_t)cur.pb * tstep;
    S.a_ready(cur);
    if constexpr (SP2) {
        PG8_STAGE(PG8_SB(0, 0), cB, voffB); PG8_STAGE(PG8_SB(0, 1), cB + hstep, voffB); PG8_STAGE(PG8_SA(0, 0), cA, voffA); PG8_STAGE(PG8_SA(0, 1), cA + hstep, voffA);
        if (wr == 1) PG8_BAR;
        PG8_WAIT_V(2); PG8_BAR;
        PG8_STAGE(PG8_SB(1, 0), cB + kstep, voffB); PG8_STAGE(PG8_SA(1, 0), cA + kstep, voffA); PG8_STAGE(PG8_SB(1, 1), cB + hstep + kstep, voffB);
        PG8_WAIT_V(6); PG8_BAR;
    } else {
        PG8_STAGE(PG8_SB(0, 0), cB, voffB); PG8_STAGE(PG8_SA(0, 0), cA, voffA); PG8_STAGE(PG8_SB(0, 1), cB + hstep, voffB); PG8_STAGE(PG8_SA(0, 1), cA + hstep, voffA);
        if (wr == 1) PG8_BAR;
        PG8_WAIT_V(4); PG8_BAR;
        PG8_STAGE(PG8_SB(1, 0), cB + kstep, voffB); PG8_STAGE(PG8_SA(1, 0), cA + kstep, voffA); PG8_STAGE(PG8_SB(1, 1), cB + hstep + kstep, voffB);
        PG8_WAIT_V(6); PG8_BAR;
    }
    for (;;) {
        const bool has_next = S.next(ui + 1, nxt);
        const char* nA = has_next ? (const char*)g.A + (size_t)nxt.pm * tstep : cA; const char* nB = has_next ? (const char*)g.Bt + (size_t)nxt.pb * tstep : cB;
        for (int t = 0; t < nt; t += 2) {
            const bool last = (t == nt - 2);
            const char* a1 = cA + (size_t)(t + 1) * kstep;
            const char* a2 = last ? nA : cA + (size_t)(t + 2) * kstep; const char* b2 = last ? nB : cB + (size_t)(t + 2) * kstep;
            const char* a3 = a2 + kstep; const char* b3 = b2 + kstep;
            if (last && has_next) S.a_ready(nxt);
            if constexpr (SP2) {
            PG8_LDB(B0, 0, 0); PG8_LDB(B1, 0, 1); PG8_SCHED; PG8_LDA(At, 0, 0); PG8_STAGE(PG8_SA(1, 1), a1 + hstep, voffA);
            PG8_WAIT_V(8); PG8_WAIT_L(0); PG8_BAR; PG8_MMA(0, 0, At, B0); PG8_MMA(0, 1, At, B1); PG8_BAR; PG8_SCHED;
            PG8_LDA(At, 0, 1); PG8_STAGE(PG8_SB(0, 0), b2, voffB); PG8_STAGE(PG8_SB(0, 1), b2 + hstep, voffB); PG8_STAGE(PG8_SA(0, 0), a2, voffA);
            PG8_WAIT_V(8); PG8_WAIT_L(0); PG8_BAR; PG8_MMA(1, 0, At, B0); PG8_MMA(1, 1, At, B1); PG8_BAR; PG8_SCHED;
            PG8_LDB(B0, 1, 0); PG8_LDB(B1, 1, 1); PG8_SCHED; PG8_LDA(At, 1, 0); PG8_STAGE(PG8_SA(0, 1), a2 + hstep, voffA);
            PG8_WAIT_V(8); PG8_WAIT_L(0); PG8_BAR; PG8_MMA(0, 0, At, B0); PG8_MMA(0, 1, At, B1); PG8_BAR; PG8_SCHED;
            PG8_LDA(At, 1, 1); PG8_STAGE(PG8_SB(1, 0), b3, voffB); PG8_STAGE(PG8_SB(1, 1), b3 + hstep, voffB); PG8_STAGE(PG8_SA(1, 0), a3, voffA);
            PG8_WAIT_V(8); PG8_WAIT_L(0); PG8_BAR; PG8_MMA(1, 0, At, B0); PG8_MMA(1, 1, At, B1); PG8_BAR; PG8_SCHED;
            } else {
            PG8_LDB(B0, 0, 0); PG8_SCHED; PG8_LDA(At, 0, 0); PG8_STAGE(PG8_SA(1, 1), a1 + hstep, voffA);
            PG8_WAIT_L(8); PG8_BAR; PG8_WAIT_L(0); PG8_MMA(0, 0, At, B0); PG8_BAR; PG8_SCHED;
            PG8_LDB(B1, 0, 1); PG8_STAGE(PG8_SB(0, 0), b2, voffB);
            PG8_BAR; PG8_WAIT_L(0); PG8_MMA(0, 1, At, B1); PG8_BAR;
            PG8_LDA(At, 0, 1); PG8_STAGE(PG8_SA(0, 0), a2, voffA);
            PG8_BAR; PG8_WAIT_L(0); PG8_MMA(1, 0, At, B0); PG8_BAR; PG8_SCHED;
            PG8_STAGE(PG8_SB(0, 1), b2 + hstep, voffB);
            PG8_WAIT_V(6); PG8_BAR; PG8_MMA(1, 1, At, B1); PG8_BAR;
            PG8_LDB(B0, 1, 0); PG8_SCHED; PG8_LDA(At, 1, 0); PG8_STAGE(PG8_SA(0, 1), a2 + hstep, voffA);
            PG8_WAIT_L(8); PG8_BAR; PG8_WAIT_L(0); PG8_MMA(0, 0, At, B0); PG8_BAR; PG8_SCHED;
            PG8_LDB(B1, 1, 1); PG8_STAGE(PG8_SB(1, 0), b3, voffB);
            PG8_BAR; PG8_WAIT_L(0); PG8_MMA(0, 1, At, B1); PG8_BAR;
            PG8_LDA(At, 1, 1); PG8_STAGE(PG8_SA(1, 0), a3, voffA);
            PG8_BAR; PG8_WAIT_L(0); PG8_MMA(1, 0, At, B0); PG8_BAR; PG8_SCHED;
            PG8_STAGE(PG8_SB(1, 1), b3 + hstep, voffB);
            PG8_WAIT_V(6); PG8_BAR; PG8_MMA(1, 1, At, B1); PG8_BAR;
            }
        }
        if constexpr (ALIGN_EPI) { if (wr == 0) PG8_BAR; }
        if constexpr (FP8 == 1) asm volatile("s_nop 15\n\ts_nop 15\n\ts_nop 15\n\ts_nop 15\n\ts_nop 15" ::: "memory");
        if constexpr (!Epi::AFTER_DRAIN) { E(acc, cur, wr, wc, fr, fq); S.done(cur); }
        if constexpr (Sched::SIGNALS) {
            early_cnt += (cur.pm < S.early_rt) ? 1 : 0;
            if (ui == 8) { PG8_WAIT_V(0); PG8_BAR; if (tid == 0 && early_cnt > 0) S.signal(early_cnt); early_cnt = 0; }
        }
        if (!has_next) break;
#pragma unroll
        for (int a = 0; a < 2; ++a)
#pragma unroll
            for (int b = 0; b < 2; ++b)
#pragma unroll
                for (int m = 0; m < 4; ++m)
#pragma unroll
                    for (int n = 0; n < 2; ++n) acc[a][b][m][n] = (f32x4){0.f, 0.f, 0.f, 0.f};
        cur = nxt; cA = nA; cB = nB; ++ui;
        if constexpr (ALIGN_EPI) { if (wr == 1) PG8_BAR; }
    }
    PG8_WAIT_V(0);
    if constexpr (!ALIGN_EPI) { if (wr == 0) PG8_BAR; }
    PG8_BAR;
    if constexpr (Sched::SIGNALS) { if (tid == 0 && early_cnt > 0) S.signal(early_cnt); }
#undef PG8_SA
#undef PG8_SB
#undef PG8_STAGE
#undef PG8_LDA
#undef PG8_LD8
#undef PG8_LDB
#undef PG8_MMA
#undef PG8_CAT
#undef PG8_WAIT_V
#undef PG8_WAIT_L
#undef PG8_BAR
#undef PG8_SCHED
}
}

#define XB_TMO      128
#define XB_XCNT(j)  (256  + 64 * (j))
#define XB_XSUB(j)  (1280 + 64 * (j))
#define XB_XGEN(j)  (2304 + 64 * (j))
#define XB_TOP      3328
#define XB_TOPGEN   3392
#define XCD_BAR_WORDS 3456
#define XB_SPIN_CAP (1u << 22)
__device__ __forceinline__ unsigned xb_ld(unsigned* p)              { return __hip_atomic_load(p, __ATOMIC_RELAXED, __HIP_MEMORY_SCOPE_AGENT); }
__device__ __forceinline__ unsigned xb_add(unsigned* p, unsigned v) { return __hip_atomic_fetch_add(p, v, __ATOMIC_RELAXED, __HIP_MEMORY_SCOPE_AGENT); }
__device__ __forceinline__ unsigned xb_xcc_id() { return (unsigned)__builtin_amdgcn_s_getreg((3 << 11) | 20) & 0xFu; }
#define XB_SPIN(cond, bar) do { unsigned _sp = 0; while (cond) { __builtin_amdgcn_s_sleep(1); \
    if ((++_sp & 255u) == 0u) { if (xb_ld(&(bar)[XB_TMO])) break; if (_sp > XB_SPIN_CAP) { atomicAdd(&(bar)[XB_TMO], 1u); break; } } } } while (0)
struct XcdBarrier { unsigned* bar; unsigned x; volatile LAS unsigned* st; };
__device__ __forceinline__ XcdBarrier xcd_barrier_post(unsigned* bar, volatile LAS unsigned* st) {
    XcdBarrier b; b.bar = bar; b.x = xb_xcc_id(); b.st = st;
    if (threadIdx.x == 0) (void)xb_add(&bar[XB_XCNT(b.x)], 1u);
    return b;
}
__device__ __forceinline__ void xcd_barrier_complete(unsigned* bar, unsigned x, unsigned& nloc, unsigned& nx) {
    const unsigned G = gridDim.x * gridDim.y * gridDim.z;
    unsigned sum, cnt, mine, sp = 0u;
    for (;;) {
        sum = 0u; cnt = 0u; mine = 0u;
#pragma unroll
        for (unsigned j = 0; j < 16; ++j) { const unsigned c = xb_ld(&bar[XB_XCNT(j)]); sum += c; cnt += (c > 0u) ? 1u : 0u; mine = (j == x) ? c : mine; }
        if (sum == G) break;
        __builtin_amdgcn_s_sleep(1);
        if ((++sp & 255u) == 0u) { if (xb_ld(&bar[XB_TMO])) break; if (sp > XB_SPIN_CAP) { atomicAdd(&bar[XB_TMO], 1u); break; } }
    }
    nloc = mine > 0u ? mine : 1u; nx = cnt > 0u ? cnt : 1u;
}
__device__ __forceinline__ void xcd_barrier(const XcdBarrier& b) {
    asm volatile("s_waitcnt vmcnt(0)" ::: "memory");
    __syncthreads();
    if (threadIdx.x == 0) {
        unsigned* bar = b.bar;
        __builtin_amdgcn_s_waitcnt(0);
        unsigned nloc = b.st[0], nx = b.st[1];
        if (nloc == 0u) { xcd_barrier_complete(bar, b.x, nloc, nx); b.st[0] = nloc; b.st[1] = nx; }
        const unsigned old = xb_add(&bar[XB_XSUB(b.x)], 1u);
        const unsigned gen = old / nloc;
        if (old + 1u == (gen + 1u) * nloc) {
            __builtin_amdgcn_fence(__ATOMIC_RELEASE, "agent");
            asm volatile("s_waitcnt vmcnt(0)" ::: "memory");
            const unsigned og = xb_add(&bar[XB_TOP], 1u);
            const unsigned tg = og / nx;
            if (og + 1u == (tg + 1u) * nx) xb_add(&bar[XB_TOPGEN], 1u);
            else XB_SPIN(xb_ld(&bar[XB_TOPGEN]) == tg, bar);
            __builtin_amdgcn_fence(__ATOMIC_ACQUIRE, "agent");
            xb_add(&bar[XB_XGEN(b.x)], 1u);
            asm volatile("s_waitcnt vmcnt(0)" ::: "memory");
        } else {
            XB_SPIN(xb_ld(&bar[XB_XGEN(b.x)]) == gen, bar);
            __builtin_amdgcn_fence(__ATOMIC_ACQUIRE, "agent");
            asm volatile("s_waitcnt vmcnt(0)" ::: "memory");
        }
    }
    __syncthreads();
}

struct Frame {
    LAS unsigned char* lds;
    int tid, lane, wave, G, bx;
};
__device__ __forceinline__ Frame phase_frame(const Frame& F) { Frame R = F; int t = threadIdx.x; asm volatile("" : "+v"(t)); R.tid = t; R.lane = t & 63; R.wave = __builtin_amdgcn_readfirstlane(t >> 6); return R; }

struct TrDesc { const float* W; unsigned char* WT; const float* kgain; float nscale; int K, N, drow0, k0, n0, f8; };
__device__ __forceinline__ void tr_load(const TrDesc& d, float (&tv)[32], int lane) {
    const float* wp = d.W + (size_t)(d.k0 + (lane >> 5)) * d.N + d.n0 + (lane & 31);
#pragma unroll
    for (int i = 0; i < 32; ++i) tv[i] = wp[(size_t)(2 * i) * d.N];
}
__device__ __forceinline__ void tr_finish(const TrDesc& d, const float (&tv)[32], LAS float* scr, int lane) {
#pragma unroll
    for (int i = 0; i < 32; ++i) { float v = tv[i] * d.nscale; if (d.kgain) v *= d.kgain[d.k0 + 2 * i + (lane >> 5)]; scr[(2 * i + (lane >> 5)) * 33 + (lane & 31)] = v; }
    LDS_WAIT(); asm volatile("" ::: "memory");
    const int c = lane & 7;
#pragma unroll
    for (int j = 0; j < 4; ++j) { const int n = (lane >> 3) + 8 * j; const LAS float* s = scr + (8 * c) * 33 + n;
        if (d.f8) { u32x2 o; o.x = pk4_fp8(s[0 * 33], s[1 * 33], s[2 * 33], s[3 * 33]); o.y = pk4_fp8(s[4 * 33], s[5 * 33], s[6 * 33], s[7 * 33]);
            *(u32x2*)(d.WT + (size_t)(d.drow0 + n) * d.K + d.k0 + 8 * c) = o; }
        else { u32x4 o; o.x = pk2(s[0 * 33], s[1 * 33]); o.y = pk2(s[2 * 33], s[3 * 33]); o.z = pk2(s[4 * 33], s[5 * 33]); o.w = pk2(s[6 * 33], s[7 * 33]);
            *(u32x4*)(d.WT + ((size_t)(d.drow0 + n) * d.K + d.k0 + 8 * c) * 2) = o; } }
    LDS_WAIT(); asm volatile("" ::: "memory");
}
__device__ __forceinline__ int gu_row(int n0, int Fh) { return n0 < Fh ? ((n0 >> 7) * 256 + (n0 & 127)) : (((n0 - Fh) >> 7) * 256 + 128 + ((n0 - Fh) & 127)); }

struct Ptrs {
    const float *x, *mem, *anpre, *anpost, *fnpre, *fnpost, *w_in_a, *hlb, *hon, *w_in_b, *kvn, *w_kv, *memn, *w_mem_kv, *w_out, *w_gu, *w_dn, *w_router, *w_egu, *w_edn;
    float* out; unsigned char* ws;
};

__device__ __forceinline__ float row_rstd(const f32x4 (&a)[4]);
__device__ __forceinline__ void rms_row_to_bf16(const float* xrow, bf16_t* orow, const float* gain, int lane) {
    const f32x4* xr = (const f32x4*)xrow + lane;
    f32x4 v[4]; float s = 0.f;
#pragma unroll
    for (int j = 0; j < 4; ++j) { v[j] = xr[64 * j]; s += (v[j].x * v[j].x + v[j].y * v[j].y) + (v[j].z * v[j].z + v[j].w * v[j].w); }
    const float rstd = frsq(wave_sum(s) * (1.f / DM) + RMS_EPS);
    u32x2* o8 = (u32x2*)orow + lane;
#pragma unroll
    for (int j = 0; j < 4; ++j) { f32x4 gg = gain ? ((const f32x4*)gain)[lane + 64 * j] : (f32x4){1.f, 1.f, 1.f, 1.f};
        u32x2 w; w.x = pk2(v[j].x * rstd * gg.x, v[j].y * rstd * gg.y); w.y = pk2(v[j].z * rstd * gg.z, v[j].w * rstd * gg.w); o8[64 * j] = w; }
}

struct TrCounts {
    static constexpr int I_INA = (DM / 64) * (AW / 32), I_MKV = (DM / 64) * (512 / 32), I_OUT = (DM / 64) * (DM / 32), I_GU = (DM / 64) * (2 * DFF / 32), I_DN = (DFF / 64) * (DM / 32),
                         I_KV = (DM / 64) * (1536 / 32), I_INB = (DM / 64) * (DM / 32), I_EGU = (DM / 64) * (2 * DFE / 32), I_EDN = (DFE / 64) * (DM / 32);
    static constexpr int NEARLY = I_INA + 2 * I_MKV + 2 * I_OUT + I_GU + I_DN + I_KV + I_INB;
    static constexpr int NITEMS = NEARLY + NEXP * I_EGU + NEXP * I_EDN;
};
__device__ __forceinline__ TrDesc tr_decode(const Ptrs& P, int it) {
    using T = TrCounts; unsigned char* ws = P.ws; TrDesc d; d.kgain = nullptr; d.nscale = 1.f; d.f8 = 0;
    int r = it - (T::I_INA + 2 * T::I_MKV);
    if (r < 2 * T::I_OUT) { const int l = r / T::I_OUT; r -= l * T::I_OUT; const int nb = DM / 32; d.k0 = 64 * (r / nb); d.n0 = 32 * (r % nb);
        d.W = P.w_out + (size_t)l * DM * DM; d.K = DM; d.N = DM; d.WT = ws + (l ? WS_WOUT1 : WS_WOUT0); d.drow0 = d.n0; if (l) { d.f8 = 1; d.nscale = FP8_SWO; } return d; } r -= 2 * T::I_OUT + T::I_GU;
    if (r < T::I_DN) { const int nb = DM / 32; d.k0 = 64 * (r / nb); d.n0 = 32 * (r % nb); d.W = P.w_dn; d.K = DFF; d.N = DM; d.WT = ws + WS_WDN; d.drow0 = d.n0; d.f8 = 1; d.nscale = FP8_SWDD; return d; } r -= T::I_DN + T::I_KV + T::I_INB;
    d.f8 = 1;
    if (r < NEXP * T::I_EGU) { const int e = r / T::I_EGU; r -= e * T::I_EGU; const int nb = 2 * DFE / 32; d.k0 = 64 * (r / nb); d.n0 = 32 * (r % nb);
        d.W = P.w_egu + (size_t)e * DM * 2 * DFE; d.K = DM; d.N = 2 * DFE; d.WT = ws + WS_WEGU + (size_t)e * 2 * DFE * DM; d.drow0 = gu_row(d.n0, DFE); d.nscale = FP8_SWGU; return d; } r -= NEXP * T::I_EGU;
    { const int e = r / T::I_EDN; r -= e * T::I_EDN; const int nb = DM / 32; d.k0 = 64 * (r / nb); d.n0 = 32 * (r % nb);
        d.W = P.w_edn + (size_t)e * DFE * DM; d.K = DFE; d.N = DM; d.WT = ws + WS_WEDN + (size_t)e * DM * DFE; d.drow0 = d.n0; d.nscale = FP8_SWDN; return d; }
}
__device__ __forceinline__ void convert_weights(const Frame& F, const Ptrs& P, int gw, int NGW) {
    LAS float* scr = (LAS float*)(F.lds + F.wave * 16384);
    const int it_lo = TrCounts::NEARLY, it_hi = TrCounts::NITEMS;
    for (int it = it_lo + gw; it < it_hi; it += 2 * NGW) {
        const bool two = it + NGW < it_hi;
        const TrDesc a = tr_decode(P, it), b = tr_decode(P, two ? it + NGW : it);
        float ta[32], tb[32];
        tr_load(a, ta, F.lane); if (two) tr_load(b, tb, F.lane);
        tr_finish(a, ta, scr, F.lane); if (two) tr_finish(b, tb, scr, F.lane);
    }
}
struct Q8Desc { const float* W; unsigned char* WT; const float* kgain; float nscale; int N, n0, drow0; float* wsc; };
constexpr int Q8_INA = AW / 32, Q8_MKV = 512 / 32, Q8_GU = 2 * DFF / 32, Q8_KV = 1536 / 32, Q8_INB = DM / 32, Q8_ITEMS = Q8_INA + 2 * Q8_MKV + Q8_GU + Q8_KV + Q8_INB;
__device__ __forceinline__ Q8Desc q8_decode(const Ptrs& P, int r) {
    unsigned char* ws = P.ws; float* const WSCp = (float*)(ws + WS_WSC); Q8Desc d; d.kgain = nullptr; d.nscale = 1.f;
    if (r < Q8_INA) { d.n0 = 32 * r; d.W = P.w_in_a; d.N = AW; d.WT = ws + WS_WINA; d.drow0 = d.n0; d.nscale = d.n0 >= 3072 ? C2 : 1.f; d.wsc = WSCp + WSC_INA; return d; } r -= Q8_INA;
    if (r < 2 * Q8_MKV) { const int l = r / Q8_MKV; r -= l * Q8_MKV; d.n0 = 32 * r; d.W = P.w_mem_kv + (size_t)l * DM * 512; d.N = 512; d.WT = ws + WS_WINA; d.drow0 = AW + l * 512 + d.n0; d.kgain = P.memn + l * DM; d.wsc = WSCp + WSC_INA; return d; } r -= 2 * Q8_MKV;
    if (r < Q8_GU) { d.n0 = 32 * r; d.W = P.w_gu; d.N = 2 * DFF; d.WT = ws + WS_WGU; d.drow0 = gu_row(d.n0, DFF); d.wsc = WSCp + WSC_GU; return d; } r -= Q8_GU;
    if (r < Q8_KV) { d.n0 = 32 * r; d.W = P.w_kv; d.N = 1536; d.WT = ws + WS_WKVB; d.drow0 = d.n0; d.kgain = P.kvn; d.wsc = WSCp + WSC_KVB; return d; } r -= Q8_KV;
    { d.n0 = 32 * r; d.W = P.w_in_b; d.N = DM; d.WT = ws + WS_WKVB; d.drow0 = 1536 + d.n0; d.kgain = P.anpre + DM; d.nscale = C2; d.wsc = WSCp + WSC_KVB; return d; }
}
__device__ __forceinline__ void q8_finish(const Q8Desc& q, const float (&tv)[32], int kbase, LAS float* scr, const LAS float* cfin, int lane) {
#pragma unroll
    for (int i = 0; i < 32; ++i) scr[(2 * i + (lane >> 5)) * 33 + (lane & 31)] = tv[i];
    LDS_WAIT(); asm volatile("" ::: "memory");
    const int c = lane & 7;
#pragma unroll
    for (int j = 0; j < 4; ++j) { const int n = (lane >> 3) + 8 * j; const LAS float* s = scr + (8 * c) * 33 + n; const float inv = 127.0f / cfin[n];
        u32x2 o; o.x = pk4_i8(s[0 * 33] * inv, s[1 * 33] * inv, s[2 * 33] * inv, s[3 * 33] * inv); o.y = pk4_i8(s[4 * 33] * inv, s[5 * 33] * inv, s[6 * 33] * inv, s[7 * 33] * inv);
        *(u32x2*)(q.WT + (size_t)(q.drow0 + n) * DM + kbase + 8 * c) = o; }
    LDS_WAIT(); asm volatile("" ::: "memory");
}
__device__ __forceinline__ void q8_item(const Frame& F, const Q8Desc& q, int parity) {
    const int lane = F.lane, kp = lane >> 5, nl = lane & 31, k0 = F.wave * 128;
    LAS float* scr = (LAS float*)(F.lds + F.wave * 16384);
    const float* wp = q.W + (size_t)(k0 + kp) * q.N + q.n0 + nl;
    float ga[32], gb[32];
    if (q.kgain) {
#pragma unroll
        for (int i = 0; i < 32; ++i) { ga[i] = q.kgain[k0 + 2 * i + kp]; gb[i] = q.kgain[k0 + 64 + 2 * i + kp]; }
    } else {
#pragma unroll
        for (int i = 0; i < 32; ++i) { ga[i] = 1.f; gb[i] = 1.f; }
    }
    float ta[32], tb[32];
#pragma unroll
    for (int i = 0; i < 32; ++i) ta[i] = wp[(size_t)(2 * i) * q.N];
#pragma unroll
    for (int i = 0; i < 32; ++i) tb[i] = wp[(size_t)(64 + 2 * i) * q.N];
    float m = 0.f;
#pragma unroll
    for (int i = 0; i < 32; ++i) { const float v = ta[i] * q.nscale * ga[i]; ta[i] = v; m = fmaxf(m, __builtin_fabsf(v)); }
#pragma unroll
    for (int i = 0; i < 32; ++i) { const float v = tb[i] * q.nscale * gb[i]; tb[i] = v; m = fmaxf(m, __builtin_fabsf(v)); }
    ((LAS float*)(F.lds + F.wave * 16384 + 12288 + parity * 256))[lane] = m;
    __syncthreads();
    float cm = 1e-30f;
#pragma unroll
    for (int w = 0; w < NWAVES; ++w) { const LAS float* cp = (const LAS float*)(F.lds + w * 16384 + 12288 + parity * 256); cm = fmaxf(cm, fmaxf(cp[nl], cp[nl + 32])); }
    LAS float* cfin = (LAS float*)(F.lds + F.wave * 16384 + 12288 + 512);
    if (lane < 32) cfin[lane] = cm;
    if (F.wave == 0 && lane < 32) q.wsc[q.drow0 + lane] = cm * (1.0f / 127.0f);
    q8_finish(q, ta, k0, scr, cfin, lane);
    q8_finish(q, tb, k0 + 64, scr, cfin, lane);
}
__device__ __forceinline__ void p0_rows4_load(const float* src, int m0, int lane, f32x4 (&v)[4][4]) {
#pragma unroll
    for (int r = 0; r < 4; ++r)
#pragma unroll
        for (int j = 0; j < 4; ++j) v[r][j] = ((const f32x4*)(src + (size_t)(m0 + r) * DM))[lane + 64 * j];
}
template <bool GAIN>
__device__ __forceinline__ void p0_rows4_finish(const f32x4 (&v)[4][4], const f32x4 (&gx)[4], unsigned char* dst, float* as, int m0, int lane) {
#pragma unroll
    for (int r = 0; r < 4; ++r) {
        const float rstd = row_rstd(v[r]);
        f32x4 uu[4];
#pragma unroll
        for (int j = 0; j < 4; ++j) { uu[j] = v[r][j] * rstd; if constexpr (GAIN) uu[j] = uu[j] * gx[j]; }
        quant_row_i8(uu, dst + (size_t)(m0 + r) * DM, as + m0 + r, lane);
    }
}
constexpr int P0_NB16 = 2 * TrCounts::I_OUT + TrCounts::I_DN, P0_G16 = P0_NB16 / 16, P0_XCH = MTOK / 32, P0_MCH = MROWS / 32, P0_WITEMS = Q8_ITEMS + P0_G16, P0_ITEMS = P0_WITEMS + P0_XCH + P0_MCH;
static_assert(P0_NB16 % 16 == 0, "bf16 wave items in groups of 16");
__device__ __forceinline__ void p0_prologue(const Frame& F, const Ptrs& P) {
    unsigned char* ws = P.ws;
    float* const ASA = (float*)(ws + WS_AS);
    int parity = 0, L = F.bx;
    for (; L < P0_WITEMS; L += F.G) {
        if (L < Q8_ITEMS) { const Q8Desc q = q8_decode(P, L); q8_item(F, q, parity); parity ^= 1; continue; }
        const int r = L - Q8_ITEMS;
        LAS float* scr = (LAS float*)(F.lds + F.wave * 16384);
        const int ia = r * 16 + F.wave, ib = ia + 8;
        const int base = TrCounts::I_INA + 2 * TrCounts::I_MKV;
        const TrDesc a = tr_decode(P, base + (ia < 2 * TrCounts::I_OUT ? ia : ia + TrCounts::I_GU)), b = tr_decode(P, base + (ib < 2 * TrCounts::I_OUT ? ib : ib + TrCounts::I_GU));
        float ta[32], tb[32];
        tr_load(a, ta, F.lane); tr_load(b, tb, F.lane);
        tr_finish(a, ta, scr, F.lane); tr_finish(b, tb, scr, F.lane);
    }
    constexpr int NTK = (P0_XCH + P0_MCH) / 2;
    unsigned* const tctr = (unsigned*)(ws + WS_CTL) + CW_P0T;
    volatile LAS unsigned* tslot = (volatile LAS unsigned*)(F.lds + LDSCTL_OFF + 1088);
    f32x4 v[4][4], vn[4][4];
#define P0_LOAD(dst, CC) do { const int c_ = (CC); const bool isx_ = c_ < P0_XCH; p0_rows4_load(isx_ ? P.x : P.mem, 32 * (isx_ ? c_ : c_ - P0_XCH) + 4 * F.wave, F.lane, dst); } while (0)
#define P0_FIN(src, CC) do { const int c_ = (CC); const bool isx_ = c_ < P0_XCH; const int m0_ = 32 * (isx_ ? c_ : c_ - P0_XCH) + 4 * F.wave; \
        if (isx_) p0_rows4_finish<true>(src, gx, ws + WS_U, ASA, m0_, F.lane); else p0_rows4_finish<false>(src, gx, ws + WS_MEMN, ASA + MTOK, m0_, F.lane); } while (0)
    f32x4 gx[4];
#pragma unroll
    for (int j = 0; j < 4; ++j) gx[j] = ((const f32x4*)P.anpre)[F.lane + 64 * j];
    if (F.tid == 0) tslot[0] = __hip_atomic_fetch_add(tctr, 1u, __ATOMIC_RELAXED, __HIP_MEMORY_SCOPE_AGENT);
    __syncthreads();
    for (int it = 0; it < NTK + 2; ++it) {
        const int tk = (int)tslot[it & 1];
        if (tk >= NTK) break;
        unsigned nxt = 0u;
        if (F.tid == 0) nxt = __hip_atomic_fetch_add(tctr, 1u, __ATOMIC_RELAXED, __HIP_MEMORY_SCOPE_AGENT);
        P0_LOAD(v, 2 * tk); P0_LOAD(vn, 2 * tk + 1);
        P0_FIN(v, 2 * tk); P0_FIN(vn, 2 * tk + 1);
        if (F.tid == 0) tslot[(it + 1) & 1] = nxt;
        __syncthreads();
    }
#undef P0_LOAD
#undef P0_FIN
}

__device__ __forceinline__ void load_bf16_row(const bf16_t* arow, int lane, f32x4 (&a)[4]) {
    const u32x2* ar = (const u32x2*)arow + lane;
#pragma unroll
    for (int j = 0; j < 4; ++j) { const u32x2 w = ar[64 * j]; a[j] = (f32x4){bflo(w.x), bfhi(w.x), bflo(w.y), bfhi(w.y)}; }
}
__device__ __forceinline__ float row_rstd(const f32x4 (&a)[4]) {
    float s = 0.f;
#pragma unroll
    for (int j = 0; j < 4; ++j) s += (a[j].x * a[j].x + a[j].y * a[j].y) + (a[j].z * a[j].z + a[j].w * a[j].w);
    return frsq(wave_sum(s) * (1.f / DM) + RMS_EPS);
}
template <bool BASE16, bool Q8OUT>
__device__ __forceinline__ void norm_phase(const Frame& F, const bf16_t* A, const void* base, bf16_t* H, const float* g1, bf16_t* U, const float* g2, float* as_out) {
    f32x4 g1v[4], g2v[4];
#pragma unroll
    for (int j = 0; j < 4; ++j) { g1v[j] = ((const f32x4*)g1)[F.lane + 64 * j]; g2v[j] = g2 ? ((const f32x4*)g2)[F.lane + 64 * j] : (f32x4){1.f, 1.f, 1.f, 1.f}; }
    for (int i0 = 0; i0 < 16; i0 += 4) {
        const int m0 = F.bx * 128 + F.wave * 16 + i0;
        u32x2 ar[4][4]; f32x4 bs[4][4]; u32x2 bh[4][4];
#pragma unroll
        for (int r = 0; r < 4; ++r)
#pragma unroll
            for (int j = 0; j < 4; ++j) { ar[r][j] = ((const u32x2*)(A + (size_t)(m0 + r) * DM))[F.lane + 64 * j];
                if constexpr (BASE16) bh[r][j] = ((const u32x2*)((const bf16_t*)base + (size_t)(m0 + r) * DM))[F.lane + 64 * j];
                else bs[r][j] = ((const f32x4*)((const float*)base + (size_t)(m0 + r) * DM))[F.lane + 64 * j]; }
#pragma unroll
        for (int r = 0; r < 4; ++r) {
            const int m = m0 + r;
            f32x4 a[4];
#pragma unroll
            for (int j = 0; j < 4; ++j) a[j] = (f32x4){bflo(ar[r][j].x), bfhi(ar[r][j].x), bflo(ar[r][j].y), bfhi(ar[r][j].y)};
            const float rs = row_rstd(a);
            f32x4 h[4];
            u32x2* h8 = (u32x2*)(H + (size_t)m * DM) + F.lane;
#pragma unroll
            for (int j = 0; j < 4; ++j) { const f32x4 gg = g1v[j];
                f32x4 b; if constexpr (BASE16) b = (f32x4){bflo(bh[r][j].x), bfhi(bh[r][j].x), bflo(bh[r][j].y), bfhi(bh[r][j].y)}; else b = bs[r][j];
                h[j] = b + a[j] * rs * gg; u32x2 w; w.x = pk2(h[j].x, h[j].y); w.y = pk2(h[j].z, h[j].w); h8[64 * j] = w; }
            const float rh = row_rstd(h);
            if constexpr (Q8OUT) {
                f32x4 uu[4];
#pragma unroll
                for (int j = 0; j < 4; ++j) uu[j] = h[j] * rh * g2v[j];
                quant_row_i8(uu, (unsigned char*)U + (size_t)m * DM, as_out + m, F.lane);
            } else {
                u32x2* o8 = (u32x2*)(U + (size_t)m * DM) + F.lane;
#pragma unroll
                for (int j = 0; j < 4; ++j) { const f32x4 gg = g2v[j];
                    u32x2 w; w.x = pk2(h[j].x * rh * gg.x, h[j].y * rh * gg.y); w.y = pk2(h[j].z * rh * gg.z, h[j].w * rh * gg.w); o8[64 * j] = w; }
            }
        }
    }
}

constexpr float HG_US = 4.f;
constexpr int HG_RAWQ = 0, HG_RAWF = 18432, HG_RAWV = 36864;
constexpr int HG_OT = 0;
constexpr int HG_SC = 33792;
constexpr int HG_QD = 55296, HG_KI = 72704;
constexpr int HG_KST = 90112, HG_VT = 108544;
constexpr int HG_DEC = 126976;
typedef short s16x4 __attribute__((ext_vector_type(4)));
__device__ __forceinline__ s16x4 lds_tr16(const LAS unsigned char* p) { return __builtin_bit_cast(s16x4, __builtin_amdgcn_ds_read_tr16_b64_v4i16((LAS s16x4*)p)); }
constexpr int PA_GH = 0, PA_GL = 17408, PA_KH = 34816, PA_QH = 52224, PA_V = 69632;
__device__ __forceinline__ bf16x8 pa_trfrag(const LAS unsigned char* p) {
    const s16x4 lo = lds_tr16(p), hi = lds_tr16(p + 4 * 272);
    return (bf16x8){lo[0], lo[1], lo[2], lo[3], hi[0], hi[1], hi[2], hi[3]};
}
__device__ __forceinline__ void hgrnA_phase(const Frame& F, const Ptrs& P) {
    const int tid = F.tid, lane = F.lane, w = F.wave;
    LAS unsigned char* L = F.lds;
    const int sc0 = tid >> 4, sch = tid & 15;
    const int fr = lane & 15, g = lane >> 4;
    bf16_t* const GQD = (bf16_t*)(P.ws + WS_HGQD); bf16_t* const GOI = (bf16_t*)(P.ws + WS_HGOI); unsigned char* const GU = P.ws + WS_HGU; float* const GDEC = (float*)(P.ws + WS_HGDEC);
    const int NU = NB * 6 * 64;
    bf16x8 tri0, tri16, ones;
#pragma unroll
    for (int j = 0; j < 8; ++j) { tri0[j] = (8 * g + j <= fr) ? (short)0x3F80 : (short)0; tri16[j] = (8 * g + j <= fr + 16) ? (short)0x3F80 : (short)0; ones[j] = (short)0x3F80; }
    const int trl = (8 * g + ((lane & 15) >> 2)) * 272 + (lane & 3) * 8;
    u32x4 rq[2], rf[2], rv[2];
    {
        const int unit = F.bx; const int bh = unit >> 6, n = unit & 63, b = bh / 6, h = bh % 6;
        const bf16_t* PR = (const bf16_t*)(P.ws + WS_R1) + (size_t)(b * SEQ + n * 64) * AW;
#pragma unroll
        for (int i = 0; i < 2; ++i) { const bf16_t* rp = PR + (size_t)(sc0 + 32 * i) * AW + sch * 8;
            rq[i] = *(const u32x4*)(rp + h * 128); rf[i] = *(const u32x4*)(rp + 768 + h * 128); rv[i] = *(const u32x4*)(rp + 1536 + h * 128); }
    }
    for (int unit = F.bx; unit < NU; unit += F.G) {
        const int bh = unit >> 6, h = bh % 6;
        {
            float lb[8];
            { const f32x4 a00 = *(const f32x4*)(P.hlb + h * 128 + 8 * sch), a01 = *(const f32x4*)(P.hlb + h * 128 + 8 * sch + 4), a10 = *(const f32x4*)(P.hlb + HF + h * 128 + 8 * sch), a11 = *(const f32x4*)(P.hlb + HF + h * 128 + 8 * sch + 4);
#pragma unroll
              for (int e = 0; e < 4; ++e) { lb[e] = frcp(1.0f + fexp2(1.4426950408889634f * (a10[e] - a00[e]))); lb[4 + e] = frcp(1.0f + fexp2(1.4426950408889634f * (a11[e] - a01[e]))); } }
#pragma unroll
            for (int i = 0; i < 2; ++i) {
                const unsigned fw[4] = {rf[i].x, rf[i].y, rf[i].z, rf[i].w}, qw[4] = {rq[i].x, rq[i].y, rq[i].z, rq[i].w};
                unsigned gh[4], gl[4], kh[4], qh[4];
#pragma unroll
                for (int e2 = 0; e2 < 4; ++e2) {
                    float gg[2], kk[2], qq[2];
#pragma unroll
                    for (int o = 0; o < 2; ++o) {
                        const float fl = o ? bfhi(fw[e2]) : bflo(fw[e2]), ql = o ? bfhi(qw[e2]) : bflo(qw[e2]);
                        const float sg = sigmoidf_(fl); const float lbk = lb[2 * e2 + o];
                        gg[o] = flog2(lbk + (1.0f - lbk) * sg); kk[o] = (1.0f - lbk) * (1.0f - sg); qq[o] = ql * sigmoidf_(ql);
                    }
                    gh[e2] = pk2(gg[0], gg[1]);
                    gl[e2] = pk2(gg[0] - bflo(gh[e2]), gg[1] - bfhi(gh[e2]));
                    kh[e2] = pk2(kk[0], kk[1]); qh[e2] = pk2(qq[0], qq[1]);
                }
                const int off = (sc0 + 32 * i) * 272 + sch * 16;
                *(LAS u32x4*)(L + PA_GH + off) = (u32x4){gh[0], gh[1], gh[2], gh[3]}; *(LAS u32x4*)(L + PA_GL + off) = (u32x4){gl[0], gl[1], gl[2], gl[3]};
                *(LAS u32x4*)(L + PA_KH + off) = (u32x4){kh[0], kh[1], kh[2], kh[3]}; *(LAS u32x4*)(L + PA_QH + off) = (u32x4){qh[0], qh[1], qh[2], qh[3]};
                *(LAS u32x4*)(L + PA_V + off) = rv[i];
            }
        }
        LDS_BARRIER();
        if (unit + F.G < NU) {
            const int u2 = unit + F.G; const int bh2 = u2 >> 6, n2 = u2 & 63, b2 = bh2 / 6, h2 = bh2 % 6;
            const bf16_t* PR = (const bf16_t*)(P.ws + WS_R1) + (size_t)(b2 * SEQ + n2 * 64) * AW;
#pragma unroll
            for (int i = 0; i < 2; ++i) { const bf16_t* rp = PR + (size_t)(sc0 + 32 * i) * AW + sch * 8;
                rq[i] = *(const u32x4*)(rp + h2 * 128); rf[i] = *(const u32x4*)(rp + 768 + h2 * 128); rv[i] = *(const u32x4*)(rp + 1536 + h2 * 128); }
        }
        f32x4 bc[4];
        {
            bf16x8 gfh[2], gfl[2];
#pragma unroll
            for (int ks = 0; ks < 2; ++ks) { gfh[ks] = pa_trfrag(L + PA_GH + (32 * ks) * 272 + (16 * w) * 2 + trl); gfl[ks] = pa_trfrag(L + PA_GL + (32 * ks) * 272 + (16 * w) * 2 + trl); }
#pragma unroll
            for (int ct = 0; ct < 4; ++ct) bc[ct] = (f32x4){0.f, 0.f, 0.f, 0.f};
            bc[0] = __builtin_amdgcn_mfma_f32_16x16x32_bf16(gfh[0], tri0, bc[0], 0, 0, 0);  bc[0] = __builtin_amdgcn_mfma_f32_16x16x32_bf16(gfl[0], tri0, bc[0], 0, 0, 0);
            bc[1] = __builtin_amdgcn_mfma_f32_16x16x32_bf16(gfh[0], tri16, bc[1], 0, 0, 0); bc[1] = __builtin_amdgcn_mfma_f32_16x16x32_bf16(gfl[0], tri16, bc[1], 0, 0, 0);
            bc[2] = __builtin_amdgcn_mfma_f32_16x16x32_bf16(gfh[0], ones, bc[2], 0, 0, 0);  bc[2] = __builtin_amdgcn_mfma_f32_16x16x32_bf16(gfl[0], ones, bc[2], 0, 0, 0);
            bc[2] = __builtin_amdgcn_mfma_f32_16x16x32_bf16(gfh[1], tri0, bc[2], 0, 0, 0);  bc[2] = __builtin_amdgcn_mfma_f32_16x16x32_bf16(gfl[1], tri0, bc[2], 0, 0, 0);
            bc[3] = __builtin_amdgcn_mfma_f32_16x16x32_bf16(gfh[0], ones, bc[3], 0, 0, 0);  bc[3] = __builtin_amdgcn_mfma_f32_16x16x32_bf16(gfl[0], ones, bc[3], 0, 0, 0);
            bc[3] = __builtin_amdgcn_mfma_f32_16x16x32_bf16(gfh[1], tri16, bc[3], 0, 0, 0); bc[3] = __builtin_amdgcn_mfma_f32_16x16x32_bf16(gfl[1], tri16, bc[3], 0, 0, 0);
        }
        {
            f32x4 dec;
#pragma unroll
            for (int r = 0; r < 4; ++r) dec[r] = fexp2(__shfl(bc[3][r], (lane & 48) | 15));
            if (fr == 0) *(f32x4*)(GDEC + (size_t)unit * 128 + 16 * w + 4 * g) = dec;
#pragma unroll
            for (int ct = 0; ct < 4; ++ct) {
                const int off = (16 * ct + fr) * 272 + (16 * w + 4 * g) * 2;
                const u32x2 qh = *(const LAS u32x2*)(L + PA_QH + off), kh = *(const LAS u32x2*)(L + PA_KH + off);
                const float qv[4] = {bflo(qh.x), bfhi(qh.x), bflo(qh.y), bfhi(qh.y)}, kv[4] = {bflo(kh.x), bfhi(kh.x), bflo(kh.y), bfhi(kh.y)};
                float qd[4], ki[4], ks[4];
#pragma unroll
                for (int r = 0; r < 4; ++r) { const float e1 = fexp2(bc[ct][r]), e2 = fexp2(-bc[ct][r]); qd[r] = qv[r] * e1; ki[r] = kv[r] * e2; ks[r] = ki[r] * dec[r]; }
                *(LAS u32x2*)(L + PA_QH + off) = (u32x2){pk2(qd[0], qd[1]), pk2(qd[2], qd[3])};
                *(LAS u32x2*)(L + PA_KH + off) = (u32x2){pk2(ki[0], ki[1]), pk2(ki[2], ki[3])};
                *(LAS u32x2*)(L + PA_GH + off) = (u32x2){pk2(ks[0], ks[1]), pk2(ks[2], ks[3])};
            }
        }
        LDS_BARRIER();
#pragma unroll
        for (int i = 0; i < 2; ++i) { const int c = sc0 + 32 * i; *(u32x4*)(GQD + ((size_t)unit * 64 + c) * 128 + sch * 8) = *(const LAS u32x4*)(L + PA_QH + c * 272 + sch * 16); }
        {
            const int ci = w >> 1;
#pragma unroll
            for (int q = 0; q < 2; ++q) { const int si = 2 * (w & 1) + q;
                if (si <= ci) {
                    f32x4 d = (f32x4){0.f, 0.f, 0.f, 0.f};
#pragma unroll
                    for (int ks = 0; ks < 4; ++ks) {
                        const bf16x8 a = *(const LAS bf16x8*)(L + PA_KH + (16 * si + fr) * 272 + ks * 64 + g * 16);
                        const bf16x8 bb = *(const LAS bf16x8*)(L + PA_QH + (16 * ci + fr) * 272 + ks * 64 + g * 16);
                        d = __builtin_amdgcn_mfma_f32_16x16x32_bf16(a, bb, d, 0, 0, 0);
                    }
                    const int c = 16 * ci + fr, s0 = 16 * si + 4 * g;
#pragma unroll
                    for (int r = 0; r < 4; ++r) if (s0 + r > c) d[r] = 0.f;
                    *(LAS u32x2*)(L + PA_GL + c * 144 + s0 * 2) = (u32x2){pk2(d[0], d[1]), pk2(d[2], d[3])};
                } else {
                    const int c = 16 * ci + fr, s0 = 16 * si + 4 * g;
                    *(LAS u32x2*)(L + PA_GL + c * 144 + s0 * 2) = (u32x2){0u, 0u};
                }
            }
        }
        LDS_BARRIER();
        {
            const int j0 = 16 * w;
            bf16x8 vfrag[2];
#pragma unroll
            for (int ks = 0; ks < 2; ++ks) vfrag[ks] = pa_trfrag(L + PA_V + (32 * ks) * 272 + j0 * 2 + trl);
#pragma unroll
            for (int ct = 0; ct < 4; ++ct) {
                f32x4 o = (f32x4){0.f, 0.f, 0.f, 0.f};
#pragma unroll
                for (int ks = 0; ks < 2; ++ks) if (32 * ks <= 16 * ct + 15) {
                    const bf16x8 sc = *(const LAS bf16x8*)(L + PA_GL + (16 * ct + fr) * 144 + ks * 64 + g * 16);
                    o = __builtin_amdgcn_mfma_f32_16x16x32_bf16(vfrag[ks], sc, o, 0, 0, 0);
                }
                *(u32x2*)(GOI + ((size_t)unit * 64 + 16 * ct + fr) * 128 + j0 + 4 * g) = (u32x2){pk2(o[0], o[1]), pk2(o[2], o[3])};
            }
            unsigned uw[8];
#pragma unroll
            for (int kt = 0; kt < 8; ++kt) {
                f32x4 acc = (f32x4){0.f, 0.f, 0.f, 0.f};
#pragma unroll
                for (int cs = 0; cs < 2; ++cs) {
                    const bf16x8 a = pa_trfrag(L + PA_GH + (32 * cs) * 272 + (16 * kt) * 2 + trl);
                    acc = __builtin_amdgcn_mfma_f32_16x16x32_bf16(a, vfrag[cs], acc, 0, 0, 0);
                }
                uw[kt] = pk4_fp8s(acc[0] * HG_US, acc[1] * HG_US, acc[2] * HG_US, acc[3] * HG_US);
            }
            u32x4* up = (u32x4*)(GU + (((size_t)unit * 8 + w) * 64 + lane) * 32);
#pragma unroll
            for (int q = 0; q < 2; ++q) up[q] = (u32x4){uw[4 * q], uw[4 * q + 1], uw[4 * q + 2], uw[4 * q + 3]};
        }
        LDS_BARRIER();
    }
}

constexpr int HC_QD = 0;
constexpr int HC_DEC = 26112;
constexpr int HC_OT = 27648;
constexpr int HC_NG = 44544;
struct HcSet { u32x4 qp; float dp; u32x4 ur[2], oi, og; };
struct HcCtx { __amdgpu_buffer_rsrc_t rQD, rOI, rU, rDEC, rPR; bf16_t* MIX; unsigned vQD, vOI, vU, vDEC, vPR; int bh, b, h, r0, sc0, sch, c5, sub, fr, g, j0, tid, lane, w; };
__device__ __forceinline__ void abl16(u32x4& d, unsigned voff, __amdgpu_buffer_rsrc_t r, unsigned soff) { asm volatile("buffer_load_dwordx4 %0, %1, %2, %3 offen" : "=v"(d) : "v"(voff), "s"(r), "s"(soff) : "memory"); }
__device__ __forceinline__ void abl4(float& d, unsigned voff, __amdgpu_buffer_rsrc_t r, unsigned soff) { asm volatile("buffer_load_dword %0, %1, %2, %3 offen" : "=v"(d) : "v"(voff), "s"(r), "s"(soff) : "memory"); }
__device__ __forceinline__ void hc_load(const HcCtx& C, HcSet& d, int n) {
    const unsigned unit = (unsigned)(C.bh * 64 + n);
    abl16(d.qp, C.vQD, C.rQD, unit * 16384u);
    if (C.w < 2) abl4(d.dp, C.vDEC, C.rDEC, unit * 512u);
    abl16(d.ur[0], C.vU, C.rU, unit * 16384u); abl16(d.ur[1], C.vU + 16u, C.rU, unit * 16384u);
    abl16(d.oi, C.vOI, C.rOI, unit * 16384u);
    { const unsigned so = (unsigned)((C.b * SEQ + n * 64) * AW * 2); abl16(d.og, C.vPR, C.rPR, so); }
}
#define HC_PIN(d) "+v"((d).qp), "+v"((d).dp), "+v"((d).ur[0]), "+v"((d).ur[1]), "+v"((d).oi), "+v"((d).og)
__device__ __forceinline__ void hc_stage(const HcCtx& C, LAS unsigned char* L, const HcSet& d, int slot) {
    *(LAS u32x4*)(L + HC_QD + slot * 8704 + C.sc0 * 272 + C.sch * 16) = d.qp;
    if (C.w < 2) *(LAS float*)(L + HC_DEC + slot * 512 + C.tid * 4) = d.dp;
}
__device__ __forceinline__ void hc_step(const HcCtx& C, LAS unsigned char* L, f32x4 (&S)[8], int n, HcSet& cur, HcSet& nxt, HcSet& nx2, int slot, int slot_nxt) {
    if (n >= 64) return;
    if (n + 2 < 64) { hc_load(C, nx2, n + 2); asm volatile("s_waitcnt vmcnt(12)" : HC_PIN(cur)); }
    else asm volatile("s_waitcnt vmcnt(0)" : HC_PIN(cur));
    const int fr = C.fr, g = C.g, j0 = C.j0;
    {
        f32x4 o[2];
#pragma unroll
        for (int ct = 0; ct < 2; ++ct) o[ct] = (f32x4){0.f, 0.f, 0.f, 0.f};
#pragma unroll
        for (int ks = 0; ks < 4; ++ks) {
            u32x4 sa; sa.x = pk2(S[2 * ks][0], S[2 * ks][1]); sa.y = pk2(S[2 * ks][2], S[2 * ks][3]); sa.z = pk2(S[2 * ks + 1][0], S[2 * ks + 1][1]); sa.w = pk2(S[2 * ks + 1][2], S[2 * ks + 1][3]);
            const bf16x8 sfrag = __builtin_bit_cast(bf16x8, sa);
#pragma unroll
            for (int ct = 0; ct < 2; ++ct) {
                const u32x2 q0 = *(const LAS u32x2*)(L + HC_QD + slot * 8704 + (16 * ct + fr) * 272 + (32 * ks + 4 * g) * 2);
                const u32x2 q1 = *(const LAS u32x2*)(L + HC_QD + slot * 8704 + (16 * ct + fr) * 272 + (32 * ks + 16 + 4 * g) * 2);
                const bf16x8 qf = __builtin_bit_cast(bf16x8, (u32x4){q0.x, q0.y, q1.x, q1.y});
                o[ct] = __builtin_amdgcn_mfma_f32_16x16x32_bf16(sfrag, qf, o[ct], 0, 0, 0);
            }
        }
#pragma unroll
        for (int ct = 0; ct < 2; ++ct) *(LAS f32x4*)(L + HC_OT + (16 * ct + fr) * 528 + (j0 + 4 * g) * 4) = o[ct];
#pragma unroll
        for (int kt = 0; kt < 8; ++kt) {
            const f32x4 dc = *(const LAS f32x4*)(L + HC_DEC + slot * 512 + (16 * kt + 4 * g) * 4);
            const unsigned uu = (kt & 3) == 0 ? cur.ur[kt >> 2].x : (kt & 3) == 1 ? cur.ur[kt >> 2].y : (kt & 3) == 2 ? cur.ur[kt >> 2].z : cur.ur[kt >> 2].w;
            const f32x2 ulo = __builtin_amdgcn_cvt_pk_f32_fp8((int)uu, false), uhi = __builtin_amdgcn_cvt_pk_f32_fp8((int)uu, true);
            S[kt] = S[kt] * dc + (f32x4){ulo.x, ulo.y, uhi.x, uhi.y} * (1.0f / HG_US);
        }
    }
    LDS_BARRIER();
    {
        f32x4 ov[2]; float ss = 0.f;
        const unsigned oiw[4] = {cur.oi.x, cur.oi.y, cur.oi.z, cur.oi.w};
#pragma unroll
        for (int j = 0; j < 2; ++j) { ov[j] = *(const LAS f32x4*)(L + HC_OT + C.c5 * 528 + (8 * C.sub + 4 * j) * 4);
            ov[j] = ov[j] + (f32x4){bflo(oiw[2 * j]), bfhi(oiw[2 * j]), bflo(oiw[2 * j + 1]), bfhi(oiw[2 * j + 1])};
            ss += (ov[j].x * ov[j].x + ov[j].y * ov[j].y) + (ov[j].z * ov[j].z + ov[j].w * ov[j].w); }
        ss += swz_xor<1>(ss); ss += swz_xor<2>(ss); ss += swz_xor<4>(ss); ss += swz_xor<8>(ss);
        const float rs = frsq(ss * (1.f / 128.f) + RMS_EPS);
        const unsigned ogw[4] = {cur.og.x, cur.og.y, cur.og.z, cur.og.w};
        float r[8]; f32x4 ngv[2];
#pragma unroll
        for (int j = 0; j < 2; ++j) ngv[j] = *(const LAS f32x4*)(L + HC_NG + (8 * C.sub + 4 * j) * 4);
#pragma unroll
        for (int j = 0; j < 2; ++j)
#pragma unroll
            for (int e = 0; e < 4; ++e) { const unsigned wv = ogw[2 * j + (e >> 1)]; const float gg = (e & 1) ? bfhi(wv) : bflo(wv); r[4 * j + e] = ov[j][e] * rs * ngv[j][e] * gg * sigmoidf_(gg); }
        bf16_t* op = C.MIX + (size_t)(n * 64 + C.r0 + C.c5) * DM + C.h * 128 + 8 * C.sub;
        *(u32x4*)op = (u32x4){pk2(r[0], r[1]), pk2(r[2], r[3]), pk2(r[4], r[5]), pk2(r[6], r[7])};
    }
    if (n + 1 < 64) {
        if (n + 2 < 64) asm volatile("s_waitcnt vmcnt(7)" : HC_PIN(nxt)); else asm volatile("s_waitcnt vmcnt(0)" : HC_PIN(nxt));
        hc_stage(C, L, nxt, slot_nxt);
    }
    LDS_BARRIER();
}
__device__ __forceinline__ void hgrn_chain(const Frame& F, const Ptrs& P, int wgi) {
    HcCtx C;
    const int bh = wgi >> 1; const int b = bh / 6; C.bh = bh; C.b = b; C.h = bh % 6; C.r0 = 32 * (wgi & 1);
    C.tid = F.tid; C.lane = F.lane; C.w = F.wave;
    LAS unsigned char* L = F.lds;
    C.MIX = (bf16_t*)(P.ws + WS_MIX) + (size_t)b * SEQ * DM;
    C.rQD = __builtin_amdgcn_make_buffer_rsrc(P.ws + WS_HGQD, 0, 3072 * 16384, 0x00020000);
    C.rOI = __builtin_amdgcn_make_buffer_rsrc(P.ws + WS_HGOI, 0, 3072 * 16384, 0x00020000);
    C.rU = __builtin_amdgcn_make_buffer_rsrc(P.ws + WS_HGU, 0, 3072 * 16384, 0x00020000);
    C.rDEC = __builtin_amdgcn_make_buffer_rsrc(P.ws + WS_HGDEC, 0, 3072 * 512, 0x00020000);
    C.rPR = __builtin_amdgcn_make_buffer_rsrc(P.ws + WS_R1, 0, MTOK * AW * 2, 0x00020000);
    C.sc0 = C.tid >> 4; C.sch = C.tid & 15; C.c5 = C.tid >> 4; C.sub = C.tid & 15;
    C.fr = C.lane & 15; C.g = C.lane >> 4; C.j0 = 16 * C.w;
    C.vQD = (unsigned)(((C.r0 + C.sc0) * 128 + C.sch * 8) * 2); C.vOI = (unsigned)(((C.r0 + C.c5) * 128 + 8 * C.sub) * 2); C.vU = (unsigned)((C.w * 64 + C.lane) * 32); C.vDEC = (unsigned)(C.tid * 4);
    C.vPR = (unsigned)(((C.r0 + C.c5) * AW + 2304 + C.h * 128 + 8 * C.sub) * 2);
    if (C.tid < 128) *(LAS float*)(L + HC_NG + C.tid * 4) = P.hon[C.tid];
    f32x4 S[8];
#pragma unroll
    for (int kt = 0; kt < 8; ++kt) S[kt] = (f32x4){0.f, 0.f, 0.f, 0.f};
    HcSet d0, d1, d2;
    d0.dp = d1.dp = d2.dp = 0.f;
    d0.qp = d1.qp = d2.qp = (u32x4){0u, 0u, 0u, 0u};
    VM_WAIT();
    hc_load(C, d0, 0); hc_load(C, d1, 1);
    asm volatile("s_waitcnt vmcnt(5)" : HC_PIN(d0));
    hc_stage(C, L, d0, 0);
    LDS_BARRIER();
    for (int n = 0; n < 66; n += 6) {
        hc_step(C, L, S, n, d0, d1, d2, 0, 1);
        hc_step(C, L, S, n + 1, d1, d2, d0, 1, 2);
        hc_step(C, L, S, n + 2, d2, d0, d1, 2, 0);
        hc_step(C, L, S, n + 3, d0, d1, d2, 0, 1);
        hc_step(C, L, S, n + 4, d1, d2, d0, 1, 2);
        hc_step(C, L, S, n + 5, d2, d0, d1, 2, 0);
        asm volatile("s_waitcnt vmcnt(0)" : HC_PIN(d0), HC_PIN(d1), HC_PIN(d2));
    }
    VM_WAIT();
}

constexpr int MA_K = 0;
constexpr int MA_VT = 36864;
constexpr int MA_OB = 70144;
template <bool OUT8>
__device__ __forceinline__ void memattn_unit(const Frame& F, const bf16_t* Q, int qpitch, int qcol, const bf16_t* MKV, int kvcol, bf16_t* MIXo, int unit) {
    const int tb = unit >> 2, mh = unit & 3, b = tb >> 4;
    const int tid = F.tid, lane = F.lane, w = F.wave, r32 = lane & 31, hi = lane >> 5;
    LAS unsigned char* L = F.lds;
#pragma unroll
    for (int i = 0; i < 4; ++i) { const int p = tid + 512 * i, key = p >> 3, chn = p & 7;
        const bf16_t* src = MKV + (size_t)(b * MEML + key) * DM + kvcol + mh * 64 + chn * 8;
        const u32x4 kk = *(const u32x4*)src; const u32x4 vv = *(const u32x4*)(src + 256);
        *(LAS u32x4*)(L + MA_K + key * 144 + chn * 16) = kk;
        const unsigned vw[4] = {vv.x, vv.y, vv.z, vv.w};
#pragma unroll
        for (int e = 0; e < 4; ++e) { *(LAS unsigned short*)(L + MA_VT + (chn * 8 + 2 * e) * 520 + key * 2) = (unsigned short)(vw[e] & 0xffffu);
            *(LAS unsigned short*)(L + MA_VT + (chn * 8 + 2 * e + 1) * 520 + key * 2) = (unsigned short)(vw[e] >> 16); } }
    const int tok0 = tb * 256 + w * 32;
    bf16x8 qr[4];
#pragma unroll
    for (int s = 0; s < 4; ++s) qr[s] = *(const bf16x8*)(Q + (size_t)(tok0 + r32) * qpitch + qcol + mh * 64 + 16 * s + 8 * hi);
    LDS_BARRIER();
    f32x16 p[8];
#pragma unroll
    for (int kt = 0; kt < 8; ++kt) { p[kt] = f32x16{};
#pragma unroll
        for (int s = 0; s < 4; ++s) { const bf16x8 a = *(const LAS bf16x8*)(L + MA_K + (32 * kt + r32) * 144 + s * 32 + hi * 16);
            p[kt] = __builtin_amdgcn_mfma_f32_32x32x16_bf16(a, qr[s], p[kt], 0, 0, 0); } }
    float mx = -3.0e38f;
#pragma unroll
    for (int kt = 0; kt < 8; ++kt)
#pragma unroll
        for (int r = 0; r < 16; ++r) mx = fmaxf(mx, p[kt][r]);
    mx = fmaxf(mx, __shfl_xor(mx, 32));
    float sum = 0.f;
#pragma unroll
    for (int kt = 0; kt < 8; ++kt)
#pragma unroll
        for (int r = 0; r < 16; ++r) { p[kt][r] = fexp2(p[kt][r] - mx); sum += p[kt][r]; }
    sum += __shfl_xor(sum, 32);
    const float inv = frcp(sum);
    f32x16 o[2]; o[0] = f32x16{}; o[1] = f32x16{};
#pragma unroll
    for (int kt = 0; kt < 8; ++kt)
#pragma unroll
        for (int s2 = 0; s2 < 2; ++s2) {
            u32x4 pw; pw.x = pk2(p[kt][8 * s2 + 0] * inv, p[kt][8 * s2 + 1] * inv); pw.y = pk2(p[kt][8 * s2 + 2] * inv, p[kt][8 * s2 + 3] * inv);
            pw.z = pk2(p[kt][8 * s2 + 4] * inv, p[kt][8 * s2 + 5] * inv); pw.w = pk2(p[kt][8 * s2 + 6] * inv, p[kt][8 * s2 + 7] * inv);
            const bf16x8 pa = __builtin_bit_cast(bf16x8, pw);
#pragma unroll
            for (int dt = 0; dt < 2; ++dt) {
                const u32x2 v0 = *(const LAS u32x2*)(L + MA_VT + (32 * dt + r32) * 520 + (32 * kt + 16 * s2 + 4 * hi) * 2);
                const u32x2 v1 = *(const LAS u32x2*)(L + MA_VT + (32 * dt + r32) * 520 + (32 * kt + 16 * s2 + 8 + 4 * hi) * 2);
                const bf16x8 vb = __builtin_bit_cast(bf16x8, (u32x4){v0.x, v0.y, v1.x, v1.y});
                o[dt] = __builtin_amdgcn_mfma_f32_32x32x16_bf16(pa, vb, o[dt], 0, 0, 0);
            }
        }
#pragma unroll
    for (int dt = 0; dt < 2; ++dt)
#pragma unroll
        for (int r = 0; r < 16; ++r) {
            if constexpr (!OUT8) MIXo[(size_t)(tok0 + crow(r, hi)) * DM + 768 + mh * 64 + 32 * dt + r32] = (bf16_t)f2bf(o[dt][r]); }
    if constexpr (OUT8) {
        LAS unsigned char* ob = L + MA_OB + w * 1024;
#pragma unroll
        for (int dt = 0; dt < 2; ++dt) {
#pragma unroll
            for (int r = 0; r < 16; ++r) ob[crow(r, hi) * 32 + r32] = fp8_1(o[dt][r] * FP8_SM);
            LDS_WAIT(); asm volatile("" ::: "memory");
            const u32x4 ov = *(const LAS u32x4*)(ob + (lane >> 1) * 32 + (lane & 1) * 16);
            *(u32x4*)((unsigned char*)MIXo + (size_t)(tok0 + (lane >> 1)) * DM + 768 + mh * 64 + 32 * dt + 16 * (lane & 1)) = ov;
            LDS_WAIT(); asm volatile("" ::: "memory");
        }
    }
    LDS_BARRIER();
}

constexpr int SB_SLOT = 19456;
constexpr int SB_VOFF = 9216;
constexpr int SB_NSLOT = 6;
constexpr int SB_FLAG = SB_NSLOT * SB_SLOT;
__device__ __forceinline__ int sb_unit_of(int L) { return (L >> 4) * 16 + (15 - (L & 15)); }
__device__ __forceinline__ void sb_prefetch_q(const Frame& F, const bf16_t* KVQ, int unit, bf16x8 (&q)[4]) {
    const int qb = unit & 15, hh = (unit >> 4) % 12, b = unit / 192;
    const int r32 = F.lane & 31, hi = F.lane >> 5;
    const bf16_t* base = KVQ + (size_t)b * SEQ * KVQW;
    const int tq = qb * 256 + F.wave * 32 + r32;
#pragma unroll
    for (int s = 0; s < 4; ++s) q[s] = *(const bf16x8*)(base + (size_t)tq * KVQW + 1536 + hh * 64 + 16 * s + 8 * hi);
}
__device__ __forceinline__ int sb_unit(const Frame& F, const bf16_t* KVQ, bf16_t* MIXo, int unit, const bf16x8 (&qpre)[4], int have_lo, int have_hi) {
    const int qb = unit & 15, hh = (unit >> 4) % 12, b = unit / 192;
    const int tid = F.tid, lane = F.lane, w = F.wave, r32 = lane & 31, hi = lane >> 5;
    LAS unsigned char* L = F.lds;
    const bf16_t* base = KVQ + (size_t)b * SEQ * KVQW;
    const int q0 = qb * 256 + w * 32;
    const int tq = q0 + r32;
    bf16x8 qr[4];
#pragma unroll
    for (int s = 0; s < 4; ++s) qr[s] = qpre[s];
    bf16x8 tri[2], ones;
#pragma unroll
    for (int s2 = 0; s2 < 2; ++s2)
#pragma unroll
        for (int j = 0; j < 8; ++j) { const int k = 16 * s2 + 8 * (j >> 2) + 4 * hi + (j & 3); tri[s2][j] = (k > r32) ? (short)0x3F80 : (short)0; }
#pragma unroll
    for (int j = 0; j < 8; ++j) ones[j] = (short)0x3F80;
    f32x16 o[2]; o[0] = f32x16{}; o[1] = f32x16{};
    float R = 0.f;
    const int skey = tid >> 3, schn = tid & 7;
    const bf16_t* srcb = base + (size_t)skey * KVQW + hh * 64 + schn * 8;
    const int kwr = skey * 144 + schn * 16, vwr = SB_VOFF + skey * 160 + schn * 16;
    const int vlane = SB_VOFF + (4 * hi + ((lane & 15) >> 2)) * 160 + ((lane >> 4) & 1) * 32 + (lane & 3) * 8;
    {
        u32x4 kk[4], vv[4];
#pragma unroll
        for (int i = 0; i < 4; ++i) { const int tt = 4 * qb + i; if (tt < have_lo || tt > have_hi) { const bf16_t* src = srcb + (size_t)(tt * 64) * KVQW; kk[i] = *(const u32x4*)src; vv[i] = *(const u32x4*)(src + 768); } }
#pragma unroll
        for (int i = 0; i < 4; ++i) { const int tt = 4 * qb + i; if (tt < have_lo || tt > have_hi) { const int sl = tt % SB_NSLOT; *(LAS u32x4*)(L + sl * SB_SLOT + kwr) = kk[i]; *(LAS u32x4*)(L + sl * SB_SLOT + vwr) = vv[i]; } }
    }
    LDS_BARRIER();
    const int jd = 4 * qb + (w >> 1);
    int slot = jd % SB_NSLOT;
    int pslot = (4 * qb + SB_NSLOT - 1) % SB_NSLOT;
    bool mydone = false;
    int lo_loaded = (have_lo <= have_hi && have_lo < 4 * qb) ? have_lo : 4 * qb;
    for (int st = 0; ; ++st) {
        const int tpre = 4 * qb - st - 1;
        u32x4 kreg, vreg;
        const bool need_pre = tpre >= 0 && (tpre < have_lo || tpre > have_hi);
        if (need_pre) { const bf16_t* src = srcb + (size_t)(tpre * 64) * KVQW; kreg = *(const u32x4*)src; vreg = *(const u32x4*)(src + 768); }
        const int t = jd - st;
        if (t >= 0 && !mydone) {
            const int k0 = 64 * t;
            const LAS unsigned char* Kb = L + slot * SB_SLOT;
            f32x16 p0 = f32x16{}, p1 = f32x16{};
#pragma unroll
            for (int s = 0; s < 4; ++s) {
                const bf16x8 a0 = *(const LAS bf16x8*)(Kb + r32 * 144 + s * 32 + hi * 16);
                const bf16x8 a1 = *(const LAS bf16x8*)(Kb + (32 + r32) * 144 + s * 32 + hi * 16);
                p0 = __builtin_amdgcn_mfma_f32_32x32x16_bf16(a0, qr[s], p0, 0, 0, 0);
                p1 = __builtin_amdgcn_mfma_f32_32x32x16_bf16(a1, qr[s], p1, 0, 0, 0);
            }
            float l0[16], l1[16];
            float csum = 0.f;
#pragma unroll
            for (int r = 0; r < 16; ++r) {
                const float z0 = fminf(p0[r], 80.f), z1 = fminf(p1[r], 80.f);
                const float sp0 = flog2(1.0f + fexp2(z0)), sp1 = flog2(1.0f + fexp2(z1));
                float a = -sp0, bq = -sp1, lb0 = z0 - sp0, lb1 = z1 - sp1;
                if (st == 0) { const int key0 = k0 + crow(r, hi); if (key0 >= tq) { a = 0.f; lb0 = -INFINITY; } if (key0 + 32 >= tq) { bq = 0.f; lb1 = -INFINITY; } }
                l0[r] = a; l1[r] = bq; p0[r] = lb0; p1[r] = lb1; csum += a + bq;
            }
            csum += __shfl_xor(csum, 32);
            bf16x8 x0[2], x1[2];
#pragma unroll
            for (int s2 = 0; s2 < 2; ++s2) {
                u32x4 t0, t1;
                t0.x = pk2(l0[8 * s2 + 0], l0[8 * s2 + 1]); t0.y = pk2(l0[8 * s2 + 2], l0[8 * s2 + 3]); t0.z = pk2(l0[8 * s2 + 4], l0[8 * s2 + 5]); t0.w = pk2(l0[8 * s2 + 6], l0[8 * s2 + 7]);
                t1.x = pk2(l1[8 * s2 + 0], l1[8 * s2 + 1]); t1.y = pk2(l1[8 * s2 + 2], l1[8 * s2 + 3]); t1.z = pk2(l1[8 * s2 + 4], l1[8 * s2 + 5]); t1.w = pk2(l1[8 * s2 + 6], l1[8 * s2 + 7]);
                x0[s2] = __builtin_bit_cast(bf16x8, t0); x1[s2] = __builtin_bit_cast(bf16x8, t1);
            }
            f32x16 y0, y1;
#pragma unroll
            for (int r = 0; r < 16; ++r) { y0[r] = R; y1[r] = R; }
            y0 = __builtin_amdgcn_mfma_f32_32x32x16_bf16(tri[0], x0[0], y0, 0, 0, 0);
            y0 = __builtin_amdgcn_mfma_f32_32x32x16_bf16(tri[1], x0[1], y0, 0, 0, 0);
            y0 = __builtin_amdgcn_mfma_f32_32x32x16_bf16(ones, x1[0], y0, 0, 0, 0);
            y0 = __builtin_amdgcn_mfma_f32_32x32x16_bf16(ones, x1[1], y0, 0, 0, 0);
            y1 = __builtin_amdgcn_mfma_f32_32x32x16_bf16(tri[0], x1[0], y1, 0, 0, 0);
            y1 = __builtin_amdgcn_mfma_f32_32x32x16_bf16(tri[1], x1[1], y1, 0, 0, 0);
#pragma unroll
            for (int r = 0; r < 16; ++r) { p0[r] = fexp2(p0[r] + y0[r]); p1[r] = fexp2(p1[r] + y1[r]); }
            R += csum;
            const LAS unsigned char* Vl = Kb + vlane;
#pragma unroll
            for (int half = 0; half < 2; ++half)
#pragma unroll
                for (int s2 = 0; s2 < 2; ++s2) {
                    u32x4 pw;
                    if (half == 0) { pw.x = pk2(p0[8 * s2 + 0], p0[8 * s2 + 1]); pw.y = pk2(p0[8 * s2 + 2], p0[8 * s2 + 3]); pw.z = pk2(p0[8 * s2 + 4], p0[8 * s2 + 5]); pw.w = pk2(p0[8 * s2 + 6], p0[8 * s2 + 7]); }
                    else { pw.x = pk2(p1[8 * s2 + 0], p1[8 * s2 + 1]); pw.y = pk2(p1[8 * s2 + 2], p1[8 * s2 + 3]); pw.z = pk2(p1[8 * s2 + 4], p1[8 * s2 + 5]); pw.w = pk2(p1[8 * s2 + 6], p1[8 * s2 + 7]); }
                    const bf16x8 pa = __builtin_bit_cast(bf16x8, pw);
#pragma unroll
                    for (int dt = 0; dt < 2; ++dt) {
                        const int kb = 32 * half + 16 * s2;
                        const s16x4 vlo = lds_tr16(Vl + kb * 160 + dt * 64), vhi = lds_tr16(Vl + (kb + 8) * 160 + dt * 64);
                        const bf16x8 vb = (bf16x8){vlo[0], vlo[1], vlo[2], vlo[3], vhi[0], vhi[1], vhi[2], vhi[3]};
                        o[dt] = __builtin_amdgcn_mfma_f32_32x32x16_bf16(pa, vb, o[dt], 0, 0, 0);
                    }
                }
        }
        if (t <= 0 || __all(R <= -150.f) != 0) mydone = true;
        if (lane == 0) *(LAS unsigned*)(L + SB_FLAG + ((st & 1) * 8 + w) * 4) = mydone ? 1u : 0u;
        if (need_pre) { *(LAS u32x4*)(L + pslot * SB_SLOT + kwr) = kreg; *(LAS u32x4*)(L + pslot * SB_SLOT + vwr) = vreg; }
        if (tpre >= 0 && tpre < lo_loaded) lo_loaded = tpre;
        LDS_BARRIER();
        { const u32x4 f0 = *(const LAS u32x4*)(L + SB_FLAG + (st & 1) * 32), f1 = *(const LAS u32x4*)(L + SB_FLAG + (st & 1) * 32 + 16);
          if ((f0.x & f0.y & f0.z & f0.w & f1.x & f1.y & f1.z & f1.w) != 0u) break; }
        slot = (slot == 0) ? SB_NSLOT - 1 : slot - 1;
        pslot = (pslot == 0) ? SB_NSLOT - 1 : pslot - 1;
    }
    LAS unsigned char* ob = L + SB_FLAG + 64 + w * 1024;
#pragma unroll
    for (int dt = 0; dt < 2; ++dt) {
#pragma unroll
        for (int r = 0; r < 16; ++r) ob[crow(r, hi) * 32 + r32] = fp8_1(o[dt][r] * FP8_SM);
        LDS_WAIT(); asm volatile("" ::: "memory");
        const u32x4 ov = *(const LAS u32x4*)(ob + (lane >> 1) * 32 + (lane & 1) * 16);
        *(u32x4*)((unsigned char*)MIXo + (size_t)(b * SEQ + q0 + (lane >> 1)) * DM + hh * 64 + 32 * dt + 16 * (lane & 1)) = ov;
        LDS_WAIT(); asm volatile("" ::: "memory");
    }
    LDS_BARRIER();
    return lo_loaded;
}
__device__ __forceinline__ void sb_phase(const Frame& F, const bf16_t* KVQ, bf16_t* MIXo) {
    bf16x8 qa[4], qb_[4];
    const int L0 = 6 * F.bx;
    sb_prefetch_q(F, KVQ, sb_unit_of(L0), qa);
    int have_lo = 1, have_hi = 0;
    for (int j = 0; j < 6; j += 2) {
        const int Lc = L0 + j;
        sb_prefetch_q(F, KVQ, sb_unit_of(Lc + 1), qb_);
        { const int u = sb_unit_of(Lc); const int lo = sb_unit(F, KVQ, MIXo, u, qa, have_lo, have_hi);
          if (((Lc + 1) >> 4) == (Lc >> 4)) { have_lo = lo; have_hi = lo + SB_NSLOT - 1; } else { have_lo = 1; have_hi = 0; } }
        if (j + 2 < 6) sb_prefetch_q(F, KVQ, sb_unit_of(Lc + 2), qa);
        { const int u = sb_unit_of(Lc + 1); const int lo = sb_unit(F, KVQ, MIXo, u, qb_, have_lo, have_hi);
          if (((Lc + 2) >> 4) == ((Lc + 1) >> 4)) { have_lo = lo; have_hi = lo + SB_NSLOT - 1; } else { have_lo = 1; have_hi = 0; } }
    }
}

struct Args { const float* in[20]; float* out; unsigned char* ws; };

__global__ void __launch_bounds__(NTHR, 2) yoco_fwd(Args args) {
    extern __shared__ __attribute__((aligned(16))) unsigned char lds_raw[];
    Frame F;
    F.lds = (LAS unsigned char*)lds_raw;
    F.tid = threadIdx.x; F.lane = F.tid & 63; F.wave = __builtin_amdgcn_readfirstlane(F.tid >> 6);
    F.G = gridDim.x; F.bx = blockIdx.x;
    Ptrs P;
    P.x = args.in[0]; P.mem = args.in[1]; P.anpre = args.in[2]; P.anpost = args.in[3]; P.fnpre = args.in[4]; P.fnpost = args.in[5];
    P.w_in_a = args.in[6]; P.hlb = args.in[7]; P.hon = args.in[8]; P.w_in_b = args.in[9]; P.kvn = args.in[10]; P.w_kv = args.in[11];
    P.memn = args.in[12]; P.w_mem_kv = args.in[13]; P.w_out = args.in[14]; P.w_gu = args.in[15]; P.w_dn = args.in[16]; P.w_router = args.in[17];
    P.w_egu = args.in[18]; P.w_edn = args.in[19]; P.out = args.out; P.ws = args.ws;
    unsigned char* ws = args.ws;
    unsigned* ctl = (unsigned*)(ws + WS_CTL);
    volatile LAS unsigned* MISC = (volatile LAS unsigned*)(F.lds + MISC_OFF);
    for (int u = F.tid; u < (LDS_BYTES - LDSCTL_OFF) / 4; u += NTHR) ((LAS unsigned*)(F.lds + LDSCTL_OFF))[u] = 0u;
    __syncthreads();
    XcdBarrier bar = xcd_barrier_post(ctl + CW_BAR, MISC + 8);
    {
        if (F.tid == 0) { const unsigned xcc = xb_xcc_id(); const unsigned rk = xb_add((unsigned*)ctl + CW_XRANK + xcc, 1u); MISC[12] = (xcc < 8u && rk < (unsigned)(F.G >> 3) && (F.G & 7) == 0) ? rk * 8u + xcc : 0xffffffffu; }
        __syncthreads();
        if (F.tid == 0 && MISC[12] == 0xffffffffu) __hip_atomic_store((unsigned*)ctl + CW_XRANK + 15, 1u, __ATOMIC_RELAXED, __HIP_MEMORY_SCOPE_AGENT);
    }
#define GRID_BAR() xcd_barrier(bar)

    bf16_t* const U = (bf16_t*)(ws + WS_U);
    bf16_t* const R1 = (bf16_t*)(ws + WS_R1);
    bf16_t* const MIX = (bf16_t*)(ws + WS_MIX);
    bf16_t* const MIXED = (bf16_t*)(ws + WS_MIXED);
    bf16_t* const MKV = (bf16_t*)(ws + WS_MKV);
    bf16_t* const H16 = (bf16_t*)(ws + WS_H16);

    { const Frame Fp = phase_frame(F); p0_prologue(Fp, P); }
    GRID_BAR();
    if (__hip_atomic_load((unsigned*)ctl + CW_XRANK + 15, __ATOMIC_RELAXED, __HIP_MEMORY_SCOPE_AGENT) == 0u) F.bx = (int)MISC[12];
    {
        pg8::Gemm g{U, (const bf16_t*)(ws + WS_WINA), MTOK, AW, DM / 2}; pg8::StaticOrder S; S.init(MTOK, AW, F.G, F.bx);
        S.ext_n = 32; S.ext_pm0 = MTOK / 256; S.ext_pn0 = AW / 256;
        pg8::EpiStoreQ E{R1, AW, (const float*)(ws + WS_AS), (const float*)(ws + WS_WSC) + WSC_INA, MKV, DM, MTOK / 256, AW / 256};
        pg8::gemm_phase<pg8::EpiStoreQ, pg8::StaticOrder, true, true, 2>(F.lds, g, S, E);
    }
    GRID_BAR();
    { const Frame Fp = phase_frame(F); hgrnA_phase(Fp, P); }
    { const Frame Fp = phase_frame(F); for (int u = F.bx; u < 512; u += F.G) memattn_unit<false>(Fp, R1, AW, 3072, MKV, 0, MIX, u); }
    GRID_BAR();
    { const Frame Fp = phase_frame(F); if (F.bx < 96) hgrn_chain(Fp, P, ((((F.bx >> 4) << 3) | (F.bx & 7)) << 1) | ((F.bx >> 3) & 1));
      else convert_weights(Fp, P, (F.bx - 96) * NWAVES + Fp.wave, (F.G - 96) * NWAVES); }
    GRID_BAR();
    {
        pg8::Gemm g{MIX, (const bf16_t*)(ws + WS_WOUT0), MTOK, DM, DM}; pg8::StaticOrder S; S.init(MTOK, DM, F.G, F.bx);
        pg8::EpiStore E{MIXED, DM, 1.f, nullptr, 0, 0, 0};
        pg8::gemm_phase<pg8::EpiStore, pg8::StaticOrder, true, true>(F.lds, g, S, E);
    }
    GRID_BAR();
    { const Frame Fp = phase_frame(F); norm_phase<false, true>(Fp, MIXED, P.x, H16, P.anpost, U, P.fnpre, (float*)(ws + WS_AS + 256 * 1024)); }
#if STOP_AFTER >= 5
    GRID_BAR();
    {
        pg8::Gemm g{U, (const bf16_t*)(ws + WS_WGU), MTOK, 2 * DFF, DM / 2}; pg8::StaticOrder S; S.init(MTOK, 2 * DFF, F.G, F.bx);
        pg8::EpiSwiGLUQ8 E{(unsigned char*)R1, DFF, (const float*)(ws + WS_AS + 256 * 1024), (const float*)(ws + WS_WSC) + WSC_GU};
        pg8::gemm_phase<pg8::EpiSwiGLUQ8, pg8::StaticOrder, true, true, 2>(F.lds, g, S, E);
    }
    GRID_BAR();
    {
        pg8::Gemm g{R1, (const bf16_t*)(ws + WS_WDN), MTOK, DM, DFF / 2}; pg8::StaticOrder S; S.init(MTOK, DM, F.G, F.bx);
        pg8::EpiStore E{MIXED, DM, 1.0f / (FP8_SHD * FP8_SWDD), nullptr, 0, 0, 0};
        pg8::gemm_phase<pg8::EpiStore, pg8::StaticOrder, true, true, 1>(F.lds, g, S, E);
    }
    GRID_BAR();
    { const Frame Fp = phase_frame(F); norm_phase<true, true>(Fp, MIXED, H16, H16, P.fnpost, U, nullptr, (float*)(ws + WS_AS + 512 * 1024)); }
#endif
#if STOP_AFTER >= 8
    GRID_BAR();
    {
        pg8::Gemm g{U, (const bf16_t*)(ws + WS_WKVB), MTOK, KVQW, DM / 2}; pg8::StaticOrder S; S.init(MTOK, KVQW, F.G, F.bx);
        pg8::EpiStoreQ E{R1, KVQW, (const float*)(ws + WS_AS + 512 * 1024), (const float*)(ws + WS_WSC) + WSC_KVB, nullptr, 0, 0, 0};
        pg8::gemm_phase<pg8::EpiStoreQ, pg8::StaticOrder, true, true, 2>(F.lds, g, S, E);
    }
    GRID_BAR();
    {
        { const Frame Fp = phase_frame(F); sb_phase(Fp, R1, MIX); }
        { const Frame Fp = phase_frame(F); for (int u = F.bx; u < 512; u += F.G) memattn_unit<true>(Fp, R1, KVQW, 2304, MKV, 512, MIX, u); }
    }
    GRID_BAR();
    {
        pg8::Gemm g{MIX, (const bf16_t*)(ws + WS_WOUT1), MTOK, DM, DM / 2}; pg8::StaticOrder S; S.init(MTOK, DM, F.G, F.bx);
        pg8::EpiStore E{MIXED, DM, 1.0f / (FP8_SM * FP8_SWO), nullptr, 0, 0, 0};
        pg8::gemm_phase<pg8::EpiStore, pg8::StaticOrder, true, true, 1>(F.lds, g, S, E);
    }
    GRID_BAR();
    {
        const Frame Fq = phase_frame(F);
        LAS unsigned* lcnt = (LAS unsigned*)(F.lds + 32768);
        LAS float* WRt = (LAS float*)(F.lds);
        if (Fq.tid < 8) lcnt[Fq.tid] = 0u;
        for (int idx = Fq.tid; idx < DM * NEXP; idx += NTHR) WRt[(idx & 7) * DM + (idx >> 3)] = P.w_router[idx];
        __syncthreads();
        f32x4 g1v[4], g2v[4];
#pragma unroll
        for (int j = 0; j < 4; ++j) { g1v[j] = ((const f32x4*)(P.anpost + DM))[Fq.lane + 64 * j]; g2v[j] = ((const f32x4*)(P.fnpre + DM))[Fq.lane + 64 * j]; }
        for (int i0 = 0; i0 < 16; i0 += 4) {
          const int m0 = F.bx * 128 + Fq.wave * 16 + i0;
          u32x2 ar[4][4], bs[4][4];
#pragma unroll
          for (int r = 0; r < 4; ++r)
#pragma unroll
            for (int j = 0; j < 4; ++j) { ar[r][j] = ((const u32x2*)(MIXED + (size_t)(m0 + r) * DM))[Fq.lane + 64 * j]; bs[r][j] = ((const u32x2*)(H16 + (size_t)(m0 + r) * DM))[Fq.lane + 64 * j]; }
          f32x4 uu[4][4];
#pragma unroll
          for (int r = 0; r < 4; ++r) {
            const int m = m0 + r;
            f32x4 a[4];
#pragma unroll
            for (int j = 0; j < 4; ++j) a[j] = (f32x4){bflo(ar[r][j].x), bfhi(ar[r][j].x), bflo(ar[r][j].y), bfhi(ar[r][j].y)};
            const float rs = row_rstd(a);
            f32x4 h[4];
#pragma unroll
            for (int j = 0; j < 4; ++j) {
                h[j] = (f32x4){bflo(bs[r][j].x), bfhi(bs[r][j].x), bflo(bs[r][j].y), bfhi(bs[r][j].y)} + a[j] * rs * g1v[j];
                u32x2 hw; hw.x = pk2(h[j].x, h[j].y); hw.y = pk2(h[j].z, h[j].w); ((u32x2*)(H16 + (size_t)m * DM))[Fq.lane + 64 * j] = hw; }
            const float rh = row_rstd(h);
            unsigned* o4 = (unsigned*)((unsigned char*)U + (size_t)m * DM) + Fq.lane;
#pragma unroll
            for (int j = 0; j < 4; ++j) { uu[r][j] = h[j] * rh * g2v[j];
                o4[64 * j] = pk4_fp8s(uu[r][j].x * FP8_SX, uu[r][j].y * FP8_SX, uu[r][j].z * FP8_SX, uu[r][j].w * FP8_SX); }
          }
          float lg[4][8];
#pragma unroll
          for (int r = 0; r < 4; ++r)
#pragma unroll
            for (int e = 0; e < 8; ++e) lg[r][e] = 0.f;
#pragma unroll
          for (int j = 0; j < 4; ++j)
#pragma unroll
            for (int e = 0; e < 8; ++e) { const f32x4 w4 = *(const LAS f32x4*)(WRt + e * DM + 4 * Fq.lane + 256 * j);
#pragma unroll
                for (int r = 0; r < 4; ++r) lg[r][e] += uu[r][j].x * w4.x + uu[r][j].y * w4.y + uu[r][j].z * w4.z + uu[r][j].w * w4.w; }
#pragma unroll
          for (int r = 0; r < 4; ++r) {
            const int m = m0 + r;
#pragma unroll
            for (int e = 0; e < 8; ++e) lg[r][e] = wave_sum(lg[r][e]);
            int i0 = 0; float l0 = lg[r][0];
#pragma unroll
            for (int e = 1; e < 8; ++e) if (lg[r][e] > l0) { l0 = lg[r][e]; i0 = e; }
            int i1 = -1; float l1 = -3.0e38f;
#pragma unroll
            for (int e = 0; e < 8; ++e) if (e != i0 && lg[r][e] > l1) { l1 = lg[r][e]; i1 = e; }
            const float g0 = 1.0f / (1.0f + __expf(l1 - l0));
            if (Fq.lane == 0) {
                const unsigned r0 = __hip_atomic_fetch_add(lcnt + i0, 1u, __ATOMIC_RELAXED, __HIP_MEMORY_SCOPE_WORKGROUP);
                const unsigned r1 = __hip_atomic_fetch_add(lcnt + i1, 1u, __ATOMIC_RELAXED, __HIP_MEMORY_SCOPE_WORKGROUP);
                ((int4*)(ws + WS_META))[m] = make_int4(i0, i1, (int)r0, (int)r1);
                ((float2*)(ws + WS_GATE))[m] = make_float2(g0, 1.0f - g0);
            }
          }
        }
        __syncthreads();
        if (Fq.tid < 8) { const unsigned base = __hip_atomic_fetch_add(ctl + CW_GCNT + Fq.tid, lcnt[Fq.tid], __ATOMIC_RELAXED, __HIP_MEMORY_SCOPE_AGENT); ((unsigned*)(ws + WS_WGB))[F.bx * 8 + Fq.tid] = base; }
    }
#endif
#if STOP_AFTER >= 12
    GRID_BAR();
    int ts[NEXP + 1];
    {
        const Frame Fq = phase_frame(F);
        ts[0] = 0;
#pragma unroll
        for (int e = 0; e < NEXP; ++e) { const unsigned c = __hip_atomic_load(ctl + CW_GCNT + e, __ATOMIC_RELAXED, __HIP_MEMORY_SCOPE_AGENT); ts[e + 1] = ts[e] + (int)((c + 255u) >> 8); }
        bf16_t* XS = R1;
        for (int i0 = 0; i0 < 16; i0 += 4) {
            const int m0 = F.bx * 128 + Fq.wave * 16 + i0;
            int4 mt[4]; u32x4 v0[4];
#pragma unroll
            for (int r = 0; r < 4; ++r) { mt[r] = ((const int4*)(ws + WS_META))[m0 + r]; v0[r] = *((const u32x4*)((const unsigned char*)U + (size_t)(m0 + r) * DM) + Fq.lane); }
#pragma unroll
            for (int r = 0; r < 4; ++r) {
                int d0 = 0, d1 = 0;
#pragma unroll
                for (int e = 0; e < NEXP; ++e) { if (mt[r].x == e) d0 = ts[e] * 256; if (mt[r].y == e) d1 = ts[e] * 256; }
                d0 += (int)((const unsigned*)(ws + WS_WGB))[F.bx * 8 + mt[r].x] + mt[r].z;
                d1 += (int)((const unsigned*)(ws + WS_WGB))[F.bx * 8 + mt[r].y] + mt[r].w;
                *((u32x4*)((unsigned char*)XS + (size_t)d0 * DM) + Fq.lane) = v0[r]; *((u32x4*)((unsigned char*)XS + (size_t)d1 * DM) + Fq.lane) = v0[r];
                if (Fq.lane == 0) ((int2*)(ws + WS_DEST))[m0 + r] = make_int2(d0, d1);
            }
        }
    }
    GRID_BAR();
    const int nMt = ts[NEXP], RT = nMt > 256 ? nMt - 256 : 0, R_early = 4 * RT, R8 = (R_early + 7) & ~7;
    unsigned* const ecnt = ctl + CW_EARLY;
    {
        pg8::Gemm g{R1, (const bf16_t*)(ws + WS_WEGU), 0, 2 * DFE, DM / 2}; pg8::SignalOrder S; S.init(256, 2 * DFE, F.G, F.bx);
        S.nM = nMt; S.nwg = S.nM * S.nN; S.moe = 1; S.sp_q = 25; S.sp_R8 = ((F.G & 7) == 0 && R8 < F.G) ? R8 : 0; S.cnt = ecnt; S.early_rt = RT;
#pragma unroll
        for (int e = 0; e < NEXP; ++e) S.ts[e] = ts[e];
        pg8::EpiSwiGLU8 E{(unsigned char*)(ws + WS_EH), DFE, 1.0f / (FP8_SX * FP8_SWGU)};
        pg8::gemm_phase<pg8::EpiSwiGLU8, pg8::SignalOrder, true, true, 1>(F.lds, g, S, E);
    }
#pragma unroll 1
    for (int pass = 0; pass < 2; ++pass) {
        pg8::Gemm g{(const bf16_t*)(ws + WS_EH), (const bf16_t*)(ws + WS_WEDN), 0, DM, DFE / 2}; pg8::StaticOrder S; S.init(256, DM, F.G, F.bx);
        S.moe = 1;
#pragma unroll
        for (int e = 0; e < NEXP; ++e) S.ts[e] = ts[e];
        if (pass == 0) {
            S.one_on = 1; S.one_has = (F.bx < R_early) ? 1 : 0; S.one_pm = F.bx >> 2; S.one_pn = F.bx & 3;
            if (S.one_has) {
                if (F.tid == 0) { unsigned sp = 0; while (__hip_atomic_load(ecnt, __ATOMIC_RELAXED, __HIP_MEMORY_SCOPE_AGENT) < (unsigned)(28 * RT) && ++sp < (1u << 22)) __builtin_amdgcn_s_sleep(2);
                    __builtin_amdgcn_fence(__ATOMIC_ACQUIRE, "agent"); }
                __syncthreads();
            }
        } else { S.nM = nMt - RT; S.nwg = S.nM * S.nN; S.pm_off = RT; }
        pg8::EpiStore E{R1 + (size_t)XS_ROWS * DM / 2, DM, 1.0f / (FP8_SH * FP8_SWDN), nullptr, 0, 0, 0};
        pg8::gemm_phase<pg8::EpiStore, pg8::StaticOrder, true, true, 1>(F.lds, g, S, E);
        GRID_BAR();
    }
    {
        const Frame Fq = phase_frame(F);
        f32x4 g1v[4];
#pragma unroll
        for (int j = 0; j < 4; ++j) g1v[j] = ((const f32x4*)(P.fnpost + DM))[Fq.lane + 64 * j];
        const bf16_t* YS = R1 + (size_t)XS_ROWS * DM / 2;
        for (int i0 = 0; i0 < 16; i0 += 4) {
            const int m0 = F.bx * 128 + Fq.wave * 16 + i0;
            int2 d[4]; float2 gt[4];
#pragma unroll
            for (int r = 0; r < 4; ++r) { d[r] = ((const int2*)(ws + WS_DEST))[m0 + r]; gt[r] = ((const float2*)(ws + WS_GATE))[m0 + r]; }
            u32x2 ya[4][4], yb[4][4], bs[4][4];
#pragma unroll
            for (int r = 0; r < 4; ++r)
#pragma unroll
                for (int j = 0; j < 4; ++j) { ya[r][j] = ((const u32x2*)(YS + (size_t)d[r].x * DM))[Fq.lane + 64 * j]; yb[r][j] = ((const u32x2*)(YS + (size_t)d[r].y * DM))[Fq.lane + 64 * j];
                    bs[r][j] = ((const u32x2*)(H16 + (size_t)(m0 + r) * DM))[Fq.lane + 64 * j]; }
#pragma unroll
            for (int r = 0; r < 4; ++r) {
                f32x4 a[4];
#pragma unroll
                for (int j = 0; j < 4; ++j) a[j] = (f32x4){bflo(ya[r][j].x), bfhi(ya[r][j].x), bflo(ya[r][j].y), bfhi(ya[r][j].y)} * gt[r].x + (f32x4){bflo(yb[r][j].x), bfhi(yb[r][j].x), bflo(yb[r][j].y), bfhi(yb[r][j].y)} * gt[r].y;
                const float rs = row_rstd(a);
#pragma unroll
                for (int j = 0; j < 4; ++j) { const f32x4 gg = g1v[j];
                    ((f32x4*)(P.out + (size_t)(m0 + r) * DM))[Fq.lane + 64 * j] = (f32x4){bflo(bs[r][j].x), bfhi(bs[r][j].x), bflo(bs[r][j].y), bfhi(bs[r][j].y)} + a[j] * rs * gg; }
            }
        }
    }
#endif
}

extern "C" void kernel_launch(void* const* d_in, const int* in_sizes, int n_in, void* d_out, int out_size, void* d_ws, size_t ws_size, hipStream_t stream) {
    static int grid = 0;
    if (grid == 0) {
        if (n_in != 20 || out_size != MTOK * DM || ws_size < WS_END) { fprintf(stderr, "kernel_launch: unexpected shapes (n_in %d out %d ws %zu)\n", n_in, out_size, ws_size); grid = -1; return; }
        int dev = 0, cus = 0, per_cu = 0;
        if (hipGetDevice(&dev) != hipSuccess || hipDeviceGetAttribute(&cus, hipDeviceAttributeMultiprocessorCount, dev) != hipSuccess) { grid = -1; return; }
        if (hipFuncSetAttribute((const void*)yoco_fwd, hipFuncAttributeMaxDynamicSharedMemorySize, LDS_BYTES) != hipSuccess) { fprintf(stderr, "kernel_launch: hipFuncSetAttribute failed\n"); grid = -1; return; }
        if (hipOccupancyMaxActiveBlocksPerMultiprocessor(&per_cu, (const void*)yoco_fwd, NTHR, LDS_BYTES) != hipSuccess || per_cu < 1) { fprintf(stderr, "kernel_launch: occupancy query says %d\n", per_cu); }
        (void)hipGetLastError();
        if (cus < 256) { fprintf(stderr, "kernel_launch: need 256 CUs, have %d\n", cus); grid = -1; return; }
        grid = 256;
    }
    if (grid < 0) return;
    if (hipMemsetAsync((char*)d_ws + WS_CTL, 0, CTL_ZERO_BYTES, stream) != hipSuccess) return;
    Args a{};
    for (int i = 0; i < 20; ++i) a.in[i] = (const float*)d_in[i];
    a.out = (float*)d_out; a.ws = (unsigned char*)d_ws;
    hipLaunchKernelGGL(yoco_fwd, dim3(grid), dim3(NTHR), LDS_BYTES, stream, a);
}
```

```cpp
#include <hip/hip_runtime.h>
#include <cstdio>
#include <cstdint>

#ifndef STOP_AFTER
#define STOP_AFTER 99
#endif

#define LAS __attribute__((address_space(3)))
#define GAS __attribute__((address_space(1)))
typedef unsigned short bf16_t;
typedef short bf16x8 __attribute__((ext_vector_type(8)));
typedef float f32x4 __attribute__((ext_vector_type(4)));
typedef float f32x16 __attribute__((ext_vector_type(16)));
typedef float f32x2 __attribute__((ext_vector_type(2)));
typedef unsigned u32x4 __attribute__((ext_vector_type(4)));
typedef unsigned u32x2 __attribute__((ext_vector_type(2)));
typedef __bf16 bf16x2_t __attribute__((ext_vector_type(2)));

constexpr int NB = 8, SEQ = 4096, DM = 1024, MTOK = NB * SEQ;
constexpr int MEML = 256, MROWS = NB * MEML;
constexpr int AW = 3328, HF = 768, DFF = 2816, NEXP = 8, DFE = 3584;
constexpr int KVQW = 2560;
constexpr int XS_ROWS = 2 * MTOK + NEXP * 256;
constexpr float RMS_EPS = 1e-6f;
constexpr float C2 = 0.125f * 1.4426950408889634f;
constexpr int NWAVES = 8, NTHR = 512;

constexpr size_t MiB = 1u << 20;
constexpr size_t WS_CTL = 0, CTL_ZERO_BYTES = 128 * 1024;
constexpr size_t WS_MEMN = 395 * MiB + 32 * MiB;
constexpr size_t WS_MEMN_OLD_UNUSED = 459 * MiB;
constexpr size_t WS_AS = 1 * MiB;
constexpr size_t WS_WSC = 2 * MiB;
constexpr int WSC_INA = 0, WSC_GU = 4352, WSC_KVB = 9984, WSC_N = 12544;
constexpr size_t WS_MKV = 5 * MiB;
constexpr size_t WS_META = 9 * MiB;
constexpr size_t WS_GATE = WS_META + 512 * 1024, WS_DEST = WS_GATE + 256 * 1024, WS_WGB = WS_DEST + 256 * 1024;
constexpr size_t WS_WOUT1 = 12 * MiB;
constexpr size_t WS_WKVB = 14 * MiB;
constexpr size_t WS_WEGU = 19 * MiB;
constexpr size_t WS_WEDN = 131 * MiB;
constexpr size_t WS_R1 = 187 * MiB;
constexpr size_t WS_EH = 395 * MiB;
constexpr size_t WS_U = 395 * MiB;
constexpr size_t WS_MIX = 459 * MiB;
constexpr size_t WS_MIXED = 523 * MiB;
constexpr size_t WS_WINA = 587 * MiB;
constexpr size_t WS_WMKV = 587 * MiB + (size_t)3328 * 1024;
constexpr size_t WS_WMKV_OLD_UNUSED = 587 * MiB + (size_t)3328 * 1024 * 2;
constexpr size_t WS_WOUT0 = 596 * MiB;
constexpr size_t WS_WGU = 598 * MiB;
constexpr size_t WS_WDN = 609 * MiB;
constexpr size_t WS_HGQD = 640 * MiB;
constexpr size_t WS_HGOI = 688 * MiB;
constexpr size_t WS_HGU = 736 * MiB;
constexpr size_t WS_HGDEC = 832 * MiB;
constexpr size_t WS_H16 = 640 * MiB;
constexpr size_t WS_END = 857 * MiB;
static_assert(WS_EH + (size_t)XS_ROWS * DFE * 2 <= WS_END, "EH fits");
static_assert(WS_R1 + (size_t)MTOK * AW * 2 <= WS_EH, "R1 fits");
constexpr int CW_BAR = 4096;
constexpr int CW_GCNT = 16384;
constexpr int CW_EARLY = 16448 + 64;
constexpr int CW_XRANK = 16448;
static_assert((CW_EARLY + 16) * 4 <= (int)CTL_ZERO_BYTES, "control words inside the zeroed region");

constexpr int RING_BYTES = 131072;
constexpr int LDSCTL_OFF = RING_BYTES, MISC_OFF = LDSCTL_OFF + 320;
constexpr int LDS_BYTES = 147456;

__device__ __forceinline__ unsigned f2bf(float f) { unsigned u = __builtin_bit_cast(unsigned, f); return (u + 0x7fffu + ((u >> 16) & 1u)) >> 16; }
__device__ __forceinline__ unsigned pk2(float lo, float hi) { f32x2 v = {lo, hi}; bf16x2_t b = __builtin_convertvector(v, bf16x2_t); return __builtin_bit_cast(unsigned, b); }
__device__ __forceinline__ float bflo(unsigned w) { return __builtin_bit_cast(float, w << 16); }
__device__ __forceinline__ float bfhi(unsigned w) { return __builtin_bit_cast(float, w & 0xffff0000u); }
__device__ __forceinline__ float bf1(unsigned short s) { return __builtin_bit_cast(float, (unsigned)s << 16); }
__device__ __forceinline__ float wave_sum(float v);
__device__ __forceinline__ float fexp2(float x) { return __builtin_amdgcn_exp2f(x); }
__device__ __forceinline__ float flog2(float x) { return __builtin_amdgcn_logf(x); }
__device__ __forceinline__ float frcp(float x) { return __builtin_amdgcn_rcpf(x); }
__device__ __forceinline__ float frsq(float x) { return __builtin_amdgcn_rsqf(x); }
template <int X> __device__ __forceinline__ float swz_xor(float v) { return __builtin_bit_cast(float, __builtin_amdgcn_ds_swizzle(__builtin_bit_cast(int, v), (X << 10) | 0x1F)); }
__device__ __forceinline__ float wave_sum(float v) {
    v += swz_xor<1>(v); v += swz_xor<2>(v); v += swz_xor<4>(v); v += swz_xor<8>(v); v += swz_xor<16>(v);
    const float lo = __builtin_bit_cast(float, __builtin_amdgcn_readlane(__builtin_bit_cast(int, v), 0)), hi = __builtin_bit_cast(float, __builtin_amdgcn_readlane(__builtin_bit_cast(int, v), 32));
    return lo + hi;
}
__device__ __forceinline__ float sigmoidf_(float x) { return frcp(1.0f + fexp2(-1.4426950408889634f * x)); }
typedef int i32x4 __attribute__((ext_vector_type(4)));
typedef int i32x8 __attribute__((ext_vector_type(8)));
__device__ __forceinline__ float sat8(float x) { return __builtin_amdgcn_fmed3f(x, -448.f, 448.f); }
__device__ __forceinline__ unsigned pk4_fp8s(float a, float b, float c, float d) { int w = 0; w = __builtin_amdgcn_cvt_pk_fp8_f32(sat8(a), sat8(b), w, false); w = __builtin_amdgcn_cvt_pk_fp8_f32(sat8(c), sat8(d), w, true); return (unsigned)w; }
__device__ __forceinline__ unsigned char fp8_1(float x) { return (unsigned char)(__builtin_amdgcn_cvt_pk_fp8_f32(sat8(x), 0.f, 0, false) & 0xff); }
__device__ __forceinline__ unsigned pk4_fp8(float a, float b, float c, float d) { int w = 0; w = __builtin_amdgcn_cvt_pk_fp8_f32(a, b, w, false); w = __builtin_amdgcn_cvt_pk_fp8_f32(c, d, w, true); return (unsigned)w; }
constexpr float FP8_SX = 8.f, FP8_SH = 8.f, FP8_SWGU = 32.f, FP8_SWDN = 64.f, FP8_SHD = 8.f, FP8_SWDD = 64.f, FP8_SM = 16.f, FP8_SWO = 64.f;
__device__ __forceinline__ float wave_max(float v) {
    v = fmaxf(v, swz_xor<1>(v)); v = fmaxf(v, swz_xor<2>(v)); v = fmaxf(v, swz_xor<4>(v)); v = fmaxf(v, swz_xor<8>(v)); v = fmaxf(v, swz_xor<16>(v));
    const float lo = __builtin_bit_cast(float, __builtin_amdgcn_readlane(__builtin_bit_cast(int, v), 0)), hi = __builtin_bit_cast(float, __builtin_amdgcn_readlane(__builtin_bit_cast(int, v), 32));
    return fmaxf(lo, hi);
}
__device__ __forceinline__ unsigned pk4_i8(float a, float b, float c, float d) {
    const int ia = (int)__builtin_rintf(__builtin_amdgcn_fmed3f(a, -127.f, 127.f)), ib = (int)__builtin_rintf(__builtin_amdgcn_fmed3f(b, -127.f, 127.f)),
              ic = (int)__builtin_rintf(__builtin_amdgcn_fmed3f(c, -127.f, 127.f)), id = (int)__builtin_rintf(__builtin_amdgcn_fmed3f(d, -127.f, 127.f));
    return (unsigned)(ia & 0xff) | ((unsigned)(ib & 0xff) << 8) | ((unsigned)(ic & 0xff) << 16) | ((unsigned)id << 24);
}
__device__ __forceinline__ void quant_row_i8(const f32x4 (&uu)[4], unsigned char* qrow, float* as_slot, int lane) {
    float am = 0.f;
#pragma unroll
    for (int j = 0; j < 4; ++j) am = fmaxf(fmaxf(am, fmaxf(__builtin_fabsf(uu[j].x), __builtin_fabsf(uu[j].y))), fmaxf(__builtin_fabsf(uu[j].z), __builtin_fabsf(uu[j].w)));
    am = fmaxf(wave_max(am), 1e-20f);
    const float inv = 127.0f / am;
    unsigned* o4 = (unsigned*)qrow + lane;
#pragma unroll
    for (int j = 0; j < 4; ++j) o4[64 * j] = pk4_i8(uu[j].x * inv, uu[j].y * inv, uu[j].z * inv, uu[j].w * inv);
    if (lane == 0) *as_slot = am * (1.0f / 127.0f);
}
__device__ __forceinline__ int crow(int r, int hi) { return (r & 3) + 8 * (r >> 2) + 4 * hi; }
#define LDS_WAIT() asm volatile("s_waitcnt lgkmcnt(0)" ::: "memory")
#define VM_WAIT() asm volatile("s_waitcnt vmcnt(0)" ::: "memory")
#define LDS_BARRIER() do { asm volatile("s_waitcnt lgkmcnt(0)" ::: "memory"); __builtin_amdgcn_s_barrier(); asm volatile("" ::: "memory"); } while (0)

namespace pg8 {
#define PG8_LAS __attribute__((address_space(3)))
constexpr int BM = 256, BK = 64, HALF = 128, HTB = HALF * BK * 2, STAGE_BYTES = 8 * HTB, NXCD = 8, WGM = 4;
__host__ __device__ __forceinline__ int lds_byte(int r, int c) { const int st = (r >> 4) * 2 + (c >> 5), rr = r & 15, cc = c & 31, ob = rr * 64 + cc * 2; return st * 1024 + (ob ^ (((ob >> 9) & 1) << 5)); }
__host__ __device__ __forceinline__ void stage_rc(int b, int& R, int& C) { const int st = b / 1024, sb = b % 1024, swz = sb ^ (((sb >> 9) & 1) << 5); R = (st >> 1) * 16 + swz / 64; C = (st & 1) * 32 + (swz % 64) / 2; }
__host__ __device__ __forceinline__ int perm32(int rho) { const int n = rho >> 4, i = rho & 15; return 8 * (i >> 2) + 4 * n + (i & 3); }

struct Unit { int pm, pn, pb; };
constexpr int SC_OFF = 131072 + 2048;
struct Gemm { const bf16_t* A; const bf16_t* Bt; int M, N, K; };

struct StaticOrder {
    static constexpr bool SIGNALS = false;
    int nM, nN, nwg, G, c;
    int ts[NEXP];
    int moe;
    int ext_n, ext_pm0, ext_pn0;
    int sp_q, sp_R8;
    int pm_off;
    int one_on, one_has, one_pm, one_pn;
    __device__ void init(int M, int N, int G_, int c_) { nM = M / BM; nN = N / BM; nwg = nM * nN; G = G_; c = c_; moe = 0; ext_n = 0; ext_pm0 = 0; ext_pn0 = 0; sp_q = 0; sp_R8 = 0; pm_off = 0; one_on = 0; one_has = 0; one_pm = 0; one_pn = 0;
#pragma unroll
        for (int e = 0; e < NEXP; ++e) ts[e] = 0; }
    __device__ __forceinline__ bool next(int i, Unit& u) const {
        int pm, pn;
        if (one_on) { if (i > 0 || !one_has) return false; pm = one_pm; pn = one_pn; }
        else {
            long L = (long)i * G + c;
            if (sp_R8 > 0 && i >= sp_q) { if (c < sp_R8) return false; L = (long)sp_q * G + (long)(i - sp_q) * (G - sp_R8) + (c - sp_R8); }
            if (L >= nwg + ext_n) return false;
            if (L >= nwg) { const int j = (int)L - nwg; pm = ext_pm0 + (j >> 2); pn = ext_pn0 + (j & 3); }
            else {
                int wgid = (int)L; { const int q = nwg / NXCD, r = nwg % NXCD, xcd = wgid % NXCD, off = wgid / NXCD; wgid = (xcd < r ? xcd * (q + 1) : r * (q + 1) + (xcd - r) * q) + off; }
                const int nig = WGM * nN, gid = wgid / nig, fm = gid * WGM, gsz = (nM - fm) < WGM ? (nM - fm) : WGM;
                pm = fm + ((wgid % nig) % gsz) + pm_off; pn = (wgid % nig) / gsz;
            }
        }
        int pb = pn;
        if (moe) { int e = 0;
#pragma unroll
            for (int j = 1; j < NEXP; ++j) e += (pm >= ts[j]) ? 1 : 0;
            pb = e * nN + pn; }
        u.pm = pm; u.pn = pn; u.pb = pb;
        return true;
    }
    __device__ __forceinline__ void a_ready(const Unit&) const {}
    __device__ __forceinline__ void done(const Unit&) const {}
};
struct SignalOrder : StaticOrder {
    static constexpr bool SIGNALS = true;
    unsigned* cnt; int early_rt;
    __device__ __forceinline__ void signal(int n) const { __builtin_amdgcn_fence(__ATOMIC_RELEASE, "agent"); (void)__hip_atomic_fetch_add(cnt, (unsigned)n, __ATOMIC_RELAXED, __HIP_MEMORY_SCOPE_AGENT); }
};

struct EpiStore {
    __device__ __forceinline__ void scale_issue(PG8_LAS unsigned char*, const Unit&, int, int, int) const {}
    static constexpr bool PERM = true, AFTER_DRAIN = false;
    bf16_t* O; int ldc; float sc;
    bf16_t* O2; int ldc2, pm2, pn2;
    __device__ __forceinline__ void operator()(const f32x4 (&acc)[2][2][4][2], const Unit& u, int wr, int wc, int fr, int fq, const PG8_LAS unsigned char* lds, int ui) const {
        int row0 = u.pm * BM + wr * 64 + fr; int col0 = u.pn * BM + wc * 32 + 8 * fq; bf16_t* Ob = O; int ld = ldc;
        if (pm2 > 0 && u.pm >= pm2) { row0 -= pm2 * BM; col0 -= pn2 * BM; Ob = O2; ld = ldc2; }
#pragma unroll
        for (int ai = 0; ai < 2; ++ai)
#pragma unroll
            for (int m = 0; m < 4; ++m) { bf16_t* rowp = Ob + (size_t)(row0 + ai * HALF + m * 16) * ld + col0;
#pragma unroll
                for (int bj = 0; bj < 2; ++bj) { const f32x4 v0 = acc[ai][bj][m][0] * sc, v1 = acc[ai][bj][m][1] * sc;
                    u32x4 w; w.x = pk2(v0[0], v0[1]); w.y = pk2(v0[2], v0[3]); w.z = pk2(v1[0], v1[1]); w.w = pk2(v1[2], v1[3]);
                    *(u32x4*)(rowp + bj * HALF) = w; } }
    }
};
struct EpiSwiGLU {
    __device__ __forceinline__ void scale_issue(PG8_LAS unsigned char*, const Unit&, int, int, int) const {}
    static constexpr bool PERM = true, AFTER_DRAIN = false;
    bf16_t* O; int ldc;
    __device__ __forceinline__ void operator()(const f32x4 (&acc)[2][2][4][2], const Unit& u, int wr, int wc, int fr, int fq, const PG8_LAS unsigned char* lds, int ui) const {
        const int row0 = u.pm * BM + wr * 64 + fr; const int col0 = u.pn * HALF + wc * 32 + 8 * fq;
#pragma unroll
        for (int ai = 0; ai < 2; ++ai)
#pragma unroll
            for (int m = 0; m < 4; ++m) { bf16_t* rowp = O + (size_t)(row0 + ai * HALF + m * 16) * ldc + col0;
                float h[8];
#pragma unroll
                for (int n = 0; n < 2; ++n)
#pragma unroll
                    for (int i = 0; i < 4; ++i) { const float g = acc[ai][0][m][n][i], up = acc[ai][1][m][n][i]; h[4 * n + i] = (g * up) * frcp(1.0f + fexp2(-1.4426950408889634f * g)); }
                u32x4 w; w.x = pk2(h[0], h[1]); w.y = pk2(h[2], h[3]); w.z = pk2(h[4], h[5]); w.w = pk2(h[6], h[7]);
                *(u32x4*)rowp = w; }
    }
};

struct EpiStoreQ {
    __device__ __forceinline__ void scale_issue(PG8_LAS unsigned char* lds, const Unit& u, int ui, int wid, int lane) const {
        const float* src = (wid < 4) ? as + (size_t)u.pm * BM + 64 * wid + lane : ws + (size_t)u.pb * BM + 64 * (wid - 4) + lane;
        __builtin_amdgcn_global_load_lds((const unsigned*)src, (PG8_LAS unsigned*)(lds + SC_OFF + (ui & 1) * 2048 + wid * 256), 4, 0, 0);
    }
    static constexpr bool PERM = true, AFTER_DRAIN = false;
    bf16_t* O; int ldc; const float* as; const float* ws;
    bf16_t* O2; int ldc2, pm2, pn2;
    __device__ __forceinline__ void operator()(const f32x4 (&acc)[2][2][4][2], const Unit& u, int wr, int wc, int fr, int fq, const PG8_LAS unsigned char* lds, int ui) const {
        const int arow0 = u.pm * BM + wr * 64 + fr, bcol0 = u.pb * BM + wc * 32 + 8 * fq;
        int row0 = arow0, col0 = u.pn * BM + wc * 32 + 8 * fq; bf16_t* Ob = O; int ld = ldc;
        if (pm2 > 0 && u.pm >= pm2) { row0 -= pm2 * BM; col0 -= pn2 * BM; Ob = O2; ld = ldc2; }
        const PG8_LAS float* sc = (const PG8_LAS float*)(lds + SC_OFF + (ui & 1) * 2048);
        f32x4 wsv[2][2];
#pragma unroll
        for (int bj = 0; bj < 2; ++bj) { wsv[bj][0] = *(const PG8_LAS f32x4*)(sc + 256 + wc * 32 + 8 * fq + bj * HALF); wsv[bj][1] = *(const PG8_LAS f32x4*)(sc + 256 + wc * 32 + 8 * fq + bj * HALF + 4); }
#pragma unroll
        for (int ai = 0; ai < 2; ++ai)
#pragma unroll
            for (int m = 0; m < 4; ++m) { const float a = sc[wr * 64 + fr + ai * HALF + m * 16]; bf16_t* rowp = Ob + (size_t)(row0 + ai * HALF + m * 16) * ld + col0;
#pragma unroll
                for (int bj = 0; bj < 2; ++bj) { const i32x4 i0 = __builtin_bit_cast(i32x4, acc[ai][bj][m][0]), i1 = __builtin_bit_cast(i32x4, acc[ai][bj][m][1]);
                    const f32x4 v0 = __builtin_convertvector(i0, f32x4) * wsv[bj][0] * a, v1 = __builtin_convertvector(i1, f32x4) * wsv[bj][1] * a;
                    u32x4 w; w.x = pk2(v0[0], v0[1]); w.y = pk2(v0[2], v0[3]); w.z = pk2(v1[0], v1[1]); w.w = pk2(v1[2], v1[3]);
                    *(u32x4*)(rowp + bj * HALF) = w; } }
    }
};
struct EpiSwiGLUQ {
    __device__ __forceinline__ void scale_issue(PG8_LAS unsigned char* lds, const Unit& u, int ui, int wid, int lane) const {
        const float* src = (wid < 4) ? as + (size_t)u.pm * BM + 64 * wid + lane : ws + (size_t)u.pb * BM + 64 * (wid - 4) + lane;
        __builtin_amdgcn_global_load_lds((const unsigned*)src, (PG8_LAS unsigned*)(lds + SC_OFF + (ui & 1) * 2048 + wid * 256), 4, 0, 0);
    }
    static constexpr bool PERM = true, AFTER_DRAIN = false;
    bf16_t* O; int ldc; const float* as; const float* ws;
    __device__ __forceinline__ void operator()(const f32x4 (&acc)[2][2][4][2], const Unit& u, int wr, int wc, int fr, int fq, const PG8_LAS unsigned char* lds, int ui) const {
        const int row0 = u.pm * BM + wr * 64 + fr; const int col0 = u.pn * HALF + wc * 32 + 8 * fq, bcol0 = u.pb * BM + wc * 32 + 8 * fq;
        f32x4 wsv[2][2];
#pragma unroll
        for (int bj = 0; bj < 2; ++bj) { wsv[bj][0] = *(const f32x4*)(ws + bcol0 + bj * HALF); wsv[bj][1] = *(const f32x4*)(ws + bcol0 + bj * HALF + 4); }
#pragma unroll
        for (int ai = 0; ai < 2; ++ai)
#pragma unroll
            for (int m = 0; m < 4; ++m) { const float a = as[row0 + ai * HALF + m * 16]; bf16_t* rowp = O + (size_t)(row0 + ai * HALF + m * 16) * ldc + col0;
                float h[8];
#pragma unroll
                for (int n = 0; n < 2; ++n) { const f32x4 gv = __builtin_convertvector(__builtin_bit_cast(i32x4, acc[ai][0][m][n]), f32x4) * wsv[0][n] * a, uv = __builtin_convertvector(__builtin_bit_cast(i32x4, acc[ai][1][m][n]), f32x4) * wsv[1][n] * a;
#pragma unroll
                    for (int i = 0; i < 4; ++i) h[4 * n + i] = (gv[i] * uv[i]) * frcp(1.0f + fexp2(-1.4426950408889634f * gv[i])); }
                u32x4 w; w.x = pk2(h[0], h[1]); w.y = pk2(h[2], h[3]); w.z = pk2(h[4], h[5]); w.w = pk2(h[6], h[7]);
                *(u32x4*)rowp = w; }
    }
};
struct EpiSwiGLUQ8 {
    __device__ __forceinline__ void scale_issue(PG8_LAS unsigned char* lds, const Unit& u, int ui, int wid, int lane) const {
        const float* src = (wid < 4) ? as + (size_t)u.pm * BM + 64 * wid + lane : ws + (size_t)u.pb * BM + 64 * (wid - 4) + lane;
        __builtin_amdgcn_global_load_lds((const unsigned*)src, (PG8_LAS unsigned*)(lds + SC_OFF + (ui & 1) * 2048 + wid * 256), 4, 0, 0);
    }
    static constexpr bool PERM = true, AFTER_DRAIN = false;
    static constexpr int NST = 8;
    unsigned char* O; int ldc; const float* as; const float* ws;
    __device__ __forceinline__ void operator()(const f32x4 (&acc)[2][2][4][2], const Unit& u, int wr, int wc, int fr, int fq, const PG8_LAS unsigned char* lds, int ui) const {
        const int row0 = u.pm * BM + wr * 64 + fr; const int col0 = u.pn * HALF + wc * 32 + 8 * fq, bcol0 = u.pb * BM + wc * 32 + 8 * fq;
        const PG8_LAS float* sc = (const PG8_LAS float*)(lds + SC_OFF + (ui & 1) * 2048);
        f32x4 wsv[2][2];
#pragma unroll
        for (int bj = 0; bj < 2; ++bj) { wsv[bj][0] = *(const PG8_LAS f32x4*)(sc + 256 + wc * 32 + 8 * fq + bj * HALF); wsv[bj][1] = *(const PG8_LAS f32x4*)(sc + 256 + wc * 32 + 8 * fq + bj * HALF + 4); }
#pragma unroll
        for (int ai = 0; ai < 2; ++ai)
#pragma unroll
            for (int m = 0; m < 4; ++m) { const float a = sc[wr * 64 + fr + ai * HALF + m * 16]; unsigned char* rowp = O + (size_t)(row0 + ai * HALF + m * 16) * ldc + col0;
                float h[8];
#pragma unroll
                for (int n = 0; n < 2; ++n) { const f32x4 gv = __builtin_convertvector(__builtin_bit_cast(i32x4, acc[ai][0][m][n]), f32x4) * wsv[0][n] * a, uv = __builtin_convertvector(__builtin_bit_cast(i32x4, acc[ai][1][m][n]), f32x4) * wsv[1][n] * (a * FP8_SHD);
#pragma unroll
                    for (int i = 0; i < 4; ++i) h[4 * n + i] = (gv[i] * uv[i]) * frcp(1.0f + fexp2(-1.4426950408889634f * gv[i])); }
                u32x2 w; w.x = pk4_fp8s(h[0], h[1], h[2], h[3]); w.y = pk4_fp8s(h[4], h[5], h[6], h[7]);
                *(u32x2*)rowp = w; }
    }
};
struct EpiSwiGLU8 {
    __device__ __forceinline__ void scale_issue(PG8_LAS unsigned char*, const Unit&, int, int, int) const {}
    static constexpr bool PERM = true, AFTER_DRAIN = false;
    unsigned char* O; int ldc; float ds;
    __device__ __forceinline__ void operator()(const f32x4 (&acc)[2][2][4][2], const Unit& u, int wr, int wc, int fr, int fq, const PG8_LAS unsigned char* lds, int ui) const {
        const float c1 = -1.4426950408889634f * ds, c2 = ds * ds * FP8_SH;
        const int row0 = u.pm * BM + wr * 64 + fr; const int col0 = u.pn * HALF + wc * 32 + 8 * fq;
#pragma unroll
        for (int ai = 0; ai < 2; ++ai)
#pragma unroll
            for (int m = 0; m < 4; ++m) { unsigned char* rowp = O + (size_t)(row0 + ai * HALF + m * 16) * ldc + col0;
                float h[8];
#pragma unroll
                for (int n = 0; n < 2; ++n)
#pragma unroll
                    for (int i = 0; i < 4; ++i) { const float ga = acc[ai][0][m][n][i], ua = acc[ai][1][m][n][i];
                        h[4 * n + i] = (ga * ua) * (c2 * frcp(1.0f + fexp2(ga * c1))); }
                u32x2 w; w.x = pk4_fp8s(h[0], h[1], h[2], h[3]); w.y = pk4_fp8s(h[4], h[5], h[6], h[7]);
                *(u32x2*)rowp = w; }
    }
};

template <class Epi, class Sched, bool ALIGN_EPI = false, bool SP2 = false, int FP8 = 0>
__device__ __forceinline__ void gemm_phase(PG8_LAS unsigned char* lds, const Gemm g, const Sched& S, const Epi& E) {
    int tid_ = threadIdx.x; asm volatile("" : "+v"(tid_));
    const int tid = tid_, wid = __builtin_amdgcn_readfirstlane(tid >> 6), lane = tid & 63, wr = wid >> 2, wc = wid & 3, fr = lane & 15, fq = lane >> 4;
    const int K = g.K, nt = K / BK;
    unsigned voffA[2], voffB[2];
#pragma unroll
    for (int i = 0; i < 2; ++i) { int R, C; stage_rc(tid * 16 + i * 8192, R, C); const int Rb = Epi::PERM ? ((R & ~31) + perm32(R & 31)) : R;
        voffA[i] = (unsigned)(R * K + C) * 2u; voffB[i] = (unsigned)(Rb * K + C) * 2u; }
    const size_t kstep = (size_t)(BK * 2);
    const size_t hstep = (size_t)HALF * K * 2;
    const size_t tstep = 2 * hstep;
    const unsigned ldsw = (unsigned)wid * 1024u;
    const int aoff = lds_byte(wr * 64 + fr, fq * 8), boff = lds_byte(wc * 32 + fr, fq * 8);
#define PG8_SA(b, h) (((b) * 2 + (h)) * HTB)
#define PG8_SB(b, h) ((4 + (b) * 2 + (h)) * HTB)
#define PG8_STAGE(bufoff, gbase, voff) do { _Pragma("unroll") for (int _i = 0; _i < 2; ++_i) \
        __builtin_amdgcn_global_load_lds((const unsigned*)((const char*)(gbase) + (voff)[_i]), (PG8_LAS unsigned*)(lds + (bufoff) + ldsw + _i * 8192), 16, 0, 0); } while (0)
#define PG8_LD8(p) __builtin_shufflevector(*(const PG8_LAS i32x4*)(p), *(const PG8_LAS i32x4*)((p) + 1024), 0, 1, 2, 3, 4, 5, 6, 7)
#define PG8_LDA(dst, b, h) do { if constexpr (FP8 == 1) { _Pragma("unroll") for (int m = 0; m < 4; ++m) dst##8[m] = PG8_LD8(lds + PG8_SA(b, h) + aoff + m * 2048); } \
        else { _Pragma("unroll") for (int m = 0; m < 4; ++m) _Pragma("unroll") for (int k = 0; k < 2; ++k) dst[m][k] = *(const PG8_LAS bf16x8*)(lds + PG8_SA(b, h) + aoff + m * 2048 + k * 1024); } } while (0)
#define PG8_LDB(dst, b, h) do { if constexpr (FP8 == 1) { _Pragma("unroll") for (int n = 0; n < 2; ++n) dst##8[n] = PG8_LD8(lds + PG8_SB(b, h) + boff + n * 2048); } \
        else { _Pragma("unroll") for (int n = 0; n < 2; ++n) _Pragma("unroll") for (int k = 0; k < 2; ++k) dst[n][k] = *(const PG8_LAS bf16x8*)(lds + PG8_SB(b, h) + boff + n * 2048 + k * 1024); } } while (0)
#define PG8_CAT(x, y) __builtin_shufflevector(__builtin_bit_cast(i32x4, x), __builtin_bit_cast(i32x4, y), 0, 1, 2, 3, 4, 5, 6, 7)
#define PG8_MMA(ai, bj, At, Bt) do { __builtin_amdgcn_s_setprio(1); \
        if constexpr (FP8 == 1) { _Pragma("unroll") for (int m = 0; m < 4; ++m) _Pragma("unroll") for (int n = 0; n < 2; ++n) \
            asm volatile("v_mfma_scale_f32_16x16x128_f8f6f4 %0, %1, %2, %0, %3, %3 op_sel_hi:[0,0,0]" : "+v"(acc[ai][bj][m][n]) : "v"(Bt##8[n]), "v"(At##8[m]), "v"(sc1)); } \
        else if constexpr (FP8 == 2) { _Pragma("unroll") for (int m = 0; m < 4; ++m) _Pragma("unroll") for (int n = 0; n < 2; ++n) _Pragma("unroll") for (int k = 0; k < 2; ++k) \
            acc[ai][bj][m][n] = __builtin_bit_cast(f32x4, __builtin_amdgcn_mfma_i32_16x16x64_i8(__builtin_bit_cast(i32x4, Bt[n][k]), __builtin_bit_cast(i32x4, At[m][k]), __builtin_bit_cast(i32x4, acc[ai][bj][m][n]), 0, 0, 0)); } \
        else { _Pragma("unroll") for (int m = 0; m < 4; ++m) _Pragma("unroll") for (int n = 0; n < 2; ++n) _Pragma("unroll") for (int k = 0; k < 2; ++k) \
            acc[ai][bj][m][n] = __builtin_amdgcn_mfma_f32_16x16x32_bf16(Bt[n][k], At[m][k], acc[ai][bj][m][n], 0, 0, 0); } \
        __builtin_amdgcn_s_setprio(0); } while (0)
#define PG8_WAIT_V(n) asm volatile("s_waitcnt vmcnt(" #n ")" ::: "memory")
#define PG8_WAIT_L(n) asm volatile("s_waitcnt lgkmcnt(" #n ")" ::: "memory")
#define PG8_BAR __builtin_amdgcn_s_barrier()
#define PG8_SCHED __builtin_amdgcn_sched_barrier(0)
    Unit cur, nxt; int ui = 0; int early_cnt = 0;
    if (!S.next(0, cur)) return;
    f32x4 acc[2][2][4][2];
#pragma unroll
    for (int a = 0; a < 2; ++a)
#pragma unroll
        for (int b = 0; b < 2; ++b)
#pragma unroll
            for (int m = 0; m < 4; ++m)
#pragma unroll
                for (int n = 0; n < 2; ++n) acc[a][b][m][n] = (f32x4){0.f, 0.f, 0.f, 0.f};
    bf16x8 At[4][2], B0[2][2], B1[2][2];
    i32x8 At8[4], B08[2], B18[2];
    int sc1 = 0x7F7F7F7F; asm volatile("" : "+v"(sc1));
    const char* cA = (const char*)g.A + (size_t)cur.pm * tstep; const char* cB = (const char*)g.Bt + (size_t)cur.pb * tstep;
    S.a_ready(cur);
    if constexpr (SP2) {
        PG8_STAGE(PG8_SB(0, 0), cB, voffB); PG8_STAGE(PG8_SB(0, 1), cB + hstep, voffB); PG8_STAGE(PG8_SA(0, 0), cA, voffA); PG8_STAGE(PG8_SA(0, 1), cA + hstep, voffA);
        if (wr == 1) PG8_BAR;
        PG8_WAIT_V(2); PG8_BAR;
        PG8_STAGE(PG8_SB(1, 0), cB + kstep, voffB); PG8_STAGE(PG8_SA(1, 0), cA + kstep, voffA); PG8_STAGE(PG8_SB(1, 1), cB + hstep + kstep, voffB);
        PG8_WAIT_V(6); PG8_BAR;
    } else {
        PG8_STAGE(PG8_SB(0, 0), cB, voffB); PG8_STAGE(PG8_SA(0, 0), cA, voffA); PG8_STAGE(PG8_SB(0, 1), cB + hstep, voffB); PG8_STAGE(PG8_SA(0, 1), cA + hstep, voffA);
        if (wr == 1) PG8_BAR;
        PG8_WAIT_V(4); PG8_BAR;
        PG8_STAGE(PG8_SB(1, 0), cB + kstep, voffB); PG8_STAGE(PG8_SA(1, 0), cA + kstep, voffA); PG8_STAGE(PG8_SB(1, 1), cB + hstep + kstep, voffB);
        PG8_WAIT_V(6); PG8_BAR;
    }
    for (;;) {
        const bool has_next = S.next(ui + 1, nxt);
        const char* nA = has_next ? (const char*)g.A + (size_t)nxt.pm * tstep : cA; const char* nB = has_next ? (const char*)g.Bt + (size_t)nxt.pb * tstep : cB;
        E.scale_issue(lds, cur, ui, wid, lane);
        for (int t = 0; t < nt; t += 2) {
            const bool last = (t == nt - 2);
            const char* a1 = cA + (size_t)(t + 1) * kstep;
            const char* a2 = last ? nA : cA + (size_t)(t + 2) * kstep; const char* b2 = last ? nB : cB + (size_t)(t + 2) * kstep;
            const char* a3 = a2 + kstep; const char* b3 = b2 + kstep;
            if (last && has_next) S.a_ready(nxt);
            if constexpr (SP2) {
            PG8_LDB(B0, 0, 0); PG8_LDB(B1, 0, 1); PG8_SCHED; PG8_LDA(At, 0, 0); PG8_STAGE(PG8_SA(1, 1), a1 + hstep, voffA);
            PG8_WAIT_V(8); PG8_WAIT_L(0); PG8_BAR; PG8_MMA(0, 0, At, B0); PG8_MMA(0, 1, At, B1); PG8_BAR; PG8_SCHED;
            PG8_LDA(At, 0, 1); PG8_STAGE(PG8_SB(0, 0), b2, voffB); PG8_STAGE(PG8_SB(0, 1), b2 + hstep, voffB); PG8_STAGE(PG8_SA(0, 0), a2, voffA);
            PG8_WAIT_V(8); PG8_WAIT_L(0); PG8_BAR; PG8_MMA(1, 0, At, B0); PG8_MMA(1, 1, At, B1); PG8_BAR; PG8_SCHED;
            PG8_LDB(B0, 1, 0); PG8_LDB(B1, 1, 1); PG8_SCHED; PG8_LDA(At, 1, 0); PG8_STAGE(PG8_SA(0, 1), a2 + hstep, voffA);
            PG8_WAIT_V(8); PG8_WAIT_L(0); PG8_BAR; PG8_MMA(0, 0, At, B0); PG8_MMA(0, 1, At, B1); PG8_BAR; PG8_SCHED;
            PG8_LDA(At, 1, 1); PG8_STAGE(PG8_SB(1, 0), b3, voffB); PG8_STAGE(PG8_SB(1, 1), b3 + hstep, voffB); PG8_STAGE(PG8_SA(1, 0), a3, voffA);
            PG8_WAIT_V(8); PG8_WAIT_L(0); PG8_BAR; PG8_MMA(1, 0, At, B0); PG8_MMA(1, 1, At, B1); PG8_BAR; PG8_SCHED;
            } else {
            PG8_LDB(B0, 0, 0); PG8_SCHED; PG8_LDA(At, 0, 0); PG8_STAGE(PG8_SA(1, 1), a1 + hstep, voffA);
            PG8_WAIT_L(8); PG8_BAR; PG8_WAIT_L(0); PG8_MMA(0, 0, At, B0); PG8_BAR; PG8_SCHED;
            PG8_LDB(B1, 0, 1); PG8_STAGE(PG8_SB(0, 0), b2, voffB);
            PG8_BAR; PG8_WAIT_L(0); PG8_MMA(0, 1, At, B1); PG8_BAR;
            PG8_LDA(At, 0, 1); PG8_STAGE(PG8_SA(0, 0), a2, voffA);
            PG8_BAR; PG8_WAIT_L(0); PG8_MMA(1, 0, At, B0); PG8_BAR; PG8_SCHED;
            PG8_STAGE(PG8_SB(0, 1), b2 + hstep, voffB);
            PG8_WAIT_V(6); PG8_BAR; PG8_MMA(1, 1, At, B1); PG8_BAR;
            PG8_LDB(B0, 1, 0); PG8_SCHED; PG8_LDA(At, 1, 0); PG8_STAGE(PG8_SA(0, 1), a2 + hstep, voffA);
            PG8_WAIT_L(8); PG8_BAR; PG8_WAIT_L(0); PG8_MMA(0, 0, At, B0); PG8_BAR; PG8_SCHED;
            PG8_LDB(B1, 1, 1); PG8_STAGE(PG8_SB(1, 0), b3, voffB);
            PG8_BAR; PG8_WAIT_L(0); PG8_MMA(0, 1, At, B1); PG8_BAR;
            PG8_LDA(At, 1, 1); PG8_STAGE(PG8_SA(1, 0), a3, voffA);
            PG8_BAR; PG8_WAIT_L(0); PG8_MMA(1, 0, At, B0); PG8_BAR; PG8_SCHED;
            PG8_STAGE(PG8_SB(1, 1), b3 + hstep, voffB);
            PG8_WAIT_V(6); PG8_BAR; PG8_MMA(1, 1, At, B1); PG8_BAR;
            }
        }
        if constexpr (ALIGN_EPI) { if (wr == 0) PG8_BAR; }
        if constexpr (FP8 == 1) asm volatile("s_nop 15\n\ts_nop 15\n\ts_nop 15\n\ts_nop 15\n\ts_nop 15" ::: "memory");
        if constexpr (!Epi::AFTER_DRAIN) { E(acc, cur, wr, wc, fr, fq, lds, ui); S.done(cur); }
        if constexpr (Sched::SIGNALS) {
            early_cnt += (cur.pm < S.early_rt) ? 1 : 0;
            if (ui == 8) { PG8_WAIT_V(0); PG8_BAR; if (tid == 0 && early_cnt > 0) S.signal(early_cnt); early_cnt = 0; }
        }
        if (!has_next) break;
#pragma unroll
        for (int a = 0; a < 2; ++a)
#pragma unroll
            for (int b = 0; b < 2; ++b)
#pragma unroll
                for (int m = 0; m < 4; ++m)
#pragma unroll
                    for (int n = 0; n < 2; ++n) acc[a][b][m][n] = (f32x4){0.f, 0.f, 0.f, 0.f};
        cur = nxt; cA = nA; cB = nB; ++ui;
        if constexpr (ALIGN_EPI) { if (wr == 1) PG8_BAR; }
    }
    PG8_WAIT_V(0);
    if constexpr (!ALIGN_EPI) { if (wr == 0) PG8_BAR; }
    PG8_BAR;
    if constexpr (Sched::SIGNALS) { if (tid == 0 && early_cnt > 0) S.signal(early_cnt); }
#undef PG8_SA
#undef PG8_SB
#undef PG8_STAGE
#undef PG8_LDA
#undef PG8_LD8
#undef PG8_LDB
#undef PG8_MMA
#undef PG8_CAT
#undef PG8_WAIT_V
#undef PG8_WAIT_L
#undef PG8_BAR
#undef PG8_SCHED
}
}

#define XB_TMO      128
#define XB_XCNT(j)  (256  + 64 * (j))
#define XB_XSUB(j)  (1280 + 64 * (j))
#define XB_XGEN(j)  (2304 + 64 * (j))
#define XB_TOP      3328
#define XB_TOPGEN   3392
#define XCD_BAR_WORDS 3456
#define XB_SPIN_CAP (1u << 22)
__device__ __forceinline__ unsigned xb_ld(unsigned* p)              { return __hip_atomic_load(p, __ATOMIC_RELAXED, __HIP_MEMORY_SCOPE_AGENT); }
__device__ __forceinline__ unsigned xb_add(unsigned* p, unsigned v) { return __hip_atomic_fetch_add(p, v, __ATOMIC_RELAXED, __HIP_MEMORY_SCOPE_AGENT); }
__device__ __forceinline__ unsigned xb_xcc_id() { return (unsigned)__builtin_amdgcn_s_getreg((3 << 11) | 20) & 0xFu; }
#define XB_SPIN(cond, bar) do { unsigned _sp = 0; while (cond) { __builtin_amdgcn_s_sleep(1); \
    if ((++_sp & 255u) == 0u) { if (xb_ld(&(bar)[XB_TMO])) break; if (_sp > XB_SPIN_CAP) { atomicAdd(&(bar)[XB_TMO], 1u); break; } } } } while (0)
struct XcdBarrier { unsigned* bar; unsigned x; volatile LAS unsigned* st; };
__device__ __forceinline__ XcdBarrier xcd_barrier_post(unsigned* bar, volatile LAS unsigned* st) {
    XcdBarrier b; b.bar = bar; b.x = xb_xcc_id(); b.st = st;
    if (threadIdx.x == 0) (void)xb_add(&bar[XB_XCNT(b.x)], 1u);
    return b;
}
__device__ __forceinline__ void xcd_barrier_complete(unsigned* bar, unsigned x, unsigned& nloc, unsigned& nx) {
    const unsigned G = gridDim.x * gridDim.y * gridDim.z;
    unsigned sum, cnt, mine, sp = 0u;
    for (;;) {
        sum = 0u; cnt = 0u; mine = 0u;
#pragma unroll
        for (unsigned j = 0; j < 16; ++j) { const unsigned c = xb_ld(&bar[XB_XCNT(j)]); sum += c; cnt += (c > 0u) ? 1u : 0u; mine = (j == x) ? c : mine; }
        if (sum == G) break;
        __builtin_amdgcn_s_sleep(1);
        if ((++sp & 255u) == 0u) { if (xb_ld(&bar[XB_TMO])) break; if (sp > XB_SPIN_CAP) { atomicAdd(&bar[XB_TMO], 1u); break; } }
    }
    nloc = mine > 0u ? mine : 1u; nx = cnt > 0u ? cnt : 1u;
}
__device__ __forceinline__ void xcd_barrier(const XcdBarrier& b) {
    asm volatile("s_waitcnt vmcnt(0)" ::: "memory");
    __syncthreads();
    if (threadIdx.x == 0) {
        unsigned* bar = b.bar;
        __builtin_amdgcn_s_waitcnt(0);
        unsigned nloc = b.st[0], nx = b.st[1];
        if (nloc == 0u) { xcd_barrier_complete(bar, b.x, nloc, nx); b.st[0] = nloc; b.st[1] = nx; }
        const unsigned old = xb_add(&bar[XB_XSUB(b.x)], 1u);
        const unsigned gen = old / nloc;
        if (old + 1u == (gen + 1u) * nloc) {
            __builtin_amdgcn_fence(__ATOMIC_RELEASE, "agent");
            asm volatile("s_waitcnt vmcnt(0)" ::: "memory");
            const unsigned og = xb_add(&bar[XB_TOP], 1u);
            const unsigned tg = og / nx;
            if (og + 1u == (tg + 1u) * nx) xb_add(&bar[XB_TOPGEN], 1u);
            else XB_SPIN(xb_ld(&bar[XB_TOPGEN]) == tg, bar);
            __builtin_amdgcn_fence(__ATOMIC_ACQUIRE, "agent");
            xb_add(&bar[XB_XGEN(b.x)], 1u);
            asm volatile("s_waitcnt vmcnt(0)" ::: "memory");
        } else {
            XB_SPIN(xb_ld(&bar[XB_XGEN(b.x)]) == gen, bar);
            __builtin_amdgcn_fence(__ATOMIC_ACQUIRE, "agent");
            asm volatile("s_waitcnt vmcnt(0)" ::: "memory");
        }
    }
    __syncthreads();
}

struct Frame {
    LAS unsigned char* lds;
    int tid, lane, wave, G, bx;
};
__device__ __forceinline__ Frame phase_frame(const Frame& F) { Frame R = F; int t = threadIdx.x; asm volatile("" : "+v"(t)); R.tid = t; R.lane = t & 63; R.wave = __builtin_amdgcn_readfirstlane(t >> 6); return R; }

struct TrDesc { const float* W; unsigned char* WT; const float* kgain; float nscale; int K, N, drow0, k0, n0, f8; };
__device__ __forceinline__ void tr_load(const TrDesc& d, float (&tv)[32], int lane) {
    const float* wp = d.W + (size_t)(d.k0 + (lane >> 5)) * d.N + d.n0 + (lane & 31);
#pragma unroll
    for (int i = 0; i < 32; ++i) tv[i] = wp[(size_t)(2 * i) * d.N];
}
__device__ __forceinline__ void tr_finish(const TrDesc& d, const float (&tv)[32], LAS float* scr, int lane) {
#pragma unroll
    for (int i = 0; i < 32; ++i) { float v = tv[i] * d.nscale; if (d.kgain) v *= d.kgain[d.k0 + 2 * i + (lane >> 5)]; scr[(2 * i + (lane >> 5)) * 33 + (lane & 31)] = v; }
    LDS_WAIT(); asm volatile("" ::: "memory");
    const int c = lane & 7;
#pragma unroll
    for (int j = 0; j < 4; ++j) { const int n = (lane >> 3) + 8 * j; const LAS float* s = scr + (8 * c) * 33 + n;
        if (d.f8) { u32x2 o; o.x = pk4_fp8(s[0 * 33], s[1 * 33], s[2 * 33], s[3 * 33]); o.y = pk4_fp8(s[4 * 33], s[5 * 33], s[6 * 33], s[7 * 33]);
            *(u32x2*)(d.WT + (size_t)(d.drow0 + n) * d.K + d.k0 + 8 * c) = o; }
        else { u32x4 o; o.x = pk2(s[0 * 33], s[1 * 33]); o.y = pk2(s[2 * 33], s[3 * 33]); o.z = pk2(s[4 * 33], s[5 * 33]); o.w = pk2(s[6 * 33], s[7 * 33]);
            *(u32x4*)(d.WT + ((size_t)(d.drow0 + n) * d.K + d.k0 + 8 * c) * 2) = o; } }
    LDS_WAIT(); asm volatile("" ::: "memory");
}
__device__ __forceinline__ int gu_row(int n0, int Fh) { return n0 < Fh ? ((n0 >> 7) * 256 + (n0 & 127)) : (((n0 - Fh) >> 7) * 256 + 128 + ((n0 - Fh) & 127)); }

struct Ptrs {
    const float *x, *mem, *anpre, *anpost, *fnpre, *fnpost, *w_in_a, *hlb, *hon, *w_in_b, *kvn, *w_kv, *memn, *w_mem_kv, *w_out, *w_gu, *w_dn, *w_router, *w_egu, *w_edn;
    float* out; unsigned char* ws;
};

__device__ __forceinline__ float row_rstd(const f32x4 (&a)[4]);
__device__ __forceinline__ void rms_row_to_bf16(const float* xrow, bf16_t* orow, const float* gain, int lane) {
    const f32x4* xr = (const f32x4*)xrow + lane;
    f32x4 v[4]; float s = 0.f;
#pragma unroll
    for (int j = 0; j < 4; ++j) { v[j] = xr[64 * j]; s += (v[j].x * v[j].x + v[j].y * v[j].y) + (v[j].z * v[j].z + v[j].w * v[j].w); }
    const float rstd = frsq(wave_sum(s) * (1.f / DM) + RMS_EPS);
    u32x2* o8 = (u32x2*)orow + lane;
#pragma unroll
    for (int j = 0; j < 4; ++j) { f32x4 gg = gain ? ((const f32x4*)gain)[lane + 64 * j] : (f32x4){1.f, 1.f, 1.f, 1.f};
        u32x2 w; w.x = pk2(v[j].x * rstd * gg.x, v[j].y * rstd * gg.y); w.y = pk2(v[j].z * rstd * gg.z, v[j].w * rstd * gg.w); o8[64 * j] = w; }
}

struct TrCounts {
    static constexpr int I_INA = (DM / 64) * (AW / 32), I_MKV = (DM / 64) * (512 / 32), I_OUT = (DM / 64) * (DM / 32), I_GU = (DM / 64) * (2 * DFF / 32), I_DN = (DFF / 64) * (DM / 32),
                         I_KV = (DM / 64) * (1536 / 32), I_INB = (DM / 64) * (DM / 32), I_EGU = (DM / 64) * (2 * DFE / 32), I_EDN = (DFE / 64) * (DM / 32);
    static constexpr int NEARLY = I_INA + 2 * I_MKV + 2 * I_OUT + I_GU + I_DN + I_KV + I_INB;
    static constexpr int NITEMS = NEARLY + NEXP * I_EGU + NEXP * I_EDN;
};
__device__ __forceinline__ TrDesc tr_decode(const Ptrs& P, int it) {
    using T = TrCounts; unsigned char* ws = P.ws; TrDesc d; d.kgain = nullptr; d.nscale = 1.f; d.f8 = 0;
    int r = it - (T::I_INA + 2 * T::I_MKV);
    if (r < 2 * T::I_OUT) { const int l = r / T::I_OUT; r -= l * T::I_OUT; const int nb = DM / 32; d.k0 = 64 * (r / nb); d.n0 = 32 * (r % nb);
        d.W = P.w_out + (size_t)l * DM * DM; d.K = DM; d.N = DM; d.WT = ws + (l ? WS_WOUT1 : WS_WOUT0); d.drow0 = d.n0; if (l) { d.f8 = 1; d.nscale = FP8_SWO; } return d; } r -= 2 * T::I_OUT + T::I_GU;
    if (r < T::I_DN) { const int nb = DM / 32; d.k0 = 64 * (r / nb); d.n0 = 32 * (r % nb); d.W = P.w_dn; d.K = DFF; d.N = DM; d.WT = ws + WS_WDN; d.drow0 = d.n0; d.f8 = 1; d.nscale = FP8_SWDD; return d; } r -= T::I_DN + T::I_KV + T::I_INB;
    d.f8 = 1;
    if (r < NEXP * T::I_EGU) { const int e = r / T::I_EGU; r -= e * T::I_EGU; const int nb = 2 * DFE / 32; d.k0 = 64 * (r / nb); d.n0 = 32 * (r % nb);
        d.W = P.w_egu + (size_t)e * DM * 2 * DFE; d.K = DM; d.N = 2 * DFE; d.WT = ws + WS_WEGU + (size_t)e * 2 * DFE * DM; d.drow0 = gu_row(d.n0, DFE); d.nscale = FP8_SWGU; return d; } r -= NEXP * T::I_EGU;
    { const int e = r / T::I_EDN; r -= e * T::I_EDN; const int nb = DM / 32; d.k0 = 64 * (r / nb); d.n0 = 32 * (r % nb);
        d.W = P.w_edn + (size_t)e * DFE * DM; d.K = DFE; d.N = DM; d.WT = ws + WS_WEDN + (size_t)e * DM * DFE; d.drow0 = d.n0; d.nscale = FP8_SWDN; return d; }
}
__device__ __forceinline__ void convert_weights(const Frame& F, const Ptrs& P, int gw, int NGW) {
    LAS float* scr = (LAS float*)(F.lds + F.wave * 16384);
    const int it_lo = TrCounts::NEARLY, it_hi = TrCounts::NITEMS;
    for (int it = it_lo + gw; it < it_hi; it += 2 * NGW) {
        const bool two = it + NGW < it_hi;
        const TrDesc a = tr_decode(P, it), b = tr_decode(P, two ? it + NGW : it);
        float ta[32], tb[32];
        tr_load(a, ta, F.lane); if (two) tr_load(b, tb, F.lane);
        tr_finish(a, ta, scr, F.lane); if (two) tr_finish(b, tb, scr, F.lane);
    }
}
struct Q8Desc { const float* W; unsigned char* WT; const float* kgain; float nscale; int N, n0, drow0; float* wsc; };
constexpr int Q8_INA = AW / 32, Q8_MKV = 512 / 32, Q8_GU = 2 * DFF / 32, Q8_KV = 1536 / 32, Q8_INB = DM / 32, Q8_ITEMS = Q8_INA + 2 * Q8_MKV + Q8_GU + Q8_KV + Q8_INB;
__device__ __forceinline__ Q8Desc q8_decode(const Ptrs& P, int r) {
    unsigned char* ws = P.ws; float* const WSCp = (float*)(ws + WS_WSC); Q8Desc d; d.kgain = nullptr; d.nscale = 1.f;
    if (r < Q8_INA) { d.n0 = 32 * r; d.W = P.w_in_a; d.N = AW; d.WT = ws + WS_WINA; d.drow0 = d.n0; d.nscale = d.n0 >= 3072 ? C2 : 1.f; d.wsc = WSCp + WSC_INA; return d; } r -= Q8_INA;
    if (r < 2 * Q8_MKV) { const int l = r / Q8_MKV; r -= l * Q8_MKV; d.n0 = 32 * r; d.W = P.w_mem_kv + (size_t)l * DM * 512; d.N = 512; d.WT = ws + WS_WINA; d.drow0 = AW + l * 512 + d.n0; d.kgain = P.memn + l * DM; d.wsc = WSCp + WSC_INA; return d; } r -= 2 * Q8_MKV;
    if (r < Q8_GU) { d.n0 = 32 * r; d.W = P.w_gu; d.N = 2 * DFF; d.WT = ws + WS_WGU; d.drow0 = gu_row(d.n0, DFF); d.wsc = WSCp + WSC_GU; return d; } r -= Q8_GU;
    if (r < Q8_KV) { d.n0 = 32 * r; d.W = P.w_kv; d.N = 1536; d.WT = ws + WS_WKVB; d.drow0 = d.n0; d.kgain = P.kvn; d.wsc = WSCp + WSC_KVB; return d; } r -= Q8_KV;
    { d.n0 = 32 * r; d.W = P.w_in_b; d.N = DM; d.WT = ws + WS_WKVB; d.drow0 = 1536 + d.n0; d.kgain = P.anpre + DM; d.nscale = C2; d.wsc = WSCp + WSC_KVB; return d; }
}
__device__ __forceinline__ void q8_finish(const Q8Desc& q, const float (&tv)[32], int kbase, LAS float* scr, const LAS float* cfin, int lane) {
#pragma unroll
    for (int i = 0; i < 32; ++i) scr[(2 * i + (lane >> 5)) * 33 + (lane & 31)] = tv[i];
    LDS_WAIT(); asm volatile("" ::: "memory");
    const int c = lane & 7;
#pragma unroll
    for (int j = 0; j < 4; ++j) { const int n = (lane >> 3) + 8 * j; const LAS float* s = scr + (8 * c) * 33 + n; const float inv = 127.0f / cfin[n];
        u32x2 o; o.x = pk4_i8(s[0 * 33] * inv, s[1 * 33] * inv, s[2 * 33] * inv, s[3 * 33] * inv); o.y = pk4_i8(s[4 * 33] * inv, s[5 * 33] * inv, s[6 * 33] * inv, s[7 * 33] * inv);
        *(u32x2*)(q.WT + (size_t)(q.drow0 + n) * DM + kbase + 8 * c) = o; }
    LDS_WAIT(); asm volatile("" ::: "memory");
}
__device__ __forceinline__ void q8_item(const Frame& F, const Q8Desc& q, int parity) {
    const int lane = F.lane, kp = lane >> 5, nl = lane & 31, k0 = F.wave * 128;
    LAS float* scr = (LAS float*)(F.lds + F.wave * 16384);
    const float* wp = q.W + (size_t)(k0 + kp) * q.N + q.n0 + nl;
    float ga[32], gb[32];
    if (q.kgain) {
#pragma unroll
        for (int i = 0; i < 32; ++i) { ga[i] = q.kgain[k0 + 2 * i + kp]; gb[i] = q.kgain[k0 + 64 + 2 * i + kp]; }
    } else {
#pragma unroll
        for (int i = 0; i < 32; ++i) { ga[i] = 1.f; gb[i] = 1.f; }
    }
    float ta[32], tb[32];
#pragma unroll
    for (int i = 0; i < 32; ++i) ta[i] = wp[(size_t)(2 * i) * q.N];
#pragma unroll
    for (int i = 0; i < 32; ++i) tb[i] = wp[(size_t)(64 + 2 * i) * q.N];
    float m = 0.f;
#pragma unroll
    for (int i = 0; i < 32; ++i) { const float v = ta[i] * q.nscale * ga[i]; ta[i] = v; m = fmaxf(m, __builtin_fabsf(v)); }
#pragma unroll
    for (int i = 0; i < 32; ++i) { const float v = tb[i] * q.nscale * gb[i]; tb[i] = v; m = fmaxf(m, __builtin_fabsf(v)); }
    ((LAS float*)(F.lds + F.wave * 16384 + 12288 + parity * 256))[lane] = m;
    __syncthreads();
    float cm = 1e-30f;
#pragma unroll
    for (int w = 0; w < NWAVES; ++w) { const LAS float* cp = (const LAS float*)(F.lds + w * 16384 + 12288 + parity * 256); cm = fmaxf(cm, fmaxf(cp[nl], cp[nl + 32])); }
    LAS float* cfin = (LAS float*)(F.lds + F.wave * 16384 + 12288 + 512);
    if (lane < 32) cfin[lane] = cm;
    if (F.wave == 0 && lane < 32) q.wsc[q.drow0 + lane] = cm * (1.0f / 127.0f);
    q8_finish(q, ta, k0, scr, cfin, lane);
    q8_finish(q, tb, k0 + 64, scr, cfin, lane);
}
__device__ __forceinline__ void p0_rows4_load(const float* src, int m0, int lane, f32x4 (&v)[4][4]) {
#pragma unroll
    for (int r = 0; r < 4; ++r)
#pragma unroll
        for (int j = 0; j < 4; ++j) v[r][j] = ((const f32x4*)(src + (size_t)(m0 + r) * DM))[lane + 64 * j];
}
template <bool GAIN>
__device__ __forceinline__ void p0_rows4_finish(const f32x4 (&v)[4][4], const f32x4 (&gx)[4], unsigned char* dst, float* as, int m0, int lane) {
#pragma unroll
    for (int r = 0; r < 4; ++r) {
        const float rstd = row_rstd(v[r]);
        f32x4 uu[4];
#pragma unroll
        for (int j = 0; j < 4; ++j) { uu[j] = v[r][j] * rstd; if constexpr (GAIN) uu[j] = uu[j] * gx[j]; }
        quant_row_i8(uu, dst + (size_t)(m0 + r) * DM, as + m0 + r, lane);
    }
}
constexpr int P0_NB16 = 2 * TrCounts::I_OUT + TrCounts::I_DN, P0_G16 = P0_NB16 / 16, P0_XCH = MTOK / 32, P0_MCH = MROWS / 32, P0_WITEMS = Q8_ITEMS + P0_G16, P0_ITEMS = P0_WITEMS + P0_XCH + P0_MCH;
static_assert(P0_NB16 % 16 == 0, "bf16 wave items in groups of 16");
__device__ __forceinline__ void p0_prologue(const Frame& F, const Ptrs& P) {
    unsigned char* ws = P.ws;
    float* const ASA = (float*)(ws + WS_AS);
    int parity = 0, L = F.bx;
    for (; L < P0_WITEMS; L += F.G) {
        if (L < Q8_ITEMS) { const Q8Desc q = q8_decode(P, L); q8_item(F, q, parity); parity ^= 1; continue; }
        const int r = L - Q8_ITEMS;
        LAS float* scr = (LAS float*)(F.lds + F.wave * 16384);
        const int ia = r * 16 + F.wave, ib = ia + 8;
        const int base = TrCounts::I_INA + 2 * TrCounts::I_MKV;
        const TrDesc a = tr_decode(P, base + (ia < 2 * TrCounts::I_OUT ? ia : ia + TrCounts::I_GU)), b = tr_decode(P, base + (ib < 2 * TrCounts::I_OUT ? ib : ib + TrCounts::I_GU));
        float ta[32], tb[32];
        tr_load(a, ta, F.lane); tr_load(b, tb, F.lane);
        tr_finish(a, ta, scr, F.lane); tr_finish(b, tb, scr, F.lane);
    }
    f32x4 v[4][4], vn[4][4];
#define P0_LOAD(dst, LL) do { const int c_ = (LL) - P0_WITEMS; const bool isx_ = c_ < P0_XCH; p0_rows4_load(isx_ ? P.x : P.mem, 32 * (isx_ ? c_ : c_ - P0_XCH) + 4 * F.wave, F.lane, dst); } while (0)
#define P0_FIN(src, LL) do { const int c_ = (LL) - P0_WITEMS; const bool isx_ = c_ < P0_XCH; const int m0_ = 32 * (isx_ ? c_ : c_ - P0_XCH) + 4 * F.wave; \
        if (isx_) p0_rows4_finish<true>(src, gx, ws + WS_U, ASA, m0_, F.lane); else p0_rows4_finish<false>(src, gx, ws + WS_MEMN, ASA + MTOK, m0_, F.lane); } while (0)
    if (L < P0_ITEMS) {
        f32x4 gx[4];
#pragma unroll
        for (int j = 0; j < 4; ++j) gx[j] = ((const f32x4*)P.anpre)[F.lane + 64 * j];
        P0_LOAD(v, L);
        for (;;) {
            const int L1 = L + F.G; if (L1 < P0_ITEMS) P0_LOAD(vn, L1);
            P0_FIN(v, L);
            if (L1 >= P0_ITEMS) break;
            const int L2 = L1 + F.G; if (L2 < P0_ITEMS) P0_LOAD(v, L2);
            P0_FIN(vn, L1);
            if (L2 >= P0_ITEMS) break;
            L = L2;
        }
    }
#undef P0_LOAD
#undef P0_FIN
}

__device__ __forceinline__ void load_bf16_row(const bf16_t* arow, int lane, f32x4 (&a)[4]) {
    const u32x2* ar = (const u32x2*)arow + lane;
#pragma unroll
    for (int j = 0; j < 4; ++j) { const u32x2 w = ar[64 * j]; a[j] = (f32x4){bflo(w.x), bfhi(w.x), bflo(w.y), bfhi(w.y)}; }
}
__device__ __forceinline__ float row_rstd(const f32x4 (&a)[4]) {
    float s = 0.f;
#pragma unroll
    for (int j = 0; j < 4; ++j) s += (a[j].x * a[j].x + a[j].y * a[j].y) + (a[j].z * a[j].z + a[j].w * a[j].w);
    return frsq(wave_sum(s) * (1.f / DM) + RMS_EPS);
}
template <bool BASE16, bool Q8OUT>
__device__ __forceinline__ void norm_phase(const Frame& F, const bf16_t* A, const void* base, bf16_t* H, const float* g1, bf16_t* U, const float* g2, float* as_out) {
    f32x4 g1v[4], g2v[4];
#pragma unroll
    for (int j = 0; j < 4; ++j) { g1v[j] = ((const f32x4*)g1)[F.lane + 64 * j]; g2v[j] = g2 ? ((const f32x4*)g2)[F.lane + 64 * j] : (f32x4){1.f, 1.f, 1.f, 1.f}; }
    for (int i0 = 0; i0 < 16; i0 += 4) {
        const int m0 = F.bx * 128 + F.wave * 16 + i0;
        u32x2 ar[4][4]; f32x4 bs[4][4]; u32x2 bh[4][4];
#pragma unroll
        for (int r = 0; r < 4; ++r)
#pragma unroll
            for (int j = 0; j < 4; ++j) { ar[r][j] = ((const u32x2*)(A + (size_t)(m0 + r) * DM))[F.lane + 64 * j];
                if constexpr (BASE16) bh[r][j] = ((const u32x2*)((const bf16_t*)base + (size_t)(m0 + r) * DM))[F.lane + 64 * j];
                else bs[r][j] = ((const f32x4*)((const float*)base + (size_t)(m0 + r) * DM))[F.lane + 64 * j]; }
#pragma unroll
        for (int r = 0; r < 4; ++r) {
            const int m = m0 + r;
            f32x4 a[4];
#pragma unroll
            for (int j = 0; j < 4; ++j) a[j] = (f32x4){bflo(ar[r][j].x), bfhi(ar[r][j].x), bflo(ar[r][j].y), bfhi(ar[r][j].y)};
            const float rs = row_rstd(a);
            f32x4 h[4];
            u32x2* h8 = (u32x2*)(H + (size_t)m * DM) + F.lane;
#pragma unroll
            for (int j = 0; j < 4; ++j) { const f32x4 gg = g1v[j];
                f32x4 b; if constexpr (BASE16) b = (f32x4){bflo(bh[r][j].x), bfhi(bh[r][j].x), bflo(bh[r][j].y), bfhi(bh[r][j].y)}; else b = bs[r][j];
                h[j] = b + a[j] * rs * gg; u32x2 w; w.x = pk2(h[j].x, h[j].y); w.y = pk2(h[j].z, h[j].w); h8[64 * j] = w; }
            const float rh = row_rstd(h);
            if constexpr (Q8OUT) {
                f32x4 uu[4];
#pragma unroll
                for (int j = 0; j < 4; ++j) uu[j] = h[j] * rh * g2v[j];
                quant_row_i8(uu, (unsigned char*)U + (size_t)m * DM, as_out + m, F.lane);
            } else {
                u32x2* o8 = (u32x2*)(U + (size_t)m * DM) + F.lane;
#pragma unroll
                for (int j = 0; j < 4; ++j) { const f32x4 gg = g2v[j];
                    u32x2 w; w.x = pk2(h[j].x * rh * gg.x, h[j].y * rh * gg.y); w.y = pk2(h[j].z * rh * gg.z, h[j].w * rh * gg.w); o8[64 * j] = w; }
            }
        }
    }
}

constexpr float HG_US = 4.f;
constexpr int HG_RAWQ = 0, HG_RAWF = 18432, HG_RAWV = 36864;
constexpr int HG_OT = 0;
constexpr int HG_SC = 33792;
constexpr int HG_QD = 55296, HG_KI = 72704;
constexpr int HG_KST = 90112, HG_VT = 108544;
constexpr int HG_DEC = 126976;
typedef short s16x4 __attribute__((ext_vector_type(4)));
__device__ __forceinline__ s16x4 lds_tr16(const LAS unsigned char* p) { return __builtin_bit_cast(s16x4, __builtin_amdgcn_ds_read_tr16_b64_v4i16((LAS s16x4*)p)); }
constexpr int PA_GH = 0, PA_GL = 17408, PA_KH = 34816, PA_QH = 52224, PA_V = 69632;
__device__ __forceinline__ bf16x8 pa_trfrag(const LAS unsigned char* p) {
    const s16x4 lo = lds_tr16(p), hi = lds_tr16(p + 4 * 272);
    return (bf16x8){lo[0], lo[1], lo[2], lo[3], hi[0], hi[1], hi[2], hi[3]};
}
__device__ __forceinline__ void hgrnA_phase(const Frame& F, const Ptrs& P) {
    const int tid = F.tid, lane = F.lane, w = F.wave;
    LAS unsigned char* L = F.lds;
    const int sc0 = tid >> 4, sch = tid & 15;
    const int fr = lane & 15, g = lane >> 4;
    bf16_t* const GQD = (bf16_t*)(P.ws + WS_HGQD); bf16_t* const GOI = (bf16_t*)(P.ws + WS_HGOI); unsigned char* const GU = P.ws + WS_HGU; float* const GDEC = (float*)(P.ws + WS_HGDEC);
    const int NU = NB * 6 * 64;
    bf16x8 tri0, tri16, ones;
#pragma unroll
    for (int j = 0; j < 8; ++j) { tri0[j] = (8 * g + j <= fr) ? (short)0x3F80 : (short)0; tri16[j] = (8 * g + j <= fr + 16) ? (short)0x3F80 : (short)0; ones[j] = (short)0x3F80; }
    const int trl = (8 * g + ((lane & 15) >> 2)) * 272 + (lane & 3) * 8;
    u32x4 rq[2], rf[2], rv[2];
    {
        const int unit = F.bx; const int bh = unit >> 6, n = unit & 63, b = bh / 6, h = bh % 6;
        const bf16_t* PR = (const bf16_t*)(P.ws + WS_R1) + (size_t)(b * SEQ + n * 64) * AW;
#pragma unroll
        for (int i = 0; i < 2; ++i) { const bf16_t* rp = PR + (size_t)(sc0 + 32 * i) * AW + sch * 8;
            rq[i] = *(const u32x4*)(rp + h * 128); rf[i] = *(const u32x4*)(rp + 768 + h * 128); rv[i] = *(const u32x4*)(rp + 1536 + h * 128); }
    }
    for (int unit = F.bx; unit < NU; unit += F.G) {
        const int bh = unit >> 6, h = bh % 6;
        {
            float lb[8];
            { const f32x4 a00 = *(const f32x4*)(P.hlb + h * 128 + 8 * sch), a01 = *(const f32x4*)(P.hlb + h * 128 + 8 * sch + 4), a10 = *(const f32x4*)(P.hlb + HF + h * 128 + 8 * sch), a11 = *(const f32x4*)(P.hlb + HF + h * 128 + 8 * sch + 4);
#pragma unroll
              for (int e = 0; e < 4; ++e) { lb[e] = frcp(1.0f + fexp2(1.4426950408889634f * (a10[e] - a00[e]))); lb[4 + e] = frcp(1.0f + fexp2(1.4426950408889634f * (a11[e] - a01[e]))); } }
#pragma unroll
            for (int i = 0; i < 2; ++i) {
                const unsigned fw[4] = {rf[i].x, rf[i].y, rf[i].z, rf[i].w}, qw[4] = {rq[i].x, rq[i].y, rq[i].z, rq[i].w};
                unsigned gh[4], gl[4], kh[4], qh[4];
#pragma unroll
                for (int e2 = 0; e2 < 4; ++e2) {
                    float gg[2], kk[2], qq[2];
#pragma unroll
                    for (int o = 0; o < 2; ++o) {
                        const float fl = o ? bfhi(fw[e2]) : bflo(fw[e2]), ql = o ? bfhi(qw[e2]) : bflo(qw[e2]);
                        const float sg = sigmoidf_(fl); const float lbk = lb[2 * e2 + o];
                        gg[o] = flog2(lbk + (1.0f - lbk) * sg); kk[o] = (1.0f - lbk) * (1.0f - sg); qq[o] = ql * sigmoidf_(ql);
                    }
                    gh[e2] = pk2(gg[0], gg[1]);
                    gl[e2] = pk2(gg[0] - bflo(gh[e2]), gg[1] - bfhi(gh[e2]));
                    kh[e2] = pk2(kk[0], kk[1]); qh[e2] = pk2(qq[0], qq[1]);
                }
                const int off = (sc0 + 32 * i) * 272 + sch * 16;
                *(LAS u32x4*)(L + PA_GH + off) = (u32x4){gh[0], gh[1], gh[2], gh[3]}; *(LAS u32x4*)(L + PA_GL + off) = (u32x4){gl[0], gl[1], gl[2], gl[3]};
                *(LAS u32x4*)(L + PA_KH + off) = (u32x4){kh[0], kh[1], kh[2], kh[3]}; *(LAS u32x4*)(L + PA_QH + off) = (u32x4){qh[0], qh[1], qh[2], qh[3]};
                *(LAS u32x4*)(L + PA_V + off) = rv[i];
            }
        }
        LDS_BARRIER();
        if (unit + F.G < NU) {
            const int u2 = unit + F.G; const int bh2 = u2 >> 6, n2 = u2 & 63, b2 = bh2 / 6, h2 = bh2 % 6;
            const bf16_t* PR = (const bf16_t*)(P.ws + WS_R1) + (size_t)(b2 * SEQ + n2 * 64) * AW;
#pragma unroll
            for (int i = 0; i < 2; ++i) { const bf16_t* rp = PR + (size_t)(sc0 + 32 * i) * AW + sch * 8;
                rq[i] = *(const u32x4*)(rp + h2 * 128); rf[i] = *(const u32x4*)(rp + 768 + h2 * 128); rv[i] = *(const u32x4*)(rp + 1536 + h2 * 128); }
        }
        f32x4 bc[4];
        {
            bf16x8 gfh[2], gfl[2];
#pragma unroll
            for (int ks = 0; ks < 2; ++ks) { gfh[ks] = pa_trfrag(L + PA_GH + (32 * ks) * 272 + (16 * w) * 2 + trl); gfl[ks] = pa_trfrag(L + PA_GL + (32 * ks) * 272 + (16 * w) * 2 + trl); }
#pragma unroll
            for (int ct = 0; ct < 4; ++ct) bc[ct] = (f32x4){0.f, 0.f, 0.f, 0.f};
            bc[0] = __builtin_amdgcn_mfma_f32_16x16x32_bf16(gfh[0], tri0, bc[0], 0, 0, 0);  bc[0] = __builtin_amdgcn_mfma_f32_16x16x32_bf16(gfl[0], tri0, bc[0], 0, 0, 0);
            bc[1] = __builtin_amdgcn_mfma_f32_16x16x32_bf16(gfh[0], tri16, bc[1], 0, 0, 0); bc[1] = __builtin_amdgcn_mfma_f32_16x16x32_bf16(gfl[0], tri16, bc[1], 0, 0, 0);
            bc[2] = __builtin_amdgcn_mfma_f32_16x16x32_bf16(gfh[0], ones, bc[2], 0, 0, 0);  bc[2] = __builtin_amdgcn_mfma_f32_16x16x32_bf16(gfl[0], ones, bc[2], 0, 0, 0);
            bc[2] = __builtin_amdgcn_mfma_f32_16x16x32_bf16(gfh[1], tri0, bc[2], 0, 0, 0);  bc[2] = __builtin_amdgcn_mfma_f32_16x16x32_bf16(gfl[1], tri0, bc[2], 0, 0, 0);
            bc[3] = __builtin_amdgcn_mfma_f32_16x16x32_bf16(gfh[0], ones, bc[3], 0, 0, 0);  bc[3] = __builtin_amdgcn_mfma_f32_16x16x32_bf16(gfl[0], ones, bc[3], 0, 0, 0);
            bc[3] = __builtin_amdgcn_mfma_f32_16x16x32_bf16(gfh[1], tri16, bc[3], 0, 0, 0); bc[3] = __builtin_amdgcn_mfma_f32_16x16x32_bf16(gfl[1], tri16, bc[3], 0, 0, 0);
        }
        {
            f32x4 dec;
#pragma unroll
            for (int r = 0; r < 4; ++r) dec[r] = fexp2(__shfl(bc[3][r], (lane & 48) | 15));
            if (fr == 0) *(f32x4*)(GDEC + (size_t)unit * 128 + 16 * w + 4 * g) = dec;
#pragma unroll
            for (int ct = 0; ct < 4; ++ct) {
                const int off = (16 * ct + fr) * 272 + (16 * w + 4 * g) * 2;
                const u32x2 qh = *(const LAS u32x2*)(L + PA_QH + off), kh = *(const LAS u32x2*)(L + PA_KH + off);
                const float qv[4] = {bflo(qh.x), bfhi(qh.x), bflo(qh.y), bfhi(qh.y)}, kv[4] = {bflo(kh.x), bfhi(kh.x), bflo(kh.y), bfhi(kh.y)};
                float qd[4], ki[4], ks[4];
#pragma unroll
                for (int r = 0; r < 4; ++r) { const float e1 = fexp2(bc[ct][r]), e2 = fexp2(-bc[ct][r]); qd[r] = qv[r] * e1; ki[r] = kv[r] * e2; ks[r] = ki[r] * dec[r]; }
                *(LAS u32x2*)(L + PA_QH + off) = (u32x2){pk2(qd[0], qd[1]), pk2(qd[2], qd[3])};
                *(LAS u32x2*)(L + PA_KH + off) = (u32x2){pk2(ki[0], ki[1]), pk2(ki[2], ki[3])};
                *(LAS u32x2*)(L + PA_GH + off) = (u32x2){pk2(ks[0], ks[1]), pk2(ks[2], ks[3])};
            }
        }
        LDS_BARRIER();
#pragma unroll
        for (int i = 0; i < 2; ++i) { const int c = sc0 + 32 * i; *(u32x4*)(GQD + ((size_t)unit * 64 + c) * 128 + sch * 8) = *(const LAS u32x4*)(L + PA_QH + c * 272 + sch * 16); }
        {
            const int ci = w >> 1;
#pragma unroll
            for (int q = 0; q < 2; ++q) { const int si = 2 * (w & 1) + q;
                if (si <= ci) {
                    f32x4 d = (f32x4){0.f, 0.f, 0.f, 0.f};
#pragma unroll
                    for (int ks = 0; ks < 4; ++ks) {
                        const bf16x8 a = *(const LAS bf16x8*)(L + PA_KH + (16 * si + fr) * 272 + ks * 64 + g * 16);
                        const bf16x8 bb = *(const LAS bf16x8*)(L + PA_QH + (16 * ci + fr) * 272 + ks * 64 + g * 16);
                        d = __builtin_amdgcn_mfma_f32_16x16x32_bf16(a, bb, d, 0, 0, 0);
                    }
                    const int c = 16 * ci + fr, s0 = 16 * si + 4 * g;
#pragma unroll
                    for (int r = 0; r < 4; ++r) if (s0 + r > c) d[r] = 0.f;
                    *(LAS u32x2*)(L + PA_GL + c * 144 + s0 * 2) = (u32x2){pk2(d[0], d[1]), pk2(d[2], d[3])};
                } else {
                    const int c = 16 * ci + fr, s0 = 16 * si + 4 * g;
                    *(LAS u32x2*)(L + PA_GL + c * 144 + s0 * 2) = (u32x2){0u, 0u};
                }
            }
        }
        LDS_BARRIER();
        {
            const int j0 = 16 * w;
            bf16x8 vfrag[2];
#pragma unroll
            for (int ks = 0; ks < 2; ++ks) vfrag[ks] = pa_trfrag(L + PA_V + (32 * ks) * 272 + j0 * 2 + trl);
#pragma unroll
            for (int ct = 0; ct < 4; ++ct) {
                f32x4 o = (f32x4){0.f, 0.f, 0.f, 0.f};
#pragma unroll
                for (int ks = 0; ks < 2; ++ks) if (32 * ks <= 16 * ct + 15) {
                    const bf16x8 sc = *(const LAS bf16x8*)(L + PA_GL + (16 * ct + fr) * 144 + ks * 64 + g * 16);
                    o = __builtin_amdgcn_mfma_f32_16x16x32_bf16(vfrag[ks], sc, o, 0, 0, 0);
                }
                *(u32x2*)(GOI + ((size_t)unit * 64 + 16 * ct + fr) * 128 + j0 + 4 * g) = (u32x2){pk2(o[0], o[1]), pk2(o[2], o[3])};
            }
            unsigned uw[8];
#pragma unroll
            for (int kt = 0; kt < 8; ++kt) {
                f32x4 acc = (f32x4){0.f, 0.f, 0.f, 0.f};
#pragma unroll
                for (int cs = 0; cs < 2; ++cs) {
                    const bf16x8 a = pa_trfrag(L + PA_GH + (32 * cs) * 272 + (16 * kt) * 2 + trl);
                    acc = __builtin_amdgcn_mfma_f32_16x16x32_bf16(a, vfrag[cs], acc, 0, 0, 0);
                }
                uw[kt] = pk4_fp8s(acc[0] * HG_US, acc[1] * HG_US, acc[2] * HG_US, acc[3] * HG_US);
            }
            u32x4* up = (u32x4*)(GU + (((size_t)unit * 8 + w) * 64 + lane) * 32);
#pragma unroll
            for (int q = 0; q < 2; ++q) up[q] = (u32x4){uw[4 * q], uw[4 * q + 1], uw[4 * q + 2], uw[4 * q + 3]};
        }
        LDS_BARRIER();
    }
}

constexpr int HC_QD = 0;
constexpr int HC_DEC = 26112;
constexpr int HC_OT = 27648;
constexpr int HC_NG = 44544;
struct HcSet { u32x4 qp; float dp; u32x4 ur[2], oi, og; };
struct HcCtx { __amdgpu_buffer_rsrc_t rQD, rOI, rU, rDEC, rPR; bf16_t* MIX; unsigned vQD, vOI, vU, vDEC, vPR; int bh, b, h, r0, sc0, sch, c5, sub, fr, g, j0, tid, lane, w; };
__device__ __forceinline__ void abl16(u32x4& d, unsigned voff, __amdgpu_buffer_rsrc_t r, unsigned soff) { asm volatile("buffer_load_dwordx4 %0, %1, %2, %3 offen" : "=v"(d) : "v"(voff), "s"(r), "s"(soff) : "memory"); }
__device__ __forceinline__ void abl4(float& d, unsigned voff, __amdgpu_buffer_rsrc_t r, unsigned soff) { asm volatile("buffer_load_dword %0, %1, %2, %3 offen" : "=v"(d) : "v"(voff), "s"(r), "s"(soff) : "memory"); }
__device__ __forceinline__ void hc_load(const HcCtx& C, HcSet& d, int n) {
    const unsigned unit = (unsigned)(C.bh * 64 + n);
    abl16(d.qp, C.vQD, C.rQD, unit * 16384u);
    if (C.w < 2) abl4(d.dp, C.vDEC, C.rDEC, unit * 512u);
    abl16(d.ur[0], C.vU, C.rU, unit * 16384u); abl16(d.ur[1], C.vU + 16u, C.rU, unit * 16384u);
    abl16(d.oi, C.vOI, C.rOI, unit * 16384u);
    { const unsigned so = (unsigned)((C.b * SEQ + n * 64) * AW * 2); abl16(d.og, C.vPR, C.rPR, so); }
}
#define HC_PIN(d) "+v"((d).qp), "+v"((d).dp), "+v"((d).ur[0]), "+v"((d).ur[1]), "+v"((d).oi), "+v"((d).og)
__device__ __forceinline__ void hc_stage(const HcCtx& C, LAS unsigned char* L, const HcSet& d, int slot) {
    *(LAS u32x4*)(L + HC_QD + slot * 8704 + C.sc0 * 272 + C.sch * 16) = d.qp;
    if (C.w < 2) *(LAS float*)(L + HC_DEC + slot * 512 + C.tid * 4) = d.dp;
}
__device__ __forceinline__ void hc_step(const HcCtx& C, LAS unsigned char* L, f32x4 (&S)[8], int n, HcSet& cur, HcSet& nxt, HcSet& nx2, int slot, int slot_nxt) {
    if (n >= 64) return;
    if (n + 2 < 64) { hc_load(C, nx2, n + 2); asm volatile("s_waitcnt vmcnt(12)" : HC_PIN(cur)); }
    else asm volatile("s_waitcnt vmcnt(0)" : HC_PIN(cur));
    const int fr = C.fr, g = C.g, j0 = C.j0;
    {
        f32x4 o[2];
#pragma unroll
        for (int ct = 0; ct < 2; ++ct) o[ct] = (f32x4){0.f, 0.f, 0.f, 0.f};
#pragma unroll
        for (int ks = 0; ks < 4; ++ks) {
            u32x4 sa; sa.x = pk2(S[2 * ks][0], S[2 * ks][1]); sa.y = pk2(S[2 * ks][2], S[2 * ks][3]); sa.z = pk2(S[2 * ks + 1][0], S[2 * ks + 1][1]); sa.w = pk2(S[2 * ks + 1][2], S[2 * ks + 1][3]);
            const bf16x8 sfrag = __builtin_bit_cast(bf16x8, sa);
#pragma unroll
            for (int ct = 0; ct < 2; ++ct) {
                const u32x2 q0 = *(const LAS u32x2*)(L + HC_QD + slot * 8704 + (16 * ct + fr) * 272 + (32 * ks + 4 * g) * 2);
                const u32x2 q1 = *(const LAS u32x2*)(L + HC_QD + slot * 8704 + (16 * ct + fr) * 272 + (32 * ks + 16 + 4 * g) * 2);
                const bf16x8 qf = __builtin_bit_cast(bf16x8, (u32x4){q0.x, q0.y, q1.x, q1.y});
                o[ct] = __builtin_amdgcn_mfma_f32_16x16x32_bf16(sfrag, qf, o[ct], 0, 0, 0);
            }
        }
#pragma unroll
        for (int ct = 0; ct < 2; ++ct) *(LAS f32x4*)(L + HC_OT + (16 * ct + fr) * 528 + (j0 + 4 * g) * 4) = o[ct];
#pragma unroll
        for (int kt = 0; kt < 8; ++kt) {
            const f32x4 dc = *(const LAS f32x4*)(L + HC_DEC + slot * 512 + (16 * kt + 4 * g) * 4);
            const unsigned uu = (kt & 3) == 0 ? cur.ur[kt >> 2].x : (kt & 3) == 1 ? cur.ur[kt >> 2].y : (kt & 3) == 2 ? cur.ur[kt >> 2].z : cur.ur[kt >> 2].w;
            const f32x2 ulo = __builtin_amdgcn_cvt_pk_f32_fp8((int)uu, false), uhi = __builtin_amdgcn_cvt_pk_f32_fp8((int)uu, true);
            S[kt] = S[kt] * dc + (f32x4){ulo.x, ulo.y, uhi.x, uhi.y} * (1.0f / HG_US);
        }
    }
    LDS_BARRIER();
    {
        f32x4 ov[2]; float ss = 0.f;
        const unsigned oiw[4] = {cur.oi.x, cur.oi.y, cur.oi.z, cur.oi.w};
#pragma unroll
        for (int j = 0; j < 2; ++j) { ov[j] = *(const LAS f32x4*)(L + HC_OT + C.c5 * 528 + (8 * C.sub + 4 * j) * 4);
            ov[j] = ov[j] + (f32x4){bflo(oiw[2 * j]), bfhi(oiw[2 * j]), bflo(oiw[2 * j + 1]), bfhi(oiw[2 * j + 1])};
            ss += (ov[j].x * ov[j].x + ov[j].y * ov[j].y) + (ov[j].z * ov[j].z + ov[j].w * ov[j].w); }
        ss += swz_xor<1>(ss); ss += swz_xor<2>(ss); ss += swz_xor<4>(ss); ss += swz_xor<8>(ss);
        const float rs = frsq(ss * (1.f / 128.f) + RMS_EPS);
        const unsigned ogw[4] = {cur.og.x, cur.og.y, cur.og.z, cur.og.w};
        float r[8]; f32x4 ngv[2];
#pragma unroll
        for (int j = 0; j < 2; ++j) ngv[j] = *(const LAS f32x4*)(L + HC_NG + (8 * C.sub + 4 * j) * 4);
#pragma unroll
        for (int j = 0; j < 2; ++j)
#pragma unroll
            for (int e = 0; e < 4; ++e) { const unsigned wv = ogw[2 * j + (e >> 1)]; const float gg = (e & 1) ? bfhi(wv) : bflo(wv); r[4 * j + e] = ov[j][e] * rs * ngv[j][e] * gg * sigmoidf_(gg); }
        bf16_t* op = C.MIX + (size_t)(n * 64 + C.r0 + C.c5) * DM + C.h * 128 + 8 * C.sub;
        *(u32x4*)op = (u32x4){pk2(r[0], r[1]), pk2(r[2], r[3]), pk2(r[4], r[5]), pk2(r[6], r[7])};
    }
    if (n + 1 < 64) {
        if (n + 2 < 64) asm volatile("s_waitcnt vmcnt(7)" : HC_PIN(nxt)); else asm volatile("s_waitcnt vmcnt(0)" : HC_PIN(nxt));
        hc_stage(C, L, nxt, slot_nxt);
    }
    LDS_BARRIER();
}
__device__ __forceinline__ void hgrn_chain(const Frame& F, const Ptrs& P, int wgi) {
    HcCtx C;
    const int bh = wgi >> 1; const int b = bh / 6; C.bh = bh; C.b = b; C.h = bh % 6; C.r0 = 32 * (wgi & 1);
    C.tid = F.tid; C.lane = F.lane; C.w = F.wave;
    LAS unsigned char* L = F.lds;
    C.MIX = (bf16_t*)(P.ws + WS_MIX) + (size_t)b * SEQ * DM;
    C.rQD = __builtin_amdgcn_make_buffer_rsrc(P.ws + WS_HGQD, 0, 3072 * 16384, 0x00020000);
    C.rOI = __builtin_amdgcn_make_buffer_rsrc(P.ws + WS_HGOI, 0, 3072 * 16384, 0x00020000);
    C.rU = __builtin_amdgcn_make_buffer_rsrc(P.ws + WS_HGU, 0, 3072 * 16384, 0x00020000);
    C.rDEC = __builtin_amdgcn_make_buffer_rsrc(P.ws + WS_HGDEC, 0, 3072 * 512, 0x00020000);
    C.rPR = __builtin_amdgcn_make_buffer_rsrc(P.ws + WS_R1, 0, MTOK * AW * 2, 0x00020000);
    C.sc0 = C.tid >> 4; C.sch = C.tid & 15; C.c5 = C.tid >> 4; C.sub = C.tid & 15;
    C.fr = C.lane & 15; C.g = C.lane >> 4; C.j0 = 16 * C.w;
    C.vQD = (unsigned)(((C.r0 + C.sc0) * 128 + C.sch * 8) * 2); C.vOI = (unsigned)(((C.r0 + C.c5) * 128 + 8 * C.sub) * 2); C.vU = (unsigned)((C.w * 64 + C.lane) * 32); C.vDEC = (unsigned)(C.tid * 4);
    C.vPR = (unsigned)(((C.r0 + C.c5) * AW + 2304 + C.h * 128 + 8 * C.sub) * 2);
    if (C.tid < 128) *(LAS float*)(L + HC_NG + C.tid * 4) = P.hon[C.tid];
    f32x4 S[8];
#pragma unroll
    for (int kt = 0; kt < 8; ++kt) S[kt] = (f32x4){0.f, 0.f, 0.f, 0.f};
    HcSet d0, d1, d2;
    d0.dp = d1.dp = d2.dp = 0.f;
    d0.qp = d1.qp = d2.qp = (u32x4){0u, 0u, 0u, 0u};
    VM_WAIT();
    hc_load(C, d0, 0); hc_load(C, d1, 1);
    asm volatile("s_waitcnt vmcnt(5)" : HC_PIN(d0));
    hc_stage(C, L, d0, 0);
    LDS_BARRIER();
    for (int n = 0; n < 66; n += 6) {
        hc_step(C, L, S, n, d0, d1, d2, 0, 1);
        hc_step(C, L, S, n + 1, d1, d2, d0, 1, 2);
        hc_step(C, L, S, n + 2, d2, d0, d1, 2, 0);
        hc_step(C, L, S, n + 3, d0, d1, d2, 0, 1);
        hc_step(C, L, S, n + 4, d1, d2, d0, 1, 2);
        hc_step(C, L, S, n + 5, d2, d0, d1, 2, 0);
        asm volatile("s_waitcnt vmcnt(0)" : HC_PIN(d0), HC_PIN(d1), HC_PIN(d2));
    }
    VM_WAIT();
}

constexpr int MA_K = 0;
constexpr int MA_VT = 36864;
constexpr int MA_OB = 70144;
template <bool OUT8>
__device__ __forceinline__ void memattn_unit(const Frame& F, const bf16_t* Q, int qpitch, int qcol, const bf16_t* MKV, int kvcol, bf16_t* MIXo, int unit) {
    const int tb = unit >> 2, mh = unit & 3, b = tb >> 4;
    const int tid = F.tid, lane = F.lane, w = F.wave, r32 = lane & 31, hi = lane >> 5;
    LAS unsigned char* L = F.lds;
#pragma unroll
    for (int i = 0; i < 4; ++i) { const int p = tid + 512 * i, key = p >> 3, chn = p & 7;
        const bf16_t* src = MKV + (size_t)(b * MEML + key) * DM + kvcol + mh * 64 + chn * 8;
        const u32x4 kk = *(const u32x4*)src; const u32x4 vv = *(const u32x4*)(src + 256);
        *(LAS u32x4*)(L + MA_K + key * 144 + chn * 16) = kk;
        const unsigned vw[4] = {vv.x, vv.y, vv.z, vv.w};
#pragma unroll
        for (int e = 0; e < 4; ++e) { *(LAS unsigned short*)(L + MA_VT + (chn * 8 + 2 * e) * 520 + key * 2) = (unsigned short)(vw[e] & 0xffffu);
            *(LAS unsigned short*)(L + MA_VT + (chn * 8 + 2 * e + 1) * 520 + key * 2) = (unsigned short)(vw[e] >> 16); } }
    const int tok0 = tb * 256 + w * 32;
    bf16x8 qr[4];
#pragma unroll
    for (int s = 0; s < 4; ++s) qr[s] = *(const bf16x8*)(Q + (size_t)(tok0 + r32) * qpitch + qcol + mh * 64 + 16 * s + 8 * hi);
    LDS_BARRIER();
    f32x16 p[8];
#pragma unroll
    for (int kt = 0; kt < 8; ++kt) { p[kt] = f32x16{};
#pragma unroll
        for (int s = 0; s < 4; ++s) { const bf16x8 a = *(const LAS bf16x8*)(L + MA_K + (32 * kt + r32) * 144 + s * 32 + hi * 16);
            p[kt] = __builtin_amdgcn_mfma_f32_32x32x16_bf16(a, qr[s], p[kt], 0, 0, 0); } }
    float mx = -3.0e38f;
#pragma unroll
    for (int kt = 0; kt < 8; ++kt)
#pragma unroll
        for (int r = 0; r < 16; ++r) mx = fmaxf(mx, p[kt][r]);
    mx = fmaxf(mx, __shfl_xor(mx, 32));
    float sum = 0.f;
#pragma unroll
    for (int kt = 0; kt < 8; ++kt)
#pragma unroll
        for (int r = 0; r < 16; ++r) { p[kt][r] = fexp2(p[kt][r] - mx); sum += p[kt][r]; }
    sum += __shfl_xor(sum, 32);
    const float inv = frcp(sum);
    f32x16 o[2]; o[0] = f32x16{}; o[1] = f32x16{};
#pragma unroll
    for (int kt = 0; kt < 8; ++kt)
#pragma unroll
        for (int s2 = 0; s2 < 2; ++s2) {
            u32x4 pw; pw.x = pk2(p[kt][8 * s2 + 0] * inv, p[kt][8 * s2 + 1] * inv); pw.y = pk2(p[kt][8 * s2 + 2] * inv, p[kt][8 * s2 + 3] * inv);
            pw.z = pk2(p[kt][8 * s2 + 4] * inv, p[kt][8 * s2 + 5] * inv); pw.w = pk2(p[kt][8 * s2 + 6] * inv, p[kt][8 * s2 + 7] * inv);
            const bf16x8 pa = __builtin_bit_cast(bf16x8, pw);
#pragma unroll
            for (int dt = 0; dt < 2; ++dt) {
                const u32x2 v0 = *(const LAS u32x2*)(L + MA_VT + (32 * dt + r32) * 520 + (32 * kt + 16 * s2 + 4 * hi) * 2);
                const u32x2 v1 = *(const LAS u32x2*)(L + MA_VT + (32 * dt + r32) * 520 + (32 * kt + 16 * s2 + 8 + 4 * hi) * 2);
                const bf16x8 vb = __builtin_bit_cast(bf16x8, (u32x4){v0.x, v0.y, v1.x, v1.y});
                o[dt] = __builtin_amdgcn_mfma_f32_32x32x16_bf16(pa, vb, o[dt], 0, 0, 0);
            }
        }
#pragma unroll
    for (int dt = 0; dt < 2; ++dt)
#pragma unroll
        for (int r = 0; r < 16; ++r) {
            if constexpr (!OUT8) MIXo[(size_t)(tok0 + crow(r, hi)) * DM + 768 + mh * 64 + 32 * dt + r32] = (bf16_t)f2bf(o[dt][r]); }
    if constexpr (OUT8) {
        LAS unsigned char* ob = L + MA_OB + w * 1024;
#pragma unroll
        for (int dt = 0; dt < 2; ++dt) {
#pragma unroll
            for (int r = 0; r < 16; ++r) ob[crow(r, hi) * 32 + r32] = fp8_1(o[dt][r] * FP8_SM);
            LDS_WAIT(); asm volatile("" ::: "memory");
            const u32x4 ov = *(const LAS u32x4*)(ob + (lane >> 1) * 32 + (lane & 1) * 16);
            *(u32x4*)((unsigned char*)MIXo + (size_t)(tok0 + (lane >> 1)) * DM + 768 + mh * 64 + 32 * dt + 16 * (lane & 1)) = ov;
            LDS_WAIT(); asm volatile("" ::: "memory");
        }
    }
    LDS_BARRIER();
}

constexpr int SB_SLOT = 19456;
constexpr int SB_VOFF = 9216;
constexpr int SB_NSLOT = 6;
constexpr int SB_FLAG = SB_NSLOT * SB_SLOT;
__device__ __forceinline__ int sb_unit_of(int L) { return (L >> 4) * 16 + (15 - (L & 15)); }
__device__ __forceinline__ void sb_prefetch_q(const Frame& F, const bf16_t* KVQ, int unit, bf16x8 (&q)[4]) {
    const int qb = unit & 15, hh = (unit >> 4) % 12, b = unit / 192;
    const int r32 = F.lane & 31, hi = F.lane >> 5;
    const bf16_t* base = KVQ + (size_t)b * SEQ * KVQW;
    const int tq = qb * 256 + F.wave * 32 + r32;
#pragma unroll
    for (int s = 0; s < 4; ++s) q[s] = *(const bf16x8*)(base + (size_t)tq * KVQW + 1536 + hh * 64 + 16 * s + 8 * hi);
}
__device__ __forceinline__ int sb_unit(const Frame& F, const bf16_t* KVQ, bf16_t* MIXo, int unit, const bf16x8 (&qpre)[4], int have_lo, int have_hi) {
    const int qb = unit & 15, hh = (unit >> 4) % 12, b = unit / 192;
    const int tid = F.tid, lane = F.lane, w = F.wave, r32 = lane & 31, hi = lane >> 5;
    LAS unsigned char* L = F.lds;
    const bf16_t* base = KVQ + (size_t)b * SEQ * KVQW;
    const int q0 = qb * 256 + w * 32;
    const int tq = q0 + r32;
    bf16x8 qr[4];
#pragma unroll
    for (int s = 0; s < 4; ++s) qr[s] = qpre[s];
    bf16x8 tri[2], ones;
#pragma unroll
    for (int s2 = 0; s2 < 2; ++s2)
#pragma unroll
        for (int j = 0; j < 8; ++j) { const int k = 16 * s2 + 8 * (j >> 2) + 4 * hi + (j & 3); tri[s2][j] = (k > r32) ? (short)0x3F80 : (short)0; }
#pragma unroll
    for (int j = 0; j < 8; ++j) ones[j] = (short)0x3F80;
    f32x16 o[2]; o[0] = f32x16{}; o[1] = f32x16{};
    float R = 0.f;
    const int skey = tid >> 3, schn = tid & 7;
    const bf16_t* srcb = base + (size_t)skey * KVQW + hh * 64 + schn * 8;
    const int kwr = skey * 144 + schn * 16, vwr = SB_VOFF + skey * 160 + schn * 16;
    const int vlane = SB_VOFF + (4 * hi + ((lane & 15) >> 2)) * 160 + ((lane >> 4) & 1) * 32 + (lane & 3) * 8;
    {
        u32x4 kk[4], vv[4];
#pragma unroll
        for (int i = 0; i < 4; ++i) { const int tt = 4 * qb + i; if (tt < have_lo || tt > have_hi) { const bf16_t* src = srcb + (size_t)(tt * 64) * KVQW; kk[i] = *(const u32x4*)src; vv[i] = *(const u32x4*)(src + 768); } }
#pragma unroll
        for (int i = 0; i < 4; ++i) { const int tt = 4 * qb + i; if (tt < have_lo || tt > have_hi) { const int sl = tt % SB_NSLOT; *(LAS u32x4*)(L + sl * SB_SLOT + kwr) = kk[i]; *(LAS u32x4*)(L + sl * SB_SLOT + vwr) = vv[i]; } }
    }
    LDS_BARRIER();
    const int jd = 4 * qb + (w >> 1);
    int slot = jd % SB_NSLOT;
    int pslot = (4 * qb + SB_NSLOT - 1) % SB_NSLOT;
    bool mydone = false;
    int lo_loaded = (have_lo <= have_hi && have_lo < 4 * qb) ? have_lo : 4 * qb;
    for (int st = 0; ; ++st) {
        const int tpre = 4 * qb - st - 1;
        u32x4 kreg, vreg;
        const bool need_pre = tpre >= 0 && (tpre < have_lo || tpre > have_hi);
        if (need_pre) { const bf16_t* src = srcb + (size_t)(tpre * 64) * KVQW; kreg = *(const u32x4*)src; vreg = *(const u32x4*)(src + 768); }
        const int t = jd - st;
        if (t >= 0 && !mydone) {
            const int k0 = 64 * t;
            const LAS unsigned char* Kb = L + slot * SB_SLOT;
            f32x16 p0 = f32x16{}, p1 = f32x16{};
#pragma unroll
            for (int s = 0; s < 4; ++s) {
                const bf16x8 a0 = *(const LAS bf16x8*)(Kb + r32 * 144 + s * 32 + hi * 16);
                const bf16x8 a1 = *(const LAS bf16x8*)(Kb + (32 + r32) * 144 + s * 32 + hi * 16);
                p0 = __builtin_amdgcn_mfma_f32_32x32x16_bf16(a0, qr[s], p0, 0, 0, 0);
                p1 = __builtin_amdgcn_mfma_f32_32x32x16_bf16(a1, qr[s], p1, 0, 0, 0);
            }
            float l0[16], l1[16];
            float csum = 0.f;
#pragma unroll
            for (int r = 0; r < 16; ++r) {
                const float z0 = fminf(p0[r], 80.f), z1 = fminf(p1[r], 80.f);
                const float sp0 = flog2(1.0f + fexp2(z0)), sp1 = flog2(1.0f + fexp2(z1));
                float a = -sp0, bq = -sp1, lb0 = z0 - sp0, lb1 = z1 - sp1;
                if (st == 0) { const int key0 = k0 + crow(r, hi); if (key0 >= tq) { a = 0.f; lb0 = -INFINITY; } if (key0 + 32 >= tq) { bq = 0.f; lb1 = -INFINITY; } }
                l0[r] = a; l1[r] = bq; p0[r] = lb0; p1[r] = lb1; csum += a + bq;
            }
            csum += __shfl_xor(csum, 32);
            bf16x8 x0[2], x1[2];
#pragma unroll
            for (int s2 = 0; s2 < 2; ++s2) {
                u32x4 t0, t1;
                t0.x = pk2(l0[8 * s2 + 0], l0[8 * s2 + 1]); t0.y = pk2(l0[8 * s2 + 2], l0[8 * s2 + 3]); t0.z = pk2(l0[8 * s2 + 4], l0[8 * s2 + 5]); t0.w = pk2(l0[8 * s2 + 6], l0[8 * s2 + 7]);
                t1.x = pk2(l1[8 * s2 + 0], l1[8 * s2 + 1]); t1.y = pk2(l1[8 * s2 + 2], l1[8 * s2 + 3]); t1.z = pk2(l1[8 * s2 + 4], l1[8 * s2 + 5]); t1.w = pk2(l1[8 * s2 + 6], l1[8 * s2 + 7]);
                x0[s2] = __builtin_bit_cast(bf16x8, t0); x1[s2] = __builtin_bit_cast(bf16x8, t1);
            }
            f32x16 y0, y1;
#pragma unroll
            for (int r = 0; r < 16; ++r) { y0[r] = R; y1[r] = R; }
            y0 = __builtin_amdgcn_mfma_f32_32x32x16_bf16(tri[0], x0[0], y0, 0, 0, 0);
            y0 = __builtin_amdgcn_mfma_f32_32x32x16_bf16(tri[1], x0[1], y0, 0, 0, 0);
            y0 = __builtin_amdgcn_mfma_f32_32x32x16_bf16(ones, x1[0], y0, 0, 0, 0);
            y0 = __builtin_amdgcn_mfma_f32_32x32x16_bf16(ones, x1[1], y0, 0, 0, 0);
            y1 = __builtin_amdgcn_mfma_f32_32x32x16_bf16(tri[0], x1[0], y1, 0, 0, 0);
            y1 = __builtin_amdgcn_mfma_f32_32x32x16_bf16(tri[1], x1[1], y1, 0, 0, 0);
#pragma unroll
            for (int r = 0; r < 16; ++r) { p0[r] = fexp2(p0[r] + y0[r]); p1[r] = fexp2(p1[r] + y1[r]); }
            R += csum;
            const LAS unsigned char* Vl = Kb + vlane;
#pragma unroll
            for (int half = 0; half < 2; ++half)
#pragma unroll
                for (int s2 = 0; s2 < 2; ++s2) {
                    u32x4 pw;
                    if (half == 0) { pw.x = pk2(p0[8 * s2 + 0], p0[8 * s2 + 1]); pw.y = pk2(p0[8 * s2 + 2], p0[8 * s2 + 3]); pw.z = pk2(p0[8 * s2 + 4], p0[8 * s2 + 5]); pw.w = pk2(p0[8 * s2 + 6], p0[8 * s2 + 7]); }
                    else { pw.x = pk2(p1[8 * s2 + 0], p1[8 * s2 + 1]); pw.y = pk2(p1[8 * s2 + 2], p1[8 * s2 + 3]); pw.z = pk2(p1[8 * s2 + 4], p1[8 * s2 + 5]); pw.w = pk2(p1[8 * s2 + 6], p1[8 * s2 + 7]); }
                    const bf16x8 pa = __builtin_bit_cast(bf16x8, pw);
#pragma unroll
                    for (int dt = 0; dt < 2; ++dt) {
                        const int kb = 32 * half + 16 * s2;
                        const s16x4 vlo = lds_tr16(Vl + kb * 160 + dt * 64), vhi = lds_tr16(Vl + (kb + 8) * 160 + dt * 64);
                        const bf16x8 vb = (bf16x8){vlo[0], vlo[1], vlo[2], vlo[3], vhi[0], vhi[1], vhi[2], vhi[3]};
                        o[dt] = __builtin_amdgcn_mfma_f32_32x32x16_bf16(pa, vb, o[dt], 0, 0, 0);
                    }
                }
        }
        if (t <= 0 || __all(R <= -150.f) != 0) mydone = true;
        if (lane == 0) *(LAS unsigned*)(L + SB_FLAG + ((st & 1) * 8 + w) * 4) = mydone ? 1u : 0u;
        if (need_pre) { *(LAS u32x4*)(L + pslot * SB_SLOT + kwr) = kreg; *(LAS u32x4*)(L + pslot * SB_SLOT + vwr) = vreg; }
        if (tpre >= 0 && tpre < lo_loaded) lo_loaded = tpre;
        LDS_BARRIER();
        { const u32x4 f0 = *(const LAS u32x4*)(L + SB_FLAG + (st & 1) * 32), f1 = *(const LAS u32x4*)(L + SB_FLAG + (st & 1) * 32 + 16);
          if ((f0.x & f0.y & f0.z & f0.w & f1.x & f1.y & f1.z & f1.w) != 0u) break; }
        slot = (slot == 0) ? SB_NSLOT - 1 : slot - 1;
        pslot = (pslot == 0) ? SB_NSLOT - 1 : pslot - 1;
    }
    LAS unsigned char* ob = L + SB_FLAG + 64 + w * 1024;
#pragma unroll
    for (int dt = 0; dt < 2; ++dt) {
#pragma unroll
        for (int r = 0; r < 16; ++r) ob[crow(r, hi) * 32 + r32] = fp8_1(o[dt][r] * FP8_SM);
        LDS_WAIT(); asm volatile("" ::: "memory");
        const u32x4 ov = *(const LAS u32x4*)(ob + (lane >> 1) * 32 + (lane & 1) * 16);
        *(u32x4*)((unsigned char*)MIXo + (size_t)(b * SEQ + q0 + (lane >> 1)) * DM + hh * 64 + 32 * dt + 16 * (lane & 1)) = ov;
        LDS_WAIT(); asm volatile("" ::: "memory");
    }
    LDS_BARRIER();
    return lo_loaded;
}
__device__ __forceinline__ void sb_phase(const Frame& F, const bf16_t* KVQ, bf16_t* MIXo) {
    bf16x8 qa[4], qb_[4];
    const int L0 = 6 * F.bx;
    sb_prefetch_q(F, KVQ, sb_unit_of(L0), qa);
    int have_lo = 1, have_hi = 0;
    for (int j = 0; j < 6; j += 2) {
        const int Lc = L0 + j;
        sb_prefetch_q(F, KVQ, sb_unit_of(Lc + 1), qb_);
        { const int u = sb_unit_of(Lc); const int lo = sb_unit(F, KVQ, MIXo, u, qa, have_lo, have_hi);
          if (((Lc + 1) >> 4) == (Lc >> 4)) { have_lo = lo; have_hi = lo + SB_NSLOT - 1; } else { have_lo = 1; have_hi = 0; } }
        if (j + 2 < 6) sb_prefetch_q(F, KVQ, sb_unit_of(Lc + 2), qa);
        { const int u = sb_unit_of(Lc + 1); const int lo = sb_unit(F, KVQ, MIXo, u, qb_, have_lo, have_hi);
          if (((Lc + 2) >> 4) == ((Lc + 1) >> 4)) { have_lo = lo; have_hi = lo + SB_NSLOT - 1; } else { have_lo = 1; have_hi = 0; } }
    }
}

struct Args { const float* in[20]; float* out; unsigned char* ws; };

__global__ void __launch_bounds__(NTHR, 2) yoco_fwd(Args args) {
    extern __shared__ __attribute__((aligned(16))) unsigned char lds_raw[];
    Frame F;
    F.lds = (LAS unsigned char*)lds_raw;
    F.tid = threadIdx.x; F.lane = F.tid & 63; F.wave = __builtin_amdgcn_readfirstlane(F.tid >> 6);
    F.G = gridDim.x; F.bx = blockIdx.x;
    Ptrs P;
    P.x = args.in[0]; P.mem = args.in[1]; P.anpre = args.in[2]; P.anpost = args.in[3]; P.fnpre = args.in[4]; P.fnpost = args.in[5];
    P.w_in_a = args.in[6]; P.hlb = args.in[7]; P.hon = args.in[8]; P.w_in_b = args.in[9]; P.kvn = args.in[10]; P.w_kv = args.in[11];
    P.memn = args.in[12]; P.w_mem_kv = args.in[13]; P.w_out = args.in[14]; P.w_gu = args.in[15]; P.w_dn = args.in[16]; P.w_router = args.in[17];
    P.w_egu = args.in[18]; P.w_edn = args.in[19]; P.out = args.out; P.ws = args.ws;
    unsigned char* ws = args.ws;
    unsigned* ctl = (unsigned*)(ws + WS_CTL);
    volatile LAS unsigned* MISC = (volatile LAS unsigned*)(F.lds + MISC_OFF);
    for (int u = F.tid; u < (LDS_BYTES - LDSCTL_OFF) / 4; u += NTHR) ((LAS unsigned*)(F.lds + LDSCTL_OFF))[u] = 0u;
    __syncthreads();
    XcdBarrier bar = xcd_barrier_post(ctl + CW_BAR, MISC + 8);
    {
        if (F.tid == 0) { const unsigned xcc = xb_xcc_id(); const unsigned rk = xb_add((unsigned*)ctl + CW_XRANK + xcc, 1u); MISC[12] = (xcc < 8u && rk < (unsigned)(F.G >> 3) && (F.G & 7) == 0) ? rk * 8u + xcc : 0xffffffffu; }
        __syncthreads();
        if (F.tid == 0 && MISC[12] == 0xffffffffu) __hip_atomic_store((unsigned*)ctl + CW_XRANK + 15, 1u, __ATOMIC_RELAXED, __HIP_MEMORY_SCOPE_AGENT);
    }
#define GRID_BAR() xcd_barrier(bar)

    bf16_t* const U = (bf16_t*)(ws + WS_U);
    bf16_t* const R1 = (bf16_t*)(ws + WS_R1);
    bf16_t* const MIX = (bf16_t*)(ws + WS_MIX);
    bf16_t* const MIXED = (bf16_t*)(ws + WS_MIXED);
    bf16_t* const MKV = (bf16_t*)(ws + WS_MKV);
    bf16_t* const H16 = (bf16_t*)(ws + WS_H16);

    { const Frame Fp = phase_frame(F); p0_prologue(Fp, P); }
    GRID_BAR();
    if (__hip_atomic_load((unsigned*)ctl + CW_XRANK + 15, __ATOMIC_RELAXED, __HIP_MEMORY_SCOPE_AGENT) == 0u) F.bx = (int)MISC[12];
    {
        pg8::Gemm g{U, (const bf16_t*)(ws + WS_WINA), MTOK, AW, DM / 2}; pg8::StaticOrder S; S.init(MTOK, AW, F.G, F.bx);
        S.ext_n = 32; S.ext_pm0 = MTOK / 256; S.ext_pn0 = AW / 256;
        pg8::EpiStoreQ E{R1, AW, (const float*)(ws + WS_AS), (const float*)(ws + WS_WSC) + WSC_INA, MKV, DM, MTOK / 256, AW / 256};
        pg8::gemm_phase<pg8::EpiStoreQ, pg8::StaticOrder, true, true, 2>(F.lds, g, S, E);
    }
    GRID_BAR();
    { const Frame Fp = phase_frame(F); hgrnA_phase(Fp, P); }
    { const Frame Fp = phase_frame(F); for (int u = F.bx; u < 512; u += F.G) memattn_unit<false>(Fp, R1, AW, 3072, MKV, 0, MIX, u); }
    GRID_BAR();
    { const Frame Fp = phase_frame(F); if (F.bx < 96) hgrn_chain(Fp, P, ((((F.bx >> 4) << 3) | (F.bx & 7)) << 1) | ((F.bx >> 3) & 1));
      else convert_weights(Fp, P, (F.bx - 96) * NWAVES + Fp.wave, (F.G - 96) * NWAVES); }
    GRID_BAR();
    {
        pg8::Gemm g{MIX, (const bf16_t*)(ws + WS_WOUT0), MTOK, DM, DM}; pg8::StaticOrder S; S.init(MTOK, DM, F.G, F.bx);
        pg8::EpiStore E{MIXED, DM, 1.f, nullptr, 0, 0, 0};
        pg8::gemm_phase<pg8::EpiStore, pg8::StaticOrder, true, true>(F.lds, g, S, E);
    }
    GRID_BAR();
    { const Frame Fp = phase_frame(F); norm_phase<false, true>(Fp, MIXED, P.x, H16, P.anpost, U, P.fnpre, (float*)(ws + WS_AS + 256 * 1024)); }
#if STOP_AFTER >= 5
    GRID_BAR();
    {
        pg8::Gemm g{U, (const bf16_t*)(ws + WS_WGU), MTOK, 2 * DFF, DM / 2}; pg8::StaticOrder S; S.init(MTOK, 2 * DFF, F.G, F.bx);
        pg8::EpiSwiGLUQ8 E{(unsigned char*)R1, DFF, (const float*)(ws + WS_AS + 256 * 1024), (const float*)(ws + WS_WSC) + WSC_GU};
        pg8::gemm_phase<pg8::EpiSwiGLUQ8, pg8::StaticOrder, true, true, 2>(F.lds, g, S, E);
    }
    GRID_BAR();
    {
        pg8::Gemm g{R1, (const bf16_t*)(ws + WS_WDN), MTOK, DM, DFF / 2}; pg8::StaticOrder S; S.init(MTOK, DM, F.G, F.bx);
        pg8::EpiStore E{MIXED, DM, 1.0f / (FP8_SHD * FP8_SWDD), nullptr, 0, 0, 0};
        pg8::gemm_phase<pg8::EpiStore, pg8::StaticOrder, true, true, 1>(F.lds, g, S, E);
    }
    GRID_BAR();
    { const Frame Fp = phase_frame(F); norm_phase<true, true>(Fp, MIXED, H16, H16, P.fnpost, U, nullptr, (float*)(ws + WS_AS + 512 * 1024)); }
#endif
#if STOP_AFTER >= 8
    GRID_BAR();
    {
        pg8::Gemm g{U, (const bf16_t*)(ws + WS_WKVB), MTOK, KVQW, DM / 2}; pg8::StaticOrder S; S.init(MTOK, KVQW, F.G, F.bx);
        pg8::EpiStoreQ E{R1, KVQW, (const float*)(ws + WS_AS + 512 * 1024), (const float*)(ws + WS_WSC) + WSC_KVB, nullptr, 0, 0, 0};
        pg8::gemm_phase<pg8::EpiStoreQ, pg8::StaticOrder, true, true, 2>(F.lds, g, S, E);
    }
    GRID_BAR();
    {
        { const Frame Fp = phase_frame(F); sb_phase(Fp, R1, MIX); }
        { const Frame Fp = phase_frame(F); for (int u = F.bx; u < 512; u += F.G) memattn_unit<true>(Fp, R1, KVQW, 2304, MKV, 512, MIX, u); }
    }
    GRID_BAR();
    {
        pg8::Gemm g{MIX, (const bf16_t*)(ws + WS_WOUT1), MTOK, DM, DM / 2}; pg8::StaticOrder S; S.init(MTOK, DM, F.G, F.bx);
        pg8::EpiStore E{MIXED, DM, 1.0f / (FP8_SM * FP8_SWO), nullptr, 0, 0, 0};
        pg8::gemm_phase<pg8::EpiStore, pg8::StaticOrder, true, true, 1>(F.lds, g, S, E);
    }
    GRID_BAR();
    {
        const Frame Fq = phase_frame(F);
        LAS unsigned* lcnt = (LAS unsigned*)(F.lds + 32768);
        LAS float* WRt = (LAS float*)(F.lds);
        if (Fq.tid < 8) lcnt[Fq.tid] = 0u;
        for (int idx = Fq.tid; idx < DM * NEXP; idx += NTHR) WRt[(idx & 7) * DM + (idx >> 3)] = P.w_router[idx];
        __syncthreads();
        f32x4 g1v[4], g2v[4];
#pragma unroll
        for (int j = 0; j < 4; ++j) { g1v[j] = ((const f32x4*)(P.anpost + DM))[Fq.lane + 64 * j]; g2v[j] = ((const f32x4*)(P.fnpre + DM))[Fq.lane + 64 * j]; }
        for (int i0 = 0; i0 < 16; i0 += 4) {
          const int m0 = F.bx * 128 + Fq.wave * 16 + i0;
          u32x2 ar[4][4], bs[4][4];
#pragma unroll
          for (int r = 0; r < 4; ++r)
#pragma unroll
            for (int j = 0; j < 4; ++j) { ar[r][j] = ((const u32x2*)(MIXED + (size_t)(m0 + r) * DM))[Fq.lane + 64 * j]; bs[r][j] = ((const u32x2*)(H16 + (size_t)(m0 + r) * DM))[Fq.lane + 64 * j]; }
          f32x4 uu[4][4];
#pragma unroll
          for (int r = 0; r < 4; ++r) {
            const int m = m0 + r;
            f32x4 a[4];
#pragma unroll
            for (int j = 0; j < 4; ++j) a[j] = (f32x4){bflo(ar[r][j].x), bfhi(ar[r][j].x), bflo(ar[r][j].y), bfhi(ar[r][j].y)};
            const float rs = row_rstd(a);
            f32x4 h[4];
#pragma unroll
            for (int j = 0; j < 4; ++j) {
                h[j] = (f32x4){bflo(bs[r][j].x), bfhi(bs[r][j].x), bflo(bs[r][j].y), bfhi(bs[r][j].y)} + a[j] * rs * g1v[j];
                u32x2 hw; hw.x = pk2(h[j].x, h[j].y); hw.y = pk2(h[j].z, h[j].w); ((u32x2*)(H16 + (size_t)m * DM))[Fq.lane + 64 * j] = hw; }
            const float rh = row_rstd(h);
            unsigned* o4 = (unsigned*)((unsigned char*)U + (size_t)m * DM) + Fq.lane;
#pragma unroll
            for (int j = 0; j < 4; ++j) { uu[r][j] = h[j] * rh * g2v[j];
                o4[64 * j] = pk4_fp8s(uu[r][j].x * FP8_SX, uu[r][j].y * FP8_SX, uu[r][j].z * FP8_SX, uu[r][j].w * FP8_SX); }
          }
          float lg[4][8];
#pragma unroll
          for (int r = 0; r < 4; ++r)
#pragma unroll
            for (int e = 0; e < 8; ++e) lg[r][e] = 0.f;
#pragma unroll
          for (int j = 0; j < 4; ++j)
#pragma unroll
            for (int e = 0; e < 8; ++e) { const f32x4 w4 = *(const LAS f32x4*)(WRt + e * DM + 4 * Fq.lane + 256 * j);
#pragma unroll
                for (int r = 0; r < 4; ++r) lg[r][e] += uu[r][j].x * w4.x + uu[r][j].y * w4.y + uu[r][j].z * w4.z + uu[r][j].w * w4.w; }
#pragma unroll
          for (int r = 0; r < 4; ++r) {
            const int m = m0 + r;
#pragma unroll
            for (int e = 0; e < 8; ++e) lg[r][e] = wave_sum(lg[r][e]);
            int i0 = 0; float l0 = lg[r][0];
#pragma unroll
            for (int e = 1; e < 8; ++e) if (lg[r][e] > l0) { l0 = lg[r][e]; i0 = e; }
            int i1 = -1; float l1 = -3.0e38f;
#pragma unroll
            for (int e = 0; e < 8; ++e) if (e != i0 && lg[r][e] > l1) { l1 = lg[r][e]; i1 = e; }
            const float g0 = 1.0f / (1.0f + __expf(l1 - l0));
            if (Fq.lane == 0) {
                const unsigned r0 = __hip_atomic_fetch_add(lcnt + i0, 1u, __ATOMIC_RELAXED, __HIP_MEMORY_SCOPE_WORKGROUP);
                const unsigned r1 = __hip_atomic_fetch_add(lcnt + i1, 1u, __ATOMIC_RELAXED, __HIP_MEMORY_SCOPE_WORKGROUP);
                ((int4*)(ws + WS_META))[m] = make_int4(i0, i1, (int)r0, (int)r1);
                ((float2*)(ws + WS_GATE))[m] = make_float2(g0, 1.0f - g0);
            }
          }
        }
        __syncthreads();
        if (Fq.tid < 8) { const unsigned base = __hip_atomic_fetch_add(ctl + CW_GCNT + Fq.tid, lcnt[Fq.tid], __ATOMIC_RELAXED, __HIP_MEMORY_SCOPE_AGENT); ((unsigned*)(ws + WS_WGB))[F.bx * 8 + Fq.tid] = base; }
    }
#endif
#if STOP_AFTER >= 12
    GRID_BAR();
    int ts[NEXP + 1];
    {
        const Frame Fq = phase_frame(F);
        ts[0] = 0;
#pragma unroll
        for (int e = 0; e < NEXP; ++e) { const unsigned c = __hip_atomic_load(ctl + CW_GCNT + e, __ATOMIC_RELAXED, __HIP_MEMORY_SCOPE_AGENT); ts[e + 1] = ts[e] + (int)((c + 255u) >> 8); }
        bf16_t* XS = R1;
        for (int i0 = 0; i0 < 16; i0 += 4) {
            const int m0 = F.bx * 128 + Fq.wave * 16 + i0;
            int4 mt[4]; u32x4 v0[4];
#pragma unroll
            for (int r = 0; r < 4; ++r) { mt[r] = ((const int4*)(ws + WS_META))[m0 + r]; v0[r] = *((const u32x4*)((const unsigned char*)U + (size_t)(m0 + r) * DM) + Fq.lane); }
#pragma unroll
            for (int r = 0; r < 4; ++r) {
                int d0 = 0, d1 = 0;
#pragma unroll
                for (int e = 0; e < NEXP; ++e) { if (mt[r].x == e) d0 = ts[e] * 256; if (mt[r].y == e) d1 = ts[e] * 256; }
                d0 += (int)((const unsigned*)(ws + WS_WGB))[F.bx * 8 + mt[r].x] + mt[r].z;
                d1 += (int)((const unsigned*)(ws + WS_WGB))[F.bx * 8 + mt[r].y] + mt[r].w;
                *((u32x4*)((unsigned char*)XS + (size_t)d0 * DM) + Fq.lane) = v0[r]; *((u32x4*)((unsigned char*)XS + (size_t)d1 * DM) + Fq.lane) = v0[r];
                if (Fq.lane == 0) ((int2*)(ws + WS_DEST))[m0 + r] = make_int2(d0, d1);
            }
        }
    }
    GRID_BAR();
    const int nMt = ts[NEXP], RT = nMt > 256 ? nMt - 256 : 0, R_early = 4 * RT, R8 = (R_early + 7) & ~7;
    unsigned* const ecnt = ctl + CW_EARLY;
    {
        pg8::Gemm g{R1, (const bf16_t*)(ws + WS_WEGU), 0, 2 * DFE, DM / 2}; pg8::SignalOrder S; S.init(256, 2 * DFE, F.G, F.bx);
        S.nM = nMt; S.nwg = S.nM * S.nN; S.moe = 1; S.sp_q = 25; S.sp_R8 = ((F.G & 7) == 0 && R8 < F.G) ? R8 : 0; S.cnt = ecnt; S.early_rt = RT;
#pragma unroll
        for (int e = 0; e < NEXP; ++e) S.ts[e] = ts[e];
        pg8::EpiSwiGLU8 E{(unsigned char*)(ws + WS_EH), DFE, 1.0f / (FP8_SX * FP8_SWGU)};
        pg8::gemm_phase<pg8::EpiSwiGLU8, pg8::SignalOrder, true, true, 1>(F.lds, g, S, E);
    }
#pragma unroll 1
    for (int pass = 0; pass < 2; ++pass) {
        pg8::Gemm g{(const bf16_t*)(ws + WS_EH), (const bf16_t*)(ws + WS_WEDN), 0, DM, DFE / 2}; pg8::StaticOrder S; S.init(256, DM, F.G, F.bx);
        S.moe = 1;
#pragma unroll
        for (int e = 0; e < NEXP; ++e) S.ts[e] = ts[e];
        if (pass == 0) {
            S.one_on = 1; S.one_has = (F.bx < R_early) ? 1 : 0; S.one_pm = F.bx >> 2; S.one_pn = F.bx & 3;
            if (S.one_has) {
                if (F.tid == 0) { unsigned sp = 0; while (__hip_atomic_load(ecnt, __ATOMIC_RELAXED, __HIP_MEMORY_SCOPE_AGENT) < (unsigned)(28 * RT) && ++sp < (1u << 22)) __builtin_amdgcn_s_sleep(2);
                    __builtin_amdgcn_fence(__ATOMIC_ACQUIRE, "agent"); }
                __syncthreads();
            }
        } else { S.nM = nMt - RT; S.nwg = S.nM * S.nN; S.pm_off = RT; }
        pg8::EpiStore E{R1 + (size_t)XS_ROWS * DM / 2, DM, 1.0f / (FP8_SH * FP8_SWDN), nullptr, 0, 0, 0};
        pg8::gemm_phase<pg8::EpiStore, pg8::StaticOrder, true, true, 1>(F.lds, g, S, E);
        GRID_BAR();
    }
    {
        const Frame Fq = phase_frame(F);
        f32x4 g1v[4];
#pragma unroll
        for (int j = 0; j < 4; ++j) g1v[j] = ((const f32x4*)(P.fnpost + DM))[Fq.lane + 64 * j];
        const bf16_t* YS = R1 + (size_t)XS_ROWS * DM / 2;
        for (int i0 = 0; i0 < 16; i0 += 4) {
            const int m0 = F.bx * 128 + Fq.wave * 16 + i0;
            int2 d[4]; float2 gt[4];
#pragma unroll
            for (int r = 0; r < 4; ++r) { d[r] = ((const int2*)(ws + WS_DEST))[m0 + r]; gt[r] = ((const float2*)(ws + WS_GATE))[m0 + r]; }
            u32x2 ya[4][4], yb[4][4], bs[4][4];
#pragma unroll
            for (int r = 0; r < 4; ++r)
#pragma unroll
                for (int j = 0; j < 4; ++j) { ya[r][j] = ((const u32x2*)(YS + (size_t)d[r].x * DM))[Fq.lane + 64 * j]; yb[r][j] = ((const u32x2*)(YS + (size_t)d[r].y * DM))[Fq.lane + 64 * j];
                    bs[r][j] = ((const u32x2*)(H16 + (size_t)(m0 + r) * DM))[Fq.lane + 64 * j]; }
#pragma unroll
            for (int r = 0; r < 4; ++r) {
                f32x4 a[4];
#pragma unroll
                for (int j = 0; j < 4; ++j) a[j] = (f32x4){bflo(ya[r][j].x), bfhi(ya[r][j].x), bflo(ya[r][j].y), bfhi(ya[r][j].y)} * gt[r].x + (f32x4){bflo(yb[r][j].x), bfhi(yb[r][j].x), bflo(yb[r][j].y), bfhi(yb[r][j].y)} * gt[r].y;
                const float rs = row_rstd(a);
#pragma unroll
                for (int j = 0; j < 4; ++j) { const f32x4 gg = g1v[j];
                    ((f32x4*)(P.out + (size_t)(m0 + r) * DM))[Fq.lane + 64 * j] = (f32x4){bflo(bs[r][j].x), bfhi(bs[r][j].x), bflo(bs[r][j].y), bfhi(bs[r][j].y)} + a[j] * rs * gg; }
            }
        }
    }
#endif
}

extern "C" void kernel_launch(void* const* d_in, const int* in_sizes, int n_in, void* d_out, int out_size, void* d_ws, size_t ws_size, hipStream_t stream) {
    static int grid = 0;
    if (grid == 0) {
        if (n_in != 20 || out_size != MTOK * DM || ws_size < WS_END) { fprintf(stderr, "kernel_launch: unexpected shapes (n_in %d out %d ws %zu)\n", n_in, out_size, ws_size); grid = -1; return; }
        int dev = 0, cus = 0, per_cu = 0;
        if (hipGetDevice(&dev) != hipSuccess || hipDeviceGetAttribute(&cus, hipDeviceAttributeMultiprocessorCount, dev) != hipSuccess) { grid = -1; return; }
        if (hipFuncSetAttribute((const void*)yoco_fwd, hipFuncAttributeMaxDynamicSharedMemorySize, LDS_BYTES) != hipSuccess) { fprintf(stderr, "kernel_launch: hipFuncSetAttribute failed\n"); grid = -1; return; }
        if (hipOccupancyMaxActiveBlocksPerMultiprocessor(&per_cu, (const void*)yoco_fwd, NTHR, LDS_BYTES) != hipSuccess || per_cu < 1) { fprintf(stderr, "kernel_launch: occupancy query says %d\n", per_cu); }
        (void)hipGetLastError();
        if (cus < 256) { fprintf(stderr, "kernel_launch: need 256 CUs, have %d\n", cus); grid = -1; return; }
        grid = 256;
    }
    if (grid < 0) return;
    if (hipMemsetAsync((char*)d_ws + WS_CTL, 0, CTL_ZERO_BYTES, stream) != hipSuccess) return;
    Args a{};
    for (int i = 0; i < 20; ++i) a.in[i] = (const float*)d_in[i];
    a.out = (float*)d_out; a.ws = (unsigned char*)d_ws;
    hipLaunchKernelGGL(yoco_fwd, dim3(grid), dim3(NTHR), LDS_BYTES, stream, a);
}
```
